# Optimizing an MI355X kernel written in HIP

```python
import jax, jax.numpy as jnp
from jax import lax
import numpy as np


D_MODEL = 1024
BATCH = 8
SEQ = 4096
DEPTH = 4

GROUP_W = D_MODEL // 2
HEAD_DIM = 64
N_HEADS = GROUP_W // HEAD_DIM
D_MIX = 3 * GROUP_W
NORM_EPS = 1e-6
DECAY_LORA = 64
ICL_LORA = 64
RWKV_IN = 3 * GROUP_W + DECAY_LORA + ICL_LORA
GN_EPS = 64e-5
CONV_W = 4
LRU_C = 8.0
Q_LORA = D_MODEL // 4
KV_LORA = D_MODEL // 8
QK_NOPE = 64
QK_ROPE = 32
V_DIM = HEAD_DIM
ROPE_BASE = 10000.0
Q_BLOCK = 128
SPLITS = (RWKV_IN, GROUP_W, GROUP_W, GROUP_W, Q_LORA, KV_LORA, QK_ROPE, GROUP_W)
D_IN = RWKV_IN + GROUP_W + GROUP_W + GROUP_W + Q_LORA + KV_LORA + QK_ROPE + GROUP_W

kernel_name = "hybrid_rwkv7_rglru_mla_heads"


def _split_points(sizes):
    pts, acc = [], 0
    for s in sizes[:-1]:
        acc += s
        pts.append(acc)
    return pts


def rms_norm(x, g, eps=NORM_EPS):
    xf = x.astype(jnp.float32)
    y = xf * lax.rsqrt(jnp.mean(xf * xf, axis=-1, keepdims=True) + eps)
    return (y * g.astype(jnp.float32)).astype(x.dtype)


def token_shift(u):
    return jnp.pad(u[:, :-1], ((0, 0), (1, 0), (0, 0)))


def rwkv7_mix(u, mu, w0, w2, a0, a2, k_k, k_a, r_k, lnx_g, lnx_b):
    B, T, _ = u.shape
    u = u.astype(jnp.float32)
    u = u + mu * (token_shift(u) - u)
    r, k, v, wl, al = jnp.split(u, _split_points((GROUP_W, GROUP_W, GROUP_W, DECAY_LORA, ICL_LORA)), axis=-1)
    log_w = -jax.nn.softplus(-(w0 + jnp.tanh(wl) @ w2)) - 0.5
    decay = jnp.exp(-jnp.exp(log_w))
    a = jax.nn.sigmoid(a0 + al @ a2)
    heads = lambda t: t.reshape(B, T, N_HEADS, HEAD_DIM)
    kk = heads(k * k_k)
    kk = kk / jnp.maximum(jnp.sqrt(jnp.sum(kk * kk, axis=-1, keepdims=True)), 1e-12)
    k = k * (1.0 + (a - 1.0) * k_a)
    r_h, w_h, k_h, v_h, a_h = heads(r), heads(decay), heads(k), heads(v), heads(a)
    b_h = kk * a_h

    def step(S, inp):
        r_t, w_t, k_t, v_t, kk_t, b_t = inp
        sa = jnp.einsum('bhij,bhj->bhi', S, kk_t)
        S = S * w_t[:, :, None, :] - sa[..., None] * b_t[:, :, None, :] + v_t[..., None] * k_t[:, :, None, :]
        return S, jnp.einsum('bhij,bhj->bhi', S, r_t)

    xs = tuple(jnp.swapaxes(t, 0, 1) for t in (r_h, w_h, k_h, v_h, kk, b_h))
    S0 = jnp.zeros((B, N_HEADS, HEAD_DIM, HEAD_DIM), jnp.float32)
    _, y = lax.scan(step, S0, xs)
    y = jnp.swapaxes(y, 0, 1)
    mean = jnp.mean(y, axis=-1, keepdims=True)
    var = jnp.mean(jnp.square(y - mean), axis=-1, keepdims=True)
    y = ((y - mean) * lax.rsqrt(var + GN_EPS)).reshape(B, T, GROUP_W) * lnx_g + lnx_b
    bonus = jnp.sum(r_h * k_h * r_k, axis=-1, keepdims=True) * v_h
    return y + bonus.reshape(B, T, GROUP_W)


def rglru_mix(u, conv_w, conv_b, ga_w, ga_b, gx_w, gx_b, lam):
    B, T, _ = u.shape
    uf = u.astype(jnp.float32)
    up = jnp.pad(uf, ((0, 0), (CONV_W - 1, 0), (0, 0)))
    xc = conv_b + sum(up[:, j:j + T] * conv_w[j] for j in range(CONV_W))
    xb = xc.reshape(B, T, N_HEADS, HEAD_DIM)
    gate_r = jax.nn.sigmoid(jnp.einsum('bthi,hij->bthj', xb, ga_w).reshape(B, T, GROUP_W) + ga_b)
    gate_i = jax.nn.sigmoid(jnp.einsum('bthi,hij->bthj', xb, gx_w).reshape(B, T, GROUP_W) + gx_b)
    log_a = -LRU_C * gate_r * jax.nn.softplus(-lam)
    a = jnp.exp(log_a)
    bx = jnp.sqrt(-jnp.expm1(2.0 * log_a)) * (gate_i * xc)

    def combine(lhs, rhs):
        a_l, b_l = lhs
        a_r, b_r = rhs
        return a_l * a_r, a_r * b_l + b_r

    _, h = lax.associative_scan(combine, (a, bx), axis=1)
    return h


def apply_rope(x, cos, sin):
    half = x.shape[-1] // 2
    x1, x2 = x[..., :half], x[..., half:]
    return jnp.concatenate([x1 * cos - x2 * sin, x1 * sin + x2 * cos], axis=-1)


def mla_mix(q_lat, kv_lat, k_rope, q_norm_g, w_uq, kv_norm_g, w_ukv, cos, sin):
    B, T, _ = q_lat.shape
    q = (rms_norm(q_lat, q_norm_g) @ w_uq).reshape(B, T, N_HEADS, QK_NOPE + QK_ROPE)
    q_nope, q_rope = q[..., :QK_NOPE], q[..., QK_NOPE:]
    kv = (rms_norm(kv_lat, kv_norm_g) @ w_ukv).reshape(B, T, N_HEADS, QK_NOPE + V_DIM)
    k_nope, v = kv[..., :QK_NOPE], kv[..., QK_NOPE:]
    q_rope = apply_rope(q_rope, cos[:, None, :], sin[:, None, :])
    k_rope = apply_rope(k_rope, cos, sin)
    scale = (QK_NOPE + QK_ROPE) ** -0.5
    nb = T // Q_BLOCK
    qn_b = jnp.swapaxes(q_nope.reshape(B, nb, Q_BLOCK, N_HEADS, QK_NOPE), 0, 1)
    qr_b = jnp.swapaxes(q_rope.reshape(B, nb, Q_BLOCK, N_HEADS, QK_ROPE), 0, 1)
    k_pos = jnp.arange(T)

    def block(args):
        qn, qr, start = args
        s = jnp.einsum('bqhd,bkhd->bhqk', qn, k_nope) + jnp.einsum('bqhr,bkr->bhqk', qr, k_rope)
        s = s.astype(jnp.float32) * scale
        q_pos = start + jnp.arange(Q_BLOCK)
        s = jnp.where(k_pos[None, :] <= q_pos[:, None], s, -jnp.inf)
        p = jax.nn.softmax(s, axis=-1).astype(v.dtype)
        return jnp.einsum('bhqk,bkhd->bqhd', p, v)

    o = lax.map(block, (qn_b, qr_b, jnp.arange(nb) * Q_BLOCK))
    return jnp.swapaxes(o, 0, 1).reshape(B, T, GROUP_W)


def setup_inputs(seed: int = 0) -> dict:
    key = jax.random.key(seed)
    ks = jax.random.split(key, 32)
    f32 = jnp.float32
    nrm = lambda k, shape, fan_in: jax.random.normal(k, shape, f32) * (fan_in ** -0.5)
    gain = lambda k, shape: 1.0 + 0.02 * jax.random.normal(k, shape, f32)
    small = lambda k, shape: 0.01 * jax.random.normal(k, shape, f32)
    u_lam = jax.random.uniform(ks[21], (DEPTH, GROUP_W), f32, 0.9, 0.999)
    a_lam = u_lam ** (1.0 / LRU_C)
    return {
        'x': jax.random.normal(ks[0], (BATCH, SEQ, D_MODEL), f32),
        'ln_g': gain(ks[1], (DEPTH, D_MODEL)),
        'w_in': nrm(ks[2], (DEPTH, D_MODEL, D_IN), D_MODEL),
        'rwkv_mu': jax.random.uniform(ks[3], (DEPTH, RWKV_IN), f32),
        'rwkv_w0': jax.random.uniform(ks[4], (DEPTH, GROUP_W), f32, -6.0, 1.0),
        'rwkv_w2': nrm(ks[5], (DEPTH, DECAY_LORA, GROUP_W), DECAY_LORA),
        'rwkv_a0': 0.1 * jax.random.normal(ks[6], (DEPTH, GROUP_W), f32),
        'rwkv_a2': nrm(ks[7], (DEPTH, ICL_LORA, GROUP_W), ICL_LORA),
        'rwkv_k_k': 0.85 + 0.05 * jax.random.normal(ks[8], (DEPTH, GROUP_W), f32),
        'rwkv_k_a': 1.0 + 0.05 * jax.random.normal(ks[9], (DEPTH, GROUP_W), f32),
        'rwkv_r_k': 0.1 * jax.random.normal(ks[10], (DEPTH, N_HEADS, HEAD_DIM), f32),
        'rwkv_lnx_g': gain(ks[11], (DEPTH, GROUP_W)),
        'rwkv_lnx_b': small(ks[12], (DEPTH, GROUP_W)),
        'lru_conv_w': nrm(ks[13], (DEPTH, CONV_W, GROUP_W), CONV_W),
        'lru_conv_b': small(ks[14], (DEPTH, GROUP_W)),
        'lru_ga_w': nrm(ks[15], (DEPTH, N_HEADS, HEAD_DIM, HEAD_DIM), HEAD_DIM),
        'lru_ga_b': small(ks[16], (DEPTH, GROUP_W)),
        'lru_gx_w': nrm(ks[17], (DEPTH, N_HEADS, HEAD_DIM, HEAD_DIM), HEAD_DIM),
        'lru_gx_b': small(ks[18], (DEPTH, GROUP_W)),
        'lru_lam': jnp.log(a_lam) - jnp.log1p(-a_lam),
        'lru_out_g': gain(ks[19], (DEPTH, GROUP_W)),
        'mla_q_norm_g': gain(ks[20], (DEPTH, Q_LORA)),
        'mla_w_uq': nrm(ks[22], (DEPTH, Q_LORA, N_HEADS * (QK_NOPE + QK_ROPE)), Q_LORA),
        'mla_kv_norm_g': gain(ks[23], (DEPTH, KV_LORA)),
        'mla_w_ukv': nrm(ks[24], (DEPTH, KV_LORA, N_HEADS * (QK_NOPE + V_DIM)), KV_LORA),
        'mla_out_g': gain(ks[25], (DEPTH, GROUP_W)),
        'w_out': nrm(ks[26], (DEPTH, D_MIX, D_MODEL), D_MIX),
        'final_g': gain(ks[27], (D_MODEL,)),
    }


def reference(x, ln_g, w_in, rwkv_mu, rwkv_w0, rwkv_w2, rwkv_a0, rwkv_a2, rwkv_k_k, rwkv_k_a, rwkv_r_k,
              rwkv_lnx_g, rwkv_lnx_b, lru_conv_w, lru_conv_b, lru_ga_w, lru_ga_b, lru_gx_w, lru_gx_b, lru_lam,
              lru_out_g, mla_q_norm_g, mla_w_uq, mla_kv_norm_g, mla_w_ukv, mla_out_g, w_out, final_g):
    T = x.shape[1]
    half = QK_ROPE // 2
    inv_freq = ROPE_BASE ** (-jnp.arange(half, dtype=jnp.float32) * 2.0 / QK_ROPE)
    ang = jnp.arange(T, dtype=jnp.float32)[:, None] * inv_freq[None, :]
    cos, sin = jnp.cos(ang), jnp.sin(ang)
    pts = _split_points(SPLITS)
    h = x
    for l in range(DEPTH):
        xn = rms_norm(h, ln_g[l])
        proj = xn @ w_in[l]
        u_a, z_a, u_b, z_b, q_lat, kv_lat, k_rope, z_c = jnp.split(proj, pts, axis=-1)
        y_a = rwkv7_mix(u_a, rwkv_mu[l], rwkv_w0[l], rwkv_w2[l], rwkv_a0[l], rwkv_a2[l], rwkv_k_k[l],
                        rwkv_k_a[l], rwkv_r_k[l], rwkv_lnx_g[l], rwkv_lnx_b[l]).astype(h.dtype)
        y_b = rms_norm(rglru_mix(u_b, lru_conv_w[l], lru_conv_b[l], lru_ga_w[l], lru_ga_b[l], lru_gx_w[l],
                                 lru_gx_b[l], lru_lam[l]), lru_out_g[l]).astype(h.dtype)
        y_c = rms_norm(mla_mix(q_lat, kv_lat, k_rope, mla_q_norm_g[l], mla_w_uq[l], mla_kv_norm_g[l],
                               mla_w_ukv[l], cos, sin), mla_out_g[l]).astype(h.dtype)
        y = jnp.concatenate([y_a * jax.nn.silu(z_a), y_b * jax.nn.silu(z_b), y_c * jax.nn.silu(z_c)], axis=-1)
        h = h + y @ w_out[l]
    return rms_norm(h, final_g)
```

```cpp
#include <hip/hip_runtime.h>
#include <stdint.h>
#include <cstdio>
#include <cstring>

constexpr int DM = 1024, NB = 8, SEQ = 4096, DEPTH = 4, MTOK = NB * SEQ;
constexpr int GW = 512, HD = 64, NH = 8, DMIX = 1536, DIN = 4128;
constexpr int QL = 256, KVL = 128;
constexpr int C_R = 0, C_K = 512, C_V = 1024, C_WL = 1536, C_AL = 1600, C_UB = 1664, C_QL = 2176, C_KVL = 2432, C_KR = 2560,
              C_ZA = 2592, C_ZB = 3104, C_ZC = 3616;
__device__ __forceinline__ int orig_col(int c) {
    if (c < 1664) return c;
    if (c < 2176) return c - 1664 + 2176;
    if (c < 2432) return c - 2176 + 3200;
    if (c < 2560) return c - 2432 + 3456;
    if (c < 2592) return c - 2560 + 3584;
    if (c < 3104) return c - 2592 + 1664;
    if (c < 3616) return c - 3104 + 2688;
    return c;
}
constexpr size_t MiB = 1u << 20;
constexpr size_t WS_CTL = 0, CTL_BYTES = 65536;
constexpr size_t WS_ROPE = 1 * MiB;
constexpr size_t WS_RSTD = 2 * MiB;
constexpr size_t WS_PROJ = 16 * MiB;
constexpr size_t WS_XN = 280 * MiB;
constexpr size_t WS_OATT = 280 * MiB;
constexpr size_t WS_OLRU = 312 * MiB;
constexpr size_t WS_KN = 344 * MiB;
constexpr size_t WS_KR = 376 * MiB;
constexpr size_t WS_V = 378 * MiB;
constexpr size_t WS_Q = 410 * MiB;
constexpr size_t WS_END = 458 * MiB;
constexpr int CW_QUEUE = 8192;

typedef unsigned short bf16_t;
__device__ __forceinline__ float bf2f(bf16_t v) { return __builtin_bit_cast(float, (unsigned)v << 16); }
__device__ __forceinline__ bf16_t f2bf(float f) { unsigned u = __builtin_bit_cast(unsigned, f); return (bf16_t)((u + 0x7fffu + ((u >> 16) & 1u)) >> 16); }
__device__ __forceinline__ float wave_sum(float v) {
#pragma unroll
    for (int o = 32; o >= 1; o >>= 1) v += __shfl_xor(v, o);
    return v;
}
__device__ __forceinline__ float sigmoidf_(float x) { return 1.0f / (1.0f + expf(-x)); }
__device__ __forceinline__ float softplusf_(float x) { return x > 20.f ? x : log1pf(expf(x)); }
__device__ __forceinline__ float siluf_(float x) { return x / (1.0f + expf(-x)); }

#define XB_TMO      128
#define XB_XCNT(j)  (256  + 64 * (j))
#define XB_XSUB(j)  (1280 + 64 * (j))
#define XB_XGEN(j)  (2304 + 64 * (j))
#define XB_TOP      3328
#define XB_TOPGEN   3392
#define XCD_BAR_WORDS 3456
#define XB_SPIN_CAP (1u << 24)
#define LAS __attribute__((address_space(3)))

__device__ __forceinline__ unsigned xb_ld(unsigned* p)              { return __hip_atomic_load(p, __ATOMIC_RELAXED, __HIP_MEMORY_SCOPE_AGENT); }
__device__ __forceinline__ unsigned xb_add(unsigned* p, unsigned v) { return __hip_atomic_fetch_add(p, v, __ATOMIC_RELAXED, __HIP_MEMORY_SCOPE_AGENT); }
__device__ __forceinline__ unsigned xb_xcc_id() { return (unsigned)__builtin_amdgcn_s_getreg((3 << 11) | 20) & 0xFu; }
#define XB_SPIN(cond, bar) do { unsigned _sp = 0; while (cond) { __builtin_amdgcn_s_sleep(1); \
    if ((++_sp & 255u) == 0u) { if (xb_ld(&(bar)[XB_TMO])) break; if (_sp > XB_SPIN_CAP) { atomicAdd(&(bar)[XB_TMO], 1u); break; } } } } while (0)

struct XcdBarrier { unsigned* bar; unsigned x; volatile LAS unsigned* st; };

__device__ __forceinline__ XcdBarrier xcd_barrier_post(unsigned* bar, volatile LAS unsigned* st) {
    XcdBarrier b; b.bar = bar; b.x = xb_xcc_id(); b.st = st;
    if (threadIdx.x == 0) (void)xb_add(&bar[XB_XCNT(b.x)], 1u);
    return b;
}
__device__ __forceinline__ void xcd_barrier_complete(unsigned* bar, unsigned x, unsigned& nloc, unsigned& nx) {
    const unsigned G = gridDim.x * gridDim.y * gridDim.z;
    unsigned sum, cnt, mine, sp = 0u;
    for (;;) {
        sum = 0u; cnt = 0u; mine = 0u;
#pragma unroll
        for (unsigned j = 0; j < 16; ++j) { const unsigned c = xb_ld(&bar[XB_XCNT(j)]); sum += c; cnt += (c > 0u) ? 1u : 0u; mine = (j == x) ? c : mine; }
        if (sum == G) break;
        __builtin_amdgcn_s_sleep(1);
        if ((++sp & 255u) == 0u) { if (xb_ld(&bar[XB_TMO])) break; if (sp > XB_SPIN_CAP) { atomicAdd(&bar[XB_TMO], 1u); break; } }
    }
    nloc = mine > 0u ? mine : 1u; nx = cnt > 0u ? cnt : 1u;
}
__device__ __forceinline__ void xcd_barrier(const XcdBarrier& b) {
    asm volatile("s_waitcnt vmcnt(0)" ::: "memory");
    __syncthreads();
    if (threadIdx.x == 0) {
        unsigned* bar = b.bar;
        __builtin_amdgcn_s_waitcnt(0);
        unsigned nloc = b.st[0], nx = b.st[1];
        if (nloc == 0u) { xcd_barrier_complete(bar, b.x, nloc, nx); b.st[0] = nloc; b.st[1] = nx; }
        const unsigned old = xb_add(&bar[XB_XSUB(b.x)], 1u);
        const unsigned gen = old / nloc;
        if (old + 1u == (gen + 1u) * nloc) {
            __builtin_amdgcn_fence(__ATOMIC_RELEASE, "agent");
            asm volatile("s_waitcnt vmcnt(0)" ::: "memory");
            const unsigned og = xb_add(&bar[XB_TOP], 1u);
            const unsigned tg = og / nx;
            if (og + 1u == (tg + 1u) * nx) xb_add(&bar[XB_TOPGEN], 1u);
            else XB_SPIN(xb_ld(&bar[XB_TOPGEN]) == tg, bar);
            __builtin_amdgcn_fence(__ATOMIC_ACQUIRE, "agent");
            xb_add(&bar[XB_XGEN(b.x)], 1u);
            asm volatile("s_waitcnt vmcnt(0)" ::: "memory");
        } else {
            XB_SPIN(xb_ld(&bar[XB_XGEN(b.x)]) == gen, bar);
            __builtin_amdgcn_fence(__ATOMIC_ACQUIRE, "agent");
            asm volatile("s_waitcnt vmcnt(0)" ::: "memory");
        }
    }
    __syncthreads();
}

__device__ __forceinline__ int otid() { int t = threadIdx.x; asm volatile("" : "+v"(t)); return t; }

struct Args {
    const float* in[28];
    float* out;
    unsigned char* ws;
};

template <class AL, class BL, class ST>
__device__ __forceinline__ void gemm_naive(int M, int N, int K, const AL& al, const BL& bl, const ST& st, float* lds) {
    float* As = lds;
    float* Bs = lds + 16 * 132;
    const int tid = otid(), ty = tid >> 4, tx = tid & 15;
    const int ntn = (N + 127) / 128, ntiles = (M / 128) * ntn;
    for (int u = blockIdx.x; u < ntiles; u += gridDim.x) {
        const int tm = u / ntn, tn = u % ntn;
        float acc[4][8];
#pragma unroll
        for (int i = 0; i < 4; ++i)
#pragma unroll
            for (int j = 0; j < 8; ++j) acc[i][j] = 0.f;
        for (int k0 = 0; k0 < K; k0 += 16) {
#pragma unroll
            for (int j = 0; j < 4; ++j) { const int idx = tid + j * 512, r = idx >> 4, k = idx & 15; As[k * 132 + r] = al(tm * 128 + r, k0 + k); }
#pragma unroll
            for (int j = 0; j < 4; ++j) { const int idx = tid + j * 512, k = idx >> 7, c = idx & 127; Bs[k * 132 + c] = bl(k0 + k, tn * 128 + c); }
            __syncthreads();
#pragma unroll 2
            for (int k = 0; k < 16; ++k) {
                const float4 a4 = *(const float4*)&As[k * 132 + ty * 4];
                const float4 b0 = *(const float4*)&Bs[k * 132 + tx * 8], b1 = *(const float4*)&Bs[k * 132 + tx * 8 + 4];
                const float av[4] = {a4.x, a4.y, a4.z, a4.w};
                const float bv[8] = {b0.x, b0.y, b0.z, b0.w, b1.x, b1.y, b1.z, b1.w};
#pragma unroll
                for (int i = 0; i < 4; ++i)
#pragma unroll
                    for (int j = 0; j < 8; ++j) acc[i][j] = fmaf(av[i], bv[j], acc[i][j]);
            }
            __syncthreads();
        }
#pragma unroll
        for (int i = 0; i < 4; ++i)
#pragma unroll
            for (int j = 0; j < 8; ++j) st(tm * 128 + ty * 4 + i, tn * 128 + tx * 8 + j, acc[i][j]);
    }
}

__device__ __forceinline__ void rwkv_unit(const Args& A, int l, int b, int h, float* lds) {
    constexpr int TB = 32;
    float* xr = lds;
    float* xk = xr + TB * 64;
    float* xv = xk + TB * 64;
    float* xwl = xv + TB * 64;
    float* xal = xwl + TB * 64;
    float* wd = xal + TB * 64;
    float* kp = wd + TB * 64;
    float* kks = kp + TB * 64;
    float* bbs = kks + TB * 64;
    float* avs = bbs + TB * 64;
    float* ys = avs + TB * 64;
    float* bon = ys + TB * 64;
    bf16_t* PROJ = (bf16_t*)(A.ws + WS_PROJ);
    const float* mu = A.in[3] + (size_t)l * 1664;
    const float* w0 = A.in[4] + (size_t)l * 512;
    const float* w2 = A.in[5] + (size_t)l * 64 * 512;
    const float* a0 = A.in[6] + (size_t)l * 512;
    const float* a2 = A.in[7] + (size_t)l * 64 * 512;
    const float* k_k = A.in[8] + (size_t)l * 512;
    const float* k_a = A.in[9] + (size_t)l * 512;
    const float* r_k = A.in[10] + (size_t)l * 512;
    const float* lng = A.in[11] + (size_t)l * 512;
    const float* lnb = A.in[12] + (size_t)l * 512;
    const int tid = otid(), lane = tid & 63, wv = tid >> 6;
    const int si = tid >> 3, sc = tid & 7;
    float S[8];
#pragma unroll
    for (int j = 0; j < 8; ++j) S[j] = 0.f;
    for (int t0 = 0; t0 < SEQ; t0 += TB) {
        __syncthreads();
        for (int idx = tid; idx < TB * 320; idx += 512) {
            const int tt = idx / 320, cc = idx % 320;
            int col; float* dst;
            if (cc < 64) { col = C_R + h * 64 + cc; dst = xr + tt * 64 + cc; }
            else if (cc < 128) { col = C_K + h * 64 + (cc - 64); dst = xk + tt * 64 + (cc - 64); }
            else if (cc < 192) { col = C_V + h * 64 + (cc - 128); dst = xv + tt * 64 + (cc - 128); }
            else if (cc < 256) { col = C_WL + (cc - 192); dst = xwl + tt * 64 + (cc - 192); }
            else { col = C_AL + (cc - 256); dst = xal + tt * 64 + (cc - 256); }
            const int t = t0 + tt; const size_t row = (size_t)b * SEQ + t;
            const float cur = bf2f(PROJ[row * DIN + col]);
            const float prv = (t > 0) ? bf2f(PROJ[(row - 1) * DIN + col]) : 0.f;
            float u = cur + mu[col] * (prv - cur);
            if (cc >= 192 && cc < 256) u = tanhf(u);
            *dst = u;
        }
        __syncthreads();
        {
            const int j = lane, c = h * 64 + j;
            float ds[4], as[4];
#pragma unroll
            for (int q = 0; q < 4; ++q) { ds[q] = w0[c]; as[q] = a0[c]; }
            for (int i = 0; i < 64; ++i) {
                const float w2v = w2[i * 512 + c], a2v = a2[i * 512 + c];
#pragma unroll
                for (int q = 0; q < 4; ++q) { const int tt = wv + 8 * q; ds[q] = fmaf(xwl[tt * 64 + i], w2v, ds[q]); as[q] = fmaf(xal[tt * 64 + i], a2v, as[q]); }
            }
            const float kkc = k_k[c], kac = k_a[c];
#pragma unroll
            for (int q = 0; q < 4; ++q) {
                const int tt = wv + 8 * q;
                const float lw = -softplusf_(-ds[q]) - 0.5f;
                const float decay = expf(-expf(lw));
                const float av = sigmoidf_(as[q]);
                const float kraw = xk[tt * 64 + j];
                wd[tt * 64 + j] = decay; avs[tt * 64 + j] = av;
                kks[tt * 64 + j] = kraw * kkc;
                kp[tt * 64 + j] = kraw * (1.0f + (av - 1.0f) * kac);
            }
        }
        __syncthreads();
#pragma unroll
        for (int q = 0; q < 4; ++q) {
            const int tt = wv + 8 * q;
            const float kr = kks[tt * 64 + lane];
            const float n2 = wave_sum(kr * kr);
            const float kn = kr / fmaxf(sqrtf(n2), 1e-12f);
            kks[tt * 64 + lane] = kn; bbs[tt * 64 + lane] = kn * avs[tt * 64 + lane];
            const float bs = wave_sum(xr[tt * 64 + lane] * kp[tt * 64 + lane] * r_k[h * 64 + lane]);
            if (lane == 0) bon[tt] = bs;
        }
        __syncthreads();
        for (int tt = 0; tt < TB; ++tt) {
            const float4 k0 = *(const float4*)&kks[tt * 64 + sc * 8], k1 = *(const float4*)&kks[tt * 64 + sc * 8 + 4];
            const float4 w0v = *(const float4*)&wd[tt * 64 + sc * 8], w1v = *(const float4*)&wd[tt * 64 + sc * 8 + 4];
            const float4 b0 = *(const float4*)&bbs[tt * 64 + sc * 8], b1 = *(const float4*)&bbs[tt * 64 + sc * 8 + 4];
            const float4 p0 = *(const float4*)&kp[tt * 64 + sc * 8], p1 = *(const float4*)&kp[tt * 64 + sc * 8 + 4];
            const float4 r0 = *(const float4*)&xr[tt * 64 + sc * 8], r1 = *(const float4*)&xr[tt * 64 + sc * 8 + 4];
            const float kk8[8] = {k0.x, k0.y, k0.z, k0.w, k1.x, k1.y, k1.z, k1.w};
            const float w8[8] = {w0v.x, w0v.y, w0v.z, w0v.w, w1v.x, w1v.y, w1v.z, w1v.w};
            const float b8[8] = {b0.x, b0.y, b0.z, b0.w, b1.x, b1.y, b1.z, b1.w};
            const float p8[8] = {p0.x, p0.y, p0.z, p0.w, p1.x, p1.y, p1.z, p1.w};
            const float r8[8] = {r0.x, r0.y, r0.z, r0.w, r1.x, r1.y, r1.z, r1.w};
            const float vi = xv[tt * 64 + si];
            float sa = 0.f;
#pragma unroll
            for (int j = 0; j < 8; ++j) sa = fmaf(S[j], kk8[j], sa);
            sa += __shfl_xor(sa, 1); sa += __shfl_xor(sa, 2); sa += __shfl_xor(sa, 4);
            float y = 0.f;
#pragma unroll
            for (int j = 0; j < 8; ++j) { S[j] = S[j] * w8[j] - sa * b8[j] + vi * p8[j]; y = fmaf(S[j], r8[j], y); }
            y += __shfl_xor(y, 1); y += __shfl_xor(y, 2); y += __shfl_xor(y, 4);
            if (sc == 0) ys[tt * 64 + si] = y;
        }
        __syncthreads();
#pragma unroll
        for (int q = 0; q < 4; ++q) {
            const int tt = wv + 8 * q; const size_t row = (size_t)b * SEQ + t0 + tt; const int c = h * 64 + lane;
            const float y = ys[tt * 64 + lane];
            const float mean = wave_sum(y) * (1.0f / 64.0f);
            const float d = y - mean;
            const float var = wave_sum(d * d) * (1.0f / 64.0f);
            float o = d * rsqrtf(var + 64e-5f) * lng[c] + lnb[c] + bon[tt] * xv[tt * 64 + lane];
            const float z = bf2f(PROJ[row * DIN + C_ZA + c]);
            PROJ[row * DIN + C_ZA + c] = f2bf(o * siluf_(z));
        }
    }
}

__device__ __forceinline__ void lru_unit(const Args& A, int l, int b, int hh, float* lds) {
    constexpr int TB = 64;
    float* ub = lds;
    float* xc = ub + (TB + 3) * 64;
    float* as_ = xc + TB * 64;
    float* bx = as_ + TB * 64;
    bf16_t* PROJ = (bf16_t*)(A.ws + WS_PROJ);
    bf16_t* OLRU = (bf16_t*)(A.ws + WS_OLRU);
    const float* conv_w = A.in[13] + (size_t)l * 4 * 512;
    const float* conv_b = A.in[14] + (size_t)l * 512;
    const float* ga_w = A.in[15] + ((size_t)l * 8 + hh) * 4096;
    const float* ga_b = A.in[16] + (size_t)l * 512;
    const float* gx_w = A.in[17] + ((size_t)l * 8 + hh) * 4096;
    const float* gx_b = A.in[18] + (size_t)l * 512;
    const float* lam = A.in[19] + (size_t)l * 512;
    const int tid = otid(), lane = tid & 63, wv = tid >> 6;
    float hstate = 0.f;
    for (int t0 = 0; t0 < SEQ; t0 += TB) {
        __syncthreads();
        for (int idx = tid; idx < (TB + 3) * 64; idx += 512) {
            const int tt = idx >> 6, j = idx & 63; const int t = t0 - 3 + tt;
            ub[idx] = (t >= 0) ? bf2f(PROJ[((size_t)b * SEQ + t) * DIN + C_UB + hh * 64 + j]) : 0.f;
        }
        __syncthreads();
        for (int idx = tid; idx < TB * 64; idx += 512) {
            const int tt = idx >> 6, j = idx & 63, c = hh * 64 + j;
            float v = conv_b[c];
#pragma unroll
            for (int q = 0; q < 4; ++q) v = fmaf(ub[(tt + q) * 64 + j], conv_w[q * 512 + c], v);
            xc[idx] = v;
        }
        __syncthreads();
        {
            const int j = lane, c = hh * 64 + j;
            float gr[8], gi[8];
#pragma unroll
            for (int q = 0; q < 8; ++q) { gr[q] = ga_b[c]; gi[q] = gx_b[c]; }
            for (int i = 0; i < 64; ++i) {
                const float gav = ga_w[i * 64 + j], gxv = gx_w[i * 64 + j];
#pragma unroll
                for (int q = 0; q < 8; ++q) { const float x = xc[(wv + 8 * q) * 64 + i]; gr[q] = fmaf(x, gav, gr[q]); gi[q] = fmaf(x, gxv, gi[q]); }
            }
            const float spl = softplusf_(-lam[c]);
#pragma unroll
            for (int q = 0; q < 8; ++q) {
                const int tt = wv + 8 * q;
                const float la = -8.0f * sigmoidf_(gr[q]) * spl;
                as_[tt * 64 + j] = expf(la);
                bx[tt * 64 + j] = sqrtf(-expm1f(2.0f * la)) * (sigmoidf_(gi[q]) * xc[tt * 64 + j]);
            }
        }
        __syncthreads();
        if (tid < 64) {
            for (int tt = 0; tt < TB; ++tt) {
                hstate = fmaf(as_[tt * 64 + tid], hstate, bx[tt * 64 + tid]);
                OLRU[((size_t)b * SEQ + t0 + tt) * 512 + hh * 64 + tid] = f2bf(hstate);
            }
        }
    }
}

__device__ __forceinline__ void attn_unit(const Args& A, int b, int h, int qb, float* lds) {
    float* Qs = lds;
    float* Ks = Qs + 64 * 100;
    float* Vs = Ks + 64 * 100;
    float* Ps = Vs + 64 * 68;
    const bf16_t* Q = (const bf16_t*)(A.ws + WS_Q);
    const bf16_t* KN = (const bf16_t*)(A.ws + WS_KN);
    const bf16_t* KR = (const bf16_t*)(A.ws + WS_KR);
    const bf16_t* V = (const bf16_t*)(A.ws + WS_V);
    bf16_t* OATT = (bf16_t*)(A.ws + WS_OATT);
    const float* rope = (const float*)(A.ws + WS_ROPE);
    const int tid = otid(), r = tid >> 3, s = tid & 7;
    const size_t row0 = (size_t)b * SEQ + (size_t)qb * 64;
    const float scale = 0.10206207261596577f;
    __syncthreads();
    for (int idx = tid; idx < 64 * 96; idx += 512) { const int rr = idx / 96, d = idx % 96; Qs[rr * 100 + d] = bf2f(Q[((row0 + rr) * 8 + h) * 96 + d]); }
    __syncthreads();
    for (int idx = tid; idx < 64 * 16; idx += 512) {
        const int rr = idx >> 4, i = idx & 15; const int t = qb * 64 + rr;
        const float cs = rope[(t * 16 + i) * 2], sn = rope[(t * 16 + i) * 2 + 1];
        const float x1 = Qs[rr * 100 + 64 + i], x2 = Qs[rr * 100 + 80 + i];
        Qs[rr * 100 + 64 + i] = x1 * cs - x2 * sn; Qs[rr * 100 + 80 + i] = x1 * sn + x2 * cs;
    }
    __syncthreads();
    for (int idx = tid; idx < 64 * 96; idx += 512) { const int rr = idx / 96, d = idx % 96; Qs[rr * 100 + d] *= scale; }
    float m = -INFINITY, lsum = 0.f, o[8];
#pragma unroll
    for (int d = 0; d < 8; ++d) o[d] = 0.f;
    const int qpos = qb * 64 + r;
    for (int kt = 0; kt <= qb; ++kt) {
        __syncthreads();
        const size_t krow0 = (size_t)b * SEQ + (size_t)kt * 64;
        for (int idx = tid; idx < 64 * 96; idx += 512) {
            const int kk = idx / 96, d = idx % 96;
            Ks[kk * 100 + d] = (d < 64) ? bf2f(KN[((krow0 + kk) * 8 + h) * 64 + d]) : bf2f(KR[(krow0 + kk) * 32 + (d - 64)]);
        }
        for (int idx = tid; idx < 64 * 64; idx += 512) { const int kk = idx >> 6, d = idx & 63; Vs[kk * 68 + d] = bf2f(V[((krow0 + kk) * 8 + h) * 64 + d]); }
        __syncthreads();
        float sc[8]; float mt = -INFINITY;
#pragma unroll
        for (int k8 = 0; k8 < 8; ++k8) {
            const int key = k8 * 8 + s, kpos = kt * 64 + key;
            float a = 0.f;
#pragma unroll
            for (int d4 = 0; d4 < 24; ++d4) {
                const float4 q4 = *(const float4*)&Qs[r * 100 + d4 * 4], k4 = *(const float4*)&Ks[key * 100 + d4 * 4];
                a = fmaf(q4.x, k4.x, a); a = fmaf(q4.y, k4.y, a); a = fmaf(q4.z, k4.z, a); a = fmaf(q4.w, k4.w, a);
            }
            sc[k8] = (kpos <= qpos) ? a : -INFINITY;
            mt = fmaxf(mt, sc[k8]);
        }
        mt = fmaxf(mt, __shfl_xor(mt, 1)); mt = fmaxf(mt, __shfl_xor(mt, 2)); mt = fmaxf(mt, __shfl_xor(mt, 4));
        const float mn = fmaxf(m, mt), corr = expf(m - mn);
        m = mn;
        float ps = 0.f;
#pragma unroll
        for (int k8 = 0; k8 < 8; ++k8) { const float p = expf(sc[k8] - mn); ps += p; Ps[r * 68 + k8 * 8 + s] = p; }
        lsum = lsum * corr + ps;
        __syncthreads();
#pragma unroll
        for (int d = 0; d < 8; ++d) o[d] *= corr;
        for (int key = 0; key < 64; ++key) {
            const float p = Ps[r * 68 + key];
            const float4 v0 = *(const float4*)&Vs[key * 68 + s * 8], v1 = *(const float4*)&Vs[key * 68 + s * 8 + 4];
            o[0] = fmaf(p, v0.x, o[0]); o[1] = fmaf(p, v0.y, o[1]); o[2] = fmaf(p, v0.z, o[2]); o[3] = fmaf(p, v0.w, o[3]);
            o[4] = fmaf(p, v1.x, o[4]); o[5] = fmaf(p, v1.y, o[5]); o[6] = fmaf(p, v1.z, o[6]); o[7] = fmaf(p, v1.w, o[7]);
        }
    }
    lsum += __shfl_xor(lsum, 1); lsum += __shfl_xor(lsum, 2); lsum += __shfl_xor(lsum, 4);
    const float inv = 1.0f / lsum;
#pragma unroll
    for (int d = 0; d < 8; ++d) OATT[(row0 + r) * 512 + h * 64 + s * 8 + d] = f2bf(o[d] * inv);
}

__global__ void __launch_bounds__(512, 2) fwd_kernel(Args A) {
    extern __shared__ __attribute__((aligned(16))) unsigned char smem[];
    float* lds = (float*)smem;
    volatile LAS unsigned* xbw = (volatile LAS unsigned*)(smem + 147456 - 16);
    unsigned* ctl = (unsigned*)(A.ws + WS_CTL);
    const int tid = threadIdx.x, lane = tid & 63, wv = tid >> 6;
    if (tid == 0) { xbw[0] = 0u; xbw[1] = 0u; xbw[2] = 0u; xbw[3] = 0u; }
    __syncthreads();
    XcdBarrier bar = xcd_barrier_post(ctl, xbw);
    LAS int* s_unit = (LAS int*)(smem + 147456 - 32);

    bf16_t* PROJ = (bf16_t*)(A.ws + WS_PROJ);
    bf16_t* XN = (bf16_t*)(A.ws + WS_XN);
    float* RSTD = (float*)(A.ws + WS_RSTD);
    float* rope = (float*)(A.ws + WS_ROPE);
    const int nwaves = gridDim.x * 8, gw = blockIdx.x * 8 + wv;

    for (int idx = blockIdx.x * 512 + tid; idx < SEQ * 16; idx += gridDim.x * 512) {
        const int t = idx >> 4, i = idx & 15;
        const float inv = powf(10000.0f, -((float)i * 2.0f / 32.0f));
        const float ang = (float)t * inv;
        const double twopi = 6.283185307179586476925286766559;
        double rr = (double)ang; rr -= twopi * floor(rr / twopi + 0.5);
        const double r2 = rr * rr; double ts = rr, ss = rr, tc = 1.0, cc = 1.0;
        for (int n = 1; n <= 13; ++n) { ts *= -r2 / (double)((2 * n) * (2 * n + 1)); ss += ts; tc *= -r2 / (double)((2 * n - 1) * (2 * n)); cc += tc; }
        rope[idx * 2] = (float)cc; rope[idx * 2 + 1] = (float)ss;
    }

    for (int l = 0; l < DEPTH; ++l) {
        const float* hsrc = (l == 0) ? A.in[0] : A.out;
        {
            const float* g = A.in[1] + (size_t)l * DM;
            for (int row = gw; row < MTOK; row += nwaves) {
                float4 v[4]; float ss = 0.f;
#pragma unroll
                for (int q = 0; q < 4; ++q) { v[q] = *(const float4*)&hsrc[(size_t)row * DM + q * 256 + lane * 4]; ss += v[q].x * v[q].x + v[q].y * v[q].y + v[q].z * v[q].z + v[q].w * v[q].w; }
                ss = wave_sum(ss);
                const float rs = rsqrtf(ss * (1.0f / DM) + 1e-6f);
#pragma unroll
                for (int q = 0; q < 4; ++q) {
                    const float4 gg = *(const float4*)&g[q * 256 + lane * 4];
                    ushort4 o; o.x = f2bf(v[q].x * rs * gg.x); o.y = f2bf(v[q].y * rs * gg.y); o.z = f2bf(v[q].z * rs * gg.z); o.w = f2bf(v[q].w * rs * gg.w);
                    *(ushort4*)&XN[(size_t)row * DM + q * 256 + lane * 4] = o;
                }
            }
        }
        xcd_barrier(bar);
        {
            const float* W = A.in[2] + (size_t)l * DM * DIN;
            auto al = [&](int row, int k) -> float { return bf2f(XN[(size_t)row * DM + k]); };
            auto bl = [&](int k, int col) -> float { return col < DIN ? W[(size_t)k * DIN + orig_col(col)] : 0.f; };
            auto st = [&](int row, int col, float v) { if (col < DIN) PROJ[(size_t)row * DIN + col] = f2bf(v); };
            gemm_naive(MTOK, DIN, DM, al, bl, st, lds);
        }
        xcd_barrier(bar);
        {
            bf16_t* KR = (bf16_t*)(A.ws + WS_KR);
            for (int row = gw; row < MTOK; row += nwaves) {
                float sq = 0.f, sk = 0.f;
#pragma unroll
                for (int q = 0; q < 4; ++q) { const float x = bf2f(PROJ[(size_t)row * DIN + C_QL + q * 64 + lane]); sq += x * x; }
#pragma unroll
                for (int q = 0; q < 2; ++q) { const float x = bf2f(PROJ[(size_t)row * DIN + C_KVL + q * 64 + lane]); sk += x * x; }
                sq = wave_sum(sq); sk = wave_sum(sk);
                if (lane == 0) { RSTD[(size_t)row * 2] = rsqrtf(sq * (1.0f / QL) + 1e-6f); RSTD[(size_t)row * 2 + 1] = rsqrtf(sk * (1.0f / KVL) + 1e-6f); }
                if (lane < 16) {
                    const int t = row % SEQ;
                    const float cs = rope[(t * 16 + lane) * 2], sn = rope[(t * 16 + lane) * 2 + 1];
                    const float x1 = bf2f(PROJ[(size_t)row * DIN + C_KR + lane]), x2 = bf2f(PROJ[(size_t)row * DIN + C_KR + 16 + lane]);
                    KR[(size_t)row * 32 + lane] = f2bf(x1 * cs - x2 * sn); KR[(size_t)row * 32 + 16 + lane] = f2bf(x1 * sn + x2 * cs);
                }
            }
        }
        xcd_barrier(bar);
        {
            bf16_t* Q = (bf16_t*)(A.ws + WS_Q); bf16_t* KN = (bf16_t*)(A.ws + WS_KN); bf16_t* V = (bf16_t*)(A.ws + WS_V);
            const float* qg = A.in[21] + (size_t)l * QL; const float* wuq = A.in[22] + (size_t)l * QL * 768;
            const float* kg = A.in[23] + (size_t)l * KVL; const float* wukv = A.in[24] + (size_t)l * KVL * 1024;
            {
                auto al = [&](int row, int k) -> float { return bf2f(PROJ[(size_t)row * DIN + C_QL + k]) * RSTD[(size_t)row * 2] * qg[k]; };
                auto bl = [&](int k, int col) -> float { return wuq[(size_t)k * 768 + col]; };
                auto st = [&](int row, int col, float v) { const int hh = col / 96, d = col % 96; Q[((size_t)row * 8 + hh) * 96 + d] = f2bf(v); };
                gemm_naive(MTOK, 768, QL, al, bl, st, lds);
            }
            {
                auto al = [&](int row, int k) -> float { return bf2f(PROJ[(size_t)row * DIN + C_KVL + k]) * RSTD[(size_t)row * 2 + 1] * kg[k]; };
                auto bl = [&](int k, int col) -> float { return wukv[(size_t)k * 1024 + col]; };
                auto st = [&](int row, int col, float v) { const int hh = col >> 7, d = col & 127; if (d < 64) KN[((size_t)row * 8 + hh) * 64 + d] = f2bf(v); else V[((size_t)row * 8 + hh) * 64 + (d - 64)] = f2bf(v); };
                gemm_naive(MTOK, 1024, KVL, al, bl, st, lds);
            }
        }
        xcd_barrier(bar);
        {
            unsigned* qw = ctl + CW_QUEUE + 64 * l;
            for (;;) {
                __syncthreads();
                if (tid == 0) *s_unit = (int)atomicAdd(qw, 1u);
                __syncthreads();
                const int u = *s_unit;
                if (u >= 128 + 4096) break;
                if (u < 64) rwkv_unit(A, l, u >> 3, u & 7, lds);
                else if (u < 128) lru_unit(A, l, (u - 64) >> 3, (u - 64) & 7, lds);
                else { const int a = u - 128; attn_unit(A, (a & 63) >> 3, a & 7, 63 - (a >> 6), lds); }
            }
        }
        xcd_barrier(bar);
        {
            const bf16_t* OLRU = (const bf16_t*)(A.ws + WS_OLRU); const bf16_t* OATT = (const bf16_t*)(A.ws + WS_OATT);
            const float* gb = A.in[20] + (size_t)l * 512; const float* gc = A.in[25] + (size_t)l * 512;
            for (int row = gw; row < MTOK; row += nwaves) {
                float xb[8], xc[8], sb = 0.f, sc = 0.f;
#pragma unroll
                for (int q = 0; q < 8; ++q) { xb[q] = bf2f(OLRU[(size_t)row * 512 + q * 64 + lane]); xc[q] = bf2f(OATT[(size_t)row * 512 + q * 64 + lane]); sb += xb[q] * xb[q]; sc += xc[q] * xc[q]; }
                sb = wave_sum(sb); sc = wave_sum(sc);
                const float rb = rsqrtf(sb * (1.0f / 512) + 1e-6f), rc = rsqrtf(sc * (1.0f / 512) + 1e-6f);
#pragma unroll
                for (int q = 0; q < 8; ++q) {
                    const int c = q * 64 + lane;
                    const float zb = bf2f(PROJ[(size_t)row * DIN + C_ZB + c]), zc = bf2f(PROJ[(size_t)row * DIN + C_ZC + c]);
                    PROJ[(size_t)row * DIN + C_ZB + c] = f2bf(xb[q] * rb * gb[c] * siluf_(zb));
                    PROJ[(size_t)row * DIN + C_ZC + c] = f2bf(xc[q] * rc * gc[c] * siluf_(zc));
                }
            }
        }
        xcd_barrier(bar);
        {
            const float* W = A.in[26] + (size_t)l * DMIX * DM;
            float* out = A.out;
            auto al = [&](int row, int k) -> float { return bf2f(PROJ[(size_t)row * DIN + C_ZA + k]); };
            auto bl = [&](int k, int col) -> float { return W[(size_t)k * DM + col]; };
            auto st = [&](int row, int col, float v) { out[(size_t)row * DM + col] = hsrc[(size_t)row * DM + col] + v; };
            gemm_naive(MTOK, DM, DMIX, al, bl, st, lds);
        }
        xcd_barrier(bar);
    }
    {
        const float* g = A.in[27];
        for (int row = gw; row < MTOK; row += nwaves) {
            float4 v[4]; float ss = 0.f;
#pragma unroll
            for (int q = 0; q < 4; ++q) { v[q] = *(const float4*)&A.out[(size_t)row * DM + q * 256 + lane * 4]; ss += v[q].x * v[q].x + v[q].y * v[q].y + v[q].z * v[q].z + v[q].w * v[q].w; }
            ss = wave_sum(ss);
            const float rs = rsqrtf(ss * (1.0f / DM) + 1e-6f);
#pragma unroll
            for (int q = 0; q < 4; ++q) {
                const float4 gg = *(const float4*)&g[q * 256 + lane * 4];
                float4 o; o.x = v[q].x * rs * gg.x; o.y = v[q].y * rs * gg.y; o.z = v[q].z * rs * gg.z; o.w = v[q].w * rs * gg.w;
                *(float4*)&A.out[(size_t)row * DM + q * 256 + lane * 4] = o;
            }
        }
    }
}

extern "C" void kernel_launch(void* const* d_in, const int* in_sizes, int n_in, void* d_out, int out_size, void* d_ws, size_t ws_size, hipStream_t stream) {
    (void)in_sizes; (void)n_in; (void)out_size; (void)ws_size;
    constexpr int kDynLds = 147456;
    static int grid = 0;
    if (!grid) {
        int dev = 0, cus = 0;
        hipGetDevice(&dev);
        hipDeviceGetAttribute(&cus, hipDeviceAttributeMultiprocessorCount, dev);
        hipFuncSetAttribute((const void*)fwd_kernel, hipFuncAttributeMaxDynamicSharedMemorySize, kDynLds);
        int per_cu = 0;
        hipOccupancyMaxActiveBlocksPerMultiprocessor(&per_cu, fwd_kernel, 512, kDynLds);
        if (per_cu < 1) fprintf(stderr, "occupancy query says %d\n", per_cu);
        grid = cus > 0 ? cus : 256;
    }
    hipMemsetAsync(d_ws, 0, CTL_BYTES, stream);
    Args a;
    memset(&a, 0, sizeof(a));
    for (int i = 0; i < 28; ++i) a.in[i] = (const float*)d_in[i];
    a.out = (float*)d_out;
    a.ws = (unsigned char*)d_ws;
    hipLaunchKernelGGL(fwd_kernel, dim3(grid), dim3(512), kDynLds, stream, a);
}
```

```cpp
#include <hip/hip_runtime.h>
#include <stdint.h>
#include <cstdio>
#include <cstring>

constexpr int DM = 1024, NB = 8, SEQ = 4096, DEPTH = 4, MTOK = NB * SEQ;
constexpr int GW = 512, HD = 64, NH = 8, DMIX = 1536, DIN = 4128;
constexpr int QL = 256, KVL = 128;
constexpr int C_R = 0, C_K = 512, C_V = 1024, C_WL = 1536, C_AL = 1600, C_UB = 1664, C_QL = 2176, C_KVL = 2432, C_KR = 2560,
              C_ZA = 2592, C_ZB = 3104, C_ZC = 3616;
__device__ __forceinline__ int orig_col(int c) {
    if (c < 1664) return c;
    if (c < 2176) return c - 1664 + 2176;
    if (c < 2432) return c - 2176 + 3200;
    if (c < 2560) return c - 2432 + 3456;
    if (c < 2592) return c - 2560 + 3584;
    if (c < 3104) return c - 2592 + 1664;
    if (c < 3616) return c - 3104 + 2688;
    return c;
}
constexpr size_t MiB = 1u << 20;
constexpr size_t WS_CTL = 0, CTL_BYTES = 65536;
constexpr size_t WS_ROPE = 1 * MiB;
constexpr size_t WS_RSTD = 2 * MiB;
constexpr size_t WS_WMLA = 3 * MiB;
constexpr size_t WS_PROJ = 16 * MiB;
constexpr size_t WS_XN = 274 * MiB;
constexpr size_t WS_K = 274 * MiB;
constexpr size_t WS_V = 322 * MiB;
constexpr size_t WS_Q = 354 * MiB;
constexpr size_t WS_GAT = 9 * MiB;
constexpr size_t WS_LSUM = 10 * MiB;
constexpr size_t WS_RWP = 402 * MiB;
constexpr size_t WS_WIN = 434 * MiB;
constexpr size_t WS_WOUT = 468 * MiB;
constexpr size_t WS_FREE = 480 * MiB;
constexpr int NPAD_IN = 4352, NMLA = 1792, KMLA = 384;
constexpr int CW_QUEUE = 8192;
#ifndef ATT_THR
#define ATT_THR 8
#endif

typedef unsigned short bf16_t;
__device__ __forceinline__ float bf2f(bf16_t v) { return __builtin_bit_cast(float, (unsigned)v << 16); }
__device__ __forceinline__ bf16_t f2bf(float f) { unsigned u = __builtin_bit_cast(unsigned, f); return (bf16_t)((u + 0x7fffu + ((u >> 16) & 1u)) >> 16); }
template <int MASK> __device__ __forceinline__ float shx(float v) {
    static_assert(MASK < 32, "shx: within 32 lanes");
    return __builtin_bit_cast(float, __builtin_amdgcn_ds_swizzle(__builtin_bit_cast(int, v), (MASK << 10) | 0x1f));
}
__device__ __forceinline__ void swap32(float v, float& x, float& y) {
    auto rr = __builtin_amdgcn_permlane32_swap(__builtin_bit_cast(unsigned, v), __builtin_bit_cast(unsigned, v), false, false);
    unsigned a = rr[0], b = rr[1]; asm volatile("" : "+v"(a), "+v"(b));
    x = __builtin_bit_cast(float, a); y = __builtin_bit_cast(float, b);
}
__device__ __forceinline__ float wave_sum(float v) {
    v += shx<1>(v); v += shx<2>(v); v += shx<4>(v); v += shx<8>(v); v += shx<16>(v);
    float x, y; swap32(v, x, y);
    return x + y;
}
__device__ __forceinline__ float sigmoidf_(float x) { return 1.0f / (1.0f + expf(-x)); }
__device__ __forceinline__ float softplusf_(float x) { return x > 20.f ? x : log1pf(expf(x)); }
__device__ __forceinline__ float siluf_(float x) { return x / (1.0f + expf(-x)); }

__device__ __forceinline__ int otid() { int t = threadIdx.x; asm volatile("" : "+v"(t)); return t; }
template <int K> __device__ __forceinline__ const float* argp() {
    int k = K; asm volatile("" : "+s"(k));
    return (const float*)(((const unsigned long long*)__builtin_amdgcn_kernarg_segment_ptr())[k]);
}
#define ARG(k) argp<k>()
#define ARG_OUT ((float*)argp<28>())
#define ARG_WS ((unsigned char*)argp<29>())

#define XB_TMO      128
#define XB_XCNT(j)  (256  + 64 * (j))
#define XB_XSUB(j)  (1280 + 64 * (j))
#define XB_XGEN(j)  (2304 + 64 * (j))
#define XB_TOP      3328
#define XB_TOPGEN   3392
#define XCD_BAR_WORDS 3456
#define XB_SPIN_CAP (1u << 24)
#define LAS __attribute__((address_space(3)))

__device__ __forceinline__ unsigned xb_ld(unsigned* p)              { return __hip_atomic_load(p, __ATOMIC_RELAXED, __HIP_MEMORY_SCOPE_AGENT); }
__device__ __forceinline__ unsigned xb_add(unsigned* p, unsigned v) { return __hip_atomic_fetch_add(p, v, __ATOMIC_RELAXED, __HIP_MEMORY_SCOPE_AGENT); }
__device__ __forceinline__ unsigned xb_xcc_id() { return (unsigned)__builtin_amdgcn_s_getreg((3 << 11) | 20) & 0xFu; }
#define XB_SPIN(cond, bar) do { unsigned _sp = 0; while (cond) { __builtin_amdgcn_s_sleep(1); \
    if ((++_sp & 255u) == 0u) { if (xb_ld(&(bar)[XB_TMO])) break; if (_sp > XB_SPIN_CAP) { atomicAdd(&(bar)[XB_TMO], 1u); break; } } } } while (0)

struct XcdBarrier { unsigned* bar; unsigned x; volatile LAS unsigned* st; };

__device__ __forceinline__ XcdBarrier xcd_barrier_post(unsigned* bar, volatile LAS unsigned* st) {
    XcdBarrier b; b.bar = bar; b.x = xb_xcc_id(); b.st = st;
    if (threadIdx.x == 0) (void)xb_add(&bar[XB_XCNT(b.x)], 1u);
    return b;
}
__device__ __forceinline__ void xcd_barrier_complete(unsigned* bar, unsigned x, unsigned& nloc, unsigned& nx) {
    const unsigned G = gridDim.x * gridDim.y * gridDim.z;
    unsigned sum, cnt, mine, sp = 0u;
    for (;;) {
        sum = 0u; cnt = 0u; mine = 0u;
#pragma unroll
        for (unsigned j = 0; j < 16; ++j) { const unsigned c = xb_ld(&bar[XB_XCNT(j)]); sum += c; cnt += (c > 0u) ? 1u : 0u; mine = (j == x) ? c : mine; }
        if (sum == G) break;
        __builtin_amdgcn_s_sleep(1);
        if ((++sp & 255u) == 0u) { if (xb_ld(&bar[XB_TMO])) break; if (sp > XB_SPIN_CAP) { atomicAdd(&bar[XB_TMO], 1u); break; } }
    }
    nloc = mine > 0u ? mine : 1u; nx = cnt > 0u ? cnt : 1u;
}
__device__ __forceinline__ void xcd_barrier(const XcdBarrier& b) {
    asm volatile("s_waitcnt vmcnt(0)" ::: "memory");
    __syncthreads();
    if (threadIdx.x == 0) {
        unsigned* bar = b.bar;
        __builtin_amdgcn_s_waitcnt(0);
        const unsigned bx = (unsigned)__builtin_amdgcn_readfirstlane((int)xb_xcc_id());
        unsigned nloc = b.st[0], nx = b.st[1];
        if (nloc == 0u) { xcd_barrier_complete(bar, bx, nloc, nx); b.st[0] = nloc; b.st[1] = nx; }
        const unsigned old = xb_add(&bar[XB_XSUB(bx)], 1u);
        const unsigned gen = old / nloc;
        if (old + 1u == (gen + 1u) * nloc) {
            __builtin_amdgcn_fence(__ATOMIC_RELEASE, "agent");
            asm volatile("s_waitcnt vmcnt(0)" ::: "memory");
            const unsigned og = xb_add(&bar[XB_TOP], 1u);
            const unsigned tg = og / nx;
            if (og + 1u == (tg + 1u) * nx) xb_add(&bar[XB_TOPGEN], 1u);
            else XB_SPIN(xb_ld(&bar[XB_TOPGEN]) == tg, bar);
            __builtin_amdgcn_fence(__ATOMIC_ACQUIRE, "agent");
            xb_add(&bar[XB_XGEN(bx)], 1u);
            asm volatile("s_waitcnt vmcnt(0)" ::: "memory");
        } else {
            XB_SPIN(xb_ld(&bar[XB_XGEN(bx)]) == gen, bar);
            __builtin_amdgcn_fence(__ATOMIC_ACQUIRE, "agent");
            asm volatile("s_waitcnt vmcnt(0)" ::: "memory");
        }
    }
    __syncthreads();
}

struct Args {
    const float* in[28];
    float* out;
    unsigned char* ws;
};

namespace pg8 {
#define PG8_LAS __attribute__((address_space(3)))
typedef unsigned short bf16_t;
typedef short bf16x8 __attribute__((ext_vector_type(8)));
typedef float f32x4 __attribute__((ext_vector_type(4)));
typedef unsigned u32x4 __attribute__((ext_vector_type(4)));
constexpr int BM = 256, BK = 64, HALF = 128, HTB = HALF * BK * 2  , STAGE_BYTES = 8 * HTB, NXCD = 8, WGM = 8;

__host__ __device__ __forceinline__ int lds_byte(int r, int c) { const int st = (r >> 4) * 2 + (c >> 5), rr = r & 15, cc = c & 31, ob = rr * 64 + cc * 2; return st * 1024 + (ob ^ (((ob >> 9) & 1) << 5)); }
__host__ __device__ __forceinline__ void stage_rc(int b, int& R, int& C) { const int st = b / 1024, sb = b % 1024, swz = sb ^ (((sb >> 9) & 1) << 5); R = (st >> 1) * 16 + swz / 64; C = (st & 1) * 32 + (swz % 64) / 2; }
__host__ __device__ __forceinline__ int perm32(int rho) { const int n = rho >> 4, i = rho & 15; return 8 * (i >> 2) + 4 * n + (i & 3); }

struct Unit { int pm, pn; };
struct Gemm { const bf16_t* A; const bf16_t* Bt; int M, N, K, lda, ldb; };

struct StaticOrder {
    int nM, nN, nwg, G, c;
    __host__ __device__ void init(int M, int N, int G_, int c_) { nM = M / BM; nN = N / BM; nwg = nM * nN; G = G_; c = c_; }
    __host__ __device__ bool next(int i, Unit& u) const {
        const long L = (long)i * G + c; if (L >= nwg) return false;
        int wgid = (int)L; { const int q = nwg / NXCD, r = nwg % NXCD, xcd = wgid % NXCD, off = wgid / NXCD; wgid = (xcd < r ? xcd * (q + 1) : r * (q + 1) + (xcd - r) * q) + off; }
        const int nig = WGM * nN, gid = wgid / nig, fm = gid * WGM, gsz = (nM - fm) < WGM ? (nM - fm) : WGM;
        u.pm = fm + ((wgid % nig) % gsz); u.pn = (wgid % nig) / gsz; return true;
    }
    __device__ __forceinline__ void a_ready(const Unit&) const {}
    __device__ __forceinline__ void done(const Unit&) const {}
};

__device__ __forceinline__ unsigned cvt_pk_bf16(float lo, float hi) { unsigned r; asm volatile("v_cvt_pk_bf16_f32 %0, %1, %2" : "=v"(r) : "v"(lo), "v"(hi)); return r; }
template <class Epi, class Sched, bool ALIGN_EPI = false, bool SP2 = false>
__device__ __forceinline__ void gemm_phase(PG8_LAS unsigned char* lds, const Gemm g, const Sched& S, const Epi& E) {
    const int tid = otid(), wid = __builtin_amdgcn_readfirstlane(tid >> 6), lane = tid & 63, wr = wid >> 2, wc = wid & 3, fr = lane & 15, fq = lane >> 4;
    const int K = g.K, nt = K / BK;
    unsigned voffA[2], voffB[2];
#pragma unroll
    for (int i = 0; i < 2; ++i) { int R, C; stage_rc(tid * 16 + i * 8192, R, C); const int Rb = Epi::PERM ? ((R & ~31) + perm32(R & 31)) : R;
        voffA[i] = (unsigned)(R * g.lda + C) * 2u; voffB[i] = (unsigned)(Rb * g.ldb + C) * 2u; }
    const size_t kstep = (size_t)(BK * 2);
    const size_t hstepA = (size_t)HALF * g.lda * 2, hstepB = (size_t)HALF * g.ldb * 2;
    const size_t tstepA = 2 * hstepA, tstepB = 2 * hstepB;
    const unsigned ldsw = (unsigned)wid * 1024u;
    const int aoff = lds_byte(wr * 64 + fr, fq * 8), boff = lds_byte(wc * 32 + fr, fq * 8);
#define PG8_SA(b, h) (((b) * 2 + (h)) * HTB)
#define PG8_SB(b, h) ((4 + (b) * 2 + (h)) * HTB)
#define PG8_STAGE(bufoff, gbase, voff) do { _Pragma("unroll") for (int _i = 0; _i < 2; ++_i) \
        __builtin_amdgcn_global_load_lds((const unsigned*)((const char*)(gbase) + (voff)[_i]), (PG8_LAS unsigned*)(lds + (bufoff) + ldsw + _i * 8192), 16, 0, 0); } while (0)
#define PG8_LDA(dst, b, h) do { _Pragma("unroll") for (int m = 0; m < 4; ++m) _Pragma("unroll") for (int k = 0; k < 2; ++k) dst[m][k] = *(const PG8_LAS bf16x8*)(lds + PG8_SA(b, h) + aoff + m * 2048 + k * 1024); } while (0)
#define PG8_LDB(dst, b, h) do { _Pragma("unroll") for (int n = 0; n < 2; ++n) _Pragma("unroll") for (int k = 0; k < 2; ++k) dst[n][k] = *(const PG8_LAS bf16x8*)(lds + PG8_SB(b, h) + boff + n * 2048 + k * 1024); } while (0)
#define PG8_MMA(ai, bj, At, Bt) do { __builtin_amdgcn_s_setprio(1); _Pragma("unroll") for (int m = 0; m < 4; ++m) _Pragma("unroll") for (int n = 0; n < 2; ++n) _Pragma("unroll") for (int k = 0; k < 2; ++k) \
        acc[ai][bj][m][n] = __builtin_amdgcn_mfma_f32_16x16x32_bf16(Bt[n][k], At[m][k], acc[ai][bj][m][n], 0, 0, 0); __builtin_amdgcn_s_setprio(0); } while (0)
#define PG8_WAIT_V(n) asm volatile("s_waitcnt vmcnt(" #n ")" ::: "memory")
#define PG8_WAIT_L(n) asm volatile("s_waitcnt lgkmcnt(" #n ")" ::: "memory")
#define PG8_BAR __builtin_amdgcn_s_barrier()
#define PG8_SCHED __builtin_amdgcn_sched_barrier(0)
    Unit cur, nxt; int ui = 0;
    if (!S.next(0, cur)) return;
    f32x4 acc[2][2][4][2];
#pragma unroll
    for (int a = 0; a < 2; ++a)
#pragma unroll
        for (int b = 0; b < 2; ++b)
#pragma unroll
            for (int m = 0; m < 4; ++m)
#pragma unroll
                for (int n = 0; n < 2; ++n) acc[a][b][m][n] = (f32x4){0.f, 0.f, 0.f, 0.f};
    bf16x8 At[4][2], B0[2][2], B1[2][2];
    const char* cA = (const char*)g.A + (size_t)cur.pm * tstepA; const char* cB = (const char*)g.Bt + (size_t)cur.pn * tstepB;
    S.a_ready(cur);
    if constexpr (SP2) {
        PG8_STAGE(PG8_SB(0, 0), cB, voffB); PG8_STAGE(PG8_SB(0, 1), cB + hstepB, voffB); PG8_STAGE(PG8_SA(0, 0), cA, voffA); PG8_STAGE(PG8_SA(0, 1), cA + hstepA, voffA);
        if (wr == 1) PG8_BAR;
        PG8_WAIT_V(2); PG8_BAR;
        PG8_STAGE(PG8_SB(1, 0), cB + kstep, voffB); PG8_STAGE(PG8_SA(1, 0), cA + kstep, voffA); PG8_STAGE(PG8_SB(1, 1), cB + hstepB + kstep, voffB);
        PG8_WAIT_V(6); PG8_BAR;
    } else {
        PG8_STAGE(PG8_SB(0, 0), cB, voffB); PG8_STAGE(PG8_SA(0, 0), cA, voffA); PG8_STAGE(PG8_SB(0, 1), cB + hstepB, voffB); PG8_STAGE(PG8_SA(0, 1), cA + hstepA, voffA);
        if (wr == 1) PG8_BAR;
        PG8_WAIT_V(4); PG8_BAR;
        PG8_STAGE(PG8_SB(1, 0), cB + kstep, voffB); PG8_STAGE(PG8_SA(1, 0), cA + kstep, voffA); PG8_STAGE(PG8_SB(1, 1), cB + hstepB + kstep, voffB);
        PG8_WAIT_V(6); PG8_BAR;
    }
    for (;;) {
        const bool has_next = S.next(ui + 1, nxt);
        const char* nA = has_next ? (const char*)g.A + (size_t)nxt.pm * tstepA : cA; const char* nB = has_next ? (const char*)g.Bt + (size_t)nxt.pn * tstepB : cB;
        for (int t = 0; t < nt; t += 2) {
            const bool last = (t == nt - 2);
            const char* a1 = cA + (size_t)(t + 1) * kstep;
            const char* a2 = last ? nA : cA + (size_t)(t + 2) * kstep; const char* b2 = last ? nB : cB + (size_t)(t + 2) * kstep;
            const char* a3 = a2 + kstep; const char* b3 = b2 + kstep;
            if (last && has_next) S.a_ready(nxt);
            if constexpr (SP2) {
            PG8_LDB(B0, 0, 0); PG8_LDB(B1, 0, 1); PG8_SCHED; PG8_LDA(At, 0, 0); PG8_STAGE(PG8_SA(1, 1), a1 + hstepA, voffA);
            PG8_WAIT_V(8); PG8_WAIT_L(0); PG8_BAR; PG8_MMA(0, 0, At, B0); PG8_MMA(0, 1, At, B1); PG8_BAR; PG8_SCHED;
            PG8_LDA(At, 0, 1); PG8_STAGE(PG8_SB(0, 0), b2, voffB); PG8_STAGE(PG8_SB(0, 1), b2 + hstepB, voffB); PG8_STAGE(PG8_SA(0, 0), a2, voffA);
            PG8_WAIT_V(8); PG8_WAIT_L(0); PG8_BAR; PG8_MMA(1, 0, At, B0); PG8_MMA(1, 1, At, B1); PG8_BAR; PG8_SCHED;
            PG8_LDB(B0, 1, 0); PG8_LDB(B1, 1, 1); PG8_SCHED; PG8_LDA(At, 1, 0); PG8_STAGE(PG8_SA(0, 1), a2 + hstepA, voffA);
            PG8_WAIT_V(8); PG8_WAIT_L(0); PG8_BAR; PG8_MMA(0, 0, At, B0); PG8_MMA(0, 1, At, B1); PG8_BAR; PG8_SCHED;
            PG8_LDA(At, 1, 1); PG8_STAGE(PG8_SB(1, 0), b3, voffB); PG8_STAGE(PG8_SB(1, 1), b3 + hstepB, voffB); PG8_STAGE(PG8_SA(1, 0), a3, voffA);
            PG8_WAIT_V(8); PG8_WAIT_L(0); PG8_BAR; PG8_MMA(1, 0, At, B0); PG8_MMA(1, 1, At, B1); PG8_BAR; PG8_SCHED;
            } else {
            PG8_LDB(B0, 0, 0); PG8_SCHED; PG8_LDA(At, 0, 0); PG8_STAGE(PG8_SA(1, 1), a1 + hstepA, voffA);
            PG8_WAIT_L(8); PG8_BAR; PG8_WAIT_L(0); PG8_MMA(0, 0, At, B0); PG8_BAR; PG8_SCHED;
            PG8_LDB(B1, 0, 1); PG8_STAGE(PG8_SB(0, 0), b2, voffB);
            PG8_BAR; PG8_WAIT_L(0); PG8_MMA(0, 1, At, B1); PG8_BAR;
            PG8_LDA(At, 0, 1); PG8_STAGE(PG8_SA(0, 0), a2, voffA);
            PG8_BAR; PG8_WAIT_L(0); PG8_MMA(1, 0, At, B0); PG8_BAR; PG8_SCHED;
            PG8_STAGE(PG8_SB(0, 1), b2 + hstepB, voffB);
            PG8_WAIT_V(6); PG8_BAR; PG8_MMA(1, 1, At, B1); PG8_BAR;
            PG8_LDB(B0, 1, 0); PG8_SCHED; PG8_LDA(At, 1, 0); PG8_STAGE(PG8_SA(0, 1), a2 + hstepA, voffA);
            PG8_WAIT_L(8); PG8_BAR; PG8_WAIT_L(0); PG8_MMA(0, 0, At, B0); PG8_BAR; PG8_SCHED;
            PG8_LDB(B1, 1, 1); PG8_STAGE(PG8_SB(1, 0), b3, voffB);
            PG8_BAR; PG8_WAIT_L(0); PG8_MMA(0, 1, At, B1); PG8_BAR;
            PG8_LDA(At, 1, 1); PG8_STAGE(PG8_SA(1, 0), a3, voffA);
            PG8_BAR; PG8_WAIT_L(0); PG8_MMA(1, 0, At, B0); PG8_BAR; PG8_SCHED;
            PG8_STAGE(PG8_SB(1, 1), b3 + hstepB, voffB);
            PG8_WAIT_V(6); PG8_BAR; PG8_MMA(1, 1, At, B1); PG8_BAR;
            }
        }
        if constexpr (ALIGN_EPI) { if (wr == 0) PG8_BAR; }
        if constexpr (!Epi::AFTER_DRAIN) { E(acc, cur, wr, wc, fr, fq); S.done(cur); }
        if (!has_next) break;
#pragma unroll
        for (int a = 0; a < 2; ++a)
#pragma unroll
            for (int b = 0; b < 2; ++b)
#pragma unroll
                for (int m = 0; m < 4; ++m)
#pragma unroll
                    for (int n = 0; n < 2; ++n) acc[a][b][m][n] = (f32x4){0.f, 0.f, 0.f, 0.f};
        cur = nxt; cA = nA; cB = nB; ++ui;
        if constexpr (ALIGN_EPI) { if (wr == 1) PG8_BAR; }
    }
    PG8_WAIT_V(0);
    if constexpr (!ALIGN_EPI) { if (wr == 0) PG8_BAR; }
    PG8_BAR;
    if constexpr (Epi::AFTER_DRAIN) { E.fused(acc, cur, wr, wc, fr, fq, lds, wid, lane); S.done(cur); }
#undef PG8_SA
#undef PG8_SB
#undef PG8_STAGE
#undef PG8_LDA
#undef PG8_LDB
#undef PG8_MMA
#undef PG8_WAIT_V
#undef PG8_WAIT_L
#undef PG8_BAR
#undef PG8_SCHED
}
}

namespace pg8 {
struct EpiProj {
    static constexpr bool PERM = true, AFTER_DRAIN = false;
    bf16_t* O; int ldc; int ncols;
    __device__ __forceinline__ void operator()(const f32x4 (&acc)[2][2][4][2], const Unit& u, int wr, int wc, int fr, int fq) const {
        const int row0 = u.pm * BM + wr * 64 + fr, col0 = u.pn * BM + wc * 32 + 8 * fq;
#pragma unroll
        for (int ai = 0; ai < 2; ++ai)
#pragma unroll
            for (int m = 0; m < 4; ++m) { bf16_t* rowp = O + (size_t)(row0 + ai * HALF + m * 16) * ldc + col0;
#pragma unroll
                for (int bj = 0; bj < 2; ++bj) { const f32x4 v0 = acc[ai][bj][m][0], v1 = acc[ai][bj][m][1];
                    u32x4 w; w.x = cvt_pk_bf16(v0[0], v0[1]); w.y = cvt_pk_bf16(v0[2], v0[3]); w.z = cvt_pk_bf16(v1[0], v1[1]); w.w = cvt_pk_bf16(v1[2], v1[3]);
                    if (col0 + bj * HALF < ncols) *(u32x4*)(rowp + bj * HALF) = w; } }
    }
};
struct EpiResid {
    static constexpr bool PERM = false, AFTER_DRAIN = false;
    float* C; const float* R; int ldc;
    __device__ __forceinline__ void operator()(const f32x4 (&acc)[2][2][4][2], const Unit& u, int wr, int wc, int fr, int fq) const {
        const int row0 = u.pm * BM + wr * 64 + fr, col0 = u.pn * BM + wc * 32 + 4 * fq;
#pragma unroll
        for (int ai = 0; ai < 2; ++ai)
#pragma unroll
            for (int m = 0; m < 4; ++m) { const size_t off = (size_t)(row0 + ai * HALF + m * 16) * ldc + col0;
#pragma unroll
                for (int bj = 0; bj < 2; ++bj)
#pragma unroll
                    for (int n = 0; n < 2; ++n) { const f32x4 r = *(const f32x4*)(R + off + bj * HALF + n * 16); *(f32x4*)(C + off + bj * HALF + n * 16) = r + acc[ai][bj][m][n]; } }
    }
};
struct EpiMla {
    static constexpr bool PERM = false, AFTER_DRAIN = false;
    bf16_t* Q; bf16_t* K; bf16_t* V; const float* rstd; const float* rope; float c2;
    __device__ __forceinline__ void operator()(const f32x4 (&acc)[2][2][4][2], const Unit& u, int wr, int wc, int fr, int fq) const {
        const int row0 = u.pm * BM + wr * 64 + fr;
        typedef unsigned u32x2 __attribute__((ext_vector_type(2)));
#pragma unroll
        for (int ai = 0; ai < 2; ++ai)
#pragma unroll
            for (int m = 0; m < 4; ++m) {
                const int row = row0 + ai * HALF + m * 16;
                const float rq = rstd[(size_t)row * 2], rk = rstd[(size_t)row * 2 + 1];
#pragma unroll
                for (int bj = 0; bj < 2; ++bj) {
                    const int cg = u.pn * BM + bj * HALF + wc * 32;
                    f32x4 v0 = acc[ai][bj][m][0], v1 = acc[ai][bj][m][1];
                    if (u.pn < 3) {
                        v0 = v0 * rq; v1 = v1 * rq;
                        if (((cg >> 5) % 3) == 2) {
                            const int t = row & (SEQ - 1);
                            const f32x4 cs0 = *(const f32x4*)(rope + ((size_t)t * 16 + 4 * fq) * 2), cs1 = *(const f32x4*)(rope + ((size_t)t * 16 + 4 * fq) * 2 + 4);
                            const float c[4] = {cs0[0], cs0[2], cs1[0], cs1[2]}, sn[4] = {cs0[1], cs0[3], cs1[1], cs1[3]};
                            f32x4 o0, o1;
#pragma unroll
                            for (int j = 0; j < 4; ++j) { o0[j] = v0[j] * c[j] - v1[j] * sn[j]; o1[j] = v0[j] * sn[j] + v1[j] * c[j]; }
                            v0 = o0; v1 = o1;
                        }
                        v0 = v0 * c2; v1 = v1 * c2;
                        bf16_t* p = Q + (size_t)row * 768 + cg + 4 * fq;
                        u32x2 w0, w1; w0.x = cvt_pk_bf16(v0[0], v0[1]); w0.y = cvt_pk_bf16(v0[2], v0[3]); w1.x = cvt_pk_bf16(v1[0], v1[1]); w1.y = cvt_pk_bf16(v1[2], v1[3]);
                        *(u32x2*)p = w0; *(u32x2*)(p + 16) = w1;
                    } else {
                        v0 = v0 * rk; v1 = v1 * rk;
                        const int c = cg - 768, hh = c >> 7, d = (c & 127) + 4 * fq;
                        u32x2 w0, w1; w0.x = cvt_pk_bf16(v0[0], v0[1]); w0.y = cvt_pk_bf16(v0[2], v0[3]); w1.x = cvt_pk_bf16(v1[0], v1[1]); w1.y = cvt_pk_bf16(v1[2], v1[3]);
                        bf16_t* p = (d < 64) ? K + ((size_t)row * 8 + hh) * 96 + d : V + ((size_t)row * 8 + hh) * 64 + (d - 64);
                        *(u32x2*)p = w0; *(u32x2*)(p + 16) = w1;
                    }
                }
                asm volatile("" ::: "memory");
            }
    }
};
}

template <class SRC>
__device__ __forceinline__ void transpose_w(int K, int npad, bf16_t* WT, const SRC& src, float* lds) {
    const int tid = otid();
    const int tk = K / 64, tn = npad / 64;
    for (int u = blockIdx.x; u < tk * tn; u += gridDim.x) {
        const int k0 = (u % tk) * 64, n0 = (u / tk) * 64;
        __syncthreads();
        for (int idx = tid; idx < 4096; idx += 512) { const int kk = idx >> 6, nn = idx & 63; lds[kk * 65 + nn] = src(k0 + kk, n0 + nn); }
        __syncthreads();
        for (int idx = tid; idx < 4096; idx += 512) { const int nn = idx >> 6, kk = idx & 63; WT[(size_t)(n0 + nn) * K + k0 + kk] = f2bf(lds[kk * 65 + nn]); }
    }
}

template <class AL, class BL, class ST>
__device__ __forceinline__ void gemm_naive(int M, int N, int K, const AL& al, const BL& bl, const ST& st, float* lds) {
    float* As = lds;
    float* Bs = lds + 16 * 132;
    const int tid = otid(), ty = tid >> 4, tx = tid & 15;
    const int ntn = (N + 127) / 128, ntiles = (M / 128) * ntn;
    for (int u = blockIdx.x; u < ntiles; u += gridDim.x) {
        const int tm = u / ntn, tn = u % ntn;
        float acc[4][8];
#pragma unroll
        for (int i = 0; i < 4; ++i)
#pragma unroll
            for (int j = 0; j < 8; ++j) acc[i][j] = 0.f;
        for (int k0 = 0; k0 < K; k0 += 16) {
#pragma unroll
            for (int j = 0; j < 4; ++j) { const int idx = tid + j * 512, r = idx >> 4, k = idx & 15; As[k * 132 + r] = al(tm * 128 + r, k0 + k); }
#pragma unroll
            for (int j = 0; j < 4; ++j) { const int idx = tid + j * 512, k = idx >> 7, c = idx & 127; Bs[k * 132 + c] = bl(k0 + k, tn * 128 + c); }
            __syncthreads();
#pragma unroll 2
            for (int k = 0; k < 16; ++k) {
                const float4 a4 = *(const float4*)&As[k * 132 + ty * 4];
                const float4 b0 = *(const float4*)&Bs[k * 132 + tx * 8], b1 = *(const float4*)&Bs[k * 132 + tx * 8 + 4];
                const float av[4] = {a4.x, a4.y, a4.z, a4.w};
                const float bv[8] = {b0.x, b0.y, b0.z, b0.w, b1.x, b1.y, b1.z, b1.w};
#pragma unroll
                for (int i = 0; i < 4; ++i)
#pragma unroll
                    for (int j = 0; j < 8; ++j) acc[i][j] = fmaf(av[i], bv[j], acc[i][j]);
            }
            __syncthreads();
        }
#pragma unroll
        for (int i = 0; i < 4; ++i)
#pragma unroll
            for (int j = 0; j < 8; ++j) st(tm * 128 + ty * 4 + i, tn * 128 + tx * 8 + j, acc[i][j]);
    }
}

__device__ __forceinline__ void rwkv_unit(const Args& A, int l, int b, int h, float* lds) {
    constexpr int TB = 32;
    float* xr = lds;
    float* xk = xr + TB * 64;
    float* xv = xk + TB * 64;
    float* xwl = xv + TB * 64;
    float* xal = xwl + TB * 64;
    float* wd = xal + TB * 64;
    float* kp = wd + TB * 64;
    float* kks = kp + TB * 64;
    float* bbs = kks + TB * 64;
    float* avs = bbs + TB * 64;
    float* ys = avs + TB * 64;
    float* bon = ys + TB * 64;
    bf16_t* PROJ = (bf16_t*)(ARG_WS + WS_PROJ);
    const float* mu = ARG(3) + (size_t)l * 1664;
    const float* w0 = ARG(4) + (size_t)l * 512;
    const float* w2 = ARG(5) + (size_t)l * 64 * 512;
    const float* a0 = ARG(6) + (size_t)l * 512;
    const float* a2 = ARG(7) + (size_t)l * 64 * 512;
    const float* k_k = ARG(8) + (size_t)l * 512;
    const float* k_a = ARG(9) + (size_t)l * 512;
    const float* r_k = ARG(10) + (size_t)l * 512;
    const float* lng = ARG(11) + (size_t)l * 512;
    const float* lnb = ARG(12) + (size_t)l * 512;
    const int tid = otid(), lane = tid & 63, wv = tid >> 6;
    const int si = tid >> 3, sc = tid & 7;
    float S[8];
#pragma unroll
    for (int j = 0; j < 8; ++j) S[j] = 0.f;
    for (int t0 = 0; t0 < SEQ; t0 += TB) {
        __syncthreads();
        for (int idx = tid; idx < TB * 320; idx += 512) {
            const int tt = idx / 320, cc = idx % 320;
            int col; float* dst;
            if (cc < 64) { col = C_R + h * 64 + cc; dst = xr + tt * 64 + cc; }
            else if (cc < 128) { col = C_K + h * 64 + (cc - 64); dst = xk + tt * 64 + (cc - 64); }
            else if (cc < 192) { col = C_V + h * 64 + (cc - 128); dst = xv + tt * 64 + (cc - 128); }
            else if (cc < 256) { col = C_WL + (cc - 192); dst = xwl + tt * 64 + (cc - 192); }
            else { col = C_AL + (cc - 256); dst = xal + tt * 64 + (cc - 256); }
            const int t = t0 + tt; const size_t row = (size_t)b * SEQ + t;
            const float cur = bf2f(PROJ[row * DIN + col]);
            const float prv = (t > 0) ? bf2f(PROJ[(row - 1) * DIN + col]) : 0.f;
            float u = cur + mu[col] * (prv - cur);
            if (cc >= 192 && cc < 256) u = tanhf(u);
            *dst = u;
        }
        __syncthreads();
        {
            const int j = lane, c = h * 64 + j;
            float ds[4], as[4];
#pragma unroll
            for (int q = 0; q < 4; ++q) { ds[q] = w0[c]; as[q] = a0[c]; }
            for (int i = 0; i < 64; ++i) {
                const float w2v = w2[i * 512 + c], a2v = a2[i * 512 + c];
#pragma unroll
                for (int q = 0; q < 4; ++q) { const int tt = wv + 8 * q; ds[q] = fmaf(xwl[tt * 64 + i], w2v, ds[q]); as[q] = fmaf(xal[tt * 64 + i], a2v, as[q]); }
            }
            const float kkc = k_k[c], kac = k_a[c];
#pragma unroll
            for (int q = 0; q < 4; ++q) {
                const int tt = wv + 8 * q;
                const float lw = -softplusf_(-ds[q]) - 0.5f;
                const float decay = expf(-expf(lw));
                const float av = sigmoidf_(as[q]);
                const float kraw = xk[tt * 64 + j];
                wd[tt * 64 + j] = decay; avs[tt * 64 + j] = av;
                kks[tt * 64 + j] = kraw * kkc;
                kp[tt * 64 + j] = kraw * (1.0f + (av - 1.0f) * kac);
            }
        }
        __syncthreads();
#pragma unroll
        for (int q = 0; q < 4; ++q) {
            const int tt = wv + 8 * q;
            const float kr = kks[tt * 64 + lane];
            const float n2 = wave_sum(kr * kr);
            const float kn = kr / fmaxf(sqrtf(n2), 1e-12f);
            kks[tt * 64 + lane] = kn; bbs[tt * 64 + lane] = kn * avs[tt * 64 + lane];
            const float bs = wave_sum(xr[tt * 64 + lane] * kp[tt * 64 + lane] * r_k[h * 64 + lane]);
            if (lane == 0) bon[tt] = bs;
        }
        __syncthreads();
        for (int tt = 0; tt < TB; ++tt) {
            const float4 k0 = *(const float4*)&kks[tt * 64 + sc * 8], k1 = *(const float4*)&kks[tt * 64 + sc * 8 + 4];
            const float4 w0v = *(const float4*)&wd[tt * 64 + sc * 8], w1v = *(const float4*)&wd[tt * 64 + sc * 8 + 4];
            const float4 b0 = *(const float4*)&bbs[tt * 64 + sc * 8], b1 = *(const float4*)&bbs[tt * 64 + sc * 8 + 4];
            const float4 p0 = *(const float4*)&kp[tt * 64 + sc * 8], p1 = *(const float4*)&kp[tt * 64 + sc * 8 + 4];
            const float4 r0 = *(const float4*)&xr[tt * 64 + sc * 8], r1 = *(const float4*)&xr[tt * 64 + sc * 8 + 4];
            const float kk8[8] = {k0.x, k0.y, k0.z, k0.w, k1.x, k1.y, k1.z, k1.w};
            const float w8[8] = {w0v.x, w0v.y, w0v.z, w0v.w, w1v.x, w1v.y, w1v.z, w1v.w};
            const float b8[8] = {b0.x, b0.y, b0.z, b0.w, b1.x, b1.y, b1.z, b1.w};
            const float p8[8] = {p0.x, p0.y, p0.z, p0.w, p1.x, p1.y, p1.z, p1.w};
            const float r8[8] = {r0.x, r0.y, r0.z, r0.w, r1.x, r1.y, r1.z, r1.w};
            const float vi = xv[tt * 64 + si];
            float sa = 0.f;
#pragma unroll
            for (int j = 0; j < 8; ++j) sa = fmaf(S[j], kk8[j], sa);
            sa += shx<1>(sa); sa += shx<2>(sa); sa += shx<4>(sa);
            float y = 0.f;
#pragma unroll
            for (int j = 0; j < 8; ++j) { S[j] = S[j] * w8[j] - sa * b8[j] + vi * p8[j]; y = fmaf(S[j], r8[j], y); }
            y += shx<1>(y); y += shx<2>(y); y += shx<4>(y);
            if (sc == 0) ys[tt * 64 + si] = y;
        }
        __syncthreads();
#pragma unroll
        for (int q = 0; q < 4; ++q) {
            const int tt = wv + 8 * q; const size_t row = (size_t)b * SEQ + t0 + tt; const int c = h * 64 + lane;
            const float y = ys[tt * 64 + lane];
            const float mean = wave_sum(y) * (1.0f / 64.0f);
            const float d = y - mean;
            const float var = wave_sum(d * d) * (1.0f / 64.0f);
            float o = d * rsqrtf(var + 64e-5f) * lng[c] + lnb[c] + bon[tt] * xv[tt * 64 + lane];
            const float z = bf2f(PROJ[row * DIN + C_ZA + c]);
            PROJ[row * DIN + C_ZA + c] = f2bf(o * siluf_(z));
        }
    }
}

namespace lru {
typedef short bf16x8 __attribute__((ext_vector_type(8)));
typedef float f32x16 __attribute__((ext_vector_type(16)));
constexpr int TC = 32, XPITCH = 1040, LDS_XC = 0, LDS_OMA = 33280, LDS_BX = LDS_OMA + 32768, LDS_BYTES = LDS_BX + 32768;
__device__ __forceinline__ int crow(int r, int hi) { return (r & 3) + 8 * (r >> 2) + 4 * hi; }
template <bool FINAL>
__device__ __forceinline__ void unit(int l, int b, int c, LAS char* shm) {
    const int tid = otid(), lane = tid & 63, r32 = lane & 31, hi = lane >> 5;
    const int hh = __builtin_amdgcn_readfirstlane(tid >> 6);
    bf16_t* PROJ = (bf16_t*)(ARG_WS + WS_PROJ);
    const int t0 = c * TC; const size_t row0 = (size_t)b * SEQ + t0;
    __syncthreads();
    {
        const float* conv_w = ARG(13) + (size_t)l * 4 * 512; const float cb = (ARG(14) + (size_t)l * 512)[tid];
        const float w0 = conv_w[tid], w1 = conv_w[512 + tid], w2 = conv_w[1024 + tid], w3 = conv_w[1536 + tid];
        const bf16_t* up = PROJ + row0 * DIN + C_UB + tid;
        float x0 = (t0 >= 3) ? bf2f(up[-3 * (long)DIN]) : 0.f, x1 = (t0 >= 2) ? bf2f(up[-2 * (long)DIN]) : 0.f, x2 = (t0 >= 1) ? bf2f(up[-1 * (long)DIN]) : 0.f;
        LAS bf16_t* xc = (LAS bf16_t*)(shm + LDS_XC);
#pragma unroll 8
        for (int t = 0; t < TC; ++t) {
            const float x3 = bf2f(up[(size_t)t * DIN]);
            xc[t * (XPITCH / 2) + tid] = f2bf(cb + x0 * w0 + x1 * w1 + x2 * w2 + x3 * w3);
            x0 = x1; x1 = x2; x2 = x3;
        }
    }
    __syncthreads();
    {
        const bf16_t* gat = (const bf16_t*)(ARG_WS + WS_GAT) + ((size_t)(l * 8 + hh) * 64) * 64;
        const bf16_t* gxt = gat + (size_t)DEPTH * 8 * 64 * 64;
        const float* ga_b = ARG(16) + (size_t)l * 512; const float* gx_b = ARG(18) + (size_t)l * 512; const float* lam = ARG(19) + (size_t)l * 512;
        f32x16 ar[2], ai[2];
#pragma unroll
        for (int nt = 0; nt < 2; ++nt)
#pragma unroll
            for (int r = 0; r < 16; ++r) { ar[nt][r] = 0.f; ai[nt][r] = 0.f; }
        const LAS char* xa = (const LAS char*)shm + LDS_XC + r32 * XPITCH + (hh * 64 + 8 * hi) * 2;
#pragma unroll
        for (int ks = 0; ks < 4; ++ks) {
            const bf16x8 a = *(const LAS bf16x8*)(xa + ks * 32);
#pragma unroll
            for (int nt = 0; nt < 2; ++nt) {
                const bf16x8 wr_ = *(const bf16x8*)(gat + (size_t)(32 * nt + r32) * 64 + 16 * ks + 8 * hi);
                const bf16x8 wi_ = *(const bf16x8*)(gxt + (size_t)(32 * nt + r32) * 64 + 16 * ks + 8 * hi);
                ar[nt] = __builtin_amdgcn_mfma_f32_32x32x16_bf16(a, wr_, ar[nt], 0, 0, 0);
                ai[nt] = __builtin_amdgcn_mfma_f32_32x32x16_bf16(a, wi_, ai[nt], 0, 0, 0);
            }
        }
        LAS bf16_t* xc = (LAS bf16_t*)(shm + LDS_XC); LAS bf16_t* oma = (LAS bf16_t*)(shm + LDS_OMA); LAS bf16_t* bxs = (LAS bf16_t*)(shm + LDS_BX);
#pragma unroll
        for (int nt = 0; nt < 2; ++nt) {
            const int ch = hh * 64 + 32 * nt + r32;
            const float br = ga_b[ch], bi = gx_b[ch], spl = softplusf_(-lam[ch]);
#pragma unroll
            for (int r = 0; r < 16; ++r) {
                const int t = crow(r, hi);
                const float la = -8.0f * sigmoidf_(ar[nt][r] + br) * spl;
                const float x = bf2f(xc[t * (XPITCH / 2) + ch]);
                oma[t * 512 + ch] = f2bf(-expm1f(la));
                bxs[t * 512 + ch] = f2bf(sqrtf(-expm1f(2.0f * la)) * (sigmoidf_(ai[nt][r] + bi) * x));
            }
        }
    }
    {
        float* lsum = (float*)(ARG_WS + WS_LSUM);
        const LAS bf16_t* oma = (const LAS bf16_t*)(shm + LDS_OMA); const LAS bf16_t* bxs = (const LAS bf16_t*)(shm + LDS_BX);
        float h = 0.f;
        if (FINAL) {
            const float2* sp = (const float2*)lsum + ((size_t)b * 128) * 512 + tid;
#pragma unroll 8
            for (int cc = 0; cc < c; ++cc) { const float2 ah = sp[(size_t)cc * 512]; h = fmaf(ah.x, h, ah.y); }
        }
        float ap = 1.f;
        LAS float* hb = (LAS float*)(shm + LDS_OMA);
        float hv[TC];
#pragma unroll
        for (int t = 0; t < TC; ++t) {
            const float om = bf2f(oma[t * 512 + tid]), bx = bf2f(bxs[t * 512 + tid]);
            h = fmaf(-om, h, h) + bx; ap *= (1.0f - om); hv[t] = h;
        }
        if (!FINAL) { ((float2*)lsum)[((size_t)b * 128 + c) * 512 + tid] = make_float2(ap, h); }
        else {
            __syncthreads();
#pragma unroll
            for (int t = 0; t < TC; ++t) hb[t * 512 + tid] = hv[t];
        }
    }
    if (FINAL) {
        __syncthreads();
        const float* go = ARG(20) + (size_t)l * 512;
        const LAS float* hb = (const LAS float*)(shm + LDS_OMA);
#pragma unroll
        for (int q = 0; q < 4; ++q) {
            const int t = hh * 4 + q; float x[8], ss = 0.f;
#pragma unroll
            for (int e = 0; e < 8; ++e) { x[e] = hb[t * 512 + e * 64 + lane]; ss += x[e] * x[e]; }
            ss = wave_sum(ss);
            const float rs = rsqrtf(ss * (1.0f / 512) + 1e-6f);
            bf16_t* zp = PROJ + (row0 + t) * DIN + C_ZB;
#pragma unroll
            for (int e = 0; e < 8; ++e) { const int ch = e * 64 + lane; const float z = bf2f(zp[ch]); zp[ch] = f2bf(x[e] * rs * go[ch] * siluf_(z)); }
        }
    }
}
}

namespace att {
typedef short bf16x8 __attribute__((ext_vector_type(8)));
typedef short s16x4 __attribute__((ext_vector_type(4)));
typedef short v4i16_t __attribute__((ext_vector_type(4)));
typedef float f32x16 __attribute__((ext_vector_type(16)));
typedef unsigned u32x4 __attribute__((ext_vector_type(4)));
typedef float f32x2_t __attribute__((ext_vector_type(2)));
typedef __bf16 bf16x2_t __attribute__((ext_vector_type(2)));
typedef LAS const char* lds_cptr;
constexpr int KSLOT = 12288, VSLOT = 8192, LDS_K = 0, LDS_V = 2 * KSLOT, LDS_WS = LDS_V + 2 * VSLOT, LDS_OST = LDS_WS + 8 * 256, LDS_BYTES = LDS_OST + 8 * 4096;
__device__ __forceinline__ int crow(int r, int hi) { return (r & 3) + 8 * (r >> 2) + 4 * hi; }
__device__ __forceinline__ void glds16(const void* gsrc, unsigned lds_dst) { unsigned keep;
    asm volatile("s_mov_b32 %0, m0\n\ts_mov_b32 m0, %2\n\ts_nop 0\n\tglobal_load_lds_dwordx4 %1, off\n\ts_mov_b32 m0, %0" : "=&s"(keep) : "v"(gsrc), "s"(lds_dst) : "memory"); }
__device__ __forceinline__ unsigned cvtpk(float lo, float hi) { f32x2_t v = {lo, hi}; bf16x2_t b = __builtin_convertvector(v, bf16x2_t); return __builtin_bit_cast(unsigned, b); }
__device__ __forceinline__ s16x4 vtr(lds_cptr p) { return __builtin_bit_cast(s16x4, __builtin_amdgcn_ds_read_tr16_b64_v4i16((LAS v4i16_t*)p)); }
#define ATT_WAITB() asm volatile("s_waitcnt vmcnt(0) lgkmcnt(0)\n\ts_barrier" ::: "memory")

template <int THR>
__device__ __forceinline__ void attn_unit(bf16_t* Qb, const bf16_t* Kb, const bf16_t* Vb, int b, int h, int qb, LAS char* shm) {
    const int tid = otid(), lane = tid & 63, r32 = lane & 31, hi = lane >> 5;
    const int wid = __builtin_amdgcn_readfirstlane(tid >> 6);
    const size_t rowb = (size_t)b * SEQ; const int q0 = qb * 256;
    bf16_t* Qw = Qb + ((rowb + q0 + wid * 32) * 8 + h) * 96;
    const bf16_t* Kh = Kb + (rowb * 8 + h) * 96;
    const bf16_t* Vh = Vb + (rowb * 8 + h) * 64;
    const unsigned lds0 = (unsigned)(size_t)shm;
    LAS float* wsf = (LAS float*)(shm + LDS_WS) + wid * 64;
    const bf16_t* ksrc = Kh + (size_t)lane * 768 + wid * 8;
    const bf16_t* vsrc = Vh + (size_t)(16 * (wid & 3) + (lane >> 2)) * 512 + (wid >> 2) * 32 + (lane & 3) * 8;
    const unsigned kdst = lds0 + LDS_K + wid * 1024, vdst = lds0 + LDS_V + wid * 1024;
#define ATT_DMA(t, sl) do { glds16(ksrc + (size_t)(t) * 64 * 768, (unsigned)__builtin_amdgcn_readfirstlane(kdst + (sl) * KSLOT)); \
        if (wid < 4) glds16(ksrc + (size_t)(t) * 64 * 768 + 64, (unsigned)__builtin_amdgcn_readfirstlane(kdst + (sl) * KSLOT + 8192)); \
        glds16(vsrc + (size_t)(t) * 64 * 512, (unsigned)__builtin_amdgcn_readfirstlane(vdst + (sl) * VSLOT)); } while (0)
    const int NT = 4 * (qb + 1);
    ATT_DMA(0, 0);
    bf16x8 qr[6];
#pragma unroll
    for (int d0 = 0; d0 < 6; ++d0) qr[d0] = *(const bf16x8*)(Qw + (size_t)r32 * 768 + d0 * 16 + hi * 8);
    float m = -INFINITY, l = 0.f; f32x16 o[2];
#pragma unroll
    for (int r = 0; r < 16; ++r) { o[0][r] = 0.f; o[1][r] = 0.f; }
    const int qrel = wid * 32 + r32;
    const lds_cptr kp0 = (lds_cptr)shm + LDS_K + hi * 1024 + r32 * 16;
    const lds_cptr vp0 = (lds_cptr)shm + LDS_V + ((lane >> 4) & 1) * 32 + (lane & 3) * 8 + (4 * hi + ((lane & 15) >> 2)) * 64;
    for (int t = 0; t < NT; ++t) {
        const int sl = t & 1;
        ATT_WAITB();
        if (t + 1 < NT) ATT_DMA(t + 1, sl ^ 1);
        const int jb = t - (NT - 4);
        if (jb >= 1 && 64 * jb > wid * 32 + 31) continue;
        f32x16 p0, p1;
#pragma unroll
        for (int r = 0; r < 16; ++r) { p0[r] = 0.f; p1[r] = 0.f; }
        const lds_cptr kp = kp0 + sl * KSLOT;
#pragma unroll
        for (int d0 = 0; d0 < 6; ++d0) {
            const bf16x8 k0 = *(const LAS bf16x8*)(kp + d0 * 2048), k1 = *(const LAS bf16x8*)(kp + d0 * 2048 + 512);
            p0 = __builtin_amdgcn_mfma_f32_32x32x16_bf16(k0, qr[d0], p0, 0, 0, 0);
            p1 = __builtin_amdgcn_mfma_f32_32x32x16_bf16(k1, qr[d0], p1, 0, 0, 0);
        }
        if (jb >= 0) {
            const int kb = 64 * jb + 4 * hi;
#pragma unroll
            for (int r = 0; r < 16; ++r) { const int kv = kb + (r & 3) + 8 * (r >> 2); if (kv > qrel) p0[r] = -INFINITY; if (kv + 32 > qrel) p1[r] = -INFINITY; }
        }
        float mx = fmaxf(p0[0], p1[0]);
#pragma unroll
        for (int r = 1; r < 16; ++r) mx = fmaxf(mx, fmaxf(p0[r], p1[r]));
        { float x, y; swap32(mx, x, y); mx = fmaxf(x, y); }
        if (__any(mx > m + (float)THR)) {
            const float mn = fmaxf(m, mx), alpha = __builtin_amdgcn_exp2f(m - mn);
            m = mn; l *= alpha;
            if (hi == 0) wsf[r32] = alpha;
#pragma unroll
            for (int r = 0; r < 16; ++r) { const float f = wsf[crow(r, hi)]; o[0][r] *= f; o[1][r] *= f; }
        }
        float ps = 0.f;
#pragma unroll
        for (int r = 0; r < 16; ++r) { p0[r] = __builtin_amdgcn_exp2f(p0[r] - m); p1[r] = __builtin_amdgcn_exp2f(p1[r] - m); ps += p0[r] + p1[r]; }
        l += ps;
        u32x4 pw[4];
#pragma unroll
        for (int q = 0; q < 4; ++q) { pw[0][q] = cvtpk(p0[2 * q], p0[2 * q + 1]); pw[1][q] = cvtpk(p0[8 + 2 * q], p0[9 + 2 * q]); pw[2][q] = cvtpk(p1[2 * q], p1[2 * q + 1]); pw[3][q] = cvtpk(p1[8 + 2 * q], p1[9 + 2 * q]); }
        const lds_cptr vp = vp0 + sl * VSLOT;
#pragma unroll
        for (int d0 = 0; d0 < 2; ++d0)
#pragma unroll
            for (int ks = 0; ks < 4; ++ks) {
                const s16x4 lo = vtr(vp + d0 * 4096 + ks * 1024), hh = vtr(vp + d0 * 4096 + ks * 1024 + 512);
                const bf16x8 vf = (bf16x8){lo[0], lo[1], lo[2], lo[3], hh[0], hh[1], hh[2], hh[3]};
                o[d0] = __builtin_amdgcn_mfma_f32_32x32x16_bf16(__builtin_bit_cast(bf16x8, pw[ks]), vf, o[d0], 0, 0, 0);
            }
    }
    { float x, y; swap32(l, x, y); l = x + y; }
    if (hi == 0) wsf[32 + r32] = l;
    float rli[16];
#pragma unroll
    for (int r = 0; r < 16; ++r) rli[r] = 1.0f / wsf[32 + crow(r, hi)];
    LAS bf16_t* stg = (LAS bf16_t*)(shm + LDS_OST) + wid * 2048;
#pragma unroll
    for (int r = 0; r < 16; ++r) { const int orow = crow(r, hi);
#pragma unroll
        for (int d0 = 0; d0 < 2; ++d0) stg[orow * 64 + d0 * 32 + r32] = f2bf(o[d0][r] * rli[r]); }
#pragma unroll
    for (int i = 0; i < 4; ++i) { const int row = i * 8 + (lane >> 3), ch = lane & 7; const u32x4 v = *(const LAS u32x4*)(stg + row * 64 + ch * 8); *(u32x4*)(Qw + (size_t)row * 768 + ch * 8) = v; }
    asm volatile("s_waitcnt lgkmcnt(0)\n\ts_barrier" ::: "memory");
#undef ATT_DMA
}
}

__global__ void __launch_bounds__(512, 2) fwd_kernel(Args A) {
    extern __shared__ __attribute__((aligned(16))) unsigned char smem[];
    float* lds = (float*)smem;
    volatile LAS unsigned* xbw = (volatile LAS unsigned*)(smem + 147456 - 16);
    unsigned* ctl = (unsigned*)(ARG_WS + WS_CTL);
    const int tid = threadIdx.x;
    if (tid == 0) { xbw[0] = 0u; xbw[1] = 0u; xbw[2] = 0u; xbw[3] = 0u; }
    __syncthreads();
    XcdBarrier bar = xcd_barrier_post(ctl, xbw);
    LAS int* s_unit = (LAS int*)(smem + 147456 - 32);

    bf16_t* PROJ = (bf16_t*)(ARG_WS + WS_PROJ);
    bf16_t* XN = (bf16_t*)(ARG_WS + WS_XN);
    float* RSTD = (float*)(ARG_WS + WS_RSTD);
    float* rope = (float*)(ARG_WS + WS_ROPE);
    const int nwaves = gridDim.x * 8;
#define PHASE_IDS() const int ptid = otid(), lane = ptid & 63, wv = ptid >> 6, gw = blockIdx.x * 8 + wv; (void)lane; (void)gw

    for (int idx = blockIdx.x * 512 + otid(); idx < SEQ * 16; idx += gridDim.x * 512) {
        const int t = idx >> 4, i = idx & 15;
        const float inv = powf(10000.0f, -((float)i * 2.0f / 32.0f));
        const float ang = (float)t * inv;
        const double twopi = 6.283185307179586476925286766559;
        double rr = (double)ang; rr -= twopi * floor(rr / twopi + 0.5);
        const double r2 = rr * rr; double ts = rr, ss = rr, tc = 1.0, cc = 1.0;
        for (int n = 1; n <= 13; ++n) { ts *= -r2 / (double)((2 * n) * (2 * n + 1)); ss += ts; tc *= -r2 / (double)((2 * n - 1) * (2 * n)); cc += tc; }
        rope[idx * 2] = (float)cc; rope[idx * 2 + 1] = (float)ss;
    }

    for (int l = 0; l < DEPTH; ++l) {
        { const float* W = ARG(2) + (size_t)l * DM * DIN;
          transpose_w(DM, NPAD_IN, (bf16_t*)(ARG_WS + WS_WIN) + (size_t)l * NPAD_IN * DM, [=](int k, int n) -> float { return n < DIN ? W[(size_t)k * DIN + orig_col(n)] : 0.f; }, lds); }
        { const float* W = ARG(26) + (size_t)l * DMIX * DM;
          transpose_w(DMIX, DM, (bf16_t*)(ARG_WS + WS_WOUT) + (size_t)l * DM * DMIX, [=](int k, int n) -> float { return W[(size_t)k * DM + n]; }, lds); }
        { const float* qg = ARG(21) + (size_t)l * QL; const float* wuq = ARG(22) + (size_t)l * QL * 768;
          const float* kg = ARG(23) + (size_t)l * KVL; const float* wukv = ARG(24) + (size_t)l * KVL * 1024;
          transpose_w(KMLA, NMLA, (bf16_t*)(ARG_WS + WS_WMLA) + (size_t)l * NMLA * KMLA, [=](int k, int n) -> float {
              if (n < 768) return k < QL ? wuq[(size_t)k * 768 + n] * qg[k] : 0.f;
              return k >= QL ? wukv[(size_t)(k - QL) * 1024 + (n - 768)] * kg[k - QL] : 0.f; }, lds); }
    }
    { const float* ga = ARG(15); const float* gx = ARG(17);
      transpose_w(64, DEPTH * 8 * 64, (bf16_t*)(ARG_WS + WS_GAT), [=](int k, int n) -> float { return ga[((size_t)(n >> 6) * 64 + k) * 64 + (n & 63)]; }, lds);
      transpose_w(64, DEPTH * 8 * 64, (bf16_t*)(ARG_WS + WS_GAT) + (size_t)DEPTH * 8 * 64 * 64, [=](int k, int n) -> float { return gx[((size_t)(n >> 6) * 64 + k) * 64 + (n & 63)]; }, lds); }
    xcd_barrier(bar);

    for (int l = 0; l < DEPTH; ++l) {
        const float* hsrc = (l == 0) ? ARG(0) : ARG_OUT;
        {
            PHASE_IDS();
            const float* g = ARG(1) + (size_t)l * DM;
            for (int row = gw; row < MTOK; row += nwaves) {
                float4 v[4]; float ss = 0.f;
#pragma unroll
                for (int q = 0; q < 4; ++q) { v[q] = *(const float4*)&hsrc[(size_t)row * DM + q * 256 + lane * 4]; ss += v[q].x * v[q].x + v[q].y * v[q].y + v[q].z * v[q].z + v[q].w * v[q].w; }
                ss = wave_sum(ss);
                const float rs = rsqrtf(ss * (1.0f / DM) + 1e-6f);
#pragma unroll
                for (int q = 0; q < 4; ++q) {
                    const float4 gg = *(const float4*)&g[q * 256 + lane * 4];
                    ushort4 o; o.x = f2bf(v[q].x * rs * gg.x); o.y = f2bf(v[q].y * rs * gg.y); o.z = f2bf(v[q].z * rs * gg.z); o.w = f2bf(v[q].w * rs * gg.w);
                    *(ushort4*)&XN[(size_t)row * DM + q * 256 + lane * 4] = o;
                }
            }
        }
        xcd_barrier(bar);
        {
            pg8::Gemm g{XN, (const bf16_t*)(ARG_WS + WS_WIN) + (size_t)l * NPAD_IN * DM, MTOK, NPAD_IN, DM, DM, DM};
            pg8::StaticOrder S; S.init(MTOK, NPAD_IN, (int)gridDim.x, (int)blockIdx.x);
            pg8::EpiProj E{PROJ, DIN, DIN};
            pg8::gemm_phase<pg8::EpiProj, pg8::StaticOrder, true, true>((PG8_LAS unsigned char*)smem, g, S, E);
        }
        xcd_barrier(bar);
        {
            PHASE_IDS();
            bf16_t* Kb = (bf16_t*)(ARG_WS + WS_K);
            for (int row = gw; row < MTOK; row += nwaves) {
                float sq = 0.f, sk = 0.f;
#pragma unroll
                for (int q = 0; q < 4; ++q) { const float x = bf2f(PROJ[(size_t)row * DIN + C_QL + q * 64 + lane]); sq += x * x; }
#pragma unroll
                for (int q = 0; q < 2; ++q) { const float x = bf2f(PROJ[(size_t)row * DIN + C_KVL + q * 64 + lane]); sk += x * x; }
                sq = wave_sum(sq); sk = wave_sum(sk);
                if (lane == 0) { RSTD[(size_t)row * 2] = rsqrtf(sq * (1.0f / QL) + 1e-6f); RSTD[(size_t)row * 2 + 1] = rsqrtf(sk * (1.0f / KVL) + 1e-6f); }
                {
                    const int t = row % SEQ, i = lane & 15, hsel = lane >> 4;
                    const float cs = rope[(t * 16 + i) * 2], sn = rope[(t * 16 + i) * 2 + 1];
                    const float x1 = bf2f(PROJ[(size_t)row * DIN + C_KR + i]), x2 = bf2f(PROJ[(size_t)row * DIN + C_KR + 16 + i]);
                    const bf16_t o1 = f2bf(x1 * cs - x2 * sn), o2 = f2bf(x1 * sn + x2 * cs);
#pragma unroll
                    for (int q = 0; q < 2; ++q) { bf16_t* p = Kb + ((size_t)row * 8 + hsel + 4 * q) * 96 + 64; p[i] = o1; p[16 + i] = o2; }
                }
            }
        }
        xcd_barrier(bar);
        {
            int kmla = KMLA; asm volatile("" : "+s"(kmla));
            pg8::Gemm g{PROJ + C_QL, (const bf16_t*)(ARG_WS + WS_WMLA) + (size_t)l * NMLA * KMLA, MTOK, NMLA, kmla, DIN, KMLA};
            pg8::StaticOrder S; S.init(MTOK, NMLA, (int)gridDim.x, (int)blockIdx.x);
            pg8::EpiMla E{(bf16_t*)(ARG_WS + WS_Q), (bf16_t*)(ARG_WS + WS_K), (bf16_t*)(ARG_WS + WS_V), RSTD, rope, 0.10206207261596577f * 1.4426950408889634f};
            pg8::gemm_phase<pg8::EpiMla, pg8::StaticOrder, true, true>((PG8_LAS unsigned char*)smem, g, S, E);
        }
        xcd_barrier(bar);
        {
            unsigned* qw = ctl + CW_QUEUE + 64 * (2 * l);
            for (;;) {
                __syncthreads();
                if (threadIdx.x == 0) *s_unit = (int)atomicAdd(qw, 1u);
                __syncthreads();
                const int u = *s_unit;
                if (u >= 64 + 1024) break;
                if (u < 64) rwkv_unit(A, l, u >> 3, u & 7, lds);
                else { const int a = u - 64; lru::unit<false>(l, a >> 7, a & 127, (LAS char*)smem); }
            }
        }
        xcd_barrier(bar);
        {
            unsigned* qw = ctl + CW_QUEUE + 64 * (2 * l + 1);
            for (;;) {
                __syncthreads();
                if (threadIdx.x == 0) *s_unit = (int)atomicAdd(qw, 1u);
                __syncthreads();
                const int u = *s_unit;
                if (u >= 1024 + 1024) break;
                if (u < 1024) lru::unit<true>(l, u >> 7, u & 127, (LAS char*)smem);
                else { const int a = u - 1024; att::attn_unit<ATT_THR>((bf16_t*)(ARG_WS + WS_Q), (const bf16_t*)(ARG_WS + WS_K), (const bf16_t*)(ARG_WS + WS_V), (a & 63) >> 3, a & 7, 15 - (a >> 6), (LAS char*)smem); }
            }
        }
        xcd_barrier(bar);
        {
            const bf16_t* OATT = (const bf16_t*)(ARG_WS + WS_Q);
            const float* gc = ARG(25) + (size_t)l * 512;
            PHASE_IDS();
            for (int row = gw; row < MTOK; row += nwaves) {
                float xc[8], sc = 0.f;
#pragma unroll
                for (int q = 0; q < 8; ++q) { xc[q] = bf2f(OATT[((size_t)row * 8 + q) * 96 + lane]); sc += xc[q] * xc[q]; }
                sc = wave_sum(sc);
                const float rc = rsqrtf(sc * (1.0f / 512) + 1e-6f);
#pragma unroll
                for (int q = 0; q < 8; ++q) {
                    const int c = q * 64 + lane;
                    const float zc = bf2f(PROJ[(size_t)row * DIN + C_ZC + c]);
                    PROJ[(size_t)row * DIN + C_ZC + c] = f2bf(xc[q] * rc * gc[c] * siluf_(zc));
                }
            }
        }
        xcd_barrier(bar);
        {
            pg8::Gemm g{PROJ + C_ZA, (const bf16_t*)(ARG_WS + WS_WOUT) + (size_t)l * DM * DMIX, MTOK, DM, DMIX, DIN, DMIX};
            pg8::StaticOrder S; S.init(MTOK, DM, (int)gridDim.x, (int)blockIdx.x);
            pg8::EpiResid E{ARG_OUT, hsrc, DM};
            pg8::gemm_phase<pg8::EpiResid, pg8::StaticOrder, true, true>((PG8_LAS unsigned char*)smem, g, S, E);
        }
        xcd_barrier(bar);
    }
    {
        const float* g = ARG(27);
        PHASE_IDS();
        for (int row = gw; row < MTOK; row += nwaves) {
            float4 v[4]; float ss = 0.f;
#pragma unroll
            for (int q = 0; q < 4; ++q) { v[q] = *(const float4*)&ARG_OUT[(size_t)row * DM + q * 256 + lane * 4]; ss += v[q].x * v[q].x + v[q].y * v[q].y + v[q].z * v[q].z + v[q].w * v[q].w; }
            ss = wave_sum(ss);
            const float rs = rsqrtf(ss * (1.0f / DM) + 1e-6f);
#pragma unroll
            for (int q = 0; q < 4; ++q) {
                const float4 gg = *(const float4*)&g[q * 256 + lane * 4];
                float4 o; o.x = v[q].x * rs * gg.x; o.y = v[q].y * rs * gg.y; o.z = v[q].z * rs * gg.z; o.w = v[q].w * rs * gg.w;
                *(float4*)&ARG_OUT[(size_t)row * DM + q * 256 + lane * 4] = o;
            }
        }
    }
}

extern "C" void kernel_launch(void* const* d_in, const int* in_sizes, int n_in, void* d_out, int out_size, void* d_ws, size_t ws_size, hipStream_t stream) {
    (void)in_sizes; (void)n_in; (void)out_size; (void)ws_size;
    constexpr int kDynLds = 147456;
    static int grid = 0;
    if (!grid) {
        int dev = 0, cus = 0;
        hipGetDevice(&dev);
        hipDeviceGetAttribute(&cus, hipDeviceAttributeMultiprocessorCount, dev);
        hipFuncSetAttribute((const void*)fwd_kernel, hipFuncAttributeMaxDynamicSharedMemorySize, kDynLds);
        int per_cu = 0;
        hipOccupancyMaxActiveBlocksPerMultiprocessor(&per_cu, fwd_kernel, 512, kDynLds);
        if (per_cu < 1) fprintf(stderr, "occupancy query says %d\n", per_cu);
        grid = cus > 0 ? cus : 256;
    }
    hipMemsetAsync(d_ws, 0, CTL_BYTES, stream);
    Args a;
    memset(&a, 0, sizeof(a));
    for (int i = 0; i < 28; ++i) a.in[i] = (const float*)d_in[i];
    a.out = (float*)d_out;
    a.ws = (unsigned char*)d_ws;
    hipLaunchKernelGGL(fwd_kernel, dim3(grid), dim3(512), kDynLds, stream, a);
}
```

```cpp
#include <hip/hip_runtime.h>
#include <stdint.h>
#include <cstdio>
#include <cstring>

constexpr int DM = 1024, NB = 8, SEQ = 4096, DEPTH = 4, MTOK = NB * SEQ;
constexpr int GW = 512, HD = 64, NH = 8, DMIX = 1536, DIN = 4128;
constexpr int QL = 256, KVL = 128;
constexpr int C_R = 0, C_K = 512, C_V = 1024, C_WL = 1536, C_AL = 1600, C_UB = 1664, C_QL = 2176, C_KVL = 2432, C_KR = 2560,
              C_ZA = 2592, C_ZB = 3104, C_ZC = 3616;
__device__ __forceinline__ int orig_col(int c) {
    if (c < 1664) return c;
    if (c < 2176) return c - 1664 + 2176;
    if (c < 2432) return c - 2176 + 3200;
    if (c < 2560) return c - 2432 + 3456;
    if (c < 2592) return c - 2560 + 3584;
    if (c < 3104) return c - 2592 + 1664;
    if (c < 3616) return c - 3104 + 2688;
    return c;
}
constexpr size_t MiB = 1u << 20;
constexpr size_t WS_CTL = 0, CTL_BYTES = 65536;
constexpr size_t WS_ROPE = 1 * MiB;
constexpr size_t WS_RSTD = 2 * MiB;
constexpr size_t WS_WMLA = 3 * MiB;
constexpr size_t WS_PROJ = 16 * MiB;
constexpr size_t WS_XN = 274 * MiB;
constexpr size_t WS_K = 274 * MiB;
constexpr size_t WS_V = 322 * MiB;
constexpr size_t WS_Q = 354 * MiB;
constexpr size_t WS_W2T = 2 * MiB + 256 * 1024;
constexpr size_t WS_BON = 8 * MiB + 512 * 1024;
constexpr size_t WS_SAVA = 14 * MiB;
constexpr size_t WS_RWD = 480 * MiB;
constexpr size_t WS_GAT = 9 * MiB + 512 * 1024;
constexpr size_t WS_LSUM = 10 * MiB;
constexpr size_t WS_RWP = 402 * MiB;
constexpr size_t WS_WIN = 434 * MiB;
constexpr size_t WS_WOUT = 468 * MiB;
constexpr size_t WS_FREE = 480 * MiB;
constexpr int NPAD_IN = 4352, NMLA = 1792, KMLA = 384;
constexpr int CW_QUEUE = 8192;
#ifndef ATT_THR
#define ATT_THR 8
#endif

typedef unsigned short bf16_t;
__device__ __forceinline__ float bf2f(bf16_t v) { return __builtin_bit_cast(float, (unsigned)v << 16); }
__device__ __forceinline__ bf16_t f2bf(float f) { unsigned u = __builtin_bit_cast(unsigned, f); return (bf16_t)((u + 0x7fffu + ((u >> 16) & 1u)) >> 16); }
template <int MASK> __device__ __forceinline__ float shx(float v) {
    static_assert(MASK < 32, "shx: within 32 lanes");
    return __builtin_bit_cast(float, __builtin_amdgcn_ds_swizzle(__builtin_bit_cast(int, v), (MASK << 10) | 0x1f));
}
__device__ __forceinline__ void swap32(float v, float& x, float& y) {
    auto rr = __builtin_amdgcn_permlane32_swap(__builtin_bit_cast(unsigned, v), __builtin_bit_cast(unsigned, v), false, false);
    unsigned a = rr[0], b = rr[1]; asm volatile("" : "+v"(a), "+v"(b));
    x = __builtin_bit_cast(float, a); y = __builtin_bit_cast(float, b);
}
__device__ __forceinline__ float wave_sum(float v) {
    v += shx<1>(v); v += shx<2>(v); v += shx<4>(v); v += shx<8>(v); v += shx<16>(v);
    float x, y; swap32(v, x, y);
    return x + y;
}
__device__ __forceinline__ float sigmoidf_(float x) { return 1.0f / (1.0f + expf(-x)); }
__device__ __forceinline__ float softplusf_(float x) { return x > 20.f ? x : log1pf(expf(x)); }
__device__ __forceinline__ float siluf_(float x) { return x / (1.0f + expf(-x)); }

__device__ __forceinline__ int otid() { int t = threadIdx.x; asm volatile("" : "+v"(t)); return t; }
template <int K> __device__ __forceinline__ const float* argp() {
    int k = K; asm volatile("" : "+s"(k));
    return (const float*)(((const unsigned long long*)__builtin_amdgcn_kernarg_segment_ptr())[k]);
}
#define ARG(k) argp<k>()
#define ARG_OUT ((float*)argp<28>())
#define ARG_WS ((unsigned char*)argp<29>())

#define XB_TMO      128
#define XB_XCNT(j)  (256  + 64 * (j))
#define XB_XSUB(j)  (1280 + 64 * (j))
#define XB_XGEN(j)  (2304 + 64 * (j))
#define XB_TOP      3328
#define XB_TOPGEN   3392
#define XCD_BAR_WORDS 3456
#define XB_SPIN_CAP (1u << 24)
#define LAS __attribute__((address_space(3)))

__device__ __forceinline__ unsigned xb_ld(unsigned* p)              { return __hip_atomic_load(p, __ATOMIC_RELAXED, __HIP_MEMORY_SCOPE_AGENT); }
__device__ __forceinline__ unsigned xb_add(unsigned* p, unsigned v) { return __hip_atomic_fetch_add(p, v, __ATOMIC_RELAXED, __HIP_MEMORY_SCOPE_AGENT); }
__device__ __forceinline__ unsigned xb_xcc_id() { return (unsigned)__builtin_amdgcn_s_getreg((3 << 11) | 20) & 0xFu; }
#define XB_SPIN(cond, bar) do { unsigned _sp = 0; while (cond) { __builtin_amdgcn_s_sleep(1); \
    if ((++_sp & 255u) == 0u) { if (xb_ld(&(bar)[XB_TMO])) break; if (_sp > XB_SPIN_CAP) { atomicAdd(&(bar)[XB_TMO], 1u); break; } } } } while (0)

struct XcdBarrier { unsigned* bar; unsigned x; volatile LAS unsigned* st; };

__device__ __forceinline__ XcdBarrier xcd_barrier_post(unsigned* bar, volatile LAS unsigned* st) {
    XcdBarrier b; b.bar = bar; b.x = xb_xcc_id(); b.st = st;
    if (threadIdx.x == 0) (void)xb_add(&bar[XB_XCNT(b.x)], 1u);
    return b;
}
__device__ __forceinline__ void xcd_barrier_complete(unsigned* bar, unsigned x, unsigned& nloc, unsigned& nx) {
    const unsigned G = gridDim.x * gridDim.y * gridDim.z;
    unsigned sum, cnt, mine, sp = 0u;
    for (;;) {
        sum = 0u; cnt = 0u; mine = 0u;
#pragma unroll
        for (unsigned j = 0; j < 16; ++j) { const unsigned c = xb_ld(&bar[XB_XCNT(j)]); sum += c; cnt += (c > 0u) ? 1u : 0u; mine = (j == x) ? c : mine; }
        if (sum == G) break;
        __builtin_amdgcn_s_sleep(1);
        if ((++sp & 255u) == 0u) { if (xb_ld(&bar[XB_TMO])) break; if (sp > XB_SPIN_CAP) { atomicAdd(&bar[XB_TMO], 1u); break; } }
    }
    nloc = mine > 0u ? mine : 1u; nx = cnt > 0u ? cnt : 1u;
}
__device__ __forceinline__ void xcd_barrier(const XcdBarrier& b) {
    asm volatile("s_waitcnt vmcnt(0)" ::: "memory");
    __syncthreads();
    if (threadIdx.x == 0) {
        unsigned* bar = b.bar;
        __builtin_amdgcn_s_waitcnt(0);
        const unsigned bx = (unsigned)__builtin_amdgcn_readfirstlane((int)xb_xcc_id());
        unsigned nloc = b.st[0], nx = b.st[1];
        if (nloc == 0u) { xcd_barrier_complete(bar, bx, nloc, nx); b.st[0] = nloc; b.st[1] = nx; }
        const unsigned old = xb_add(&bar[XB_XSUB(bx)], 1u);
        const unsigned gen = old / nloc;
        if (old + 1u == (gen + 1u) * nloc) {
            __builtin_amdgcn_fence(__ATOMIC_RELEASE, "agent");
            asm volatile("s_waitcnt vmcnt(0)" ::: "memory");
            const unsigned og = xb_add(&bar[XB_TOP], 1u);
            const unsigned tg = og / nx;
            if (og + 1u == (tg + 1u) * nx) xb_add(&bar[XB_TOPGEN], 1u);
            else XB_SPIN(xb_ld(&bar[XB_TOPGEN]) == tg, bar);
            __builtin_amdgcn_fence(__ATOMIC_ACQUIRE, "agent");
            xb_add(&bar[XB_XGEN(bx)], 1u);
            asm volatile("s_waitcnt vmcnt(0)" ::: "memory");
        } else {
            XB_SPIN(xb_ld(&bar[XB_XGEN(bx)]) == gen, bar);
            __builtin_amdgcn_fence(__ATOMIC_ACQUIRE, "agent");
            asm volatile("s_waitcnt vmcnt(0)" ::: "memory");
        }
    }
    __syncthreads();
}

struct Args {
    const float* in[28];
    float* out;
    unsigned char* ws;
};

namespace pg8 {
#define PG8_LAS __attribute__((address_space(3)))
typedef unsigned short bf16_t;
typedef short bf16x8 __attribute__((ext_vector_type(8)));
typedef float f32x4 __attribute__((ext_vector_type(4)));
typedef unsigned u32x4 __attribute__((ext_vector_type(4)));
constexpr int BM = 256, BK = 64, HALF = 128, HTB = HALF * BK * 2  , STAGE_BYTES = 8 * HTB, NXCD = 8, WGM = 8;

__host__ __device__ __forceinline__ int lds_byte(int r, int c) { const int st = (r >> 4) * 2 + (c >> 5), rr = r & 15, cc = c & 31, ob = rr * 64 + cc * 2; return st * 1024 + (ob ^ (((ob >> 9) & 1) << 5)); }
__host__ __device__ __forceinline__ void stage_rc(int b, int& R, int& C) { const int st = b / 1024, sb = b % 1024, swz = sb ^ (((sb >> 9) & 1) << 5); R = (st >> 1) * 16 + swz / 64; C = (st & 1) * 32 + (swz % 64) / 2; }
__host__ __device__ __forceinline__ int perm32(int rho) { const int n = rho >> 4, i = rho & 15; return 8 * (i >> 2) + 4 * n + (i & 3); }

struct Unit { int pm, pn; };
struct Gemm { const bf16_t* A; const bf16_t* Bt; int M, N, K, lda, ldb; };

struct StaticOrder {
    int nM, nN, nwg, G, c;
    __host__ __device__ void init(int M, int N, int G_, int c_) { nM = M / BM; nN = N / BM; nwg = nM * nN; G = G_; c = c_; }
    __host__ __device__ bool next(int i, Unit& u) const {
        const long L = (long)i * G + c; if (L >= nwg) return false;
        int wgid = (int)L; { const int q = nwg / NXCD, r = nwg % NXCD, xcd = wgid % NXCD, off = wgid / NXCD; wgid = (xcd < r ? xcd * (q + 1) : r * (q + 1) + (xcd - r) * q) + off; }
        const int nig = WGM * nN, gid = wgid / nig, fm = gid * WGM, gsz = (nM - fm) < WGM ? (nM - fm) : WGM;
        u.pm = fm + ((wgid % nig) % gsz); u.pn = (wgid % nig) / gsz; return true;
    }
    __device__ __forceinline__ void a_ready(const Unit&) const {}
    __device__ __forceinline__ void done(const Unit&) const {}
};

__device__ __forceinline__ unsigned cvt_pk_bf16(float lo, float hi) { unsigned r; asm volatile("v_cvt_pk_bf16_f32 %0, %1, %2" : "=v"(r) : "v"(lo), "v"(hi)); return r; }
template <class Epi, class Sched, bool ALIGN_EPI = false, bool SP2 = false>
__device__ __forceinline__ void gemm_phase(PG8_LAS unsigned char* lds, const Gemm g, const Sched& S, const Epi& E) {
    const int tid = otid(), wid = __builtin_amdgcn_readfirstlane(tid >> 6), lane = tid & 63, wr = wid >> 2, wc = wid & 3, fr = lane & 15, fq = lane >> 4;
    const int K = g.K, nt = K / BK;
    unsigned voffA[2], voffB[2];
#pragma unroll
    for (int i = 0; i < 2; ++i) { int R, C; stage_rc(tid * 16 + i * 8192, R, C); const int Rb = Epi::PERM ? ((R & ~31) + perm32(R & 31)) : R;
        voffA[i] = (unsigned)(R * g.lda + C) * 2u; voffB[i] = (unsigned)(Rb * g.ldb + C) * 2u; }
    const size_t kstep = (size_t)(BK * 2);
    const size_t hstepA = (size_t)HALF * g.lda * 2, hstepB = (size_t)HALF * g.ldb * 2;
    const size_t tstepA = 2 * hstepA, tstepB = 2 * hstepB;
    const unsigned ldsw = (unsigned)wid * 1024u;
    const int aoff = lds_byte(wr * 64 + fr, fq * 8), boff = lds_byte(wc * 32 + fr, fq * 8);
#define PG8_SA(b, h) (((b) * 2 + (h)) * HTB)
#define PG8_SB(b, h) ((4 + (b) * 2 + (h)) * HTB)
#define PG8_STAGE(bufoff, gbase, voff) do { _Pragma("unroll") for (int _i = 0; _i < 2; ++_i) \
        __builtin_amdgcn_global_load_lds((const unsigned*)((const char*)(gbase) + (voff)[_i]), (PG8_LAS unsigned*)(lds + (bufoff) + ldsw + _i * 8192), 16, 0, 0); } while (0)
#define PG8_LDA(dst, b, h) do { _Pragma("unroll") for (int m = 0; m < 4; ++m) _Pragma("unroll") for (int k = 0; k < 2; ++k) dst[m][k] = *(const PG8_LAS bf16x8*)(lds + PG8_SA(b, h) + aoff + m * 2048 + k * 1024); } while (0)
#define PG8_LDB(dst, b, h) do { _Pragma("unroll") for (int n = 0; n < 2; ++n) _Pragma("unroll") for (int k = 0; k < 2; ++k) dst[n][k] = *(const PG8_LAS bf16x8*)(lds + PG8_SB(b, h) + boff + n * 2048 + k * 1024); } while (0)
#define PG8_MMA(ai, bj, At, Bt) do { __builtin_amdgcn_s_setprio(1); _Pragma("unroll") for (int m = 0; m < 4; ++m) _Pragma("unroll") for (int n = 0; n < 2; ++n) _Pragma("unroll") for (int k = 0; k < 2; ++k) \
        acc[ai][bj][m][n] = __builtin_amdgcn_mfma_f32_16x16x32_bf16(Bt[n][k], At[m][k], acc[ai][bj][m][n], 0, 0, 0); __builtin_amdgcn_s_setprio(0); } while (0)
#define PG8_WAIT_V(n) asm volatile("s_waitcnt vmcnt(" #n ")" ::: "memory")
#define PG8_WAIT_L(n) asm volatile("s_waitcnt lgkmcnt(" #n ")" ::: "memory")
#define PG8_BAR __builtin_amdgcn_s_barrier()
#define PG8_SCHED __builtin_amdgcn_sched_barrier(0)
    Unit cur, nxt; int ui = 0;
    if (!S.next(0, cur)) return;
    f32x4 acc[2][2][4][2];
#pragma unroll
    for (int a = 0; a < 2; ++a)
#pragma unroll
        for (int b = 0; b < 2; ++b)
#pragma unroll
            for (int m = 0; m < 4; ++m)
#pragma unroll
                for (int n = 0; n < 2; ++n) acc[a][b][m][n] = (f32x4){0.f, 0.f, 0.f, 0.f};
    bf16x8 At[4][2], B0[2][2], B1[2][2];
    const char* cA = (const char*)g.A + (size_t)cur.pm * tstepA; const char* cB = (const char*)g.Bt + (size_t)cur.pn * tstepB;
    S.a_ready(cur);
    if constexpr (SP2) {
        PG8_STAGE(PG8_SB(0, 0), cB, voffB); PG8_STAGE(PG8_SB(0, 1), cB + hstepB, voffB); PG8_STAGE(PG8_SA(0, 0), cA, voffA); PG8_STAGE(PG8_SA(0, 1), cA + hstepA, voffA);
        if (wr == 1) PG8_BAR;
        PG8_WAIT_V(2); PG8_BAR;
        PG8_STAGE(PG8_SB(1, 0), cB + kstep, voffB); PG8_STAGE(PG8_SA(1, 0), cA + kstep, voffA); PG8_STAGE(PG8_SB(1, 1), cB + hstepB + kstep, voffB);
        PG8_WAIT_V(6); PG8_BAR;
    } else {
        PG8_STAGE(PG8_SB(0, 0), cB, voffB); PG8_STAGE(PG8_SA(0, 0), cA, voffA); PG8_STAGE(PG8_SB(0, 1), cB + hstepB, voffB); PG8_STAGE(PG8_SA(0, 1), cA + hstepA, voffA);
        if (wr == 1) PG8_BAR;
        PG8_WAIT_V(4); PG8_BAR;
        PG8_STAGE(PG8_SB(1, 0), cB + kstep, voffB); PG8_STAGE(PG8_SA(1, 0), cA + kstep, voffA); PG8_STAGE(PG8_SB(1, 1), cB + hstepB + kstep, voffB);
        PG8_WAIT_V(6); PG8_BAR;
    }
    for (;;) {
        const bool has_next = S.next(ui + 1, nxt);
        const char* nA = has_next ? (const char*)g.A + (size_t)nxt.pm * tstepA : cA; const char* nB = has_next ? (const char*)g.Bt + (size_t)nxt.pn * tstepB : cB;
        for (int t = 0; t < nt; t += 2) {
            const bool last = (t == nt - 2);
            const char* a1 = cA + (size_t)(t + 1) * kstep;
            const char* a2 = last ? nA : cA + (size_t)(t + 2) * kstep; const char* b2 = last ? nB : cB + (size_t)(t + 2) * kstep;
            const char* a3 = a2 + kstep; const char* b3 = b2 + kstep;
            if (last && has_next) S.a_ready(nxt);
            if constexpr (SP2) {
            PG8_LDB(B0, 0, 0); PG8_LDB(B1, 0, 1); PG8_SCHED; PG8_LDA(At, 0, 0); PG8_STAGE(PG8_SA(1, 1), a1 + hstepA, voffA);
            PG8_WAIT_V(8); PG8_WAIT_L(0); PG8_BAR; PG8_MMA(0, 0, At, B0); PG8_MMA(0, 1, At, B1); PG8_BAR; PG8_SCHED;
            PG8_LDA(At, 0, 1); PG8_STAGE(PG8_SB(0, 0), b2, voffB); PG8_STAGE(PG8_SB(0, 1), b2 + hstepB, voffB); PG8_STAGE(PG8_SA(0, 0), a2, voffA);
            PG8_WAIT_V(8); PG8_WAIT_L(0); PG8_BAR; PG8_MMA(1, 0, At, B0); PG8_MMA(1, 1, At, B1); PG8_BAR; PG8_SCHED;
            PG8_LDB(B0, 1, 0); PG8_LDB(B1, 1, 1); PG8_SCHED; PG8_LDA(At, 1, 0); PG8_STAGE(PG8_SA(0, 1), a2 + hstepA, voffA);
            PG8_WAIT_V(8); PG8_WAIT_L(0); PG8_BAR; PG8_MMA(0, 0, At, B0); PG8_MMA(0, 1, At, B1); PG8_BAR; PG8_SCHED;
            PG8_LDA(At, 1, 1); PG8_STAGE(PG8_SB(1, 0), b3, voffB); PG8_STAGE(PG8_SB(1, 1), b3 + hstepB, voffB); PG8_STAGE(PG8_SA(1, 0), a3, voffA);
            PG8_WAIT_V(8); PG8_WAIT_L(0); PG8_BAR; PG8_MMA(1, 0, At, B0); PG8_MMA(1, 1, At, B1); PG8_BAR; PG8_SCHED;
            } else {
            PG8_LDB(B0, 0, 0); PG8_SCHED; PG8_LDA(At, 0, 0); PG8_STAGE(PG8_SA(1, 1), a1 + hstepA, voffA);
            PG8_WAIT_L(8); PG8_BAR; PG8_WAIT_L(0); PG8_MMA(0, 0, At, B0); PG8_BAR; PG8_SCHED;
            PG8_LDB(B1, 0, 1); PG8_STAGE(PG8_SB(0, 0), b2, voffB);
            PG8_BAR; PG8_WAIT_L(0); PG8_MMA(0, 1, At, B1); PG8_BAR;
            PG8_LDA(At, 0, 1); PG8_STAGE(PG8_SA(0, 0), a2, voffA);
            PG8_BAR; PG8_WAIT_L(0); PG8_MMA(1, 0, At, B0); PG8_BAR; PG8_SCHED;
            PG8_STAGE(PG8_SB(0, 1), b2 + hstepB, voffB);
            PG8_WAIT_V(6); PG8_BAR; PG8_MMA(1, 1, At, B1); PG8_BAR;
            PG8_LDB(B0, 1, 0); PG8_SCHED; PG8_LDA(At, 1, 0); PG8_STAGE(PG8_SA(0, 1), a2 + hstepA, voffA);
            PG8_WAIT_L(8); PG8_BAR; PG8_WAIT_L(0); PG8_MMA(0, 0, At, B0); PG8_BAR; PG8_SCHED;
            PG8_LDB(B1, 1, 1); PG8_STAGE(PG8_SB(1, 0), b3, voffB);
            PG8_BAR; PG8_WAIT_L(0); PG8_MMA(0, 1, At, B1); PG8_BAR;
            PG8_LDA(At, 1, 1); PG8_STAGE(PG8_SA(1, 0), a3, voffA);
            PG8_BAR; PG8_WAIT_L(0); PG8_MMA(1, 0, At, B0); PG8_BAR; PG8_SCHED;
            PG8_STAGE(PG8_SB(1, 1), b3 + hstepB, voffB);
            PG8_WAIT_V(6); PG8_BAR; PG8_MMA(1, 1, At, B1); PG8_BAR;
            }
        }
        if constexpr (ALIGN_EPI) { if (wr == 0) PG8_BAR; }
        if constexpr (!Epi::AFTER_DRAIN) { E(acc, cur, wr, wc, fr, fq); S.done(cur); }
        if (!has_next) break;
#pragma unroll
        for (int a = 0; a < 2; ++a)
#pragma unroll
            for (int b = 0; b < 2; ++b)
#pragma unroll
                for (int m = 0; m < 4; ++m)
#pragma unroll
                    for (int n = 0; n < 2; ++n) acc[a][b][m][n] = (f32x4){0.f, 0.f, 0.f, 0.f};
        cur = nxt; cA = nA; cB = nB; ++ui;
        if constexpr (ALIGN_EPI) { if (wr == 1) PG8_BAR; }
    }
    PG8_WAIT_V(0);
    if constexpr (!ALIGN_EPI) { if (wr == 0) PG8_BAR; }
    PG8_BAR;
    if constexpr (Epi::AFTER_DRAIN) { E.fused(acc, cur, wr, wc, fr, fq, lds, wid, lane); S.done(cur); }
#undef PG8_SA
#undef PG8_SB
#undef PG8_STAGE
#undef PG8_LDA
#undef PG8_LDB
#undef PG8_MMA
#undef PG8_WAIT_V
#undef PG8_WAIT_L
#undef PG8_BAR
#undef PG8_SCHED
}
}

namespace pg8 {
struct EpiProj {
    static constexpr bool PERM = true, AFTER_DRAIN = false;
    bf16_t* O; int ldc; int ncols;
    __device__ __forceinline__ void operator()(const f32x4 (&acc)[2][2][4][2], const Unit& u, int wr, int wc, int fr, int fq) const {
        const int row0 = u.pm * BM + wr * 64 + fr, col0 = u.pn * BM + wc * 32 + 8 * fq;
#pragma unroll
        for (int ai = 0; ai < 2; ++ai)
#pragma unroll
            for (int m = 0; m < 4; ++m) { bf16_t* rowp = O + (size_t)(row0 + ai * HALF + m * 16) * ldc + col0;
#pragma unroll
                for (int bj = 0; bj < 2; ++bj) { const f32x4 v0 = acc[ai][bj][m][0], v1 = acc[ai][bj][m][1];
                    u32x4 w; w.x = cvt_pk_bf16(v0[0], v0[1]); w.y = cvt_pk_bf16(v0[2], v0[3]); w.z = cvt_pk_bf16(v1[0], v1[1]); w.w = cvt_pk_bf16(v1[2], v1[3]);
                    if (col0 + bj * HALF < ncols) *(u32x4*)(rowp + bj * HALF) = w; } }
    }
};
struct EpiResid {
    static constexpr bool PERM = false, AFTER_DRAIN = false;
    float* C; const float* R; int ldc;
    __device__ __forceinline__ void operator()(const f32x4 (&acc)[2][2][4][2], const Unit& u, int wr, int wc, int fr, int fq) const {
        const int row0 = u.pm * BM + wr * 64 + fr, col0 = u.pn * BM + wc * 32 + 4 * fq;
#pragma unroll
        for (int ai = 0; ai < 2; ++ai)
#pragma unroll
            for (int m = 0; m < 4; ++m) { const size_t off = (size_t)(row0 + ai * HALF + m * 16) * ldc + col0;
#pragma unroll
                for (int bj = 0; bj < 2; ++bj)
#pragma unroll
                    for (int n = 0; n < 2; ++n) { const f32x4 r = *(const f32x4*)(R + off + bj * HALF + n * 16); *(f32x4*)(C + off + bj * HALF + n * 16) = r + acc[ai][bj][m][n]; } }
    }
};
struct EpiMla {
    static constexpr bool PERM = false, AFTER_DRAIN = false;
    bf16_t* Q; bf16_t* K; bf16_t* V; const float* rstd; const float* rope; float c2;
    __device__ __forceinline__ void operator()(const f32x4 (&acc)[2][2][4][2], const Unit& u, int wr, int wc, int fr, int fq) const {
        const int row0 = u.pm * BM + wr * 64 + fr;
        typedef unsigned u32x2 __attribute__((ext_vector_type(2)));
#pragma unroll
        for (int ai = 0; ai < 2; ++ai)
#pragma unroll
            for (int m = 0; m < 4; ++m) {
                const int row = row0 + ai * HALF + m * 16;
                const float rq = rstd[(size_t)row * 2], rk = rstd[(size_t)row * 2 + 1];
#pragma unroll
                for (int bj = 0; bj < 2; ++bj) {
                    const int cg = u.pn * BM + bj * HALF + wc * 32;
                    f32x4 v0 = acc[ai][bj][m][0], v1 = acc[ai][bj][m][1];
                    if (u.pn < 3) {
                        v0 = v0 * rq; v1 = v1 * rq;
                        if (((cg >> 5) % 3) == 2) {
                            const int t = row & (SEQ - 1);
                            const f32x4 cs0 = *(const f32x4*)(rope + ((size_t)t * 16 + 4 * fq) * 2), cs1 = *(const f32x4*)(rope + ((size_t)t * 16 + 4 * fq) * 2 + 4);
                            const float c[4] = {cs0[0], cs0[2], cs1[0], cs1[2]}, sn[4] = {cs0[1], cs0[3], cs1[1], cs1[3]};
                            f32x4 o0, o1;
#pragma unroll
                            for (int j = 0; j < 4; ++j) { o0[j] = v0[j] * c[j] - v1[j] * sn[j]; o1[j] = v0[j] * sn[j] + v1[j] * c[j]; }
                            v0 = o0; v1 = o1;
                        }
                        v0 = v0 * c2; v1 = v1 * c2;
                        bf16_t* p = Q + (size_t)row * 768 + cg + 4 * fq;
                        u32x2 w0, w1; w0.x = cvt_pk_bf16(v0[0], v0[1]); w0.y = cvt_pk_bf16(v0[2], v0[3]); w1.x = cvt_pk_bf16(v1[0], v1[1]); w1.y = cvt_pk_bf16(v1[2], v1[3]);
                        *(u32x2*)p = w0; *(u32x2*)(p + 16) = w1;
                    } else {
                        v0 = v0 * rk; v1 = v1 * rk;
                        const int c = cg - 768, hh = c >> 7, d = (c & 127) + 4 * fq;
                        u32x2 w0, w1; w0.x = cvt_pk_bf16(v0[0], v0[1]); w0.y = cvt_pk_bf16(v0[2], v0[3]); w1.x = cvt_pk_bf16(v1[0], v1[1]); w1.y = cvt_pk_bf16(v1[2], v1[3]);
                        bf16_t* p = (d < 64) ? K + ((size_t)row * 8 + hh) * 96 + d : V + ((size_t)row * 8 + hh) * 64 + (d - 64);
                        *(u32x2*)p = w0; *(u32x2*)(p + 16) = w1;
                    }
                }
                asm volatile("" ::: "memory");
            }
    }
};
}

template <class SRC>
__device__ __forceinline__ void transpose_w(int K, int npad, bf16_t* WT, const SRC& src, float* lds) {
    const int tid = otid();
    const int tk = K / 64, tn = npad / 64;
    for (int u = blockIdx.x; u < tk * tn; u += gridDim.x) {
        const int k0 = (u % tk) * 64, n0 = (u / tk) * 64;
        __syncthreads();
        for (int idx = tid; idx < 4096; idx += 512) { const int kk = idx >> 6, nn = idx & 63; lds[kk * 65 + nn] = src(k0 + kk, n0 + nn); }
        __syncthreads();
        for (int idx = tid; idx < 4096; idx += 512) { const int nn = idx >> 6, kk = idx & 63; WT[(size_t)(n0 + nn) * K + k0 + kk] = f2bf(lds[kk * 65 + nn]); }
    }
}

template <class AL, class BL, class ST>
__device__ __forceinline__ void gemm_naive(int M, int N, int K, const AL& al, const BL& bl, const ST& st, float* lds) {
    float* As = lds;
    float* Bs = lds + 16 * 132;
    const int tid = otid(), ty = tid >> 4, tx = tid & 15;
    const int ntn = (N + 127) / 128, ntiles = (M / 128) * ntn;
    for (int u = blockIdx.x; u < ntiles; u += gridDim.x) {
        const int tm = u / ntn, tn = u % ntn;
        float acc[4][8];
#pragma unroll
        for (int i = 0; i < 4; ++i)
#pragma unroll
            for (int j = 0; j < 8; ++j) acc[i][j] = 0.f;
        for (int k0 = 0; k0 < K; k0 += 16) {
#pragma unroll
            for (int j = 0; j < 4; ++j) { const int idx = tid + j * 512, r = idx >> 4, k = idx & 15; As[k * 132 + r] = al(tm * 128 + r, k0 + k); }
#pragma unroll
            for (int j = 0; j < 4; ++j) { const int idx = tid + j * 512, k = idx >> 7, c = idx & 127; Bs[k * 132 + c] = bl(k0 + k, tn * 128 + c); }
            __syncthreads();
#pragma unroll 2
            for (int k = 0; k < 16; ++k) {
                const float4 a4 = *(const float4*)&As[k * 132 + ty * 4];
                const float4 b0 = *(const float4*)&Bs[k * 132 + tx * 8], b1 = *(const float4*)&Bs[k * 132 + tx * 8 + 4];
                const float av[4] = {a4.x, a4.y, a4.z, a4.w};
                const float bv[8] = {b0.x, b0.y, b0.z, b0.w, b1.x, b1.y, b1.z, b1.w};
#pragma unroll
                for (int i = 0; i < 4; ++i)
#pragma unroll
                    for (int j = 0; j < 8; ++j) acc[i][j] = fmaf(av[i], bv[j], acc[i][j]);
            }
            __syncthreads();
        }
#pragma unroll
        for (int i = 0; i < 4; ++i)
#pragma unroll
            for (int j = 0; j < 8; ++j) st(tm * 128 + ty * 4 + i, tn * 128 + tx * 8 + j, acc[i][j]);
    }
}

namespace rw {
typedef short bf16x8 __attribute__((ext_vector_type(8)));
typedef float f32x16 __attribute__((ext_vector_type(16)));
typedef float f32x4 __attribute__((ext_vector_type(4)));
typedef unsigned u32x2 __attribute__((ext_vector_type(2)));
typedef unsigned u32x4 __attribute__((ext_vector_type(4)));
constexpr int PB = 144, MB = 64 * PB;
constexpr int L_KKD = 0, L_RD = MB, L_BH = 2 * MB, L_KH = 3 * MB, L_BDT = 4 * MB, L_KDT = 5 * MB, L_VT = 6 * MB, L_KKDT = 7 * MB, L_BK = 8 * MB, L_WTT = 9 * MB, L_VTT = 10 * MB;
constexpr int L_AB = L_KKD, L_AK = L_BH, L_BB = L_KH, L_XWL = L_BK, L_XAL = L_WTT;
constexpr int L_F32 = 11 * MB;
constexpr int L_DEC = L_F32, L_AA = L_F32 + 17408, L_AKVT = L_F32, L_DIAG = L_F32 + 17408, L_TINV = L_DIAG + 4096;
constexpr int L_GC = L_F32 + 34816, L_SEG = L_GC + 256, L_END = L_SEG + 2048;
__device__ __forceinline__ int crow(int r, int hi) { return (r & 3) + 8 * (r >> 2) + 4 * hi; }
__device__ __forceinline__ unsigned pk2(float lo, float hi) { return (unsigned)f2bf(lo) | ((unsigned)f2bf(hi) << 16); }
#define RW_FRAG(base, row, ks) (*(const LAS bf16x8*)(shm + (base) + (row) * PB + (16 * (ks) + 8 * hi) * 2))
#define RW_MFMA(a, b, c) __builtin_amdgcn_mfma_f32_32x32x16_bf16(a, b, c, 0, 0, 0)

__device__ __forceinline__ void r1_unit(int l, int b, int h, int c, LAS char* shm) {
    const int tid = otid(), lane = tid & 63, r32 = lane & 31, hi = lane >> 5;
    const int wid = __builtin_amdgcn_readfirstlane(tid >> 6);
    bf16_t* PROJ = (bf16_t*)(ARG_WS + WS_PROJ);
    const size_t row0 = (size_t)b * SEQ + (size_t)c * 64;
    const int unit = (b * 8 + h) * 64 + c;
    const int ch = h * 64 + lane;
    const int tq = wid * 8;
    float xr[8], xk[8];
    __syncthreads();
    {
        const float* mu = ARG(3) + (size_t)l * 1664;
        const bf16_t* sav = (const bf16_t*)(ARG_WS + WS_SAVA) + ((size_t)b * 64 + c) * 1664;
        auto ldcol = [&](int col, float (&x)[8]) {
            float prv;
            if (tq == 0) prv = (c > 0) ? bf2f(sav[col]) : 0.f; else prv = bf2f(PROJ[(row0 + tq - 1) * DIN + col]);
            const float m = mu[col];
#pragma unroll
            for (int e = 0; e < 8; ++e) { const float cur = bf2f(PROJ[(row0 + tq + e) * DIN + col]); x[e] = cur + m * (prv - cur); prv = cur; }
        };
        float xv[8], xw[8], xa[8];
        ldcol(C_R + ch, xr); ldcol(C_K + ch, xk); ldcol(C_V + ch, xv); ldcol(C_WL + lane, xw); ldcol(C_AL + lane, xa);
        u32x4 vv; vv.x = pk2(xv[0], xv[1]); vv.y = pk2(xv[2], xv[3]); vv.z = pk2(xv[4], xv[5]); vv.w = pk2(xv[6], xv[7]);
        *(LAS u32x4*)(shm + L_VT + lane * PB + tq * 2) = vv;
#pragma unroll
        for (int e = 0; e < 8; ++e) {
            *(LAS bf16_t*)(shm + L_XWL + (tq + e) * PB + lane * 2) = f2bf(tanhf(xw[e]));
            *(LAS bf16_t*)(shm + L_XAL + (tq + e) * PB + lane * 2) = f2bf(xa[e]);
        }
    }
    __syncthreads();
    {
        const int p = wid >> 2, tl = wid & 3, tr = 32 * (tl >> 1), nc = 32 * (tl & 1);
        const bf16_t* wt = (const bf16_t*)(ARG_WS + WS_W2T) + (size_t)p * DEPTH * 512 * 64 + ((size_t)l * 512 + h * 64 + nc + r32) * 64;
        const float bias = ((p ? ARG(6) : ARG(4)) + (size_t)l * 512)[h * 64 + nc + r32];
        f32x16 acc;
#pragma unroll
        for (int r = 0; r < 16; ++r) acc[r] = bias;
        const int xb = p ? L_XAL : L_XWL;
#pragma unroll
        for (int ks = 0; ks < 4; ++ks) acc = RW_MFMA(RW_FRAG(xb, tr + r32, ks), *(const bf16x8*)(wt + 16 * ks + 8 * hi), acc);
        LAS float* dst = (LAS float*)(shm + (p ? L_AA : L_DEC));
#pragma unroll
        for (int r = 0; r < 16; ++r) dst[(tr + crow(r, hi)) * 68 + nc + r32] = acc[r];
    }
    __syncthreads();
    {
        const float kkc = (ARG(8) + (size_t)l * 512)[ch], kac = (ARG(9) + (size_t)l * 512)[ch], rkc = (ARG(10) + (size_t)l * 512)[ch];
        float* bon = (float*)(ARG_WS + WS_BON);
        float kkn[8], kpv[8], bbv[8], ld[8], lg[8];
        float run = 0.f;
#pragma unroll
        for (int e = 0; e < 8; ++e) {
            const float dec = ((const LAS float*)(shm + L_DEC))[(tq + e) * 68 + lane], aav = ((const LAS float*)(shm + L_AA))[(tq + e) * 68 + lane];
            const float lw = -softplusf_(-dec) - 0.5f;
            ld[e] = -expf(lw);
            const float av = sigmoidf_(aav);
            const float kkr = xk[e] * kkc;
            const float n2 = wave_sum(kkr * kkr);
            kkn[e] = kkr / fmaxf(sqrtf(n2), 1e-12f);
            kpv[e] = xk[e] * (1.0f + (av - 1.0f) * kac);
            bbv[e] = kkn[e] * av;
            const float bs = wave_sum(xr[e] * kpv[e] * rkc);
            if (lane == 0) bon[(row0 + tq + e) * 8 + h] = bs;
            run += ld[e]; lg[e] = run;
        }
        ((LAS float*)(shm + L_SEG))[wid * 64 + lane] = run;
        __syncthreads();
        float off = 0.f, tot = 0.f;
#pragma unroll
        for (int w = 0; w < 8; ++w) { const float sgm = ((const LAS float*)(shm + L_SEG))[w * 64 + lane]; tot += sgm; if (w < wid) off += sgm; }
        if (wid == 0) ((LAS float*)(shm + L_GC))[lane] = expf(tot);
        float tb[8], tk[8], tkk[8];
#pragma unroll
        for (int e = 0; e < 8; ++e) {
            const float L = off + lg[e];
            const float g = expf(L), gp = expf(L - ld[e]), ig = expf(-L), ge = expf(tot - L);
            const int t = tq + e;
            const float kkd = kkn[e] * gp;
            *(LAS bf16_t*)(shm + L_KKD + t * PB + lane * 2) = f2bf(kkd);
            *(LAS bf16_t*)(shm + L_RD + t * PB + lane * 2) = f2bf(xr[e] * g);
            *(LAS bf16_t*)(shm + L_BH + t * PB + lane * 2) = f2bf(bbv[e] * ig);
            *(LAS bf16_t*)(shm + L_KH + t * PB + lane * 2) = f2bf(kpv[e] * ig);
            tb[e] = bbv[e] * ge; tk[e] = kpv[e] * ge; tkk[e] = kkd;
        }
        u32x4 v;
        v.x = pk2(tb[0], tb[1]); v.y = pk2(tb[2], tb[3]); v.z = pk2(tb[4], tb[5]); v.w = pk2(tb[6], tb[7]); *(LAS u32x4*)(shm + L_BDT + lane * PB + tq * 2) = v;
        v.x = pk2(tk[0], tk[1]); v.y = pk2(tk[2], tk[3]); v.z = pk2(tk[4], tk[5]); v.w = pk2(tk[6], tk[7]); *(LAS u32x4*)(shm + L_KDT + lane * PB + tq * 2) = v;
        v.x = pk2(tkk[0], tkk[1]); v.y = pk2(tkk[2], tkk[3]); v.z = pk2(tkk[4], tkk[5]); v.w = pk2(tkk[6], tkk[7]); *(LAS u32x4*)(shm + L_KKDT + lane * PB + tq * 2) = v;
    }
    __syncthreads();
    {
        f32x16 acc[2];
#pragma unroll
        for (int q = 0; q < 2; ++q) {
            const int id = 2 * wid + q, mat = id >> 2, sub = id & 3, tr = 32 * (sub >> 1), sc = 32 * (sub & 1);
            const int ab = (mat < 2) ? L_KKD : L_RD, bb = (mat & 1) ? L_KH : L_BH;
#pragma unroll
            for (int r = 0; r < 16; ++r) acc[q][r] = 0.f;
#pragma unroll
            for (int ks = 0; ks < 4; ++ks) acc[q] = RW_MFMA(RW_FRAG(ab, tr + r32, ks), RW_FRAG(bb, sc + r32, ks), acc[q]);
        }
        __syncthreads();
#pragma unroll
        for (int q = 0; q < 2; ++q) {
            const int id = 2 * wid + q, mat = id >> 2, sub = id & 3, tr = 32 * (sub >> 1), sc = 32 * (sub & 1);
            const int ob = (mat == 0) ? L_AB : (mat == 1) ? L_AK : (mat == 2) ? L_BB : L_BK;
            const int s = sc + r32;
#pragma unroll
            for (int r = 0; r < 16; ++r) {
                const int t = tr + crow(r, hi);
                const bool keep = (mat < 2) ? (t > s) : (t >= s);
                const float v = keep ? acc[q][r] : 0.f;
                *(LAS bf16_t*)(shm + ob + t * PB + s * 2) = f2bf(v);
                if (mat == 0 && (t >> 4) == (s >> 4)) ((LAS float*)(shm + L_DIAG))[(t >> 4) * 256 + (t & 15) * 16 + (s & 15)] = v;
            }
        }
    }
    __syncthreads();
    if (wid >= 4) {
        const int tl = wid - 4, tr = 32 * (tl >> 1), ic = 32 * (tl & 1);
        f32x16 acc;
#pragma unroll
        for (int r = 0; r < 16; ++r) acc[r] = 0.f;
#pragma unroll
        for (int ks = 0; ks < 4; ++ks) acc = RW_MFMA(RW_FRAG(L_AK, tr + r32, ks), RW_FRAG(L_VT, ic + r32, ks), acc);
        LAS float* dst = (LAS float*)(shm + L_AKVT) + (ic + r32) * 68;
#pragma unroll
        for (int g = 0; g < 4; ++g) *(LAS f32x4*)(dst + tr + 8 * g + 4 * hi) = (f32x4){acc[4 * g], acc[4 * g + 1], acc[4 * g + 2], acc[4 * g + 3]};
    } else if (wid == 0) {
        const int blk = lane >> 4, n = lane & 15;
        const LAS float* N = (const LAS float*)(shm + L_DIAG) + blk * 256;
        float m[16];
#pragma unroll
        for (int t = 0; t < 16; ++t) {
            float a = (t == n) ? 1.f : 0.f;
#pragma unroll
            for (int s = 0; s < t; ++s) a = fmaf(-N[t * 16 + s], m[s], a);
            m[t] = a;
            *(LAS bf16_t*)(shm + L_TINV + (blk * 256 + t * 16 + n) * 2) = f2bf(a);
        }
    }
    __syncthreads();
    {
        const int n = lane & 15, q = lane >> 4;
        typedef float f32x4v __attribute__((ext_vector_type(4)));
        const int col = 16 * (wid & 3) + n;
        u32x2 xn[4];
#pragma unroll
        for (int blk = 0; blk < 4; ++blk) {
            f32x4v acc;
            if (wid < 4) { const u32x2 rv = *(const LAS u32x2*)(shm + L_KKDT + col * PB + (16 * blk + 4 * q) * 2);
                acc[0] = bf2f((bf16_t)(rv.x & 0xffffu)); acc[1] = bf2f((bf16_t)(rv.x >> 16)); acc[2] = bf2f((bf16_t)(rv.y & 0xffffu)); acc[3] = bf2f((bf16_t)(rv.y >> 16)); }
            else acc = *(const LAS f32x4v*)((const LAS float*)(shm + L_AKVT) + col * 68 + 16 * blk + 4 * q);
#pragma unroll
            for (int a = 0; a < blk; a += 2) {
                const u32x2 a0 = *(const LAS u32x2*)(shm + L_AB + (16 * blk + n) * PB + (16 * a + 4 * q) * 2);
                const bool two = (a + 1 < blk);
                u32x2 a1 = {0u, 0u}, b1 = {0u, 0u};
                if (two) { a1 = *(const LAS u32x2*)(shm + L_AB + (16 * blk + n) * PB + (16 * (a + 1) + 4 * q) * 2); b1 = xn[a + 1]; }
                const u32x4 af = {a0.x, a0.y, a1.x, a1.y}, bf = {xn[a].x, xn[a].y, b1.x, b1.y};
                acc = __builtin_amdgcn_mfma_f32_16x16x32_bf16(__builtin_bit_cast(bf16x8, af), __builtin_bit_cast(bf16x8, bf), acc, 0, 0, 0);
            }
            const u32x2 ti = *(const LAS u32x2*)(shm + L_TINV + (blk * 256 + n * 16 + 4 * q) * 2);
            const u32x4 af = {ti.x, ti.y, 0u, 0u}, bf = {pk2(acc[0], acc[1]), pk2(acc[2], acc[3]), 0u, 0u};
            f32x4v x = {0.f, 0.f, 0.f, 0.f};
            x = __builtin_amdgcn_mfma_f32_16x16x32_bf16(__builtin_bit_cast(bf16x8, af), __builtin_bit_cast(bf16x8, bf), x, 0, 0, 0);
            xn[blk].x = pk2(-x[0], -x[1]); xn[blk].y = pk2(-x[2], -x[3]);
            *(LAS u32x2*)(shm + ((wid < 4) ? L_WTT : L_VTT) + col * PB + (16 * blk + 4 * q) * 2) = xn[blk];
        }
    }
    __syncthreads();
    {
        const int tl = wid & 3, tr = 32 * (tl >> 1), cc = 32 * (tl & 1);
        f32x16 a0, a1;
        if (wid < 4) {
#pragma unroll
            for (int r = 0; r < 16; ++r) { a0[r] = bf2f(*(const LAS bf16_t*)(shm + L_RD + (tr + crow(r, hi)) * PB + (cc + r32) * 2)); a1[r] = 0.f; }
#pragma unroll
            for (int ks = 0; ks < 4; ++ks) {
                const bf16x8 bbf = RW_FRAG(L_BB, tr + r32, ks);
                a0 = RW_MFMA(bbf, RW_FRAG(L_WTT, cc + r32, ks), a0);
                a1 = RW_MFMA(RW_FRAG(L_BK, tr + r32, ks), RW_FRAG(L_VT, cc + r32, ks), a1);
                a1 = RW_MFMA(bbf, RW_FRAG(L_VTT, cc + r32, ks), a1);
            }
#pragma unroll
            for (int r = 0; r < 16; ++r) {
                bf16_t* rowp = PROJ + (row0 + tr + crow(r, hi)) * DIN + h * 64 + cc + r32;
                rowp[C_K] = f2bf(a0[r]); rowp[C_R] = f2bf(a1[r]);
            }
        } else {
#pragma unroll
            for (int r = 0; r < 16; ++r) { a0[r] = 0.f; a1[r] = 0.f; }
#pragma unroll
            for (int ks = 0; ks < 4; ++ks) {
                const bf16x8 bdf = RW_FRAG(L_BDT, tr + r32, ks);
                a0 = RW_MFMA(bdf, RW_FRAG(L_WTT, cc + r32, ks), a0);
                a1 = RW_MFMA(RW_FRAG(L_KDT, tr + r32, ks), RW_FRAG(L_VT, cc + r32, ks), a1);
                a1 = RW_MFMA(bdf, RW_FRAG(L_VTT, cc + r32, ks), a1);
            }
            bf16_t* Pm = (bf16_t*)(ARG_WS + WS_RWP) + (size_t)unit * 4096;
            bf16_t* Dt = (bf16_t*)(ARG_WS + WS_RWD) + (size_t)unit * 4096;
            const float gc = ((const LAS float*)(shm + L_GC))[cc + r32];
#pragma unroll
            for (int r = 0; r < 16; ++r) { const int jr = tr + crow(r, hi), jc = cc + r32; Pm[jr * 64 + jc] = f2bf(a0[r] + ((jr == jc) ? gc : 0.f)); }
#pragma unroll
            for (int g = 0; g < 4; ++g) { u32x2 w; w.x = pk2(a1[4 * g], a1[4 * g + 1]); w.y = pk2(a1[4 * g + 2], a1[4 * g + 3]); *(u32x2*)(Dt + (cc + r32) * 64 + tr + 8 * g + 4 * hi) = w; }
        }
        const u32x4 vv = *(const LAS u32x4*)(shm + L_VT + lane * PB + tq * 2);
        bf16_t* vp = PROJ + (row0 + tq) * DIN + C_V + ch;
        vp[0] = (bf16_t)(vv.x & 0xffffu); vp[DIN] = (bf16_t)(vv.x >> 16); vp[2 * DIN] = (bf16_t)(vv.y & 0xffffu); vp[3 * DIN] = (bf16_t)(vv.y >> 16);
        vp[4 * DIN] = (bf16_t)(vv.z & 0xffffu); vp[5 * DIN] = (bf16_t)(vv.z >> 16); vp[6 * DIN] = (bf16_t)(vv.w & 0xffffu); vp[7 * DIN] = (bf16_t)(vv.w >> 16);
    }
}

__device__ __forceinline__ void r2_unit(int b, int h, int cg, LAS char* shm) {
    const int tid = otid(), lane = tid & 63, n = lane & 15, q = lane >> 4;
    const int wid = __builtin_amdgcn_readfirstlane(tid >> 6);
    typedef float f32x4v __attribute__((ext_vector_type(4)));
    bf16_t* PROJ = (bf16_t*)(ARG_WS + WS_PROJ);
    const bf16_t* Pm = (const bf16_t*)(ARG_WS + WS_RWP) + (size_t)((b * 8 + h) * 64) * 4096;
    const bf16_t* Dt = (const bf16_t*)(ARG_WS + WS_RWD) + (size_t)((b * 8 + h) * 64) * 4096;
    constexpr int TPB = 144, TBUF = 16 * TPB;
    __syncthreads();
    for (int i = tid; i < 2 * TBUF / 4; i += 512) ((LAS unsigned*)shm)[i] = 0u;
    __syncthreads();
    const size_t rowb = (size_t)b * SEQ;
    if (wid < 4) {
        bf16x8 pa[2]; u32x2 dv;
        auto ldop = [&](int c) { const bf16_t* pp = Pm + (size_t)c * 4096 + (16 * wid + n) * 64 + 8 * q; pa[0] = *(const bf16x8*)pp; pa[1] = *(const bf16x8*)(pp + 32);
                                 dv = *(const u32x2*)(Dt + (size_t)c * 4096 + (16 * cg + n) * 64 + 16 * wid + 4 * q); };
        ldop(0);
        for (int c = 0; c < 64; ++c) {
            const bf16x8 a0 = pa[0], a1 = pa[1]; const u32x2 d = dv;
            if (c + 1 < 64) ldop(c + 1);
            const LAS char* tb = shm + (c & 1) * TBUF + n * TPB + 8 * q * 2;
            const bf16x8 t0 = *(const LAS bf16x8*)tb, t1 = *(const LAS bf16x8*)(tb + 64);
            f32x4v acc = {bf2f((bf16_t)(d.x & 0xffffu)), bf2f((bf16_t)(d.x >> 16)), bf2f((bf16_t)(d.y & 0xffffu)), bf2f((bf16_t)(d.y >> 16))};
            acc = __builtin_amdgcn_mfma_f32_16x16x32_bf16(a0, t0, acc, 0, 0, 0);
            acc = __builtin_amdgcn_mfma_f32_16x16x32_bf16(a1, t1, acc, 0, 0, 0);
            u32x2 w; w.x = rw::pk2(acc[0], acc[1]); w.y = rw::pk2(acc[2], acc[3]);
            *(LAS u32x2*)(shm + ((c + 1) & 1) * TBUF + n * TPB + (16 * wid + 4 * q) * 2) = w;
            __syncthreads();
        }
    } else {
        const int tw = wid - 4;
        bf16x8 rb[2]; u32x2 yv;
        auto ldop = [&](int c) { const bf16_t* rp = PROJ + (rowb + (size_t)c * 64 + 16 * tw + n) * DIN + C_K + h * 64 + 8 * q; rb[0] = *(const bf16x8*)rp; rb[1] = *(const bf16x8*)(rp + 32);
                                 yv = *(const u32x2*)(PROJ + (rowb + (size_t)c * 64 + 16 * tw + n) * DIN + C_R + h * 64 + 16 * cg + 4 * q); };
        ldop(0);
        for (int c = 0; c < 64; ++c) {
            const bf16x8 b0 = rb[0], b1 = rb[1]; const u32x2 y0 = yv;
            if (c + 1 < 64) ldop(c + 1);
            const LAS char* tb = shm + (c & 1) * TBUF + n * TPB + 8 * q * 2;
            const bf16x8 t0 = *(const LAS bf16x8*)tb, t1 = *(const LAS bf16x8*)(tb + 64);
            f32x4v acc = {bf2f((bf16_t)(y0.x & 0xffffu)), bf2f((bf16_t)(y0.x >> 16)), bf2f((bf16_t)(y0.y & 0xffffu)), bf2f((bf16_t)(y0.y >> 16))};
            acc = __builtin_amdgcn_mfma_f32_16x16x32_bf16(t0, b0, acc, 0, 0, 0);
            acc = __builtin_amdgcn_mfma_f32_16x16x32_bf16(t1, b1, acc, 0, 0, 0);
            u32x2 w; w.x = rw::pk2(acc[0], acc[1]); w.y = rw::pk2(acc[2], acc[3]);
            *(u32x2*)(PROJ + (rowb + (size_t)c * 64 + 16 * tw + n) * DIN + C_R + h * 64 + 16 * cg + 4 * q) = w;
            __syncthreads();
        }
    }
}
#undef RW_FRAG
#undef RW_MFMA
}

namespace lru {
typedef short bf16x8 __attribute__((ext_vector_type(8)));
typedef float f32x16 __attribute__((ext_vector_type(16)));
constexpr int TC = 32, XPITCH = 1040, LDS_XC = 0, LDS_OMA = 33280, LDS_BX = LDS_OMA + 32768, LDS_BYTES = LDS_BX + 32768;
__device__ __forceinline__ int crow(int r, int hi) { return (r & 3) + 8 * (r >> 2) + 4 * hi; }
template <bool FINAL>
__device__ __forceinline__ void unit(int l, int b, int c, LAS char* shm) {
    const int tid = otid(), lane = tid & 63, r32 = lane & 31, hi = lane >> 5;
    const int hh = __builtin_amdgcn_readfirstlane(tid >> 6);
    bf16_t* PROJ = (bf16_t*)(ARG_WS + WS_PROJ);
    const int t0 = c * TC; const size_t row0 = (size_t)b * SEQ + t0;
    __syncthreads();
    {
        const float* conv_w = ARG(13) + (size_t)l * 4 * 512; const float cb = (ARG(14) + (size_t)l * 512)[tid];
        const float w0 = conv_w[tid], w1 = conv_w[512 + tid], w2 = conv_w[1024 + tid], w3 = conv_w[1536 + tid];
        const bf16_t* up = PROJ + row0 * DIN + C_UB + tid;
        float x0 = (t0 >= 3) ? bf2f(up[-3 * (long)DIN]) : 0.f, x1 = (t0 >= 2) ? bf2f(up[-2 * (long)DIN]) : 0.f, x2 = (t0 >= 1) ? bf2f(up[-1 * (long)DIN]) : 0.f;
        LAS bf16_t* xc = (LAS bf16_t*)(shm + LDS_XC);
#pragma unroll 8
        for (int t = 0; t < TC; ++t) {
            const float x3 = bf2f(up[(size_t)t * DIN]);
            xc[t * (XPITCH / 2) + tid] = f2bf(cb + x0 * w0 + x1 * w1 + x2 * w2 + x3 * w3);
            x0 = x1; x1 = x2; x2 = x3;
        }
    }
    __syncthreads();
    {
        const bf16_t* gat = (const bf16_t*)(ARG_WS + WS_GAT) + ((size_t)(l * 8 + hh) * 64) * 64;
        const bf16_t* gxt = gat + (size_t)DEPTH * 8 * 64 * 64;
        const float* ga_b = ARG(16) + (size_t)l * 512; const float* gx_b = ARG(18) + (size_t)l * 512; const float* lam = ARG(19) + (size_t)l * 512;
        f32x16 ar[2], ai[2];
#pragma unroll
        for (int nt = 0; nt < 2; ++nt)
#pragma unroll
            for (int r = 0; r < 16; ++r) { ar[nt][r] = 0.f; ai[nt][r] = 0.f; }
        const LAS char* xa = (const LAS char*)shm + LDS_XC + r32 * XPITCH + (hh * 64 + 8 * hi) * 2;
#pragma unroll
        for (int ks = 0; ks < 4; ++ks) {
            const bf16x8 a = *(const LAS bf16x8*)(xa + ks * 32);
#pragma unroll
            for (int nt = 0; nt < 2; ++nt) {
                const bf16x8 wr_ = *(const bf16x8*)(gat + (size_t)(32 * nt + r32) * 64 + 16 * ks + 8 * hi);
                const bf16x8 wi_ = *(const bf16x8*)(gxt + (size_t)(32 * nt + r32) * 64 + 16 * ks + 8 * hi);
                ar[nt] = __builtin_amdgcn_mfma_f32_32x32x16_bf16(a, wr_, ar[nt], 0, 0, 0);
                ai[nt] = __builtin_amdgcn_mfma_f32_32x32x16_bf16(a, wi_, ai[nt], 0, 0, 0);
            }
        }
        LAS bf16_t* xc = (LAS bf16_t*)(shm + LDS_XC); LAS bf16_t* oma = (LAS bf16_t*)(shm + LDS_OMA); LAS bf16_t* bxs = (LAS bf16_t*)(shm + LDS_BX);
#pragma unroll
        for (int nt = 0; nt < 2; ++nt) {
            const int ch = hh * 64 + 32 * nt + r32;
            const float br = ga_b[ch], bi = gx_b[ch], spl = softplusf_(-lam[ch]);
#pragma unroll
            for (int r = 0; r < 16; ++r) {
                const int t = crow(r, hi);
                const float la = -8.0f * sigmoidf_(ar[nt][r] + br) * spl;
                const float x = bf2f(xc[t * (XPITCH / 2) + ch]);
                oma[t * 512 + ch] = f2bf(-expm1f(la));
                bxs[t * 512 + ch] = f2bf(sqrtf(-expm1f(2.0f * la)) * (sigmoidf_(ai[nt][r] + bi) * x));
            }
        }
    }
    {
        float* lsum = (float*)(ARG_WS + WS_LSUM);
        const LAS bf16_t* oma = (const LAS bf16_t*)(shm + LDS_OMA); const LAS bf16_t* bxs = (const LAS bf16_t*)(shm + LDS_BX);
        float h = 0.f;
        if (FINAL) {
            const float2* sp = (const float2*)lsum + ((size_t)b * 128) * 512 + tid;
#pragma unroll 8
            for (int cc = 0; cc < c; ++cc) { const float2 ah = sp[(size_t)cc * 512]; h = fmaf(ah.x, h, ah.y); }
        }
        float ap = 1.f;
        LAS float* hb = (LAS float*)(shm + LDS_OMA);
        float hv[TC];
#pragma unroll
        for (int t = 0; t < TC; ++t) {
            const float om = bf2f(oma[t * 512 + tid]), bx = bf2f(bxs[t * 512 + tid]);
            h = fmaf(-om, h, h) + bx; ap *= (1.0f - om); hv[t] = h;
        }
        if (!FINAL) { ((float2*)lsum)[((size_t)b * 128 + c) * 512 + tid] = make_float2(ap, h); }
        else {
            __syncthreads();
#pragma unroll
            for (int t = 0; t < TC; ++t) hb[t * 512 + tid] = hv[t];
        }
    }
    if (FINAL) {
        __syncthreads();
        const float* go = ARG(20) + (size_t)l * 512;
        const LAS float* hb = (const LAS float*)(shm + LDS_OMA);
#pragma unroll
        for (int q = 0; q < 4; ++q) {
            const int t = hh * 4 + q; float x[8], ss = 0.f;
#pragma unroll
            for (int e = 0; e < 8; ++e) { x[e] = hb[t * 512 + e * 64 + lane]; ss += x[e] * x[e]; }
            ss = wave_sum(ss);
            const float rs = rsqrtf(ss * (1.0f / 512) + 1e-6f);
            bf16_t* zp = PROJ + (row0 + t) * DIN + C_ZB;
#pragma unroll
            for (int e = 0; e < 8; ++e) { const int ch = e * 64 + lane; const float z = bf2f(zp[ch]); zp[ch] = f2bf(x[e] * rs * go[ch] * siluf_(z)); }
        }
    }
}
}

namespace att {
typedef short bf16x8 __attribute__((ext_vector_type(8)));
typedef short s16x4 __attribute__((ext_vector_type(4)));
typedef short v4i16_t __attribute__((ext_vector_type(4)));
typedef float f32x16 __attribute__((ext_vector_type(16)));
typedef unsigned u32x4 __attribute__((ext_vector_type(4)));
typedef float f32x2_t __attribute__((ext_vector_type(2)));
typedef __bf16 bf16x2_t __attribute__((ext_vector_type(2)));
typedef LAS const char* lds_cptr;
constexpr int KSLOT = 12288, VSLOT = 8192, LDS_K = 0, LDS_V = 2 * KSLOT, LDS_WS = LDS_V + 2 * VSLOT, LDS_OST = LDS_WS + 8 * 256, LDS_BYTES = LDS_OST + 8 * 4096;
__device__ __forceinline__ int crow(int r, int hi) { return (r & 3) + 8 * (r >> 2) + 4 * hi; }
__device__ __forceinline__ void glds16(const void* gsrc, unsigned lds_dst) { unsigned keep;
    asm volatile("s_mov_b32 %0, m0\n\ts_mov_b32 m0, %2\n\ts_nop 0\n\tglobal_load_lds_dwordx4 %1, off\n\ts_mov_b32 m0, %0" : "=&s"(keep) : "v"(gsrc), "s"(lds_dst) : "memory"); }
__device__ __forceinline__ unsigned cvtpk(float lo, float hi) { f32x2_t v = {lo, hi}; bf16x2_t b = __builtin_convertvector(v, bf16x2_t); return __builtin_bit_cast(unsigned, b); }
__device__ __forceinline__ s16x4 vtr(lds_cptr p) { return __builtin_bit_cast(s16x4, __builtin_amdgcn_ds_read_tr16_b64_v4i16((LAS v4i16_t*)p)); }
#define ATT_WAITB() asm volatile("s_waitcnt vmcnt(0) lgkmcnt(0)\n\ts_barrier" ::: "memory")

template <int THR>
__device__ __forceinline__ void attn_unit(bf16_t* Qb, const bf16_t* Kb, const bf16_t* Vb, int b, int h, int qb, LAS char* shm) {
    const int tid = otid(), lane = tid & 63, r32 = lane & 31, hi = lane >> 5;
    const int wid = __builtin_amdgcn_readfirstlane(tid >> 6);
    const size_t rowb = (size_t)b * SEQ; const int q0 = qb * 256;
    bf16_t* Qw = Qb + ((rowb + q0 + wid * 32) * 8 + h) * 96;
    const bf16_t* Kh = Kb + (rowb * 8 + h) * 96;
    const bf16_t* Vh = Vb + (rowb * 8 + h) * 64;
    const unsigned lds0 = (unsigned)(size_t)shm;
    LAS float* wsf = (LAS float*)(shm + LDS_WS) + wid * 64;
    const bf16_t* ksrc = Kh + (size_t)lane * 768 + wid * 8;
    const bf16_t* vsrc = Vh + (size_t)(16 * (wid & 3) + (lane >> 2)) * 512 + (wid >> 2) * 32 + (lane & 3) * 8;
    const unsigned kdst = lds0 + LDS_K + wid * 1024, vdst = lds0 + LDS_V + wid * 1024;
#define ATT_DMA(t, sl) do { glds16(ksrc + (size_t)(t) * 64 * 768, (unsigned)__builtin_amdgcn_readfirstlane(kdst + (sl) * KSLOT)); \
        if (wid < 4) glds16(ksrc + (size_t)(t) * 64 * 768 + 64, (unsigned)__builtin_amdgcn_readfirstlane(kdst + (sl) * KSLOT + 8192)); \
        glds16(vsrc + (size_t)(t) * 64 * 512, (unsigned)__builtin_amdgcn_readfirstlane(vdst + (sl) * VSLOT)); } while (0)
    const int NT = 4 * (qb + 1);
    ATT_DMA(0, 0);
    bf16x8 qr[6];
#pragma unroll
    for (int d0 = 0; d0 < 6; ++d0) qr[d0] = *(const bf16x8*)(Qw + (size_t)r32 * 768 + d0 * 16 + hi * 8);
    float m = -INFINITY, l = 0.f; f32x16 o[2];
#pragma unroll
    for (int r = 0; r < 16; ++r) { o[0][r] = 0.f; o[1][r] = 0.f; }
    const int qrel = wid * 32 + r32;
    const lds_cptr kp0 = (lds_cptr)shm + LDS_K + hi * 1024 + r32 * 16;
    const lds_cptr vp0 = (lds_cptr)shm + LDS_V + ((lane >> 4) & 1) * 32 + (lane & 3) * 8 + (4 * hi + ((lane & 15) >> 2)) * 64;
    for (int t = 0; t < NT; ++t) {
        const int sl = t & 1;
        ATT_WAITB();
        if (t + 1 < NT) ATT_DMA(t + 1, sl ^ 1);
        const int jb = t - (NT - 4);
        if (jb >= 1 && 64 * jb > wid * 32 + 31) continue;
        f32x16 p0, p1;
#pragma unroll
        for (int r = 0; r < 16; ++r) { p0[r] = 0.f; p1[r] = 0.f; }
        const lds_cptr kp = kp0 + sl * KSLOT;
#pragma unroll
        for (int d0 = 0; d0 < 6; ++d0) {
            const bf16x8 k0 = *(const LAS bf16x8*)(kp + d0 * 2048), k1 = *(const LAS bf16x8*)(kp + d0 * 2048 + 512);
            p0 = __builtin_amdgcn_mfma_f32_32x32x16_bf16(k0, qr[d0], p0, 0, 0, 0);
            p1 = __builtin_amdgcn_mfma_f32_32x32x16_bf16(k1, qr[d0], p1, 0, 0, 0);
        }
        if (jb >= 0) {
            const int kb = 64 * jb + 4 * hi;
#pragma unroll
            for (int r = 0; r < 16; ++r) { const int kv = kb + (r & 3) + 8 * (r >> 2); if (kv > qrel) p0[r] = -INFINITY; if (kv + 32 > qrel) p1[r] = -INFINITY; }
        }
        float mx = fmaxf(p0[0], p1[0]);
#pragma unroll
        for (int r = 1; r < 16; ++r) mx = fmaxf(mx, fmaxf(p0[r], p1[r]));
        { float x, y; swap32(mx, x, y); mx = fmaxf(x, y); }
        if (__any(mx > m + (float)THR)) {
            const float mn = fmaxf(m, mx), alpha = __builtin_amdgcn_exp2f(m - mn);
            m = mn; l *= alpha;
            if (hi == 0) wsf[r32] = alpha;
#pragma unroll
            for (int r = 0; r < 16; ++r) { const float f = wsf[crow(r, hi)]; o[0][r] *= f; o[1][r] *= f; }
        }
        float ps = 0.f;
#pragma unroll
        for (int r = 0; r < 16; ++r) { p0[r] = __builtin_amdgcn_exp2f(p0[r] - m); p1[r] = __builtin_amdgcn_exp2f(p1[r] - m); ps += p0[r] + p1[r]; }
        l += ps;
        u32x4 pw[4];
#pragma unroll
        for (int q = 0; q < 4; ++q) { pw[0][q] = cvtpk(p0[2 * q], p0[2 * q + 1]); pw[1][q] = cvtpk(p0[8 + 2 * q], p0[9 + 2 * q]); pw[2][q] = cvtpk(p1[2 * q], p1[2 * q + 1]); pw[3][q] = cvtpk(p1[8 + 2 * q], p1[9 + 2 * q]); }
        const lds_cptr vp = vp0 + sl * VSLOT;
#pragma unroll
        for (int d0 = 0; d0 < 2; ++d0)
#pragma unroll
            for (int ks = 0; ks < 4; ++ks) {
                const s16x4 lo = vtr(vp + d0 * 4096 + ks * 1024), hh = vtr(vp + d0 * 4096 + ks * 1024 + 512);
                const bf16x8 vf = (bf16x8){lo[0], lo[1], lo[2], lo[3], hh[0], hh[1], hh[2], hh[3]};
                o[d0] = __builtin_amdgcn_mfma_f32_32x32x16_bf16(__builtin_bit_cast(bf16x8, pw[ks]), vf, o[d0], 0, 0, 0);
            }
    }
    { float x, y; swap32(l, x, y); l = x + y; }
    if (hi == 0) wsf[32 + r32] = l;
    float rli[16];
#pragma unroll
    for (int r = 0; r < 16; ++r) rli[r] = 1.0f / wsf[32 + crow(r, hi)];
    LAS bf16_t* stg = (LAS bf16_t*)(shm + LDS_OST) + wid * 2048;
#pragma unroll
    for (int r = 0; r < 16; ++r) { const int orow = crow(r, hi);
#pragma unroll
        for (int d0 = 0; d0 < 2; ++d0) stg[orow * 64 + d0 * 32 + r32] = f2bf(o[d0][r] * rli[r]); }
#pragma unroll
    for (int i = 0; i < 4; ++i) { const int row = i * 8 + (lane >> 3), ch = lane & 7; const u32x4 v = *(const LAS u32x4*)(stg + row * 64 + ch * 8); *(u32x4*)(Qw + (size_t)row * 768 + ch * 8) = v; }
    asm volatile("s_waitcnt lgkmcnt(0)\n\ts_barrier" ::: "memory");
#undef ATT_DMA
}
}

__global__ void __launch_bounds__(512, 2) fwd_kernel(Args A) {
    extern __shared__ __attribute__((aligned(16))) unsigned char smem[];
    float* lds = (float*)smem;
    volatile LAS unsigned* xbw = (volatile LAS unsigned*)(smem + 147456 - 16);
    unsigned* ctl = (unsigned*)(ARG_WS + WS_CTL);
    const int tid = threadIdx.x;
    if (tid == 0) { xbw[0] = 0u; xbw[1] = 0u; xbw[2] = 0u; xbw[3] = 0u; }
    __syncthreads();
    XcdBarrier bar = xcd_barrier_post(ctl, xbw);
    LAS int* s_unit = (LAS int*)(smem + 147456 - 32);

    bf16_t* PROJ = (bf16_t*)(ARG_WS + WS_PROJ);
    bf16_t* XN = (bf16_t*)(ARG_WS + WS_XN);
    float* RSTD = (float*)(ARG_WS + WS_RSTD);
    float* rope = (float*)(ARG_WS + WS_ROPE);
    const int nwaves = gridDim.x * 8;
#define PHASE_IDS() const int ptid = otid(), lane = ptid & 63, wv = ptid >> 6, gw = blockIdx.x * 8 + wv; (void)lane; (void)gw

    for (int idx = blockIdx.x * 512 + otid(); idx < SEQ * 16; idx += gridDim.x * 512) {
        const int t = idx >> 4, i = idx & 15;
        const float inv = powf(10000.0f, -((float)i * 2.0f / 32.0f));
        const float ang = (float)t * inv;
        const double twopi = 6.283185307179586476925286766559;
        double rr = (double)ang; rr -= twopi * floor(rr / twopi + 0.5);
        const double r2 = rr * rr; double ts = rr, ss = rr, tc = 1.0, cc = 1.0;
        for (int n = 1; n <= 13; ++n) { ts *= -r2 / (double)((2 * n) * (2 * n + 1)); ss += ts; tc *= -r2 / (double)((2 * n - 1) * (2 * n)); cc += tc; }
        rope[idx * 2] = (float)cc; rope[idx * 2 + 1] = (float)ss;
    }

    for (int l = 0; l < DEPTH; ++l) {
        { const float* W = ARG(2) + (size_t)l * DM * DIN;
          transpose_w(DM, NPAD_IN, (bf16_t*)(ARG_WS + WS_WIN) + (size_t)l * NPAD_IN * DM, [=](int k, int n) -> float { return n < DIN ? W[(size_t)k * DIN + orig_col(n)] : 0.f; }, lds); }
        { const float* W = ARG(26) + (size_t)l * DMIX * DM;
          transpose_w(DMIX, DM, (bf16_t*)(ARG_WS + WS_WOUT) + (size_t)l * DM * DMIX, [=](int k, int n) -> float { return W[(size_t)k * DM + n]; }, lds); }
        { const float* qg = ARG(21) + (size_t)l * QL; const float* wuq = ARG(22) + (size_t)l * QL * 768;
          const float* kg = ARG(23) + (size_t)l * KVL; const float* wukv = ARG(24) + (size_t)l * KVL * 1024;
          transpose_w(KMLA, NMLA, (bf16_t*)(ARG_WS + WS_WMLA) + (size_t)l * NMLA * KMLA, [=](int k, int n) -> float {
              if (n < 768) return k < QL ? wuq[(size_t)k * 768 + n] * qg[k] : 0.f;
              return k >= QL ? wukv[(size_t)(k - QL) * 1024 + (n - 768)] * kg[k - QL] : 0.f; }, lds); }
    }
    { const float* w2 = ARG(5); const float* a2 = ARG(7);
      transpose_w(64, DEPTH * 512, (bf16_t*)(ARG_WS + WS_W2T), [=](int k, int n) -> float { return w2[((size_t)(n >> 9) * 64 + k) * 512 + (n & 511)]; }, lds);
      transpose_w(64, DEPTH * 512, (bf16_t*)(ARG_WS + WS_W2T) + (size_t)DEPTH * 512 * 64, [=](int k, int n) -> float { return a2[((size_t)(n >> 9) * 64 + k) * 512 + (n & 511)]; }, lds); }
    { const float* ga = ARG(15); const float* gx = ARG(17);
      transpose_w(64, DEPTH * 8 * 64, (bf16_t*)(ARG_WS + WS_GAT), [=](int k, int n) -> float { return ga[((size_t)(n >> 6) * 64 + k) * 64 + (n & 63)]; }, lds);
      transpose_w(64, DEPTH * 8 * 64, (bf16_t*)(ARG_WS + WS_GAT) + (size_t)DEPTH * 8 * 64 * 64, [=](int k, int n) -> float { return gx[((size_t)(n >> 6) * 64 + k) * 64 + (n & 63)]; }, lds); }
    xcd_barrier(bar);

    for (int l = 0; l < DEPTH; ++l) {
        const float* hsrc = (l == 0) ? ARG(0) : ARG_OUT;
        {
            PHASE_IDS();
            const float* g = ARG(1) + (size_t)l * DM;
            for (int row = gw; row < MTOK; row += nwaves) {
                float4 v[4]; float ss = 0.f;
#pragma unroll
                for (int q = 0; q < 4; ++q) { v[q] = *(const float4*)&hsrc[(size_t)row * DM + q * 256 + lane * 4]; ss += v[q].x * v[q].x + v[q].y * v[q].y + v[q].z * v[q].z + v[q].w * v[q].w; }
                ss = wave_sum(ss);
                const float rs = rsqrtf(ss * (1.0f / DM) + 1e-6f);
#pragma unroll
                for (int q = 0; q < 4; ++q) {
                    const float4 gg = *(const float4*)&g[q * 256 + lane * 4];
                    ushort4 o; o.x = f2bf(v[q].x * rs * gg.x); o.y = f2bf(v[q].y * rs * gg.y); o.z = f2bf(v[q].z * rs * gg.z); o.w = f2bf(v[q].w * rs * gg.w);
                    *(ushort4*)&XN[(size_t)row * DM + q * 256 + lane * 4] = o;
                }
            }
        }
        xcd_barrier(bar);
        {
            pg8::Gemm g{XN, (const bf16_t*)(ARG_WS + WS_WIN) + (size_t)l * NPAD_IN * DM, MTOK, NPAD_IN, DM, DM, DM};
            pg8::StaticOrder S; S.init(MTOK, NPAD_IN, (int)gridDim.x, (int)blockIdx.x);
            pg8::EpiProj E{PROJ, DIN, DIN};
            pg8::gemm_phase<pg8::EpiProj, pg8::StaticOrder, true, true>((PG8_LAS unsigned char*)smem, g, S, E);
        }
        xcd_barrier(bar);
        {
            PHASE_IDS();
            bf16_t* Kb = (bf16_t*)(ARG_WS + WS_K);
            { bf16_t* sav = (bf16_t*)(ARG_WS + WS_SAVA);
              for (int u = gw; u < NB * 64; u += nwaves) { const int bb = u >> 6, cc = u & 63; if (cc == 0) continue;
                  const bf16_t* src = PROJ + ((size_t)bb * SEQ + cc * 64 - 1) * DIN;
                  for (int k = lane; k < 1664; k += 64) sav[(size_t)u * 1664 + k] = src[k]; } }
            for (int row = gw; row < MTOK; row += nwaves) {
                float sq = 0.f, sk = 0.f;
#pragma unroll
                for (int q = 0; q < 4; ++q) { const float x = bf2f(PROJ[(size_t)row * DIN + C_QL + q * 64 + lane]); sq += x * x; }
#pragma unroll
                for (int q = 0; q < 2; ++q) { const float x = bf2f(PROJ[(size_t)row * DIN + C_KVL + q * 64 + lane]); sk += x * x; }
                sq = wave_sum(sq); sk = wave_sum(sk);
                if (lane == 0) { RSTD[(size_t)row * 2] = rsqrtf(sq * (1.0f / QL) + 1e-6f); RSTD[(size_t)row * 2 + 1] = rsqrtf(sk * (1.0f / KVL) + 1e-6f); }
                {
                    const int t = row % SEQ, i = lane & 15, hsel = lane >> 4;
                    const float cs = rope[(t * 16 + i) * 2], sn = rope[(t * 16 + i) * 2 + 1];
                    const float x1 = bf2f(PROJ[(size_t)row * DIN + C_KR + i]), x2 = bf2f(PROJ[(size_t)row * DIN + C_KR + 16 + i]);
                    const bf16_t o1 = f2bf(x1 * cs - x2 * sn), o2 = f2bf(x1 * sn + x2 * cs);
#pragma unroll
                    for (int q = 0; q < 2; ++q) { bf16_t* p = Kb + ((size_t)row * 8 + hsel + 4 * q) * 96 + 64; p[i] = o1; p[16 + i] = o2; }
                }
            }
        }
        xcd_barrier(bar);
        {
            int kmla = KMLA; asm volatile("" : "+s"(kmla));
            pg8::Gemm g{PROJ + C_QL, (const bf16_t*)(ARG_WS + WS_WMLA) + (size_t)l * NMLA * KMLA, MTOK, NMLA, kmla, DIN, KMLA};
            pg8::StaticOrder S; S.init(MTOK, NMLA, (int)gridDim.x, (int)blockIdx.x);
            pg8::EpiMla E{(bf16_t*)(ARG_WS + WS_Q), (bf16_t*)(ARG_WS + WS_K), (bf16_t*)(ARG_WS + WS_V), RSTD, rope, 0.10206207261596577f * 1.4426950408889634f};
            pg8::gemm_phase<pg8::EpiMla, pg8::StaticOrder, true, true>((PG8_LAS unsigned char*)smem, g, S, E);
        }
        xcd_barrier(bar);
        {
            unsigned* qw = ctl + CW_QUEUE + 64 * (2 * l);
            for (;;) {
                __syncthreads();
                if (threadIdx.x == 0) *s_unit = (int)atomicAdd(qw, 1u);
                __syncthreads();
                const int u = *s_unit;
                if (u >= 4096 + 1024) break;
                if (u < 4096) rw::r1_unit(l, u >> 9, (u >> 6) & 7, u & 63, (LAS char*)smem);
                else { const int a = u - 4096; lru::unit<false>(l, a >> 7, a & 127, (LAS char*)smem); }
            }
        }
        xcd_barrier(bar);
        {
            unsigned* qw = ctl + CW_QUEUE + 64 * (2 * l + 1);
            for (;;) {
                __syncthreads();
                if (threadIdx.x == 0) *s_unit = (int)atomicAdd(qw, 1u);
                __syncthreads();
                const int u = *s_unit;
                if (u >= 256 + 1024 + 1024) break;
                if (u < 256) rw::r2_unit(u >> 5, (u >> 2) & 7, u & 3, (LAS char*)smem);
                else if (u < 256 + 1024) { const int a = u - 256; lru::unit<true>(l, a >> 7, a & 127, (LAS char*)smem); }
                else { const int a = u - 256 - 1024; att::attn_unit<ATT_THR>((bf16_t*)(ARG_WS + WS_Q), (const bf16_t*)(ARG_WS + WS_K), (const bf16_t*)(ARG_WS + WS_V), (a & 63) >> 3, a & 7, 15 - (a >> 6), (LAS char*)smem); }
            }
        }
        xcd_barrier(bar);
        {
            const bf16_t* OATT = (const bf16_t*)(ARG_WS + WS_Q);
            const float* gc = ARG(25) + (size_t)l * 512;
            PHASE_IDS();
            const float* lng = ARG(11) + (size_t)l * 512; const float* lnb = ARG(12) + (size_t)l * 512; const float* bon = (const float*)(ARG_WS + WS_BON);
            for (int row = gw; row < MTOK; row += nwaves) {
#pragma unroll 2
                for (int hh = 0; hh < 8; ++hh) {
                    const int c = hh * 64 + lane;
                    const float y = bf2f(PROJ[(size_t)row * DIN + C_R + c]);
                    const float mean = wave_sum(y) * (1.0f / 64.0f);
                    const float d = y - mean;
                    const float var = wave_sum(d * d) * (1.0f / 64.0f);
                    const float o = d * rsqrtf(var + 64e-5f) * lng[c] + lnb[c] + bon[(size_t)row * 8 + hh] * bf2f(PROJ[(size_t)row * DIN + C_V + c]);
                    const float z = bf2f(PROJ[(size_t)row * DIN + C_ZA + c]);
                    PROJ[(size_t)row * DIN + C_ZA + c] = f2bf(o * siluf_(z));
                }
                float xc[8], sc = 0.f;
#pragma unroll
                for (int q = 0; q < 8; ++q) { xc[q] = bf2f(OATT[((size_t)row * 8 + q) * 96 + lane]); sc += xc[q] * xc[q]; }
                sc = wave_sum(sc);
                const float rc = rsqrtf(sc * (1.0f / 512) + 1e-6f);
#pragma unroll
                for (int q = 0; q < 8; ++q) {
                    const int c = q * 64 + lane;
                    const float zc = bf2f(PROJ[(size_t)row * DIN + C_ZC + c]);
                    PROJ[(size_t)row * DIN + C_ZC + c] = f2bf(xc[q] * rc * gc[c] * siluf_(zc));
                }
            }
        }
        xcd_barrier(bar);
        {
            pg8::Gemm g{PROJ + C_ZA, (const bf16_t*)(ARG_WS + WS_WOUT) + (size_t)l * DM * DMIX, MTOK, DM, DMIX, DIN, DMIX};
            pg8::StaticOrder S; S.init(MTOK, DM, (int)gridDim.x, (int)blockIdx.x);
            pg8::EpiResid E{ARG_OUT, hsrc, DM};
            pg8::gemm_phase<pg8::EpiResid, pg8::StaticOrder, true, true>((PG8_LAS unsigned char*)smem, g, S, E);
        }
        xcd_barrier(bar);
    }
    {
        const float* g = ARG(27);
        PHASE_IDS();
        for (int row = gw; row < MTOK; row += nwaves) {
            float4 v[4]; float ss = 0.f;
#pragma unroll
            for (int q = 0; q < 4; ++q) { v[q] = *(const float4*)&ARG_OUT[(size_t)row * DM + q * 256 + lane * 4]; ss += v[q].x * v[q].x + v[q].y * v[q].y + v[q].z * v[q].z + v[q].w * v[q].w; }
            ss = wave_sum(ss);
            const float rs = rsqrtf(ss * (1.0f / DM) + 1e-6f);
#pragma unroll
            for (int q = 0; q < 4; ++q) {
                const float4 gg = *(const float4*)&g[q * 256 + lane * 4];
                float4 o; o.x = v[q].x * rs * gg.x; o.y = v[q].y * rs * gg.y; o.z = v[q].z * rs * gg.z; o.w = v[q].w * rs * gg.w;
                *(float4*)&ARG_OUT[(size_t)row * DM + q * 256 + lane * 4] = o;
            }
        }
    }
}

extern "C" void kernel_launch(void* const* d_in, const int* in_sizes, int n_in, void* d_out, int out_size, void* d_ws, size_t ws_size, hipStream_t stream) {
    (void)in_sizes; (void)n_in; (void)out_size; (void)ws_size;
    constexpr int kDynLds = 147456;
    static int grid = 0;
    if (!grid) {
        int dev = 0, cus = 0;
        hipGetDevice(&dev);
        hipDeviceGetAttribute(&cus, hipDeviceAttributeMultiprocessorCount, dev);
        hipFuncSetAttribute((const void*)fwd_kernel, hipFuncAttributeMaxDynamicSharedMemorySize, kDynLds);
        int per_cu = 0;
        hipOccupancyMaxActiveBlocksPerMultiprocessor(&per_cu, fwd_kernel, 512, kDynLds);
        if (per_cu < 1) fprintf(stderr, "occupancy query says %d\n", per_cu);
        grid = cus > 0 ? cus : 256;
    }
    hipMemsetAsync(d_ws, 0, CTL_BYTES, stream);
    Args a;
    memset(&a, 0, sizeof(a));
    for (int i = 0; i < 28; ++i) a.in[i] = (const float*)d_in[i];
    a.out = (float*)d_out;
    a.ws = (unsigned char*)d_ws;
    hipLaunchKernelGGL(fwd_kernel, dim3(grid), dim3(512), kDynLds, stream, a);
}
```

```cpp
#include <hip/hip_runtime.h>
#include <stdint.h>
#include <cstdio>
#include <cstring>
#ifndef PROBE
#define PROBE 0
#endif
#define PAMP_BEGIN(id) unsigned long long pamp_t0_##id = 0; if (PROBE == (id)) pamp_t0_##id = __builtin_amdgcn_s_memrealtime()
#define PAMP_END(id) do { if (PROBE == (id)) { __syncthreads(); const unsigned long long t1_ = __builtin_amdgcn_s_memrealtime(), d_ = t1_ - pamp_t0_##id; while (__builtin_amdgcn_s_memrealtime() - t1_ < d_) __builtin_amdgcn_s_sleep(8); __syncthreads(); } } while (0)

constexpr int DM = 1024, NB = 8, SEQ = 4096, DEPTH = 4, MTOK = NB * SEQ;
constexpr int GW = 512, HD = 64, NH = 8, DMIX = 1536, DIN = 4128;
constexpr int QL = 256, KVL = 128;
constexpr int C_R = 0, C_K = 512, C_V = 1024, C_WL = 1536, C_AL = 1600, C_UB = 1664, C_QL = 2176, C_KVL = 2432, C_KR = 2560,
              C_ZA = 2592, C_ZB = 3104, C_ZC = 3616;
__device__ __forceinline__ int orig_col(int c) {
    if (c < 1664) return c;
    if (c < 2176) return c - 1664 + 2176;
    if (c < 2432) return c - 2176 + 3200;
    if (c < 2560) return c - 2432 + 3456;
    if (c < 2592) return c - 2560 + 3584;
    if (c < 3104) return c - 2592 + 1664;
    if (c < 3616) return c - 3104 + 2688;
    return c;
}
constexpr size_t MiB = 1u << 20;
constexpr size_t WS_CTL = 0, CTL_BYTES = 65536;
constexpr size_t WS_ROPE = 64 * 1024;
constexpr size_t WS_W2T = 576 * 1024;
constexpr size_t WS_SQQ = 1088 * 1024;
constexpr size_t WS_SQKV = 2112 * 1024;
constexpr size_t WS_SSQH = 10 * MiB;
constexpr size_t WS_WMLA = 3 * MiB;
constexpr size_t WS_PROJ = 16 * MiB;
constexpr size_t WS_XN = 354 * MiB;
constexpr size_t WS_K = 274 * MiB;
constexpr size_t WS_V = 322 * MiB;
constexpr size_t WS_Q = 354 * MiB;
constexpr size_t WS_BON = 8 * MiB + 512 * 1024;
constexpr size_t WS_SAVA = 14 * MiB;
constexpr size_t WS_RWD = 480 * MiB;
constexpr size_t WS_GAT = 9 * MiB + 512 * 1024;
constexpr size_t WS_LSUM = 10 * MiB;
constexpr size_t WS_RWP = 402 * MiB;
constexpr size_t WS_WIN = 434 * MiB;
constexpr size_t WS_WOUT = 468 * MiB;
constexpr size_t WS_FREE = 480 * MiB;
constexpr int NPAD_IN = 4352, NMLA = 1792, KMLA = 384;
constexpr int CW_QUEUE = 8192, CW_PROBEQ = 12288, CW_PROBE = 4000, CW_LCNT = 14336, CW_ATTQ = 15000;

#ifndef ATT_THR
#define ATT_THR 8
#endif

typedef unsigned short bf16_t;
__device__ __forceinline__ float bf2f(bf16_t v) { return __builtin_bit_cast(float, (unsigned)v << 16); }
typedef float f32x2_cv __attribute__((ext_vector_type(2)));
typedef __bf16 bf16x2_cv __attribute__((ext_vector_type(2)));
__device__ __forceinline__ unsigned f2bf2(float lo, float hi) { f32x2_cv v = {lo, hi}; bf16x2_cv b = __builtin_convertvector(v, bf16x2_cv); return __builtin_bit_cast(unsigned, b); }
__device__ __forceinline__ bf16_t f2bf(float f) { return (bf16_t)(f2bf2(f, f) & 0xffffu); }
template <int MASK> __device__ __forceinline__ float shx(float v) {
    static_assert(MASK < 32, "shx: within 32 lanes");
    return __builtin_bit_cast(float, __builtin_amdgcn_ds_swizzle(__builtin_bit_cast(int, v), (MASK << 10) | 0x1f));
}
__device__ __forceinline__ void swap32(float v, float& x, float& y) {
    auto rr = __builtin_amdgcn_permlane32_swap(__builtin_bit_cast(unsigned, v), __builtin_bit_cast(unsigned, v), false, false);
    unsigned a = rr[0], b = rr[1]; asm("" : "+v"(a), "+v"(b));
    x = __builtin_bit_cast(float, a); y = __builtin_bit_cast(float, b);
}
template <int CTRL> __device__ __forceinline__ float dppx(float v) { return __builtin_bit_cast(float, __builtin_amdgcn_mov_dpp(__builtin_bit_cast(int, v), CTRL, 0xf, 0xf, true)); }
__device__ __forceinline__ float sum8(float v) { v += dppx<0xB1>(v); v += dppx<0x4E>(v); v += dppx<0x141>(v); return v; }
__device__ __forceinline__ float wave_sum(float v) {
    v += dppx<0xB1>(v); v += dppx<0x4E>(v); v += dppx<0x141>(v); v += dppx<0x140>(v);
    v += shx<16>(v);
    float x, y; swap32(v, x, y);
    return x + y;
}
__device__ __forceinline__ float fexp(float x) { return __builtin_amdgcn_exp2f(x * 1.4426950408889634f); }
__device__ __forceinline__ float frcp(float x) { return __builtin_amdgcn_rcpf(x); }
__device__ __forceinline__ float sigmoidf_(float x) { return frcp(1.0f + fexp(-x)); }
__device__ __forceinline__ float softplusf_(float x) { return x > 20.f ? x : __builtin_amdgcn_logf(1.0f + fexp(x)) * 0.6931471805599453f; }
__device__ __forceinline__ float siluf_(float x) { return x * frcp(1.0f + fexp(-x)); }
__device__ __forceinline__ float ftanh(float x) { return 1.0f - 2.0f * frcp(1.0f + fexp(2.0f * x)); }
__device__ __forceinline__ float nexpm1(float x) { return x > -0.02f ? -x * (1.0f + x * (0.5f + x * 0.16666667f)) : 1.0f - fexp(x); }

__device__ __forceinline__ int otid() { int t = threadIdx.x; asm volatile("" : "+v"(t)); return t; }
template <int K> __device__ __forceinline__ const float* argp() {
    int k = K; asm volatile("" : "+s"(k));
    return (const float*)(((const unsigned long long*)__builtin_amdgcn_kernarg_segment_ptr())[k]);
}
#define ARG(k) argp<k>()
#define ARG_OUT ((float*)argp<28>())
#define ARG_WS ((unsigned char*)argp<29>())

#define XB_TMO      128
#define XB_XCNT(j)  (256  + 64 * (j))
#define XB_XSUB(j)  (1280 + 64 * (j))
#define XB_XGEN(j)  (2304 + 64 * (j))
#define XB_TOP      3328
#define XB_TOPGEN   3392
#define XCD_BAR_WORDS 3456
#define XB_SPIN_CAP (1u << 24)
#define LAS __attribute__((address_space(3)))

__device__ __forceinline__ unsigned xb_ld(unsigned* p)              { return __hip_atomic_load(p, __ATOMIC_RELAXED, __HIP_MEMORY_SCOPE_AGENT); }
__device__ __forceinline__ unsigned xb_add(unsigned* p, unsigned v) { return __hip_atomic_fetch_add(p, v, __ATOMIC_RELAXED, __HIP_MEMORY_SCOPE_AGENT); }
__device__ __forceinline__ unsigned xb_xcc_id() { return (unsigned)__builtin_amdgcn_s_getreg((3 << 11) | 20) & 0xFu; }
#define XB_SPIN(cond, bar) do { unsigned _sp = 0; while (cond) { __builtin_amdgcn_s_sleep(1); \
    if ((++_sp & 255u) == 0u) { if (xb_ld(&(bar)[XB_TMO])) break; if (_sp > XB_SPIN_CAP) { atomicAdd(&(bar)[XB_TMO], 1u); break; } } } } while (0)

struct XcdBarrier { unsigned* bar; unsigned x; volatile LAS unsigned* st; };

__device__ __forceinline__ XcdBarrier xcd_barrier_post(unsigned* bar, volatile LAS unsigned* st) {
    XcdBarrier b; b.bar = bar; b.x = xb_xcc_id(); b.st = st;
    if (threadIdx.x == 0) (void)xb_add(&bar[XB_XCNT(b.x)], 1u);
    return b;
}
__device__ __forceinline__ void xcd_barrier_complete(unsigned* bar, unsigned x, unsigned& nloc, unsigned& nx) {
    const unsigned G = gridDim.x * gridDim.y * gridDim.z;
    unsigned sum, cnt, mine, sp = 0u;
    for (;;) {
        sum = 0u; cnt = 0u; mine = 0u;
#pragma unroll
        for (unsigned j = 0; j < 16; ++j) { const unsigned c = xb_ld(&bar[XB_XCNT(j)]); sum += c; cnt += (c > 0u) ? 1u : 0u; mine = (j == x) ? c : mine; }
        if (sum == G) break;
        __builtin_amdgcn_s_sleep(1);
        if ((++sp & 255u) == 0u) { if (xb_ld(&bar[XB_TMO])) break; if (sp > XB_SPIN_CAP) { atomicAdd(&bar[XB_TMO], 1u); break; } }
    }
    nloc = mine > 0u ? mine : 1u; nx = cnt > 0u ? cnt : 1u;
}
__device__ __forceinline__ void xcd_barrier_raw(const XcdBarrier& b);
__device__ __forceinline__ void xcd_barrier(const XcdBarrier& b) {
#if PROBE == 30
    const unsigned long long t0_ = __builtin_amdgcn_s_memrealtime();
    xcd_barrier_raw(b);
    const unsigned long long t1_ = __builtin_amdgcn_s_memrealtime(), d_ = t1_ - t0_;
    while (__builtin_amdgcn_s_memrealtime() - t1_ < d_) __builtin_amdgcn_s_sleep(8);
    __syncthreads();
#else
    xcd_barrier_raw(b);
#endif
}
__device__ __forceinline__ void xcd_barrier_raw(const XcdBarrier& b) {
    asm volatile("s_waitcnt vmcnt(0)" ::: "memory");
    __syncthreads();
    if (threadIdx.x == 0) {
        unsigned* bar = b.bar;
        __builtin_amdgcn_s_waitcnt(0);
        const unsigned bx = (unsigned)__builtin_amdgcn_readfirstlane((int)xb_xcc_id());
        unsigned nloc = b.st[0], nx = b.st[1];
        if (nloc == 0u) { xcd_barrier_complete(bar, bx, nloc, nx); b.st[0] = nloc; b.st[1] = nx; }
        const unsigned old = xb_add(&bar[XB_XSUB(bx)], 1u);
        const unsigned gen = old / nloc;
        if (old + 1u == (gen + 1u) * nloc) {
            __builtin_amdgcn_fence(__ATOMIC_RELEASE, "agent");
            asm volatile("s_waitcnt vmcnt(0)" ::: "memory");
            const unsigned og = xb_add(&bar[XB_TOP], 1u);
            const unsigned tg = og / nx;
            if (og + 1u == (tg + 1u) * nx) xb_add(&bar[XB_TOPGEN], 1u);
            else XB_SPIN(xb_ld(&bar[XB_TOPGEN]) == tg, bar);
            __builtin_amdgcn_fence(__ATOMIC_ACQUIRE, "agent");
            xb_add(&bar[XB_XGEN(bx)], 1u);
            asm volatile("s_waitcnt vmcnt(0)" ::: "memory");
        } else {
            XB_SPIN(xb_ld(&bar[XB_XGEN(bx)]) == gen, bar);
            __builtin_amdgcn_fence(__ATOMIC_ACQUIRE, "agent");
            asm volatile("s_waitcnt vmcnt(0)" ::: "memory");
        }
    }
    __syncthreads();
}

struct Args {
    const float* in[28];
    float* out;
    unsigned char* ws;
};

namespace pg8 {
#define PG8_LAS __attribute__((address_space(3)))
typedef unsigned short bf16_t;
typedef short bf16x8 __attribute__((ext_vector_type(8)));
typedef float f32x4 __attribute__((ext_vector_type(4)));
typedef unsigned u32x4 __attribute__((ext_vector_type(4)));
constexpr int BM = 256, BK = 64, HALF = 128, HTB = HALF * BK * 2  , STAGE_BYTES = 8 * HTB, NXCD = 8, WGM = 8;

__host__ __device__ __forceinline__ int lds_byte(int r, int c) { const int st = (r >> 4) * 2 + (c >> 5), rr = r & 15, cc = c & 31, ob = rr * 64 + cc * 2; return st * 1024 + (ob ^ (((ob >> 9) & 1) << 5)); }
__host__ __device__ __forceinline__ void stage_rc(int b, int& R, int& C) { const int st = b / 1024, sb = b % 1024, swz = sb ^ (((sb >> 9) & 1) << 5); R = (st >> 1) * 16 + swz / 64; C = (st & 1) * 32 + (swz % 64) / 2; }
__host__ __device__ __forceinline__ int perm32(int rho) { const int n = rho >> 4, i = rho & 15; return 8 * (i >> 2) + 4 * n + (i & 3); }

struct Unit { int pm, pn; };
struct Gemm { const bf16_t* A; const bf16_t* Bt; int M, N, K, lda, ldb; int a_split_pn; int a_split_off; };

struct StaticOrder {
    int nM, nN, nwg, G, c;
    __host__ __device__ void init(int M, int N, int G_, int c_) { nM = M / BM; nN = N / BM; nwg = nM * nN; G = G_; c = c_; }
    __host__ __device__ bool next(int i, Unit& u) const {
        const long L = (long)i * G + c; if (L >= nwg) return false;
        int wgid = (int)L; { const int q = nwg / NXCD, r = nwg % NXCD, xcd = wgid % NXCD, off = wgid / NXCD; wgid = (xcd < r ? xcd * (q + 1) : r * (q + 1) + (xcd - r) * q) + off; }
        const int nig = WGM * nN, gid = wgid / nig, fm = gid * WGM, gsz = (nM - fm) < WGM ? (nM - fm) : WGM;
        u.pm = fm + ((wgid % nig) % gsz); u.pn = (wgid % nig) / gsz; return true;
    }
    __device__ __forceinline__ void a_ready(const Unit&) const {}
    __device__ __forceinline__ void done(const Unit&) const {}
};

__device__ __forceinline__ unsigned cvt_pk_bf16(float lo, float hi) { unsigned r; asm volatile("v_cvt_pk_bf16_f32 %0, %1, %2" : "=v"(r) : "v"(lo), "v"(hi)); return r; }
template <class Epi, class Sched, bool ALIGN_EPI = false, bool SP2 = false>
__device__ __forceinline__ void gemm_phase(PG8_LAS unsigned char* lds, const Gemm g, const Sched& S, const Epi& E) {
    const int tid = otid(), wid = __builtin_amdgcn_readfirstlane(tid >> 6), lane = tid & 63, wr = wid >> 2, wc = wid & 3, fr = lane & 15, fq = lane >> 4;
    const int K = g.K, nt = K / BK;
    unsigned voffA[2], voffB[2];
#pragma unroll
    for (int i = 0; i < 2; ++i) { int R, C; stage_rc(tid * 16 + i * 8192, R, C); const int Rb = Epi::PERM ? ((R & ~31) + perm32(R & 31)) : R;
        voffA[i] = (unsigned)(R * g.lda + C) * 2u; voffB[i] = (unsigned)(Rb * g.ldb + C) * 2u; }
    const size_t kstep = (size_t)(BK * 2);
    const size_t hstepA = (size_t)HALF * g.lda * 2, hstepB = (size_t)HALF * g.ldb * 2;
    const size_t tstepA = 2 * hstepA, tstepB = 2 * hstepB;
    const unsigned ldsw = (unsigned)wid * 1024u;
    const int aoff = lds_byte(wr * 64 + fr, fq * 8), boff = lds_byte(wc * 32 + fr, fq * 8);
#define PG8_SA(b, h) (((b) * 2 + (h)) * HTB)
#define PG8_SB(b, h) ((4 + (b) * 2 + (h)) * HTB)
#define PG8_STAGE(bufoff, gbase, voff) do { _Pragma("unroll") for (int _i = 0; _i < 2; ++_i) \
        __builtin_amdgcn_global_load_lds((const unsigned*)((const char*)(gbase) + (voff)[_i]), (PG8_LAS unsigned*)(lds + (bufoff) + ldsw + _i * 8192), 16, 0, 0); } while (0)
#define PG8_LDA(dst, b, h) do { _Pragma("unroll") for (int m = 0; m < 4; ++m) _Pragma("unroll") for (int k = 0; k < 2; ++k) dst[m][k] = *(const PG8_LAS bf16x8*)(lds + PG8_SA(b, h) + aoff + m * 2048 + k * 1024); } while (0)
#define PG8_LDB(dst, b, h) do { _Pragma("unroll") for (int n = 0; n < 2; ++n) _Pragma("unroll") for (int k = 0; k < 2; ++k) dst[n][k] = *(const PG8_LAS bf16x8*)(lds + PG8_SB(b, h) + boff + n * 2048 + k * 1024); } while (0)
#define PG8_MMA(ai, bj, At, Bt) do { __builtin_amdgcn_s_setprio(1); _Pragma("unroll") for (int m = 0; m < 4; ++m) _Pragma("unroll") for (int n = 0; n < 2; ++n) _Pragma("unroll") for (int k = 0; k < 2; ++k) \
        acc[ai][bj][m][n] = __builtin_amdgcn_mfma_f32_16x16x32_bf16(Bt[n][k], At[m][k], acc[ai][bj][m][n], 0, 0, 0); __builtin_amdgcn_s_setprio(0); } while (0)
#define PG8_WAIT_V(n) asm volatile("s_waitcnt vmcnt(" #n ")" ::: "memory")
#define PG8_WAIT_L(n) asm volatile("s_waitcnt lgkmcnt(" #n ")" ::: "memory")
#define PG8_BAR __builtin_amdgcn_s_barrier()
#define PG8_SCHED __builtin_amdgcn_sched_barrier(0)
    Unit cur, nxt; int ui = 0;
    if (!S.next(0, cur)) return;
    f32x4 acc[2][2][4][2];
#pragma unroll
    for (int a = 0; a < 2; ++a)
#pragma unroll
        for (int b = 0; b < 2; ++b)
#pragma unroll
            for (int m = 0; m < 4; ++m)
#pragma unroll
                for (int n = 0; n < 2; ++n) acc[a][b][m][n] = (f32x4){0.f, 0.f, 0.f, 0.f};
    bf16x8 At[4][2], B0[2][2], B1[2][2];
    const char* cA = (const char*)g.A + (size_t)cur.pm * tstepA + (cur.pn >= g.a_split_pn ? g.a_split_off : 0); const char* cB = (const char*)g.Bt + (size_t)cur.pn * tstepB;
    S.a_ready(cur);
    if constexpr (SP2) {
        PG8_STAGE(PG8_SB(0, 0), cB, voffB); PG8_STAGE(PG8_SB(0, 1), cB + hstepB, voffB); PG8_STAGE(PG8_SA(0, 0), cA, voffA); PG8_STAGE(PG8_SA(0, 1), cA + hstepA, voffA);
        if (wr == 1) PG8_BAR;
        PG8_WAIT_V(2); PG8_BAR;
        PG8_STAGE(PG8_SB(1, 0), cB + kstep, voffB); PG8_STAGE(PG8_SA(1, 0), cA + kstep, voffA); PG8_STAGE(PG8_SB(1, 1), cB + hstepB + kstep, voffB);
        PG8_WAIT_V(6); PG8_BAR;
    } else {
        PG8_STAGE(PG8_SB(0, 0), cB, voffB); PG8_STAGE(PG8_SA(0, 0), cA, voffA); PG8_STAGE(PG8_SB(0, 1), cB + hstepB, voffB); PG8_STAGE(PG8_SA(0, 1), cA + hstepA, voffA);
        if (wr == 1) PG8_BAR;
        PG8_WAIT_V(4); PG8_BAR;
        PG8_STAGE(PG8_SB(1, 0), cB + kstep, voffB); PG8_STAGE(PG8_SA(1, 0), cA + kstep, voffA); PG8_STAGE(PG8_SB(1, 1), cB + hstepB + kstep, voffB);
        PG8_WAIT_V(6); PG8_BAR;
    }
    for (;;) {
        const bool has_next = S.next(ui + 1, nxt);
        const char* nA = has_next ? (const char*)g.A + (size_t)nxt.pm * tstepA + (nxt.pn >= g.a_split_pn ? g.a_split_off : 0) : cA; const char* nB = has_next ? (const char*)g.Bt + (size_t)nxt.pn * tstepB : cB;
        for (int t = 0; t < nt; t += 2) {
            const bool last = (t == nt - 2);
            const char* a1 = cA + (size_t)(t + 1) * kstep;
            const char* a2 = last ? nA : cA + (size_t)(t + 2) * kstep; const char* b2 = last ? nB : cB + (size_t)(t + 2) * kstep;
            const char* a3 = a2 + kstep; const char* b3 = b2 + kstep;
            if (last && has_next) S.a_ready(nxt);
            if constexpr (SP2) {
            PG8_LDB(B0, 0, 0); PG8_LDB(B1, 0, 1); PG8_SCHED; PG8_LDA(At, 0, 0); PG8_STAGE(PG8_SA(1, 1), a1 + hstepA, voffA);
            PG8_WAIT_V(8); PG8_WAIT_L(0); PG8_BAR; PG8_MMA(0, 0, At, B0); PG8_MMA(0, 1, At, B1); PG8_BAR; PG8_SCHED;
            PG8_LDA(At, 0, 1); PG8_STAGE(PG8_SB(0, 0), b2, voffB); PG8_STAGE(PG8_SB(0, 1), b2 + hstepB, voffB); PG8_STAGE(PG8_SA(0, 0), a2, voffA);
            PG8_WAIT_V(8); PG8_WAIT_L(0); PG8_BAR; PG8_MMA(1, 0, At, B0); PG8_MMA(1, 1, At, B1); PG8_BAR; PG8_SCHED;
            PG8_LDB(B0, 1, 0); PG8_LDB(B1, 1, 1); PG8_SCHED; PG8_LDA(At, 1, 0); PG8_STAGE(PG8_SA(0, 1), a2 + hstepA, voffA);
            PG8_WAIT_V(8); PG8_WAIT_L(0); PG8_BAR; PG8_MMA(0, 0, At, B0); PG8_MMA(0, 1, At, B1); PG8_BAR; PG8_SCHED;
            PG8_LDA(At, 1, 1); PG8_STAGE(PG8_SB(1, 0), b3, voffB); PG8_STAGE(PG8_SB(1, 1), b3 + hstepB, voffB); PG8_STAGE(PG8_SA(1, 0), a3, voffA);
            PG8_WAIT_V(8); PG8_WAIT_L(0); PG8_BAR; PG8_MMA(1, 0, At, B0); PG8_MMA(1, 1, At, B1); PG8_BAR; PG8_SCHED;
            } else {
            PG8_LDB(B0, 0, 0); PG8_SCHED; PG8_LDA(At, 0, 0); PG8_STAGE(PG8_SA(1, 1), a1 + hstepA, voffA);
            PG8_WAIT_L(8); PG8_BAR; PG8_WAIT_L(0); PG8_MMA(0, 0, At, B0); PG8_BAR; PG8_SCHED;
            PG8_LDB(B1, 0, 1); PG8_STAGE(PG8_SB(0, 0), b2, voffB);
            PG8_BAR; PG8_WAIT_L(0); PG8_MMA(0, 1, At, B1); PG8_BAR;
            PG8_LDA(At, 0, 1); PG8_STAGE(PG8_SA(0, 0), a2, voffA);
            PG8_BAR; PG8_WAIT_L(0); PG8_MMA(1, 0, At, B0); PG8_BAR; PG8_SCHED;
            PG8_STAGE(PG8_SB(0, 1), b2 + hstepB, voffB);
            PG8_WAIT_V(6); PG8_BAR; PG8_MMA(1, 1, At, B1); PG8_BAR;
            PG8_LDB(B0, 1, 0); PG8_SCHED; PG8_LDA(At, 1, 0); PG8_STAGE(PG8_SA(0, 1), a2 + hstepA, voffA);
            PG8_WAIT_L(8); PG8_BAR; PG8_WAIT_L(0); PG8_MMA(0, 0, At, B0); PG8_BAR; PG8_SCHED;
            PG8_LDB(B1, 1, 1); PG8_STAGE(PG8_SB(1, 0), b3, voffB);
            PG8_BAR; PG8_WAIT_L(0); PG8_MMA(0, 1, At, B1); PG8_BAR;
            PG8_LDA(At, 1, 1); PG8_STAGE(PG8_SA(1, 0), a3, voffA);
            PG8_BAR; PG8_WAIT_L(0); PG8_MMA(1, 0, At, B0); PG8_BAR; PG8_SCHED;
            PG8_STAGE(PG8_SB(1, 1), b3 + hstepB, voffB);
            PG8_WAIT_V(6); PG8_BAR; PG8_MMA(1, 1, At, B1); PG8_BAR;
            }
        }
        if constexpr (ALIGN_EPI) { if (wr == 0) PG8_BAR; }
        if constexpr (!Epi::AFTER_DRAIN) { E(acc, cur, wr, wc, fr, fq); S.done(cur); }
        if (!has_next) break;
#pragma unroll
        for (int a = 0; a < 2; ++a)
#pragma unroll
            for (int b = 0; b < 2; ++b)
#pragma unroll
                for (int m = 0; m < 4; ++m)
#pragma unroll
                    for (int n = 0; n < 2; ++n) acc[a][b][m][n] = (f32x4){0.f, 0.f, 0.f, 0.f};
        cur = nxt; cA = nA; cB = nB; ++ui;
        if constexpr (ALIGN_EPI) { if (wr == 1) PG8_BAR; }
    }
    PG8_WAIT_V(0);
    if constexpr (!ALIGN_EPI) { if (wr == 0) PG8_BAR; }
    PG8_BAR;
    if constexpr (Epi::AFTER_DRAIN) { E.fused(acc, cur, wr, wc, fr, fq, lds, wid, lane); S.done(cur); }
#undef PG8_SA
#undef PG8_SB
#undef PG8_STAGE
#undef PG8_LDA
#undef PG8_LDB
#undef PG8_MMA
#undef PG8_WAIT_V
#undef PG8_WAIT_L
#undef PG8_BAR
#undef PG8_SCHED
}
}

namespace pg8 {
struct EpiProj {
    static constexpr bool PERM = true, AFTER_DRAIN = false;
    bf16_t* O; int ldc; int ncols; const float* ssqh; float* sqq; float* sqkv; bf16_t* Kb; const float* rope; bf16_t* sav;
    __device__ __forceinline__ void operator()(const f32x4 (&acc)[2][2][4][2], const Unit& u, int wr, int wc, int fr, int fq) const {
        const int row0 = u.pm * BM + wr * 64 + fr, col0 = u.pn * BM + wc * 32 + 8 * fq;
        const int lane_hi = (fq >> 1);
#pragma unroll
        for (int ai = 0; ai < 2; ++ai)
#pragma unroll
            for (int m = 0; m < 4; ++m) {
                const int row = row0 + ai * HALF + m * 16;
                float rs;
                { const f32x4 s0 = *(const f32x4*)(ssqh + (size_t)row * 16), s1 = *(const f32x4*)(ssqh + (size_t)row * 16 + 4), s2 = *(const f32x4*)(ssqh + (size_t)row * 16 + 8), s3 = *(const f32x4*)(ssqh + (size_t)row * 16 + 12);
                  const float t = (((s0[0] + s0[1]) + (s0[2] + s0[3])) + ((s1[0] + s1[1]) + (s1[2] + s1[3]))) + (((s2[0] + s2[1]) + (s2[2] + s2[3])) + ((s3[0] + s3[1]) + (s3[2] + s3[3])));
                  rs = rsqrtf(t * (1.0f / DM) + 1e-6f); }
                bf16_t* rowp = O + (size_t)row * ldc + col0;
#pragma unroll
                for (int bj = 0; bj < 2; ++bj) {
                    const f32x4 v0 = acc[ai][bj][m][0] * rs, v1 = acc[ai][bj][m][1] * rs;
                    u32x4 w; w.x = cvt_pk_bf16(v0[0], v0[1]); w.y = cvt_pk_bf16(v0[2], v0[3]); w.z = cvt_pk_bf16(v1[0], v1[1]); w.w = cvt_pk_bf16(v1[2], v1[3]);
                    const int col = col0 + bj * HALF;
                    if (col < ncols) *(u32x4*)(rowp + bj * HALF) = w;
                    if (u.pn <= 6 && m == 3 && fr == 15 && col < 1664) {
                        const int t = row & (SEQ - 1), cn = (t >> 6) + 1;
                        if (cn < 64) *(u32x4*)(sav + ((size_t)(row >> 12) * 64 + cn) * 1664 + col) = w;
                    }
                    const bool isq = (u.pn == 8 && bj == 1) || (u.pn == 9 && bj == 0), iskv = (u.pn == 9 && bj == 1);
                    if (isq || iskv) {
                        float ss = (v0[0] * v0[0] + v0[1] * v0[1]) + (v0[2] * v0[2] + v0[3] * v0[3]) + (v1[0] * v1[0] + v1[1] * v1[1]) + (v1[2] * v1[2] + v1[3] * v1[3]);
                        ss += shx<16>(ss); { float x, y; swap32(ss, x, y); ss = x + y; }
                        if (fq == 0) { if (iskv) sqkv[(size_t)row * 4 + wc] = ss; else sqq[(size_t)row * 8 + (u.pn == 8 ? 0 : 4) + wc] = ss; }
                    }
                    if (u.pn == 10 && bj == 0 && wc == 0) {
                        const int t = row & (SEQ - 1);
                        const float* rp = rope + ((size_t)t * 16 + 8 * (fq & 1)) * 2;
                        const f32x4 c0 = *(const f32x4*)rp, c1 = *(const f32x4*)(rp + 4), c2 = *(const f32x4*)(rp + 8), c3 = *(const f32x4*)(rp + 12);
                        const float cs[8] = {c0[0], c0[2], c1[0], c1[2], c2[0], c2[2], c3[0], c3[2]}, sn[8] = {c0[1], c0[3], c1[1], c1[3], c2[1], c2[3], c3[1], c3[3]};
                        const float own[8] = {v0[0], v0[1], v0[2], v0[3], v1[0], v1[1], v1[2], v1[3]};
                        float o[8];
#pragma unroll
                        for (int e = 0; e < 8; ++e) { float x, y; swap32(own[e], x, y); const float oth = lane_hi ? x : y;
                            o[e] = lane_hi ? (oth * sn[e] + own[e] * cs[e]) : (own[e] * cs[e] - oth * sn[e]); }
                        u32x4 kw; kw.x = cvt_pk_bf16(o[0], o[1]); kw.y = cvt_pk_bf16(o[2], o[3]); kw.z = cvt_pk_bf16(o[4], o[5]); kw.w = cvt_pk_bf16(o[6], o[7]);
#pragma unroll
                        for (int hh = 0; hh < 8; ++hh) *(u32x4*)(Kb + ((size_t)row * 8 + hh) * 96 + 64 + 8 * fq) = kw;
                    }
                }
                asm volatile("" ::: "memory");
            }
    }
};
struct EpiResid {
    static constexpr bool PERM = false, AFTER_DRAIN = false;
    float* C; const float* R; int ldc; bool dry; bf16_t* HB; float* ssq;
    __device__ __forceinline__ void operator()(const f32x4 (&acc)[2][2][4][2], const Unit& u, int wr, int wc, int fr, int fq) const {
        const int row0 = u.pm * BM + wr * 64 + fr, col0 = u.pn * BM + wc * 32 + 4 * fq;
        typedef unsigned u32x2 __attribute__((ext_vector_type(2)));
#pragma unroll
        for (int ai = 0; ai < 2; ++ai)
#pragma unroll
            for (int m = 0; m < 4; ++m) { const int row = row0 + ai * HALF + m * 16; const size_t off = (size_t)row * ldc + col0;
                float ss = 0.f;
#pragma unroll
                for (int bj = 0; bj < 2; ++bj)
#pragma unroll
                    for (int n = 0; n < 2; ++n) { const f32x4 r = *(const f32x4*)(R + off + bj * HALF + n * 16); const f32x4 o = r + acc[ai][bj][m][n];
                        ss += (o[0] * o[0] + o[1] * o[1]) + (o[2] * o[2] + o[3] * o[3]);
                        u32x2 hb; hb.x = cvt_pk_bf16(o[0], o[1]); hb.y = cvt_pk_bf16(o[2], o[3]);
                        if (!dry) { *(f32x4*)(C + off + bj * HALF + n * 16) = o; *(u32x2*)(HB + off + bj * HALF + n * 16) = hb; } }
                ss += shx<16>(ss); { float x, y; swap32(ss, x, y); ss = x + y; }
                if (fq == 0 && !dry) ssq[(size_t)row * 16 + u.pn * 4 + wc] = ss;
            }
    }
};
struct EpiMla {
    static constexpr bool PERM = false, AFTER_DRAIN = false;
    bf16_t* Q; bf16_t* K; bf16_t* V; const float* sqq; const float* sqkv; const float* rope; float c2; int pn0;
    __device__ __forceinline__ void operator()(const f32x4 (&acc)[2][2][4][2], const Unit& u, int wr, int wc, int fr, int fq) const {
        const int row0 = u.pm * BM + wr * 64 + fr;
        typedef unsigned u32x2 __attribute__((ext_vector_type(2)));
#pragma unroll
        for (int ai = 0; ai < 2; ++ai)
#pragma unroll
            for (int m = 0; m < 4; ++m) {
                const int row = row0 + ai * HALF + m * 16;
                const f32x4 q0 = *(const f32x4*)(sqq + (size_t)row * 8), q1 = *(const f32x4*)(sqq + (size_t)row * 8 + 4), k0 = *(const f32x4*)(sqkv + (size_t)row * 4);
                const float rq = rsqrtf((((q0[0] + q0[1]) + (q0[2] + q0[3])) + ((q1[0] + q1[1]) + (q1[2] + q1[3]))) * (1.0f / QL) + 1e-6f), rk = rsqrtf(((k0[0] + k0[1]) + (k0[2] + k0[3])) * (1.0f / KVL) + 1e-6f);
#pragma unroll
                for (int bj = 0; bj < 2; ++bj) {
                    const int pn = u.pn + pn0; const int cg = pn * BM + bj * HALF + wc * 32;
                    f32x4 v0 = acc[ai][bj][m][0], v1 = acc[ai][bj][m][1];
                    if (pn < 3) {
                        v0 = v0 * rq; v1 = v1 * rq;
                        if (((cg >> 5) % 3) == 2) {
                            const int t = row & (SEQ - 1);
                            const f32x4 cs0 = *(const f32x4*)(rope + ((size_t)t * 16 + 4 * fq) * 2), cs1 = *(const f32x4*)(rope + ((size_t)t * 16 + 4 * fq) * 2 + 4);
                            const float c[4] = {cs0[0], cs0[2], cs1[0], cs1[2]}, sn[4] = {cs0[1], cs0[3], cs1[1], cs1[3]};
                            f32x4 o0, o1;
#pragma unroll
                            for (int j = 0; j < 4; ++j) { o0[j] = v0[j] * c[j] - v1[j] * sn[j]; o1[j] = v0[j] * sn[j] + v1[j] * c[j]; }
                            v0 = o0; v1 = o1;
                        }
                        v0 = v0 * c2; v1 = v1 * c2;
                        bf16_t* p = Q + (size_t)row * 768 + cg + 4 * fq;
                        u32x2 w0, w1; w0.x = cvt_pk_bf16(v0[0], v0[1]); w0.y = cvt_pk_bf16(v0[2], v0[3]); w1.x = cvt_pk_bf16(v1[0], v1[1]); w1.y = cvt_pk_bf16(v1[2], v1[3]);
                        *(u32x2*)p = w0; *(u32x2*)(p + 16) = w1;
                    } else {
                        v0 = v0 * rk; v1 = v1 * rk;
                        const int c = cg - 768, hh = c >> 7, d = (c & 127) + 4 * fq;
                        u32x2 w0, w1; w0.x = cvt_pk_bf16(v0[0], v0[1]); w0.y = cvt_pk_bf16(v0[2], v0[3]); w1.x = cvt_pk_bf16(v1[0], v1[1]); w1.y = cvt_pk_bf16(v1[2], v1[3]);
                        bf16_t* p = (d < 64) ? K + ((size_t)row * 8 + hh) * 96 + d : V + ((size_t)row * 8 + hh) * 64 + (d - 64);
                        *(u32x2*)p = w0; *(u32x2*)(p + 16) = w1;
                    }
                }
                asm volatile("" ::: "memory");
            }
    }
};
}

template <class SRC>
__device__ __forceinline__ void transpose_w(int K, int npad, bf16_t* WT, const SRC& src, float* lds) {
    const int tid = otid();
    const int tk = K / 64, tn = npad / 64;
    for (int u = blockIdx.x; u < tk * tn; u += gridDim.x) {
        const int k0 = (u % tk) * 64, n0 = (u / tk) * 64;
        __syncthreads();
        for (int idx = tid; idx < 4096; idx += 512) { const int kk = idx >> 6, nn = idx & 63; lds[kk * 65 + nn] = src(k0 + kk, n0 + nn); }
        __syncthreads();
        for (int idx = tid; idx < 4096; idx += 512) { const int nn = idx >> 6, kk = idx & 63; WT[(size_t)(n0 + nn) * K + k0 + kk] = f2bf(lds[kk * 65 + nn]); }
    }
}

template <class AL, class BL, class ST>
__device__ __forceinline__ void gemm_naive(int M, int N, int K, const AL& al, const BL& bl, const ST& st, float* lds) {
    float* As = lds;
    float* Bs = lds + 16 * 132;
    const int tid = otid(), ty = tid >> 4, tx = tid & 15;
    const int ntn = (N + 127) / 128, ntiles = (M / 128) * ntn;
    for (int u = blockIdx.x; u < ntiles; u += gridDim.x) {
        const int tm = u / ntn, tn = u % ntn;
        float acc[4][8];
#pragma unroll
        for (int i = 0; i < 4; ++i)
#pragma unroll
            for (int j = 0; j < 8; ++j) acc[i][j] = 0.f;
        for (int k0 = 0; k0 < K; k0 += 16) {
#pragma unroll
            for (int j = 0; j < 4; ++j) { const int idx = tid + j * 512, r = idx >> 4, k = idx & 15; As[k * 132 + r] = al(tm * 128 + r, k0 + k); }
#pragma unroll
            for (int j = 0; j < 4; ++j) { const int idx = tid + j * 512, k = idx >> 7, c = idx & 127; Bs[k * 132 + c] = bl(k0 + k, tn * 128 + c); }
            __syncthreads();
#pragma unroll 2
            for (int k = 0; k < 16; ++k) {
                const float4 a4 = *(const float4*)&As[k * 132 + ty * 4];
                const float4 b0 = *(const float4*)&Bs[k * 132 + tx * 8], b1 = *(const float4*)&Bs[k * 132 + tx * 8 + 4];
                const float av[4] = {a4.x, a4.y, a4.z, a4.w};
                const float bv[8] = {b0.x, b0.y, b0.z, b0.w, b1.x, b1.y, b1.z, b1.w};
#pragma unroll
                for (int i = 0; i < 4; ++i)
#pragma unroll
                    for (int j = 0; j < 8; ++j) acc[i][j] = fmaf(av[i], bv[j], acc[i][j]);
            }
            __syncthreads();
        }
#pragma unroll
        for (int i = 0; i < 4; ++i)
#pragma unroll
            for (int j = 0; j < 8; ++j) st(tm * 128 + ty * 4 + i, tn * 128 + tx * 8 + j, acc[i][j]);
    }
}

namespace rw {
typedef short bf16x8 __attribute__((ext_vector_type(8)));
typedef float f32x16 __attribute__((ext_vector_type(16)));
typedef float f32x4 __attribute__((ext_vector_type(4)));
typedef unsigned u32x2 __attribute__((ext_vector_type(2)));
typedef unsigned u32x4 __attribute__((ext_vector_type(4)));
constexpr int PB = 144, MB = 64 * PB;
constexpr int L_KKD = 0, L_RD = MB, L_BH = 2 * MB, L_KH = 3 * MB, L_BDT = 4 * MB, L_KDT = 5 * MB, L_VT = 6 * MB, L_KKDT = 7 * MB, L_BK = 8 * MB, L_WTT = 9 * MB, L_VTT = 10 * MB;
constexpr int L_AB = L_KKD, L_AK = L_BH, L_BB = L_KH, L_XWL = L_BK, L_XAL = L_WTT;
constexpr int L_F32 = 11 * MB;
constexpr int L_DEC = L_F32, L_AA = L_F32 + 17408, L_AKVT = L_F32, L_DIAG = L_F32 + 17408, L_TINV = L_DIAG + 4096;
constexpr int L_GC = L_F32 + 34816, L_SEG = L_GC + 256, L_END = L_SEG + 2048;
__device__ __forceinline__ int crow(int r, int hi) { return (r & 3) + 8 * (r >> 2) + 4 * hi; }
__device__ __forceinline__ unsigned pk2(float lo, float hi) { return f2bf2(lo, hi); }
#define RW_FRAG(base, row, ks) (*(const LAS bf16x8*)(shm + (base) + (row) * PB + (16 * (ks) + 8 * hi) * 2))
#define RW_MFMA(a, b, c) __builtin_amdgcn_mfma_f32_32x32x16_bf16(a, b, c, 0, 0, 0)

struct R1Raw { bf16_t q[5][9]; };
__device__ __forceinline__ void r1_load(R1Raw& r, const bf16_t* PROJ, const bf16_t* sava, int b, int h, int c, int tq, int lane) {
    const unsigned row0 = (unsigned)b * SEQ + (unsigned)c * 64;
    const __amdgpu_buffer_rsrc_t rs = __builtin_amdgcn_make_buffer_rsrc((void*)PROJ, 0, 0x7fffffff, 0x00020000);
    const int cols[5] = {C_R + h * 64 + lane, C_K + h * 64 + lane, C_V + h * 64 + lane, C_WL + lane, C_AL + lane};
    const unsigned rb = (unsigned)__builtin_amdgcn_readfirstlane((int)((row0 + (unsigned)tq) * (unsigned)(DIN * 2)));
    if (tq == 0) {
        const bf16_t* sav = sava + ((size_t)b * 64 + c) * 1664;
#pragma unroll
        for (int k = 0; k < 5; ++k) r.q[k][0] = (c > 0) ? sav[cols[k]] : (bf16_t)0;
    } else {
#pragma unroll
        for (int k = 0; k < 5; ++k) r.q[k][0] = (bf16_t)__builtin_amdgcn_raw_buffer_load_b16(rs, cols[k] * 2, rb - (unsigned)(DIN * 2), 0);
    }
#pragma unroll
    for (int k = 0; k < 5; ++k)
#pragma unroll
        for (int e = 0; e < 8; ++e) r.q[k][e + 1] = (bf16_t)__builtin_amdgcn_raw_buffer_load_b16(rs, cols[k] * 2, rb + (unsigned)(e * DIN * 2), 0);
}
__device__ __forceinline__ void r1_phase(int l, LAS char* shm, const bool dry = false) {
    const int tid0 = otid(), lane_o = tid0 & 63, r32o = lane_o & 31, hio = lane_o >> 5;
    const int wid = __builtin_amdgcn_readfirstlane(tid0 >> 6);
    bf16_t* PROJ = (bf16_t*)(ARG_WS + WS_PROJ);
    const bf16_t* sava = (const bf16_t*)(ARG_WS + WS_SAVA);
    const int h = blockIdx.x & 7, jw = blockIdx.x >> 3, nper = gridDim.x >> 3;
    const int ch = h * 64 + lane_o;
    const int tq = wid * 8;
    const float* mu = ARG(3) + (size_t)l * 1664;
    const float mu5[5] = {mu[C_R + ch], mu[C_K + ch], mu[C_V + ch], mu[C_WL + lane_o], mu[C_AL + lane_o]};
    const float kkc = (ARG(8) + (size_t)l * 512)[ch], kac = (ARG(9) + (size_t)l * 512)[ch], rkc = (ARG(10) + (size_t)l * 512)[ch];
    const int pB = wid >> 2, tlB = wid & 3, trB = 32 * (tlB >> 1), ncB = 32 * (tlB & 1);
    const float biasB = ((pB ? ARG(6) : ARG(4)) + (size_t)l * 512)[h * 64 + ncB + r32o];
    R1Raw cur, nxt;
    if (jw < 512) r1_load(cur, PROJ, sava, jw >> 6, h, jw & 63, tq, lane_o);
    for (int idx = jw; idx < 512; idx += nper) {
    const int tidl = otid(), lanel = tidl & 63, r32 = lanel & 31, hi = lanel >> 5;
    (void)hio;
    const int lane = lanel;
    const int b = idx >> 6, c = idx & 63;
    const size_t row0 = (size_t)b * SEQ + (size_t)c * 64;
    const int unit = (b * 8 + h) * 64 + c;
    float xr[8], xk[8];
    bf16x8 wfr[4];
    { const bf16_t* wt = (const bf16_t*)(ARG_WS + WS_W2T) + (size_t)pB * DEPTH * 512 * 64 + ((size_t)l * 512 + h * 64 + ncB + r32) * 64;
#pragma unroll
      for (int ks = 0; ks < 4; ++ks) wfr[ks] = *(const bf16x8*)(wt + 16 * ks + 8 * hi); }
    __syncthreads();
    PAMP_BEGIN(31);
    {
        auto lerp = [&](int k, float (&x)[8]) {
            const float m = mu5[k]; float prv = bf2f(cur.q[k][0]);
#pragma unroll
            for (int e = 0; e < 8; ++e) { const float cv = bf2f(cur.q[k][e + 1]); x[e] = cv + m * (prv - cv); prv = cv; }
        };
        float xv[8], xw[8], xa[8];
        lerp(0, xr); lerp(1, xk); lerp(2, xv); lerp(3, xw); lerp(4, xa);
        u32x4 vv; vv.x = pk2(xv[0], xv[1]); vv.y = pk2(xv[2], xv[3]); vv.z = pk2(xv[4], xv[5]); vv.w = pk2(xv[6], xv[7]);
        *(LAS u32x4*)(shm + L_VT + lane * PB + tq * 2) = vv;
#pragma unroll
        for (int e = 0; e < 8; ++e) {
            *(LAS bf16_t*)(shm + L_XWL + (tq + e) * PB + lane * 2) = f2bf(ftanh(xw[e]));
            *(LAS bf16_t*)(shm + L_XAL + (tq + e) * PB + lane * 2) = f2bf(xa[e]);
        }
    }
    __syncthreads();
    {
        const int p = pB, tr = trB, nc = ncB;
        f32x16 acc;
#pragma unroll
        for (int r = 0; r < 16; ++r) acc[r] = biasB;
        const int xb = p ? L_XAL : L_XWL;
#pragma unroll
        for (int ks = 0; ks < 4; ++ks) acc = RW_MFMA(RW_FRAG(xb, tr + r32, ks), wfr[ks], acc);
        LAS float* dst = (LAS float*)(shm + (p ? L_AA : L_DEC));
#pragma unroll
        for (int r = 0; r < 16; ++r) dst[(tr + crow(r, hi)) * 68 + nc + r32] = acc[r];
    }
    __syncthreads();
    PAMP_END(31);
    PAMP_BEGIN(32);
    {
        float* bon = (float*)(ARG_WS + WS_BON);
        float kkn[8], kpv[8], bbv[8], ld[8], lg[8];
        float run = 0.f;
        LAS float* zb = (LAS float*)(shm + L_KKDT) + wid * (16 * 64 + 16);
#pragma unroll
        for (int e = 0; e < 8; ++e) {
            const float dec = ((const LAS float*)(shm + L_DEC))[(tq + e) * 68 + lane], aav = ((const LAS float*)(shm + L_AA))[(tq + e) * 68 + lane];
            ld[e] = -0.6065306597126334f * sigmoidf_(dec);
            const float av = sigmoidf_(aav);
            const float kkr = xk[e] * kkc;
            kkn[e] = kkr; bbv[e] = kkr * av;
            kpv[e] = xk[e] * (1.0f + (av - 1.0f) * kac);
            zb[e * 64 + lane] = kkr * kkr;
            zb[(8 + e) * 64 + lane] = xr[e] * kpv[e] * rkc;
            run += ld[e]; lg[e] = run;
        }
        {
            const LAS f32x4* zp = (const LAS f32x4*)(zb + (lane >> 2) * 64 + (lane & 3) * 16);
            const f32x4 z0 = zp[0], z1 = zp[1], z2 = zp[2], z3 = zp[3];
            float tsum = (((z0[0] + z0[1]) + (z0[2] + z0[3])) + ((z1[0] + z1[1]) + (z1[2] + z1[3]))) + (((z2[0] + z2[1]) + (z2[2] + z2[3])) + ((z3[0] + z3[1]) + (z3[2] + z3[3])));
            tsum += dppx<0xB1>(tsum); tsum += dppx<0x4E>(tsum);
            if ((lane & 3) == 0) zb[16 * 64 + (lane >> 2)] = tsum;
            const f32x4 n0 = *(const LAS f32x4*)(zb + 16 * 64), n1 = *(const LAS f32x4*)(zb + 16 * 64 + 4);
            const float n2[8] = {n0[0], n0[1], n0[2], n0[3], n1[0], n1[1], n1[2], n1[3]};
#pragma unroll
            for (int e = 0; e < 8; ++e) { const float rn = __builtin_amdgcn_rsqf(fmaxf(n2[e], 1e-24f)); kkn[e] *= rn; bbv[e] *= rn; }
            if (lane < 8 && !dry) bon[(row0 + tq + lane) * 8 + h] = zb[16 * 64 + 8 + lane];
        }
        ((LAS float*)(shm + L_SEG))[wid * 64 + lane] = run;
        __syncthreads();
        float off = 0.f, tot = 0.f;
#pragma unroll
        for (int w = 0; w < 8; ++w) { const float sgm = ((const LAS float*)(shm + L_SEG))[w * 64 + lane]; tot += sgm; if (w < wid) off += sgm; }
        const float gct = fexp(tot);
        if (wid == 0) ((LAS float*)(shm + L_GC))[lane] = gct;
        float tb[8], tk[8], tkk[8];
        float gprev = fexp(off);
#pragma unroll
        for (int e = 0; e < 8; ++e) {
            const float L = off + lg[e];
            const float g = fexp(L), gp = gprev, ig = frcp(g), ge = gct * ig;
            gprev = g;
            const int t = tq + e;
            const float kkd = kkn[e] * gp;
            *(LAS bf16_t*)(shm + L_KKD + t * PB + lane * 2) = f2bf(kkd);
            *(LAS bf16_t*)(shm + L_RD + t * PB + lane * 2) = f2bf(xr[e] * g);
            *(LAS bf16_t*)(shm + L_BH + t * PB + lane * 2) = f2bf(bbv[e] * ig);
            *(LAS bf16_t*)(shm + L_KH + t * PB + lane * 2) = f2bf(kpv[e] * ig);
            tb[e] = bbv[e] * ge; tk[e] = kpv[e] * ge; tkk[e] = kkd;
        }
        u32x4 v;
        v.x = pk2(tb[0], tb[1]); v.y = pk2(tb[2], tb[3]); v.z = pk2(tb[4], tb[5]); v.w = pk2(tb[6], tb[7]); *(LAS u32x4*)(shm + L_BDT + lane * PB + tq * 2) = v;
        v.x = pk2(tk[0], tk[1]); v.y = pk2(tk[2], tk[3]); v.z = pk2(tk[4], tk[5]); v.w = pk2(tk[6], tk[7]); *(LAS u32x4*)(shm + L_KDT + lane * PB + tq * 2) = v;
        v.x = pk2(tkk[0], tkk[1]); v.y = pk2(tkk[2], tkk[3]); v.z = pk2(tkk[4], tkk[5]); v.w = pk2(tkk[6], tkk[7]); *(LAS u32x4*)(shm + L_KKDT + lane * PB + tq * 2) = v;
    }
    __syncthreads();
    PAMP_END(32);
    PAMP_BEGIN(33);
    {
        const int mat = wid & 3;
        const int ab = (mat < 2) ? L_KKD : L_RD, bb = (mat & 1) ? L_KH : L_BH;
        const int ob = (mat == 0) ? L_AB : (mat == 1) ? L_AK : (mat == 2) ? L_BB : L_BK;
        f32x16 acc0, acc1;
#pragma unroll
        for (int r = 0; r < 16; ++r) { acc0[r] = 0.f; acc1[r] = 0.f; }
        if (wid < 4) {
#pragma unroll
            for (int ks = 0; ks < 4; ++ks) { acc0 = RW_MFMA(RW_FRAG(ab, r32, ks), RW_FRAG(bb, r32, ks), acc0); acc1 = RW_MFMA(RW_FRAG(ab, 32 + r32, ks), RW_FRAG(bb, 32 + r32, ks), acc1); }
        } else {
#pragma unroll
            for (int ks = 0; ks < 4; ++ks) acc0 = RW_MFMA(RW_FRAG(ab, 32 + r32, ks), RW_FRAG(bb, r32, ks), acc0);
        }
        __syncthreads();
        if (wid < 4) {
            const int lim = (mat < 2) ? 1 : 0;
            LAS char* o0 = shm + ob + (4 * hi) * PB + r32 * 2; LAS char* o1 = shm + ob + (32 + 4 * hi) * PB + (32 + r32) * 2;
#pragma unroll
            for (int r = 0; r < 16; ++r) {
                const int tl_ = (r & 3) + 8 * (r >> 2);
                const bool keep = (tl_ + 4 * hi) >= (r32 + lim);
                acc0[r] = keep ? acc0[r] : 0.f; acc1[r] = keep ? acc1[r] : 0.f;
                *(LAS bf16_t*)(o0 + tl_ * PB) = f2bf(acc0[r]);
                *(LAS bf16_t*)(o1 + tl_ * PB) = f2bf(acc1[r]);
            }
            if (mat == 0) {
                const int bsel = r32 >> 4;
                LAS float* dg = (LAS float*)(shm + L_DIAG) + (r32 & 15);
#pragma unroll
                for (int rr = 0; rr < 8; ++rr) {
                    const int t16 = (rr & 3) + 8 * (rr >> 2) + 4 * hi;
                    const float v0 = bsel ? acc0[rr + 8] : acc0[rr], v1 = bsel ? acc1[rr + 8] : acc1[rr];
                    dg[(bsel) * 256 + t16 * 16] = v0; dg[(2 + bsel) * 256 + t16 * 16] = v1;
                }
            }
        } else {
            LAS char* o0 = shm + ob + (32 + 4 * hi) * PB + r32 * 2;
#pragma unroll
            for (int r = 0; r < 16; ++r) *(LAS bf16_t*)(o0 + ((r & 3) + 8 * (r >> 2)) * PB) = f2bf(acc0[r]);
        }
    }
    __syncthreads();
    PAMP_END(33);
    PAMP_BEGIN(34);
    if (wid >= 4) {
        const int tl = wid - 4, tr = 32 * (tl >> 1), ic = 32 * (tl & 1);
        f32x16 acc;
#pragma unroll
        for (int r = 0; r < 16; ++r) acc[r] = 0.f;
#pragma unroll
        for (int ks = 0; ks < 4; ++ks) if (tr > 0 || ks < 2) acc = RW_MFMA(RW_FRAG(L_AK, tr + r32, ks), RW_FRAG(L_VT, ic + r32, ks), acc);
        LAS float* dst = (LAS float*)(shm + L_AKVT) + (ic + r32) * 68;
#pragma unroll
        for (int g = 0; g < 4; ++g) *(LAS f32x4*)(dst + tr + 8 * g + 4 * hi) = (f32x4){acc[4 * g], acc[4 * g + 1], acc[4 * g + 2], acc[4 * g + 3]};
    } else if (wid == 0) {
        const int blk = lane >> 4, n = lane & 15;
        const LAS float* N = (const LAS float*)(shm + L_DIAG) + blk * 256;
        float m[16];
#pragma unroll
        for (int t = 0; t < 16; ++t) {
            float a = (t == n) ? 1.f : 0.f;
#pragma unroll
            for (int s = 0; s < t; ++s) a = fmaf(-N[t * 16 + s], m[s], a);
            m[t] = a;
            *(LAS bf16_t*)(shm + L_TINV + (blk * 256 + t * 16 + n) * 2) = f2bf(a);
        }
    }
    __syncthreads();
    if (idx + nper < 512) r1_load(nxt, PROJ, sava, (idx + nper) >> 6, h, (idx + nper) & 63, tq, lane);
    {
        const int n = lane & 15, q = lane >> 4;
        typedef float f32x4v __attribute__((ext_vector_type(4)));
        const int col = 16 * (wid & 3) + n;
        u32x2 xn[4];
#pragma unroll
        for (int blk = 0; blk < 4; ++blk) {
            f32x4v acc;
            if (wid < 4) { const u32x2 rv = *(const LAS u32x2*)(shm + L_KKDT + col * PB + (16 * blk + 4 * q) * 2);
                acc[0] = bf2f((bf16_t)(rv.x & 0xffffu)); acc[1] = bf2f((bf16_t)(rv.x >> 16)); acc[2] = bf2f((bf16_t)(rv.y & 0xffffu)); acc[3] = bf2f((bf16_t)(rv.y >> 16)); }
            else acc = *(const LAS f32x4v*)((const LAS float*)(shm + L_AKVT) + col * 68 + 16 * blk + 4 * q);
#pragma unroll
            for (int a = 0; a < blk; a += 2) {
                const u32x2 a0 = *(const LAS u32x2*)(shm + L_AB + (16 * blk + n) * PB + (16 * a + 4 * q) * 2);
                const bool two = (a + 1 < blk);
                u32x2 a1 = {0u, 0u}, b1 = {0u, 0u};
                if (two) { a1 = *(const LAS u32x2*)(shm + L_AB + (16 * blk + n) * PB + (16 * (a + 1) + 4 * q) * 2); b1 = xn[a + 1]; }
                const u32x4 af = {a0.x, a0.y, a1.x, a1.y}, bf = {xn[a].x, xn[a].y, b1.x, b1.y};
                acc = __builtin_amdgcn_mfma_f32_16x16x32_bf16(__builtin_bit_cast(bf16x8, af), __builtin_bit_cast(bf16x8, bf), acc, 0, 0, 0);
            }
            const u32x2 ti = *(const LAS u32x2*)(shm + L_TINV + (blk * 256 + n * 16 + 4 * q) * 2);
            const u32x4 af = {ti.x, ti.y, 0u, 0u}, bf = {pk2(acc[0], acc[1]), pk2(acc[2], acc[3]), 0u, 0u};
            f32x4v x = {0.f, 0.f, 0.f, 0.f};
            x = __builtin_amdgcn_mfma_f32_16x16x32_bf16(__builtin_bit_cast(bf16x8, af), __builtin_bit_cast(bf16x8, bf), x, 0, 0, 0);
            xn[blk].x = pk2(-x[0], -x[1]); xn[blk].y = pk2(-x[2], -x[3]);
            *(LAS u32x2*)(shm + ((wid < 4) ? L_WTT : L_VTT) + col * PB + (16 * blk + 4 * q) * 2) = xn[blk];
        }
    }
    __syncthreads();
    PAMP_END(34);
    PAMP_BEGIN(35);
    {
        const int tl = wid & 3, tr = 32 * (tl >> 1), cc = 32 * (tl & 1);
        f32x16 a0, a1;
        if (wid < 4) {
#pragma unroll
            for (int r = 0; r < 16; ++r) { a0[r] = bf2f(*(const LAS bf16_t*)(shm + L_RD + (tr + crow(r, hi)) * PB + (cc + r32) * 2)); a1[r] = 0.f; }
#pragma unroll
            for (int ks = 0; ks < 4; ++ks) if (tr > 0 || ks < 2) {
                const bf16x8 bbf = RW_FRAG(L_BB, tr + r32, ks);
                a0 = RW_MFMA(bbf, RW_FRAG(L_WTT, cc + r32, ks), a0);
                a1 = RW_MFMA(RW_FRAG(L_BK, tr + r32, ks), RW_FRAG(L_VT, cc + r32, ks), a1);
                a1 = RW_MFMA(bbf, RW_FRAG(L_VTT, cc + r32, ks), a1);
            }
#pragma unroll
            for (int r = 0; r < 16; ++r) {
                bf16_t* rowp = PROJ + (row0 + tr + crow(r, hi)) * DIN + h * 64 + cc + r32;
                if (!dry) { rowp[C_K] = f2bf(a0[r]); rowp[C_R] = f2bf(a1[r]); }
            }
        } else {
#pragma unroll
            for (int r = 0; r < 16; ++r) { a0[r] = 0.f; a1[r] = 0.f; }
#pragma unroll
            for (int ks = 0; ks < 4; ++ks) {
                const bf16x8 bdf = RW_FRAG(L_BDT, tr + r32, ks);
                a0 = RW_MFMA(bdf, RW_FRAG(L_WTT, cc + r32, ks), a0);
                a1 = RW_MFMA(RW_FRAG(L_KDT, tr + r32, ks), RW_FRAG(L_VT, cc + r32, ks), a1);
                a1 = RW_MFMA(bdf, RW_FRAG(L_VTT, cc + r32, ks), a1);
            }
            bf16_t* Pm = (bf16_t*)(ARG_WS + WS_RWP) + (size_t)unit * 4096;
            bf16_t* Dt = (bf16_t*)(ARG_WS + WS_RWD) + (size_t)unit * 4096;
            const float gc = ((const LAS float*)(shm + L_GC))[cc + r32];
#pragma unroll
            for (int r = 0; r < 16; ++r) { const int jr = tr + crow(r, hi), jc = cc + r32; if (!dry) Pm[jr * 64 + jc] = f2bf(a0[r] + ((jr == jc) ? gc : 0.f)); }
#pragma unroll
            for (int g = 0; g < 4; ++g) { u32x2 w; w.x = pk2(a1[4 * g], a1[4 * g + 1]); w.y = pk2(a1[4 * g + 2], a1[4 * g + 3]); if (!dry) *(u32x2*)(Dt + (cc + r32) * 64 + tr + 8 * g + 4 * hi) = w; }
        }
        const u32x4 vv = *(const LAS u32x4*)(shm + L_VT + lane * PB + tq * 2);
        bf16_t* vp = PROJ + (row0 + tq) * DIN + C_V + ch;
        if (!dry) {
        vp[0] = (bf16_t)(vv.x & 0xffffu); vp[DIN] = (bf16_t)(vv.x >> 16); vp[2 * DIN] = (bf16_t)(vv.y & 0xffffu); vp[3 * DIN] = (bf16_t)(vv.y >> 16);
        vp[4 * DIN] = (bf16_t)(vv.z & 0xffffu); vp[5 * DIN] = (bf16_t)(vv.z >> 16); vp[6 * DIN] = (bf16_t)(vv.w & 0xffffu); vp[7 * DIN] = (bf16_t)(vv.w >> 16);
        }
    }
    PAMP_END(35);
    cur = nxt;
    }
}

__device__ __forceinline__ void r2_unit(int l, int b, int h, LAS char* shm, const bool dry = false) {
    const int tid = otid(), lane = tid & 63, n = lane & 15, q = lane >> 4;
    const int wid = __builtin_amdgcn_readfirstlane(tid >> 6);
    typedef float f32x4v __attribute__((ext_vector_type(4)));
    bf16_t* PROJ = (bf16_t*)(ARG_WS + WS_PROJ);
    const bf16_t* Pm = (const bf16_t*)(ARG_WS + WS_RWP) + (size_t)((b * 8 + h) * 64) * 4096;
    const bf16_t* Dt = (const bf16_t*)(ARG_WS + WS_RWD) + (size_t)((b * 8 + h) * 64) * 4096;
    constexpr int TPB = 144, TBUF = 64 * TPB;
    __syncthreads();
    for (int i = tid; i < 2 * TBUF / 4; i += 512) ((LAS unsigned*)shm)[i] = 0u;
    __syncthreads();
    const size_t rowb = (size_t)b * SEQ;
    if (wid < 4) {
        bf16x8 pa[2]; u32x2 dv[4];
        auto ldop = [&](int c) { const bf16_t* pp = Pm + (size_t)c * 4096 + (16 * wid + n) * 64 + 8 * q; pa[0] = *(const bf16x8*)pp; pa[1] = *(const bf16x8*)(pp + 32);
#pragma unroll
                                 for (int cg = 0; cg < 4; ++cg) dv[cg] = *(const u32x2*)(Dt + (size_t)c * 4096 + (16 * cg + n) * 64 + 16 * wid + 4 * q); };
        ldop(0);
        for (int c = 0; c < 64; ++c) {
            const bf16x8 a0 = pa[0], a1 = pa[1]; u32x2 d[4];
#pragma unroll
            for (int cg = 0; cg < 4; ++cg) d[cg] = dv[cg];
            if (c + 1 < 64) ldop(c + 1);
            const LAS char* tb = shm + (c & 1) * TBUF + n * TPB + 8 * q * 2;
            LAS char* tw_ = shm + ((c + 1) & 1) * TBUF + n * TPB + (16 * wid + 4 * q) * 2;
#pragma unroll
            for (int cg = 0; cg < 4; ++cg) {
                const bf16x8 t0 = *(const LAS bf16x8*)(tb + cg * 16 * TPB), t1 = *(const LAS bf16x8*)(tb + cg * 16 * TPB + 64);
                f32x4v acc = {bf2f((bf16_t)(d[cg].x & 0xffffu)), bf2f((bf16_t)(d[cg].x >> 16)), bf2f((bf16_t)(d[cg].y & 0xffffu)), bf2f((bf16_t)(d[cg].y >> 16))};
                acc = __builtin_amdgcn_mfma_f32_16x16x32_bf16(a0, t0, acc, 0, 0, 0);
                acc = __builtin_amdgcn_mfma_f32_16x16x32_bf16(a1, t1, acc, 0, 0, 0);
                u32x2 w; w.x = rw::pk2(acc[0], acc[1]); w.y = rw::pk2(acc[2], acc[3]);
                *(LAS u32x2*)(tw_ + cg * 16 * TPB) = w;
            }
            __syncthreads();
        }
    } else {
        const int tw = wid - 4;
        const float* lng = ARG(11) + (size_t)l * 512 + h * 64; const float* lnb = ARG(12) + (size_t)l * 512 + h * 64; const float* bon = (const float*)(ARG_WS + WS_BON);
        float gg[4][4], gb[4][4];
#pragma unroll
        for (int cg = 0; cg < 4; ++cg) { const f32x4v a4 = *(const f32x4v*)(lng + 16 * cg + 4 * q), b4 = *(const f32x4v*)(lnb + 16 * cg + 4 * q);
#pragma unroll
            for (int e = 0; e < 4; ++e) { gg[cg][e] = a4[e]; gb[cg][e] = b4[e]; } }
        bf16x8 rb[2]; u32x2 yv[4], vv[4], zv[4]; float bv;
        auto ldop = [&](int c) { const size_t row = rowb + (size_t)c * 64 + 16 * tw + n; const bf16_t* rp = PROJ + row * DIN + h * 64; rb[0] = *(const bf16x8*)(rp + C_K + 8 * q); rb[1] = *(const bf16x8*)(rp + C_K + 8 * q + 32);
                                 bv = bon[row * 8 + h];
#pragma unroll
                                 for (int cg = 0; cg < 4; ++cg) { yv[cg] = *(const u32x2*)(rp + C_R + 16 * cg + 4 * q); vv[cg] = *(const u32x2*)(rp + C_V + 16 * cg + 4 * q); zv[cg] = *(const u32x2*)(rp + C_ZA + 16 * cg + 4 * q); } };
        ldop(0);
        for (int c = 0; c < 64; ++c) {
            const bf16x8 b0 = rb[0], b1 = rb[1]; u32x2 y0[4], v0[4], z0[4]; const float bo = bv;
#pragma unroll
            for (int cg = 0; cg < 4; ++cg) { y0[cg] = yv[cg]; v0[cg] = vv[cg]; z0[cg] = zv[cg]; }
            if (c + 1 < 64) ldop(c + 1);
            const LAS char* tb = shm + (c & 1) * TBUF + n * TPB + 8 * q * 2;
            bf16_t* yp = PROJ + (rowb + (size_t)c * 64 + 16 * tw + n) * DIN + C_ZA + h * 64 + 4 * q;
            f32x4v acc[4];
#pragma unroll
            for (int cg = 0; cg < 4; ++cg) {
                const bf16x8 t0 = *(const LAS bf16x8*)(tb + cg * 16 * TPB), t1 = *(const LAS bf16x8*)(tb + cg * 16 * TPB + 64);
                acc[cg] = (f32x4v){bf2f((bf16_t)(y0[cg].x & 0xffffu)), bf2f((bf16_t)(y0[cg].x >> 16)), bf2f((bf16_t)(y0[cg].y & 0xffffu)), bf2f((bf16_t)(y0[cg].y >> 16))};
                acc[cg] = __builtin_amdgcn_mfma_f32_16x16x32_bf16(t0, b0, acc[cg], 0, 0, 0);
                acc[cg] = __builtin_amdgcn_mfma_f32_16x16x32_bf16(t1, b1, acc[cg], 0, 0, 0);
            }
            float sm = 0.f;
#pragma unroll
            for (int cg = 0; cg < 4; ++cg) sm += (acc[cg][0] + acc[cg][1]) + (acc[cg][2] + acc[cg][3]);
            sm += shx<16>(sm); { float x, y; swap32(sm, x, y); sm = x + y; }
            const float mean = sm * (1.0f / 64.0f);
            float sv = 0.f;
#pragma unroll
            for (int cg = 0; cg < 4; ++cg) { acc[cg] = acc[cg] - mean; sv += (acc[cg][0] * acc[cg][0] + acc[cg][1] * acc[cg][1]) + (acc[cg][2] * acc[cg][2] + acc[cg][3] * acc[cg][3]); }
            sv += shx<16>(sv); { float x, y; swap32(sv, x, y); sv = x + y; }
            const float rstd = rsqrtf(sv * (1.0f / 64.0f) + 64e-5f);
#pragma unroll
            for (int cg = 0; cg < 4; ++cg) {
                const float ve[4] = {bf2f((bf16_t)(v0[cg].x & 0xffffu)), bf2f((bf16_t)(v0[cg].x >> 16)), bf2f((bf16_t)(v0[cg].y & 0xffffu)), bf2f((bf16_t)(v0[cg].y >> 16))};
                const float ze[4] = {bf2f((bf16_t)(z0[cg].x & 0xffffu)), bf2f((bf16_t)(z0[cg].x >> 16)), bf2f((bf16_t)(z0[cg].y & 0xffffu)), bf2f((bf16_t)(z0[cg].y >> 16))};
                float o[4];
#pragma unroll
                for (int e = 0; e < 4; ++e) o[e] = (acc[cg][e] * rstd * gg[cg][e] + gb[cg][e] + bo * ve[e]) * siluf_(ze[e]);
                u32x2 w; w.x = rw::pk2(o[0], o[1]); w.y = rw::pk2(o[2], o[3]);
                if (!dry) *(u32x2*)(yp + 16 * cg) = w;
            }
            __syncthreads();
        }
    }
}
#undef RW_FRAG
#undef RW_MFMA
}

namespace lru {
typedef short bf16x8 __attribute__((ext_vector_type(8)));
typedef float f32x16 __attribute__((ext_vector_type(16)));
constexpr int TC = 32, XPITCH = 1040, LDS_XC = 0, LDS_OMA = 33280, LDS_BX = LDS_OMA + 32768, LDS_BYTES = LDS_BX + 32768;
__device__ __forceinline__ int crow(int r, int hi) { return (r & 3) + 8 * (r >> 2) + 4 * hi; }
__device__ __forceinline__ void carry_unit(int b, unsigned* cnt) {
    const int tid = otid();
    float2* sp = (float2*)(ARG_WS + WS_LSUM) + ((size_t)b * 128) * 512 + tid;
    float h = 0.f;
    for (int c0 = 0; c0 < 128; c0 += 16) {
        float2 ah[16];
#pragma unroll
        for (int k = 0; k < 16; ++k) ah[k] = sp[(size_t)(c0 + k) * 512];
#pragma unroll
        for (int k = 0; k < 16; ++k) { __hip_atomic_store(&sp[(size_t)(c0 + k) * 512].x, h, __ATOMIC_RELAXED, __HIP_MEMORY_SCOPE_AGENT); h = fmaf(ah[k].x, h, ah[k].y); }
    }
    asm volatile("s_waitcnt vmcnt(0)" ::: "memory");
    __syncthreads();
    if (threadIdx.x == 0) (void)xb_add(cnt, 1u);
}
constexpr int W_XC = 0, W_OMA = 4608, W_BX = 4608 + 4096, W_LDS = 4608 + 2 * 4096, L_PART = 8 * W_LDS;
template <bool FINAL>
__device__ __forceinline__ void phase(int l, LAS char* shm0, unsigned* cnt, const bool dry = false) {
    typedef unsigned u32x4 __attribute__((ext_vector_type(4)));
    typedef float f32x4 __attribute__((ext_vector_type(4)));
    const int tid0 = otid(), lane0 = tid0 & 63;
    const int hh = __builtin_amdgcn_readfirstlane(tid0 >> 6);
    bf16_t* PROJ = (bf16_t*)(ARG_WS + WS_PROJ);
    LAS char* shm = shm0 + hh * W_LDS;
    const int co0 = lane0 & 7, tg0 = lane0 >> 3;
    auto ldraw = [&](u32x4 (&raw)[7], int u) { const int b = u >> 7, t0 = (u & 127) * TC;
#pragma unroll
        for (int k = 0; k < 7; ++k) { const int t = t0 + 4 * tg0 - 3 + k; raw[k] = (t >= 0) ? *(const u32x4*)(PROJ + ((size_t)b * SEQ + t) * DIN + C_UB + hh * 64 + 8 * co0) : (u32x4){0u, 0u, 0u, 0u}; } };
    u32x4 raw[7], rawn[7];
    int parity = 0;
    if ((int)blockIdx.x < 1024) ldraw(raw, blockIdx.x);
    __syncthreads();
    for (int u = blockIdx.x; u < 1024; u += gridDim.x, parity ^= 1) {
        const int tid = otid(), lane = tid & 63, r32 = lane & 31, hi = lane >> 5, co = lane & 7, tg = lane >> 3;
        const int b = u >> 7, c = u & 127;
        const size_t row0 = (size_t)b * SEQ + (size_t)c * TC;
        const bf16_t* gat = (const bf16_t*)(ARG_WS + WS_GAT) + ((size_t)(l * 8 + hh) * 64) * 64;
        const bf16_t* gxt = gat + (size_t)DEPTH * 8 * 64 * 64;
        bf16x8 wr_[2][4], wi_[2][4];
#pragma unroll
        for (int nt = 0; nt < 2; ++nt)
#pragma unroll
            for (int ks = 0; ks < 4; ++ks) { wr_[nt][ks] = *(const bf16x8*)(gat + (size_t)(32 * nt + r32) * 64 + 16 * ks + 8 * hi); wi_[nt][ks] = *(const bf16x8*)(gxt + (size_t)(32 * nt + r32) * 64 + 16 * ks + 8 * hi); }
        {
            const float* conv_w = ARG(13) + (size_t)l * 4 * 512 + hh * 64 + 8 * co; const float* conv_b = ARG(14) + (size_t)l * 512 + hh * 64 + 8 * co;
            float cw[4][8], cb[8];
#pragma unroll
            for (int q = 0; q < 4; ++q) { const f32x4 a = *(const f32x4*)(conv_w + q * 512), bq = *(const f32x4*)(conv_w + q * 512 + 4);
                cw[q][0] = a[0]; cw[q][1] = a[1]; cw[q][2] = a[2]; cw[q][3] = a[3]; cw[q][4] = bq[0]; cw[q][5] = bq[1]; cw[q][6] = bq[2]; cw[q][7] = bq[3]; }
            { const f32x4 a = *(const f32x4*)conv_b, bq = *(const f32x4*)(conv_b + 4); cb[0] = a[0]; cb[1] = a[1]; cb[2] = a[2]; cb[3] = a[3]; cb[4] = bq[0]; cb[5] = bq[1]; cb[6] = bq[2]; cb[7] = bq[3]; }
#pragma unroll
            for (int tt = 0; tt < 4; ++tt) {
                float o[8];
#pragma unroll
                for (int e = 0; e < 8; ++e) o[e] = cb[e];
#pragma unroll
                for (int q = 0; q < 4; ++q) {
                    const u32x4 rv = raw[tt + q];
                    const unsigned wds[4] = {rv.x, rv.y, rv.z, rv.w};
#pragma unroll
                    for (int e = 0; e < 8; ++e) { const float x = bf2f((bf16_t)((e & 1) ? (wds[e >> 1] >> 16) : (wds[e >> 1] & 0xffffu))); o[e] = fmaf(x, cw[q][e], o[e]); }
                }
                u32x4 w; w.x = rw::pk2(o[0], o[1]); w.y = rw::pk2(o[2], o[3]); w.z = rw::pk2(o[4], o[5]); w.w = rw::pk2(o[6], o[7]);
                *(LAS u32x4*)(shm + W_XC + (4 * tg + tt) * 144 + co * 16) = w;
            }
        }
        if (u + (int)gridDim.x < 1024) ldraw(rawn, u + gridDim.x);
        {
            const float* ga_b = ARG(16) + (size_t)l * 512; const float* gx_b = ARG(18) + (size_t)l * 512; const float* lam = ARG(19) + (size_t)l * 512;
            f32x16 ar[2], ai[2];
#pragma unroll
            for (int nt = 0; nt < 2; ++nt)
#pragma unroll
                for (int r = 0; r < 16; ++r) { ar[nt][r] = 0.f; ai[nt][r] = 0.f; }
            const LAS char* xa = (const LAS char*)shm + W_XC + r32 * 144 + 8 * hi * 2;
#pragma unroll
            for (int ks = 0; ks < 4; ++ks) {
                const bf16x8 a = *(const LAS bf16x8*)(xa + ks * 32);
#pragma unroll
                for (int nt = 0; nt < 2; ++nt) {
                    ar[nt] = __builtin_amdgcn_mfma_f32_32x32x16_bf16(a, wr_[nt][ks], ar[nt], 0, 0, 0);
                    ai[nt] = __builtin_amdgcn_mfma_f32_32x32x16_bf16(a, wi_[nt][ks], ai[nt], 0, 0, 0);
                }
            }
            const LAS bf16_t* xc = (const LAS bf16_t*)(shm + W_XC); LAS unsigned* ob = (LAS unsigned*)(shm + W_OMA);
#pragma unroll
            for (int nt = 0; nt < 2; ++nt) {
                const int cl = 32 * nt + r32, ch = hh * 64 + cl;
                const float br = ga_b[ch], bi = gx_b[ch], c8l = -8.0f * 1.4426950408889634f * softplusf_(-lam[ch]);
#pragma unroll
                for (int r = 0; r < 16; ++r) {
                    const int t = crow(r, hi);
                    const float x = bf2f(xc[t * 72 + cl]);
                    const float om = 1.0f - __builtin_amdgcn_exp2f(sigmoidf_(ar[nt][r] + br) * c8l);
                    ob[t * 64 + cl] = f2bf2(om, __builtin_amdgcn_sqrtf(om * (2.0f - om)) * (sigmoidf_(ai[nt][r] + bi) * x));
                }
            }
        }
        {
            float2* lsum = (float2*)(ARG_WS + WS_LSUM) + ((size_t)b * 128 + c) * 512 + hh * 64 + lane;
            const LAS unsigned* ob = (const LAS unsigned*)(shm + W_OMA);
            float h = 0.f;
            if (FINAL) {
                if (lane == 0 && !dry) XB_SPIN(xb_ld(cnt) < 8u, (unsigned*)(ARG_WS + WS_CTL));
                h = __hip_atomic_load(&lsum->x, __ATOMIC_RELAXED, __HIP_MEMORY_SCOPE_AGENT);
            }
            float ap = 1.f, hv[TC];
#pragma unroll
            for (int t = 0; t < TC; ++t) {
                const unsigned pk = ob[t * 64 + lane];
                const float om = __builtin_bit_cast(float, pk << 16), bx = __builtin_bit_cast(float, pk & 0xffff0000u);
                h = fmaf(-om, h, h) + bx; ap *= (1.0f - om); hv[t] = h;
            }
            if (!FINAL) { if (!dry) *lsum = make_float2(ap, h); }
            else {
                LAS float* hb = (LAS float*)(shm + W_XC);
#pragma unroll
                for (int t = 0; t < TC; ++t) hb[t * 64 + lane] = hv[t];
                { const LAS f32x4* hp = (const LAS f32x4*)(hb + (lane >> 1) * 64 + (lane & 1) * 32);
                  float ss = 0.f;
#pragma unroll
                  for (int k = 0; k < 8; ++k) { const f32x4 v = hp[k]; ss += (v[0] * v[0] + v[1] * v[1]) + (v[2] * v[2] + v[3] * v[3]); }
                  ss += dppx<0xB1>(ss);
                  if ((lane & 1) == 0) ((LAS float*)(shm0 + L_PART))[parity * 256 + (lane >> 1) * 8 + hh] = ss; }
            }
        }
        if (FINAL) {
            __syncthreads();
            const float* go = ARG(20) + (size_t)l * 512 + hh * 64 + 8 * co;
            const f32x4 g0 = *(const f32x4*)go, g1 = *(const f32x4*)(go + 4);
            const float gg[8] = {g0[0], g0[1], g0[2], g0[3], g1[0], g1[1], g1[2], g1[3]};
            const LAS float* hb = (const LAS float*)(shm + W_XC);
#pragma unroll
            for (int tt = 0; tt < 4; ++tt) {
                const int t = 4 * tg + tt;
                const f32x4 p0 = *(const LAS f32x4*)((const LAS float*)(shm0 + L_PART) + parity * 256 + t * 8), p1 = *(const LAS f32x4*)((const LAS float*)(shm0 + L_PART) + parity * 256 + t * 8 + 4);
                const float rs = rsqrtf((((p0[0] + p0[1]) + (p0[2] + p0[3])) + ((p1[0] + p1[1]) + (p1[2] + p1[3]))) * (1.0f / 512) + 1e-6f);
                const f32x4 x0 = *(const LAS f32x4*)(hb + t * 64 + 8 * co), x1 = *(const LAS f32x4*)(hb + t * 64 + 8 * co + 4);
                const float x[8] = {x0[0], x0[1], x0[2], x0[3], x1[0], x1[1], x1[2], x1[3]};
                bf16_t* zp = PROJ + (row0 + t) * DIN + C_ZB + hh * 64 + 8 * co;
                const u32x4 zv = *(const u32x4*)zp; const unsigned zw[4] = {zv.x, zv.y, zv.z, zv.w};
                float o[8];
#pragma unroll
                for (int e = 0; e < 8; ++e) { const float z = bf2f((bf16_t)((e & 1) ? (zw[e >> 1] >> 16) : (zw[e >> 1] & 0xffffu))); o[e] = x[e] * rs * gg[e] * siluf_(z); }
                u32x4 w; w.x = rw::pk2(o[0], o[1]); w.y = rw::pk2(o[2], o[3]); w.z = rw::pk2(o[4], o[5]); w.w = rw::pk2(o[6], o[7]);
                if (!dry) *(u32x4*)zp = w;
            }
        }
#pragma unroll
        for (int k = 0; k < 7; ++k) raw[k] = rawn[k];
    }
}
}

namespace att {
typedef short bf16x8 __attribute__((ext_vector_type(8)));
typedef short s16x4 __attribute__((ext_vector_type(4)));
typedef short v4i16_t __attribute__((ext_vector_type(4)));
typedef float f32x16 __attribute__((ext_vector_type(16)));
typedef unsigned u32x4 __attribute__((ext_vector_type(4)));
typedef float f32x2_t __attribute__((ext_vector_type(2)));
typedef __bf16 bf16x2_t __attribute__((ext_vector_type(2)));
typedef LAS const char* lds_cptr;
constexpr int KSLOT = 12288, VSLOT = 8192, LDS_K = 0, LDS_V = 3 * KSLOT, LDS_WS = LDS_V + 3 * VSLOT, LDS_OST = LDS_WS + 8 * 256, LDS_BYTES = LDS_OST + 8 * 4096;
__device__ __forceinline__ int crow(int r, int hi) { return (r & 3) + 8 * (r >> 2) + 4 * hi; }
__device__ __forceinline__ void glds16(const void* gsrc, unsigned lds_dst) { unsigned keep;
    asm volatile("s_mov_b32 %0, m0\n\ts_mov_b32 m0, %2\n\ts_nop 0\n\tglobal_load_lds_dwordx4 %1, off\n\ts_mov_b32 m0, %0" : "=&s"(keep) : "v"(gsrc), "s"(lds_dst) : "memory"); }
__device__ __forceinline__ unsigned cvtpk(float lo, float hi) { f32x2_t v = {lo, hi}; bf16x2_t b = __builtin_convertvector(v, bf16x2_t); return __builtin_bit_cast(unsigned, b); }
__device__ __forceinline__ s16x4 vtr(lds_cptr p) { return __builtin_bit_cast(s16x4, __builtin_amdgcn_ds_read_tr16_b64_v4i16((LAS v4i16_t*)p)); }
#define ATT_WAITB(N) asm volatile("s_waitcnt vmcnt(" #N ") lgkmcnt(0)\n\ts_barrier" ::: "memory")
__device__ __forceinline__ float max3f(float a, float b, float c) { float r; asm volatile("v_max3_f32 %0, %1, %2, %3" : "=v"(r) : "v"(a), "v"(b), "v"(c)); return r; }
__device__ __forceinline__ float max3f_first(float a, float b, float c) { float r; asm volatile("s_nop 15\n\ts_nop 7\n\tv_max3_f32 %0, %1, %2, %3" : "=v"(r) : "v"(a), "v"(b), "v"(c)); return r; }

template <int THR>
__device__ __forceinline__ void attn_unit(bf16_t* Qb, const bf16_t* Kb, const bf16_t* Vb, int b, int h, int qb, LAS char* shm, const bool dry = false) {
    const int tid = otid(), lane = tid & 63, r32 = lane & 31, hi = lane >> 5;
    const int wid = __builtin_amdgcn_readfirstlane(tid >> 6);
    const size_t rowb = (size_t)b * SEQ; const int q0 = qb * 256;
    bf16_t* Qw = Qb + ((rowb + q0 + wid * 32) * 8 + h) * 96;
    const bf16_t* Kh = Kb + (rowb * 8 + h) * 96;
    const bf16_t* Vh = Vb + (rowb * 8 + h) * 64;
    const unsigned lds0 = (unsigned)(size_t)shm;
    LAS float* wsf = (LAS float*)(shm + LDS_WS) + wid * 64;
    const bf16_t* ksrc = Kh + (size_t)lane * 768 + wid * 8;
    const bf16_t* vsrc = Vh + (size_t)(16 * (wid & 3) + (lane >> 2)) * 512 + (wid >> 2) * 32 + (lane & 3) * 8;
    const unsigned kdst = lds0 + LDS_K + wid * 1024, vdst = lds0 + LDS_V + wid * 1024;
#define ATT_DMA(t, sl) do { glds16(ksrc + (size_t)(t) * 64 * 768, (unsigned)__builtin_amdgcn_readfirstlane(kdst + (sl) * KSLOT)); \
        if (wid < 4) glds16(ksrc + (size_t)(t) * 64 * 768 + 64, (unsigned)__builtin_amdgcn_readfirstlane(kdst + (sl) * KSLOT + 8192)); \
        glds16(vsrc + (size_t)(t) * 64 * 512, (unsigned)__builtin_amdgcn_readfirstlane(vdst + (sl) * VSLOT)); } while (0)
    const int NT = 4 * (qb + 1);
    ATT_DMA(0, 0);
    if (NT > 1) ATT_DMA(1, 1);
    bf16x8 qr[6];
#pragma unroll
    for (int d0 = 0; d0 < 6; ++d0) qr[d0] = *(const bf16x8*)(Qw + (size_t)r32 * 768 + d0 * 16 + hi * 8);
    asm volatile("s_waitcnt vmcnt(0)" : "+v"(qr[0]), "+v"(qr[1]), "+v"(qr[2]), "+v"(qr[3]), "+v"(qr[4]), "+v"(qr[5]) :: "memory");
    float m = 0.f, l = 0.f; f32x16 o[2], negm;
#pragma unroll
    for (int r = 0; r < 16; ++r) { o[0][r] = 0.f; o[1][r] = 0.f; negm[r] = 0.f; }
    const int qrel = wid * 32 + r32;
    const lds_cptr kp0 = (lds_cptr)shm + LDS_K + hi * 1024 + r32 * 16;
    const lds_cptr vp0 = (lds_cptr)shm + LDS_V + ((lane >> 4) & 1) * 32 + (lane & 3) * 8 + (4 * hi + ((lane & 15) >> 2)) * 64;
    int sl0 = 0, sl1 = 1, sl2 = 2;
    for (int t = 0; t < NT; ++t) {
        if (t + 1 < NT) { if (wid < 4) ATT_WAITB(3); else ATT_WAITB(2); } else ATT_WAITB(0);
        if (t + 2 < NT) ATT_DMA(t + 2, sl2);
        const int sl = sl0;
        sl0 = sl1; sl1 = sl2; sl2 = sl;
        const int jb = t - (NT - 4);
        if (jb >= 1 && 64 * jb > wid * 32 + 31) continue;
        f32x16 p0, p1;
        const lds_cptr kp = kp0 + sl * KSLOT;
        bf16x8 kf[12];
#pragma unroll
        for (int d0 = 0; d0 < 6; ++d0) { kf[2 * d0] = *(const LAS bf16x8*)(kp + d0 * 2048); kf[2 * d0 + 1] = *(const LAS bf16x8*)(kp + d0 * 2048 + 512); }
        __builtin_amdgcn_sched_barrier(0);
#pragma unroll
        for (int d0 = 0; d0 < 6; ++d0) {
            if (d0 == 0) { p0 = __builtin_amdgcn_mfma_f32_32x32x16_bf16(kf[0], qr[0], negm, 0, 0, 0); p1 = __builtin_amdgcn_mfma_f32_32x32x16_bf16(kf[1], qr[0], negm, 0, 0, 0); }
            else { p0 = __builtin_amdgcn_mfma_f32_32x32x16_bf16(kf[2 * d0], qr[d0], p0, 0, 0, 0); p1 = __builtin_amdgcn_mfma_f32_32x32x16_bf16(kf[2 * d0 + 1], qr[d0], p1, 0, 0, 0); }
        }
        const lds_cptr vp = vp0 + sl * VSLOT;
        s16x4 vlo[8], vhi[8];
#pragma unroll
        for (int i = 0; i < 8; ++i) { vlo[i] = vtr(vp + (i >> 2) * 4096 + (i & 3) * 1024); vhi[i] = vtr(vp + (i >> 2) * 4096 + (i & 3) * 1024 + 512); }
        __builtin_amdgcn_sched_barrier(0);
        if (jb >= 0) {
            const int kb = 64 * jb + 4 * hi;
#pragma unroll
            for (int r = 0; r < 16; ++r) { const int kv = kb + (r & 3) + 8 * (r >> 2); if (kv > qrel) p0[r] = -INFINITY; if (kv + 32 > qrel) p1[r] = -INFINITY; }
        }
        float mx = max3f_first(p0[0], p0[1], p1[0]), mb = max3f(p0[2], p0[3], p1[1]); mx = max3f(mx, p1[2], p1[3]);
#pragma unroll
        for (int r = 4; r < 16; r += 4) { mx = max3f(mx, p0[r], p0[r + 1]); mb = max3f(mb, p0[r + 2], p0[r + 3]); mx = max3f(mx, p1[r], p1[r + 1]); mb = max3f(mb, p1[r + 2], p1[r + 3]); }
        mx = fmaxf(mx, mb);
        { float x, y; swap32(mx, x, y); mx = fmaxf(x, y); }
        if (t == 0 || __any(mx > (float)THR)) {
            const float dl = (t == 0) ? mx : fmaxf(mx, 0.f);
            m += dl;
            const float alpha = __builtin_amdgcn_exp2f(-dl);
            l *= alpha;
#pragma unroll
            for (int r = 0; r < 16; ++r) { p0[r] -= dl; p1[r] -= dl; negm[r] = -m; }
            if (t > 0) {
                if (hi == 0) wsf[r32] = alpha;
#pragma unroll
                for (int r = 0; r < 16; ++r) { const float f = wsf[crow(r, hi)]; o[0][r] *= f; o[1][r] *= f; }
            }
        }
        float ps = 0.f;
#pragma unroll
        for (int r = 0; r < 16; ++r) { p0[r] = __builtin_amdgcn_exp2f(p0[r]); p1[r] = __builtin_amdgcn_exp2f(p1[r]); ps += p0[r] + p1[r]; }
        l += ps;
        u32x4 pw[4];
#pragma unroll
        for (int q = 0; q < 4; ++q) { pw[0][q] = cvtpk(p0[2 * q], p0[2 * q + 1]); pw[1][q] = cvtpk(p0[8 + 2 * q], p0[9 + 2 * q]); pw[2][q] = cvtpk(p1[2 * q], p1[2 * q + 1]); pw[3][q] = cvtpk(p1[8 + 2 * q], p1[9 + 2 * q]); }
#pragma unroll
        for (int d0 = 0; d0 < 2; ++d0)
#pragma unroll
            for (int ks = 0; ks < 4; ++ks) {
                const s16x4 lo = vlo[d0 * 4 + ks], hh = vhi[d0 * 4 + ks];
                const bf16x8 vf = (bf16x8){lo[0], lo[1], lo[2], lo[3], hh[0], hh[1], hh[2], hh[3]};
                o[d0] = __builtin_amdgcn_mfma_f32_32x32x16_bf16(__builtin_bit_cast(bf16x8, pw[ks]), vf, o[d0], 0, 0, 0);
            }
    }
    { float x, y; swap32(l, x, y); l = x + y; }
    if (hi == 0) wsf[32 + r32] = l;
    float rli[16];
#pragma unroll
    for (int r = 0; r < 16; ++r) rli[r] = 1.0f / wsf[32 + crow(r, hi)];
    LAS bf16_t* stg = (LAS bf16_t*)(shm + LDS_OST) + wid * 2048;
#pragma unroll
    for (int r = 0; r < 16; ++r) { const int orow = crow(r, hi);
#pragma unroll
        for (int d0 = 0; d0 < 2; ++d0) stg[orow * 64 + d0 * 32 + r32] = f2bf(o[d0][r] * rli[r]); }
#pragma unroll
    for (int i = 0; i < 4; ++i) { const int row = i * 8 + (lane >> 3), ch = lane & 7; const u32x4 v = *(const LAS u32x4*)(stg + row * 64 + ch * 8); if (!dry) *(u32x4*)(Qw + (size_t)row * 768 + ch * 8) = v; }
    asm volatile("s_waitcnt lgkmcnt(0)\n\ts_barrier" ::: "memory");
#undef ATT_DMA
}
}

__global__ void __launch_bounds__(512, 2) fwd_kernel(Args A) {
    extern __shared__ __attribute__((aligned(16))) unsigned char smem[];
    float* lds = (float*)smem;
    volatile LAS unsigned* xbw = (volatile LAS unsigned*)(smem + 147456 - 16);
    unsigned* ctl = (unsigned*)(ARG_WS + WS_CTL);
    const int tid = threadIdx.x;
    if (tid == 0) { xbw[0] = 0u; xbw[1] = 0u; xbw[2] = 0u; xbw[3] = 0u; }
    __syncthreads();
    XcdBarrier bar = xcd_barrier_post(ctl, xbw);
#if PROBE >= 50 && PROBE <= 52
    unsigned long long pc0 = 0, pr0 = 0, pc1 = 0, pr1 = 0;
    if (PROBE == 50) { pc0 = __builtin_amdgcn_s_memtime(); pr0 = __builtin_amdgcn_s_memrealtime(); }
#endif
    LAS int* s_unit = (LAS int*)(smem + 147456 - 32);

    bf16_t* PROJ = (bf16_t*)(ARG_WS + WS_PROJ);
    bf16_t* XN = (bf16_t*)(ARG_WS + WS_XN);
    float* rope = (float*)(ARG_WS + WS_ROPE);
    const int nwaves = gridDim.x * 8;
#define PHASE_IDS() const int ptid = otid(), lane = ptid & 63, wv = ptid >> 6, gw = blockIdx.x * 8 + wv; (void)lane; (void)gw

    PAMP_BEGIN(20);
    for (int idx = blockIdx.x * 512 + otid(); idx < SEQ * 16; idx += gridDim.x * 512) {
        const int t = idx >> 4, i = idx & 15;
        const float inv = powf(10000.0f, -((float)i * 2.0f / 32.0f));
        const float ang = (float)t * inv;
        const double twopi = 6.283185307179586476925286766559;
        double rr = (double)ang; rr -= twopi * floor(rr / twopi + 0.5);
        const double r2 = rr * rr; double ts = rr, ss = rr, tc = 1.0, cc = 1.0;
        for (int n = 1; n <= 13; ++n) { ts *= -r2 / (double)((2 * n) * (2 * n + 1)); ss += ts; tc *= -r2 / (double)((2 * n - 1) * (2 * n)); cc += tc; }
        rope[idx * 2] = (float)cc; rope[idx * 2 + 1] = (float)ss;
    }

    for (int prep = 0; prep < (PROBE == 11 ? 2 : 1); ++prep)
    for (int l = 0; l < DEPTH; ++l) {
        { const float* W = ARG(2) + (size_t)l * DM * DIN; const float* g = ARG(1) + (size_t)l * DM;
          transpose_w(DM, NPAD_IN, (bf16_t*)(ARG_WS + WS_WIN) + (size_t)l * NPAD_IN * DM, [=](int k, int n) -> float { return n < DIN ? W[(size_t)k * DIN + orig_col(n)] * g[k] : 0.f; }, lds); }
        { const float* W = ARG(26) + (size_t)l * DMIX * DM;
          transpose_w(DMIX, DM, (bf16_t*)(ARG_WS + WS_WOUT) + (size_t)l * DM * DMIX, [=](int k, int n) -> float { return W[(size_t)k * DM + n]; }, lds); }
        { const float* qg = ARG(21) + (size_t)l * QL; const float* wuq = ARG(22) + (size_t)l * QL * 768;
          const float* kg = ARG(23) + (size_t)l * KVL; const float* wukv = ARG(24) + (size_t)l * KVL * 1024;
          transpose_w(256, NMLA, (bf16_t*)(ARG_WS + WS_WMLA) + (size_t)l * NMLA * 256, [=](int k, int n) -> float {
              if (n < 768) return wuq[(size_t)k * 768 + n] * qg[k];
              return k < KVL ? wukv[(size_t)k * 1024 + (n - 768)] * kg[k] : 0.f; }, lds); }
    }
    { const float* w2 = ARG(5); const float* a2 = ARG(7);
      transpose_w(64, DEPTH * 512, (bf16_t*)(ARG_WS + WS_W2T), [=](int k, int n) -> float { return w2[((size_t)(n >> 9) * 64 + k) * 512 + (n & 511)]; }, lds);
      transpose_w(64, DEPTH * 512, (bf16_t*)(ARG_WS + WS_W2T) + (size_t)DEPTH * 512 * 64, [=](int k, int n) -> float { return a2[((size_t)(n >> 9) * 64 + k) * 512 + (n & 511)]; }, lds); }
    { const float* ga = ARG(15); const float* gx = ARG(17);
      transpose_w(64, DEPTH * 8 * 64, (bf16_t*)(ARG_WS + WS_GAT), [=](int k, int n) -> float { return ga[((size_t)(n >> 6) * 64 + k) * 64 + (n & 63)]; }, lds);
      transpose_w(64, DEPTH * 8 * 64, (bf16_t*)(ARG_WS + WS_GAT) + (size_t)DEPTH * 8 * 64 * 64, [=](int k, int n) -> float { return gx[((size_t)(n >> 6) * 64 + k) * 64 + (n & 63)]; }, lds); }
    {
        PHASE_IDS();
        const float* x = ARG(0); float* ssqh = (float*)(ARG_WS + WS_SSQH);
        for (int row = gw; row < MTOK; row += nwaves) {
            float4 v[4]; float ss = 0.f;
#pragma unroll
            for (int q = 0; q < 4; ++q) { v[q] = *(const float4*)&x[(size_t)row * DM + q * 256 + lane * 4]; ss += v[q].x * v[q].x + v[q].y * v[q].y + v[q].z * v[q].z + v[q].w * v[q].w; }
            ss = wave_sum(ss);
#pragma unroll
            for (int q = 0; q < 4; ++q) { ushort4 o; o.x = f2bf(v[q].x); o.y = f2bf(v[q].y); o.z = f2bf(v[q].z); o.w = f2bf(v[q].w); *(ushort4*)&XN[(size_t)row * DM + q * 256 + lane * 4] = o; }
            if (lane < 16) ssqh[(size_t)row * 16 + lane] = (lane == 0) ? ss : 0.f;
        }
    }
    PAMP_END(20);
    xcd_barrier(bar);

    for (int l = 0; l < DEPTH; ++l) {
        const float* hsrc = (l == 0) ? ARG(0) : ARG_OUT;
#if PROBE == 10
        for (int rep = 0; rep < 8; ++rep) xcd_barrier(bar);
#endif
#if PROBE == 40
        { const unsigned long long t1_ = __builtin_amdgcn_s_memrealtime(); while (__builtin_amdgcn_s_memrealtime() - t1_ < 20000ull) __builtin_amdgcn_s_sleep(8); __syncthreads(); }
#endif
        PAMP_BEGIN(21);
#if PROBE == 51 || PROBE == 52
        if (l == (PROBE == 51 ? 0 : 3)) { pc0 = __builtin_amdgcn_s_memtime(); pr0 = __builtin_amdgcn_s_memrealtime(); }
#endif
        for (int rep = 0; rep < (PROBE == 9 ? 2 : 1); ++rep) {
            pg8::Gemm g{XN, (const bf16_t*)(ARG_WS + WS_WIN) + (size_t)l * NPAD_IN * DM, MTOK, NPAD_IN, DM, DM, DM, 1 << 30, 0};
            pg8::StaticOrder S; S.init(MTOK, NPAD_IN, (int)gridDim.x, (int)blockIdx.x);
            pg8::EpiProj E{PROJ, DIN, DIN, (const float*)(ARG_WS + WS_SSQH), (float*)(ARG_WS + WS_SQQ), (float*)(ARG_WS + WS_SQKV), (bf16_t*)(ARG_WS + WS_K), rope, (bf16_t*)(ARG_WS + WS_SAVA)};
            pg8::gemm_phase<pg8::EpiProj, pg8::StaticOrder, true, true>((PG8_LAS unsigned char*)smem, g, S, E);
        }
#if PROBE == 51 || PROBE == 52
        if (l == (PROBE == 51 ? 0 : 3)) { __syncthreads(); pc1 = __builtin_amdgcn_s_memtime(); pr1 = __builtin_amdgcn_s_memrealtime(); }
#endif
        PAMP_END(21);
        xcd_barrier(bar);
        PAMP_BEGIN(22);
        for (int rep = 0; rep < (PROBE == 13 ? 2 : 1); ++rep) {
            int kmla = 256; asm volatile("" : "+s"(kmla));
            pg8::Gemm g{PROJ + C_QL, (const bf16_t*)(ARG_WS + WS_WMLA) + (size_t)l * NMLA * 256, MTOK, NMLA, kmla, DIN, 256, 3, 2 * (C_KVL - C_QL)};
            pg8::StaticOrder S; S.init(MTOK, NMLA, (int)gridDim.x, (int)blockIdx.x);
            pg8::EpiMla E{(bf16_t*)(ARG_WS + WS_Q), (bf16_t*)(ARG_WS + WS_K), (bf16_t*)(ARG_WS + WS_V), (const float*)(ARG_WS + WS_SQQ), (const float*)(ARG_WS + WS_SQKV), rope, 0.10206207261596577f * 1.4426950408889634f, 0};
            pg8::gemm_phase<pg8::EpiMla, pg8::StaticOrder, true, true>((PG8_LAS unsigned char*)smem, g, S, E);
        }
        PAMP_END(22);
#if PROBE == 1 || PROBE == 2
        {
            const bool dry = (xb_ld(ctl + CW_PROBE) == 0u);
            unsigned* qw = ctl + CW_PROBEQ + 64 * l;
            for (;;) {
                __syncthreads();
                if (threadIdx.x == 0) *s_unit = (int)atomicAdd(qw, 1u);
                __syncthreads();
                const int u = *s_unit;
#if PROBE == 1
                if (u >= 4096) break;
                (void)dry; break;
#else
                if (u >= 1024) break;
                break;
#endif
            }
        }
#endif
        PAMP_BEGIN(23);
#if PROBE == 1
        rw::r1_phase(l, (LAS char*)smem, (xb_ld(ctl + CW_PROBE) == 0u));
#endif
        rw::r1_phase(l, (LAS char*)smem);
        lru::phase<false>(l, (LAS char*)smem, ctl + CW_LCNT + 64 * l);
        PAMP_END(23);
        xcd_barrier(bar);
#if PROBE >= 3 && PROBE <= 5
        {
            const bool dry = (xb_ld(ctl + CW_PROBE) == 0u);
            unsigned* qw = ctl + CW_PROBEQ + 64 * l;
            for (;;) {
                __syncthreads();
                if (threadIdx.x == 0) *s_unit = (int)atomicAdd(qw, 1u);
                __syncthreads();
                const int u = *s_unit;
#if PROBE == 3
                if (u >= 64) break;
                rw::r2_unit(l, u >> 3, u & 7, (LAS char*)smem, dry);
#elif PROBE == 4
                if (u >= 1024) break;
                break;
#else
                if (u >= 1024) break;
                att::attn_unit<ATT_THR>((bf16_t*)(ARG_WS + WS_Q), (const bf16_t*)(ARG_WS + WS_K), (const bf16_t*)(ARG_WS + WS_V), (u & 63) >> 3, u & 7, 15 - (u >> 6), (LAS char*)smem, dry);
#endif
            }
        }
#endif
        {
            unsigned* qw = ctl + CW_QUEUE + 64 * (2 * l + 1);
            PAMP_BEGIN(24);
            for (;;) {
                __syncthreads();
                if (threadIdx.x == 0) *s_unit = (int)atomicAdd(qw, 1u);
                __syncthreads();
                const int u = *s_unit;
                if (u >= 8 + 64) break;
                if (u < 8) lru::carry_unit(u, ctl + CW_LCNT + 64 * l);
                else { const int a = u - 8; rw::r2_unit(l, a >> 3, a & 7, (LAS char*)smem); }
            }
            PAMP_END(24);
            PAMP_BEGIN(25);
            {
                const int x0 = (int)(xb_xcc_id() & 7u);
                for (int k = 0; k < 8; ++k) {
                    const int x = (x0 + k) & 7;
                    unsigned* qa = ctl + CW_ATTQ + 32 * (l * 8 + x);
                    for (;;) {
                        __syncthreads();
                        if (threadIdx.x == 0) *s_unit = (int)atomicAdd(qa, 1u);
                        __syncthreads();
                        const int u = *s_unit;
                        if (u >= 128) break;
                        const int bh = 8 * x + (u & 7), qb = 15 - (u >> 3);
                        att::attn_unit<ATT_THR>((bf16_t*)(ARG_WS + WS_Q), (const bf16_t*)(ARG_WS + WS_K), (const bf16_t*)(ARG_WS + WS_V), bh >> 3, bh & 7, qb, (LAS char*)smem);
                    }
                }
            }
            PAMP_END(25);
            PAMP_BEGIN(26);
            lru::phase<true>(l, (LAS char*)smem, ctl + CW_LCNT + 64 * l);
            PAMP_END(26);
        }
        xcd_barrier(bar);
        PAMP_BEGIN(27);
        for (int rep = 0; rep < (PROBE == 8 ? 2 : 1); ++rep) {
            const bool dry = (PROBE == 8) && (rep == 0) && (xb_ld(ctl + CW_PROBE) == 0u);
            typedef unsigned u32x4 __attribute__((ext_vector_type(4)));
            typedef float f32x4 __attribute__((ext_vector_type(4)));
            PHASE_IDS();
            const int hd = lane >> 3, c0 = hd * 64 + (lane & 7) * 8;
            const bf16_t* OATT = (const bf16_t*)(ARG_WS + WS_Q);
            float gcv[8];
            { const float* p2 = ARG(25) + (size_t)l * 512 + c0; const f32x4 d0 = *(const f32x4*)p2, d1 = *(const f32x4*)(p2 + 4);
#pragma unroll
              for (int e = 0; e < 4; ++e) { gcv[e] = d0[e]; gcv[4 + e] = d1[e]; } }
            auto unpack = [](const u32x4 v, float (&x)[8]) { const unsigned w[4] = {v.x, v.y, v.z, v.w};
#pragma unroll
                for (int e = 0; e < 4; ++e) { x[2 * e] = bf2f((bf16_t)(w[e] & 0xffffu)); x[2 * e + 1] = bf2f((bf16_t)(w[e] >> 16)); } };
#pragma unroll 4
            for (int row = gw; row < MTOK; row += nwaves) {
                bf16_t* pr = PROJ + (size_t)row * DIN;
                const u32x4 rzc = *(const u32x4*)(pr + C_ZC + c0);
                const u32x4 ro = *(const u32x4*)(OATT + ((size_t)row * 8 + hd) * 96 + (lane & 7) * 8);
                float zc[8], oa[8];
                unpack(rzc, zc); unpack(ro, oa);
                float sq = 0.f;
#pragma unroll
                for (int e = 0; e < 8; ++e) sq += oa[e] * oa[e];
                sq = wave_sum(sq);
                const float rc = rsqrtf(sq * (1.0f / 512) + 1e-6f);
                float yc[8];
#pragma unroll
                for (int e = 0; e < 8; ++e) yc[e] = oa[e] * rc * gcv[e] * siluf_(zc[e]);
                u32x4 wc;
                wc.x = rw::pk2(yc[0], yc[1]); wc.y = rw::pk2(yc[2], yc[3]); wc.z = rw::pk2(yc[4], yc[5]); wc.w = rw::pk2(yc[6], yc[7]);
                if (!dry) *(u32x4*)(pr + C_ZC + c0) = wc;
            }
        }
        PAMP_END(27);
        xcd_barrier(bar);
        PAMP_BEGIN(28);
        for (int rep = 0; rep < (PROBE == 14 ? 2 : 1); ++rep) {
            const bool odry = (PROBE == 14) && (rep == 0) && (xb_ld(ctl + CW_PROBE) == 0u);
            pg8::Gemm g{PROJ + C_ZA, (const bf16_t*)(ARG_WS + WS_WOUT) + (size_t)l * DM * DMIX, MTOK, DM, DMIX, DIN, DMIX, 1 << 30, 0};
            pg8::StaticOrder S; S.init(MTOK, DM, (int)gridDim.x, (int)blockIdx.x);
            pg8::EpiResid E{ARG_OUT, hsrc, DM, odry, XN, (float*)(ARG_WS + WS_SSQH)};
            pg8::gemm_phase<pg8::EpiResid, pg8::StaticOrder, true, true>((PG8_LAS unsigned char*)smem, g, S, E);
        }
        PAMP_END(28);
        xcd_barrier(bar);
    }
    {
        const float* g = ARG(27); const float* ssqh = (const float*)(ARG_WS + WS_SSQH);
        PHASE_IDS();
        float* out = ARG_OUT;
        for (int row = gw; row < MTOK; row += nwaves) {
            float tsum = (lane < 16) ? ssqh[(size_t)row * 16 + lane] : 0.f;
            tsum = wave_sum(tsum);
            const float rs = rsqrtf(tsum * (1.0f / DM) + 1e-6f);
#pragma unroll
            for (int q = 0; q < 4; ++q) {
                const float4 v = *(const float4*)&out[(size_t)row * DM + q * 256 + lane * 4];
                const float4 gg = *(const float4*)&g[q * 256 + lane * 4];
                float4 o; o.x = v.x * rs * gg.x; o.y = v.y * rs * gg.y; o.z = v.z * rs * gg.z; o.w = v.w * rs * gg.w;
                *(float4*)&out[(size_t)row * DM + q * 256 + lane * 4] = o;
            }
        }
    }
#if PROBE >= 50 && PROBE <= 52
    if (PROBE == 50) { __syncthreads(); pc1 = __builtin_amdgcn_s_memtime(); pr1 = __builtin_amdgcn_s_memrealtime(); }
    if (blockIdx.x == 0) {
        const unsigned long long mhz = (pc1 - pc0) * 100ull / (pr1 - pr0 + 1ull);
        const unsigned long long t1_ = __builtin_amdgcn_s_memrealtime(), d_ = mhz * 25ull;
        while (__builtin_amdgcn_s_memrealtime() - t1_ < d_) __builtin_amdgcn_s_sleep(8);
    }
#endif
}

extern "C" void kernel_launch(void* const* d_in, const int* in_sizes, int n_in, void* d_out, int out_size, void* d_ws, size_t ws_size, hipStream_t stream) {
    (void)in_sizes; (void)n_in; (void)out_size; (void)ws_size;
    constexpr int kDynLds = 147456;
    static int grid = 0;
    if (!grid) {
        int dev = 0, cus = 0;
        hipGetDevice(&dev);
        hipDeviceGetAttribute(&cus, hipDeviceAttributeMultiprocessorCount, dev);
        hipFuncSetAttribute((const void*)fwd_kernel, hipFuncAttributeMaxDynamicSharedMemorySize, kDynLds);
        int per_cu = 0;
        hipOccupancyMaxActiveBlocksPerMultiprocessor(&per_cu, fwd_kernel, 512, kDynLds);
        if (per_cu < 1) fprintf(stderr, "occupancy query says %d\n", per_cu);
        grid = cus > 0 ? cus : 256;
    }
    hipMemsetAsync(d_ws, 0, CTL_BYTES, stream);
    Args a;
    memset(&a, 0, sizeof(a));
    for (int i = 0; i < 28; ++i) a.in[i] = (const float*)d_in[i];
    a.out = (float*)d_out;
    a.ws = (unsigned char*)d_ws;
    hipLaunchKernelGGL(fwd_kernel, dim3(grid), dim3(512), kDynLds, stream, a);
}
```

```cpp
#include <hip/hip_runtime.h>
#include <stdint.h>
#include <cstdio>
#include <cstring>
#ifndef PROBE
#define PROBE 0
#endif
#define PAMP_BEGIN(id) unsigned long long pamp_t0_##id = 0; if (PROBE == (id)) pamp_t0_##id = __builtin_amdgcn_s_memrealtime()
#define PAMP_END(id) do { if (PROBE == (id)) { __syncthreads(); const unsigned long long t1_ = __builtin_amdgcn_s_memrealtime(), d_ = t1_ - pamp_t0_##id; while (__builtin_amdgcn_s_memrealtime() - t1_ < d_) __builtin_amdgcn_s_sleep(8); __syncthreads(); } } while (0)

constexpr int DM = 1024, NB = 8, SEQ = 4096, DEPTH = 4, MTOK = NB * SEQ;
constexpr int GW = 512, HD = 64, NH = 8, DMIX = 1536, DIN = 4128;
constexpr int QL = 256, KVL = 128;
constexpr int C_R = 0, C_K = 512, C_V = 1024, C_WL = 1536, C_AL = 1600, C_UB = 1664, C_QL = 2176, C_KVL = 2432, C_KR = 2560,
              C_ZA = 2592, C_ZB = 3104, C_ZC = 3616;
__device__ __forceinline__ int orig_col(int c) {
    if (c < 1664) return c;
    if (c < 2176) return c - 1664 + 2176;
    if (c < 2432) return c - 2176 + 3200;
    if (c < 2560) return c - 2432 + 3456;
    if (c < 2592) return c - 2560 + 3584;
    if (c < 3104) return c - 2592 + 1664;
    if (c < 3616) return c - 3104 + 2688;
    return c;
}
constexpr size_t MiB = 1u << 20;
constexpr size_t WS_CTL = 0, CTL_BYTES = 65536;
constexpr size_t WS_ROPE = 64 * 1024;
constexpr size_t WS_W2T = 576 * 1024;
constexpr size_t WS_SQQ = 1088 * 1024;
constexpr size_t WS_SQKV = 2112 * 1024;
constexpr size_t WS_SSQH = 10 * MiB;
constexpr size_t WS_WMLA = 3 * MiB;
constexpr size_t WS_PROJ = 16 * MiB;
constexpr size_t WS_XN = 354 * MiB;
constexpr size_t WS_K = 274 * MiB;
constexpr size_t WS_V = 322 * MiB;
constexpr size_t WS_Q = 354 * MiB;
constexpr size_t WS_BON = 8 * MiB + 512 * 1024;
constexpr size_t WS_SAVA = 14 * MiB;
constexpr size_t WS_RWD = 480 * MiB;
constexpr size_t WS_GAT = 9 * MiB + 512 * 1024;
constexpr size_t WS_LSUM = 10 * MiB;
constexpr size_t WS_RWP = 402 * MiB;
constexpr size_t WS_WIN = 434 * MiB;
constexpr size_t WS_WOUT = 468 * MiB;
constexpr size_t WS_FREE = 480 * MiB;
constexpr int NPAD_IN = 4352, NMLA = 1792, KMLA = 384;
constexpr int CW_QUEUE = 8192, CW_PROBEQ = 12288, CW_PROBE = 4000, CW_LCNT = 14336, CW_ATTQ = 15000;

#ifndef ATT_THR
#define ATT_THR 8
#endif

typedef unsigned short bf16_t;
__device__ __forceinline__ float bf2f(bf16_t v) { return __builtin_bit_cast(float, (unsigned)v << 16); }
typedef float f32x2_cv __attribute__((ext_vector_type(2)));
typedef __bf16 bf16x2_cv __attribute__((ext_vector_type(2)));
__device__ __forceinline__ unsigned f2bf2(float lo, float hi) { f32x2_cv v = {lo, hi}; bf16x2_cv b = __builtin_convertvector(v, bf16x2_cv); return __builtin_bit_cast(unsigned, b); }
__device__ __forceinline__ bf16_t f2bf(float f) { return (bf16_t)(f2bf2(f, f) & 0xffffu); }
template <int MASK> __device__ __forceinline__ float shx(float v) {
    static_assert(MASK < 32, "shx: within 32 lanes");
    return __builtin_bit_cast(float, __builtin_amdgcn_ds_swizzle(__builtin_bit_cast(int, v), (MASK << 10) | 0x1f));
}
__device__ __forceinline__ void swap32(float v, float& x, float& y) {
    auto rr = __builtin_amdgcn_permlane32_swap(__builtin_bit_cast(unsigned, v), __builtin_bit_cast(unsigned, v), false, false);
    unsigned a = rr[0], b = rr[1]; asm("" : "+v"(a), "+v"(b));
    x = __builtin_bit_cast(float, a); y = __builtin_bit_cast(float, b);
}
template <int CTRL> __device__ __forceinline__ float dppx(float v) { return __builtin_bit_cast(float, __builtin_amdgcn_mov_dpp(__builtin_bit_cast(int, v), CTRL, 0xf, 0xf, true)); }
__device__ __forceinline__ float sum8(float v) { v += dppx<0xB1>(v); v += dppx<0x4E>(v); v += dppx<0x141>(v); return v; }
__device__ __forceinline__ float wave_sum(float v) {
    v += dppx<0xB1>(v); v += dppx<0x4E>(v); v += dppx<0x141>(v); v += dppx<0x140>(v);
    v += shx<16>(v);
    float x, y; swap32(v, x, y);
    return x + y;
}
__device__ __forceinline__ float fexp(float x) { return __builtin_amdgcn_exp2f(x * 1.4426950408889634f); }
__device__ __forceinline__ float frcp(float x) { return __builtin_amdgcn_rcpf(x); }
__device__ __forceinline__ float sigmoidf_(float x) { return frcp(1.0f + fexp(-x)); }
__device__ __forceinline__ float softplusf_(float x) { return x > 20.f ? x : __builtin_amdgcn_logf(1.0f + fexp(x)) * 0.6931471805599453f; }
__device__ __forceinline__ float siluf_(float x) { return x * frcp(1.0f + fexp(-x)); }
__device__ __forceinline__ float ftanh(float x) { return 1.0f - 2.0f * frcp(1.0f + fexp(2.0f * x)); }
__device__ __forceinline__ float nexpm1(float x) { return x > -0.02f ? -x * (1.0f + x * (0.5f + x * 0.16666667f)) : 1.0f - fexp(x); }

__device__ __forceinline__ int otid() { int t = threadIdx.x; asm volatile("" : "+v"(t)); return t; }
template <int K> __device__ __forceinline__ const float* argp() {
    int k = K; asm volatile("" : "+s"(k));
    return (const float*)(((const unsigned long long*)__builtin_amdgcn_kernarg_segment_ptr())[k]);
}
#define ARG(k) argp<k>()
#define ARG_OUT ((float*)argp<28>())
#define ARG_WS ((unsigned char*)argp<29>())

#define XB_TMO      128
#define XB_XCNT(j)  (256  + 64 * (j))
#define XB_XSUB(j)  (1280 + 64 * (j))
#define XB_XGEN(j)  (2304 + 64 * (j))
#define XB_TOP      3328
#define XB_TOPGEN   3392
#define XCD_BAR_WORDS 3456
#define XB_SPIN_CAP (1u << 24)
#define LAS __attribute__((address_space(3)))

__device__ __forceinline__ unsigned xb_ld(unsigned* p)              { return __hip_atomic_load(p, __ATOMIC_RELAXED, __HIP_MEMORY_SCOPE_AGENT); }
__device__ __forceinline__ unsigned xb_add(unsigned* p, unsigned v) { return __hip_atomic_fetch_add(p, v, __ATOMIC_RELAXED, __HIP_MEMORY_SCOPE_AGENT); }
__device__ __forceinline__ unsigned xb_xcc_id() { return (unsigned)__builtin_amdgcn_s_getreg((3 << 11) | 20) & 0xFu; }
#define XB_SPIN(cond, bar) do { unsigned _sp = 0; while (cond) { __builtin_amdgcn_s_sleep(1); \
    if ((++_sp & 255u) == 0u) { if (xb_ld(&(bar)[XB_TMO])) break; if (_sp > XB_SPIN_CAP) { atomicAdd(&(bar)[XB_TMO], 1u); break; } } } } while (0)

struct XcdBarrier { unsigned* bar; unsigned x; volatile LAS unsigned* st; };

__device__ __forceinline__ XcdBarrier xcd_barrier_post(unsigned* bar, volatile LAS unsigned* st) {
    XcdBarrier b; b.bar = bar; b.x = xb_xcc_id(); b.st = st;
    if (threadIdx.x == 0) (void)xb_add(&bar[XB_XCNT(b.x)], 1u);
    return b;
}
__device__ __forceinline__ void xcd_barrier_complete(unsigned* bar, unsigned x, unsigned& nloc, unsigned& nx) {
    const unsigned G = gridDim.x * gridDim.y * gridDim.z;
    unsigned sum, cnt, mine, sp = 0u;
    for (;;) {
        sum = 0u; cnt = 0u; mine = 0u;
#pragma unroll
        for (unsigned j = 0; j < 16; ++j) { const unsigned c = xb_ld(&bar[XB_XCNT(j)]); sum += c; cnt += (c > 0u) ? 1u : 0u; mine = (j == x) ? c : mine; }
        if (sum == G) break;
        __builtin_amdgcn_s_sleep(1);
        if ((++sp & 255u) == 0u) { if (xb_ld(&bar[XB_TMO])) break; if (sp > XB_SPIN_CAP) { atomicAdd(&bar[XB_TMO], 1u); break; } }
    }
    nloc = mine > 0u ? mine : 1u; nx = cnt > 0u ? cnt : 1u;
}
__device__ __forceinline__ void xcd_barrier_raw(const XcdBarrier& b);
__device__ __forceinline__ void xcd_barrier(const XcdBarrier& b) {
#if PROBE == 30
    const unsigned long long t0_ = __builtin_amdgcn_s_memrealtime();
    xcd_barrier_raw(b);
    const unsigned long long t1_ = __builtin_amdgcn_s_memrealtime(), d_ = t1_ - t0_;
    while (__builtin_amdgcn_s_memrealtime() - t1_ < d_) __builtin_amdgcn_s_sleep(8);
    __syncthreads();
#else
    xcd_barrier_raw(b);
#endif
}
__device__ __forceinline__ void xcd_barrier_raw(const XcdBarrier& b) {
    asm volatile("s_waitcnt vmcnt(0)" ::: "memory");
    __syncthreads();
    if (threadIdx.x == 0) {
        unsigned* bar = b.bar;
        __builtin_amdgcn_s_waitcnt(0);
        const unsigned bx = (unsigned)__builtin_amdgcn_readfirstlane((int)xb_xcc_id());
        unsigned nloc = b.st[0], nx = b.st[1];
        if (nloc == 0u) { xcd_barrier_complete(bar, bx, nloc, nx); b.st[0] = nloc; b.st[1] = nx; }
        const unsigned old = xb_add(&bar[XB_XSUB(bx)], 1u);
        const unsigned gen = old / nloc;
        if (old + 1u == (gen + 1u) * nloc) {
            __builtin_amdgcn_fence(__ATOMIC_RELEASE, "agent");
            asm volatile("s_waitcnt vmcnt(0)" ::: "memory");
            const unsigned og = xb_add(&bar[XB_TOP], 1u);
            const unsigned tg = og / nx;
            if (og + 1u == (tg + 1u) * nx) xb_add(&bar[XB_TOPGEN], 1u);
            else XB_SPIN(xb_ld(&bar[XB_TOPGEN]) == tg, bar);
            __builtin_amdgcn_fence(__ATOMIC_ACQUIRE, "agent");
            xb_add(&bar[XB_XGEN(bx)], 1u);
            asm volatile("s_waitcnt vmcnt(0)" ::: "memory");
        } else {
            XB_SPIN(xb_ld(&bar[XB_XGEN(bx)]) == gen, bar);
            __builtin_amdgcn_fence(__ATOMIC_ACQUIRE, "agent");
            asm volatile("s_waitcnt vmcnt(0)" ::: "memory");
        }
    }
    __syncthreads();
}

struct Args {
    const float* in[28];
    float* out;
    unsigned char* ws;
};

namespace pg8 {
#define PG8_LAS __attribute__((address_space(3)))
typedef unsigned short bf16_t;
typedef short bf16x8 __attribute__((ext_vector_type(8)));
typedef float f32x4 __attribute__((ext_vector_type(4)));
typedef unsigned u32x4 __attribute__((ext_vector_type(4)));
constexpr int BM = 256, BK = 64, HALF = 128, HTB = HALF * BK * 2  , STAGE_BYTES = 8 * HTB, NXCD = 8, WGM = 8;

__host__ __device__ __forceinline__ int lds_byte(int r, int c) { const int st = (r >> 4) * 2 + (c >> 5), rr = r & 15, cc = c & 31, ob = rr * 64 + cc * 2; return st * 1024 + (ob ^ (((ob >> 9) & 1) << 5)); }
__host__ __device__ __forceinline__ void stage_rc(int b, int& R, int& C) { const int st = b / 1024, sb = b % 1024, swz = sb ^ (((sb >> 9) & 1) << 5); R = (st >> 1) * 16 + swz / 64; C = (st & 1) * 32 + (swz % 64) / 2; }
__host__ __device__ __forceinline__ int perm32(int rho) { const int n = rho >> 4, i = rho & 15; return 8 * (i >> 2) + 4 * n + (i & 3); }

struct Unit { int pm, pn; };
struct Gemm { const bf16_t* A; const bf16_t* Bt; int M, N, K, lda, ldb; int a_split_pn; int a_split_off; };

struct StaticOrder {
    int nM, nN, nwg, G, c;
    __host__ __device__ void init(int M, int N, int G_, int c_) { nM = M / BM; nN = N / BM; nwg = nM * nN; G = G_; c = c_; }
    __host__ __device__ bool next(int i, Unit& u) const {
        const long L = (long)i * G + c; if (L >= nwg) return false;
        int wgid = (int)L; { const int q = nwg / NXCD, r = nwg % NXCD, xcd = wgid % NXCD, off = wgid / NXCD; wgid = (xcd < r ? xcd * (q + 1) : r * (q + 1) + (xcd - r) * q) + off; }
        const int nig = WGM * nN, gid = wgid / nig, fm = gid * WGM, gsz = (nM - fm) < WGM ? (nM - fm) : WGM;
        u.pm = fm + ((wgid % nig) % gsz); u.pn = (wgid % nig) / gsz; return true;
    }
    __device__ __forceinline__ void a_ready(const Unit&) const {}
    __device__ __forceinline__ void done(const Unit&) const {}
};

__device__ __forceinline__ unsigned cvt_pk_bf16(float lo, float hi) { unsigned r; asm volatile("v_cvt_pk_bf16_f32 %0, %1, %2" : "=v"(r) : "v"(lo), "v"(hi)); return r; }
template <class Epi, class Sched, bool ALIGN_EPI = false, bool SP2 = false>
__device__ __forceinline__ void gemm_phase(PG8_LAS unsigned char* lds, const Gemm g, const Sched& S, const Epi& E) {
    const int tid = otid(), wid = __builtin_amdgcn_readfirstlane(tid >> 6), lane = tid & 63, wr = wid >> 2, wc = wid & 3, fr = lane & 15, fq = lane >> 4;
    const int K = g.K, nt = K / BK;
    unsigned voffA[2], voffB[2];
#pragma unroll
    for (int i = 0; i < 2; ++i) { int R, C; stage_rc(tid * 16 + i * 8192, R, C); const int Rb = Epi::PERM ? ((R & ~31) + perm32(R & 31)) : R;
        voffA[i] = (unsigned)(R * g.lda + C) * 2u; voffB[i] = (unsigned)(Rb * g.ldb + C) * 2u; }
    const size_t kstep = (size_t)(BK * 2);
    const size_t hstepA = (size_t)HALF * g.lda * 2, hstepB = (size_t)HALF * g.ldb * 2;
    const size_t tstepA = 2 * hstepA, tstepB = 2 * hstepB;
    const unsigned ldsw = (unsigned)wid * 1024u;
    const int aoff = lds_byte(wr * 64 + fr, fq * 8), boff = lds_byte(wc * 32 + fr, fq * 8);
#define PG8_SA(b, h) (((b) * 2 + (h)) * HTB)
#define PG8_SB(b, h) ((4 + (b) * 2 + (h)) * HTB)
#define PG8_STAGE(bufoff, gbase, voff) do { _Pragma("unroll") for (int _i = 0; _i < 2; ++_i) \
        __builtin_amdgcn_global_load_lds((const unsigned*)((const char*)(gbase) + (voff)[_i]), (PG8_LAS unsigned*)(lds + (bufoff) + ldsw + _i * 8192), 16, 0, 0); } while (0)
#define PG8_LDA(dst, b, h) do { _Pragma("unroll") for (int m = 0; m < 4; ++m) _Pragma("unroll") for (int k = 0; k < 2; ++k) dst[m][k] = *(const PG8_LAS bf16x8*)(lds + PG8_SA(b, h) + aoff + m * 2048 + k * 1024); } while (0)
#define PG8_LDB(dst, b, h) do { _Pragma("unroll") for (int n = 0; n < 2; ++n) _Pragma("unroll") for (int k = 0; k < 2; ++k) dst[n][k] = *(const PG8_LAS bf16x8*)(lds + PG8_SB(b, h) + boff + n * 2048 + k * 1024); } while (0)
#define PG8_MMA(ai, bj, At, Bt) do { __builtin_amdgcn_s_setprio(1); _Pragma("unroll") for (int m = 0; m < 4; ++m) _Pragma("unroll") for (int n = 0; n < 2; ++n) _Pragma("unroll") for (int k = 0; k < 2; ++k) \
        acc[ai][bj][m][n] = __builtin_amdgcn_mfma_f32_16x16x32_bf16(Bt[n][k], At[m][k], acc[ai][bj][m][n], 0, 0, 0); __builtin_amdgcn_s_setprio(0); } while (0)
#define PG8_WAIT_V(n) asm volatile("s_waitcnt vmcnt(" #n ")" ::: "memory")
#define PG8_WAIT_L(n) asm volatile("s_waitcnt lgkmcnt(" #n ")" ::: "memory")
#define PG8_BAR __builtin_amdgcn_s_barrier()
#define PG8_SCHED __builtin_amdgcn_sched_barrier(0)
    Unit cur, nxt; int ui = 0;
    if (!S.next(0, cur)) return;
    f32x4 acc[2][2][4][2];
#pragma unroll
    for (int a = 0; a < 2; ++a)
#pragma unroll
        for (int b = 0; b < 2; ++b)
#pragma unroll
            for (int m = 0; m < 4; ++m)
#pragma unroll
                for (int n = 0; n < 2; ++n) acc[a][b][m][n] = (f32x4){0.f, 0.f, 0.f, 0.f};
    bf16x8 At[4][2], B0[2][2], B1[2][2];
    const char* cA = (const char*)g.A + (size_t)cur.pm * tstepA + (cur.pn >= g.a_split_pn ? g.a_split_off : 0); const char* cB = (const char*)g.Bt + (size_t)cur.pn * tstepB;
    S.a_ready(cur);
    if constexpr (SP2) {
        PG8_STAGE(PG8_SB(0, 0), cB, voffB); PG8_STAGE(PG8_SB(0, 1), cB + hstepB, voffB); PG8_STAGE(PG8_SA(0, 0), cA, voffA); PG8_STAGE(PG8_SA(0, 1), cA + hstepA, voffA);
        if (wr == 1) PG8_BAR;
        PG8_WAIT_V(2); PG8_BAR;
        PG8_STAGE(PG8_SB(1, 0), cB + kstep, voffB); PG8_STAGE(PG8_SA(1, 0), cA + kstep, voffA); PG8_STAGE(PG8_SB(1, 1), cB + hstepB + kstep, voffB);
        PG8_WAIT_V(6); PG8_BAR;
    } else {
        PG8_STAGE(PG8_SB(0, 0), cB, voffB); PG8_STAGE(PG8_SA(0, 0), cA, voffA); PG8_STAGE(PG8_SB(0, 1), cB + hstepB, voffB); PG8_STAGE(PG8_SA(0, 1), cA + hstepA, voffA);
        if (wr == 1) PG8_BAR;
        PG8_WAIT_V(4); PG8_BAR;
        PG8_STAGE(PG8_SB(1, 0), cB + kstep, voffB); PG8_STAGE(PG8_SA(1, 0), cA + kstep, voffA); PG8_STAGE(PG8_SB(1, 1), cB + hstepB + kstep, voffB);
        PG8_WAIT_V(6); PG8_BAR;
    }
    for (;;) {
        const bool has_next = S.next(ui + 1, nxt);
        const char* nA = has_next ? (const char*)g.A + (size_t)nxt.pm * tstepA + (nxt.pn >= g.a_split_pn ? g.a_split_off : 0) : cA; const char* nB = has_next ? (const char*)g.Bt + (size_t)nxt.pn * tstepB : cB;
        for (int t = 0; t < nt; t += 2) {
            const bool last = (t == nt - 2);
            const char* a1 = cA + (size_t)(t + 1) * kstep;
            const char* a2 = last ? nA : cA + (size_t)(t + 2) * kstep; const char* b2 = last ? nB : cB + (size_t)(t + 2) * kstep;
            const char* a3 = a2 + kstep; const char* b3 = b2 + kstep;
            if (last && has_next) S.a_ready(nxt);
            if constexpr (SP2) {
            PG8_LDB(B0, 0, 0); PG8_LDB(B1, 0, 1); PG8_SCHED; PG8_LDA(At, 0, 0); PG8_STAGE(PG8_SA(1, 1), a1 + hstepA, voffA);
            PG8_WAIT_V(8); PG8_WAIT_L(0); PG8_BAR; PG8_MMA(0, 0, At, B0); PG8_MMA(0, 1, At, B1); PG8_BAR; PG8_SCHED;
            PG8_LDA(At, 0, 1); PG8_STAGE(PG8_SB(0, 0), b2, voffB); PG8_STAGE(PG8_SB(0, 1), b2 + hstepB, voffB); PG8_STAGE(PG8_SA(0, 0), a2, voffA);
            PG8_WAIT_V(8); PG8_WAIT_L(0); PG8_BAR; PG8_MMA(1, 0, At, B0); PG8_MMA(1, 1, At, B1); PG8_BAR; PG8_SCHED;
            PG8_LDB(B0, 1, 0); PG8_LDB(B1, 1, 1); PG8_SCHED; PG8_LDA(At, 1, 0); PG8_STAGE(PG8_SA(0, 1), a2 + hstepA, voffA);
            PG8_WAIT_V(8); PG8_WAIT_L(0); PG8_BAR; PG8_MMA(0, 0, At, B0); PG8_MMA(0, 1, At, B1); PG8_BAR; PG8_SCHED;
            PG8_LDA(At, 1, 1); PG8_STAGE(PG8_SB(1, 0), b3, voffB); PG8_STAGE(PG8_SB(1, 1), b3 + hstepB, voffB); PG8_STAGE(PG8_SA(1, 0), a3, voffA);
            PG8_WAIT_V(8); PG8_WAIT_L(0); PG8_BAR; PG8_MMA(1, 0, At, B0); PG8_MMA(1, 1, At, B1); PG8_BAR; PG8_SCHED;
            } else {
            PG8_LDB(B0, 0, 0); PG8_SCHED; PG8_LDA(At, 0, 0); PG8_STAGE(PG8_SA(1, 1), a1 + hstepA, voffA);
            PG8_WAIT_L(8); PG8_BAR; PG8_WAIT_L(0); PG8_MMA(0, 0, At, B0); PG8_BAR; PG8_SCHED;
            PG8_LDB(B1, 0, 1); PG8_STAGE(PG8_SB(0, 0), b2, voffB);
            PG8_BAR; PG8_WAIT_L(0); PG8_MMA(0, 1, At, B1); PG8_BAR;
            PG8_LDA(At, 0, 1); PG8_STAGE(PG8_SA(0, 0), a2, voffA);
            PG8_BAR; PG8_WAIT_L(0); PG8_MMA(1, 0, At, B0); PG8_BAR; PG8_SCHED;
            PG8_STAGE(PG8_SB(0, 1), b2 + hstepB, voffB);
            PG8_WAIT_V(6); PG8_BAR; PG8_MMA(1, 1, At, B1); PG8_BAR;
            PG8_LDB(B0, 1, 0); PG8_SCHED; PG8_LDA(At, 1, 0); PG8_STAGE(PG8_SA(0, 1), a2 + hstepA, voffA);
            PG8_WAIT_L(8); PG8_BAR; PG8_WAIT_L(0); PG8_MMA(0, 0, At, B0); PG8_BAR; PG8_SCHED;
            PG8_LDB(B1, 1, 1); PG8_STAGE(PG8_SB(1, 0), b3, voffB);
            PG8_BAR; PG8_WAIT_L(0); PG8_MMA(0, 1, At, B1); PG8_BAR;
            PG8_LDA(At, 1, 1); PG8_STAGE(PG8_SA(1, 0), a3, voffA);
            PG8_BAR; PG8_WAIT_L(0); PG8_MMA(1, 0, At, B0); PG8_BAR; PG8_SCHED;
            PG8_STAGE(PG8_SB(1, 1), b3 + hstepB, voffB);
            PG8_WAIT_V(6); PG8_BAR; PG8_MMA(1, 1, At, B1); PG8_BAR;
            }
        }
        if constexpr (ALIGN_EPI) { if (wr == 0) PG8_BAR; }
        if constexpr (!Epi::AFTER_DRAIN) { E(acc, cur, wr, wc, fr, fq); S.done(cur); }
        if (!has_next) break;
#pragma unroll
        for (int a = 0; a < 2; ++a)
#pragma unroll
            for (int b = 0; b < 2; ++b)
#pragma unroll
                for (int m = 0; m < 4; ++m)
#pragma unroll
                    for (int n = 0; n < 2; ++n) acc[a][b][m][n] = (f32x4){0.f, 0.f, 0.f, 0.f};
        cur = nxt; cA = nA; cB = nB; ++ui;
        if constexpr (ALIGN_EPI) { if (wr == 1) PG8_BAR; }
    }
    PG8_WAIT_V(0);
    if constexpr (!ALIGN_EPI) { if (wr == 0) PG8_BAR; }
    PG8_BAR;
    if constexpr (Epi::AFTER_DRAIN) { E.fused(acc, cur, wr, wc, fr, fq, lds, wid, lane); S.done(cur); }
#undef PG8_SA
#undef PG8_SB
#undef PG8_STAGE
#undef PG8_LDA
#undef PG8_LDB
#undef PG8_MMA
#undef PG8_WAIT_V
#undef PG8_WAIT_L
#undef PG8_BAR
#undef PG8_SCHED
}
}

namespace pg8 {
struct EpiProj {
    static constexpr bool PERM = true, AFTER_DRAIN = false;
    bf16_t* O; int ldc; int ncols; const float* ssqh; float* sqq; float* sqkv; bf16_t* Kb; const float* rope; bf16_t* sav;
    __device__ __forceinline__ void operator()(const f32x4 (&acc)[2][2][4][2], const Unit& u, int wr, int wc, int fr, int fq) const {
        const int row0 = u.pm * BM + wr * 64 + fr, col0 = u.pn * BM + wc * 32 + 8 * fq;
        const int lane_hi = (fq >> 1);
#pragma unroll
        for (int ai = 0; ai < 2; ++ai)
#pragma unroll
            for (int m = 0; m < 4; ++m) {
                const int row = row0 + ai * HALF + m * 16;
                float rs;
                { const f32x4 s0 = *(const f32x4*)(ssqh + (size_t)row * 16), s1 = *(const f32x4*)(ssqh + (size_t)row * 16 + 4), s2 = *(const f32x4*)(ssqh + (size_t)row * 16 + 8), s3 = *(const f32x4*)(ssqh + (size_t)row * 16 + 12);
                  const float t = (((s0[0] + s0[1]) + (s0[2] + s0[3])) + ((s1[0] + s1[1]) + (s1[2] + s1[3]))) + (((s2[0] + s2[1]) + (s2[2] + s2[3])) + ((s3[0] + s3[1]) + (s3[2] + s3[3])));
                  rs = rsqrtf(t * (1.0f / DM) + 1e-6f); }
                bf16_t* rowp = O + (size_t)row * ldc + col0;
#pragma unroll
                for (int bj = 0; bj < 2; ++bj) {
                    const f32x4 v0 = acc[ai][bj][m][0] * rs, v1 = acc[ai][bj][m][1] * rs;
                    u32x4 w; w.x = cvt_pk_bf16(v0[0], v0[1]); w.y = cvt_pk_bf16(v0[2], v0[3]); w.z = cvt_pk_bf16(v1[0], v1[1]); w.w = cvt_pk_bf16(v1[2], v1[3]);
                    const int col = col0 + bj * HALF;
                    if (col < ncols) *(u32x4*)(rowp + bj * HALF) = w;
                    if (u.pn <= 6 && m == 3 && fr == 15 && col < 1664) {
                        const int t = row & (SEQ - 1), cn = (t >> 6) + 1;
                        if (cn < 64) *(u32x4*)(sav + ((size_t)(row >> 12) * 64 + cn) * 1664 + col) = w;
                    }
                    const bool isq = (u.pn == 8 && bj == 1) || (u.pn == 9 && bj == 0), iskv = (u.pn == 9 && bj == 1);
                    if (isq || iskv) {
                        float ss = (v0[0] * v0[0] + v0[1] * v0[1]) + (v0[2] * v0[2] + v0[3] * v0[3]) + (v1[0] * v1[0] + v1[1] * v1[1]) + (v1[2] * v1[2] + v1[3] * v1[3]);
                        ss += shx<16>(ss); { float x, y; swap32(ss, x, y); ss = x + y; }
                        if (fq == 0) { if (iskv) sqkv[(size_t)row * 4 + wc] = ss; else sqq[(size_t)row * 8 + (u.pn == 8 ? 0 : 4) + wc] = ss; }
                    }
                    if (u.pn == 10 && bj == 0 && wc == 0) {
                        const int t = row & (SEQ - 1);
                        const float* rp = rope + ((size_t)t * 16 + 8 * (fq & 1)) * 2;
                        const f32x4 c0 = *(const f32x4*)rp, c1 = *(const f32x4*)(rp + 4), c2 = *(const f32x4*)(rp + 8), c3 = *(const f32x4*)(rp + 12);
                        const float cs[8] = {c0[0], c0[2], c1[0], c1[2], c2[0], c2[2], c3[0], c3[2]}, sn[8] = {c0[1], c0[3], c1[1], c1[3], c2[1], c2[3], c3[1], c3[3]};
                        const float own[8] = {v0[0], v0[1], v0[2], v0[3], v1[0], v1[1], v1[2], v1[3]};
                        float o[8];
#pragma unroll
                        for (int e = 0; e < 8; ++e) { float x, y; swap32(own[e], x, y); const float oth = lane_hi ? x : y;
                            o[e] = lane_hi ? (oth * sn[e] + own[e] * cs[e]) : (own[e] * cs[e] - oth * sn[e]); }
                        u32x4 kw; kw.x = cvt_pk_bf16(o[0], o[1]); kw.y = cvt_pk_bf16(o[2], o[3]); kw.z = cvt_pk_bf16(o[4], o[5]); kw.w = cvt_pk_bf16(o[6], o[7]);
#pragma unroll
                        for (int hh = 0; hh < 8; ++hh) *(u32x4*)(Kb + ((size_t)row * 8 + hh) * 96 + 64 + 8 * fq) = kw;
                    }
                }
                asm volatile("" ::: "memory");
            }
    }
};
struct EpiResid {
    static constexpr bool PERM = false, AFTER_DRAIN = false;
    float* C; const float* R; int ldc; bool dry; bf16_t* HB; float* ssq;
    __device__ __forceinline__ void operator()(const f32x4 (&acc)[2][2][4][2], const Unit& u, int wr, int wc, int fr, int fq) const {
        const int row0 = u.pm * BM + wr * 64 + fr, col0 = u.pn * BM + wc * 32 + 4 * fq;
        typedef unsigned u32x2 __attribute__((ext_vector_type(2)));
#pragma unroll
        for (int ai = 0; ai < 2; ++ai)
#pragma unroll
            for (int m = 0; m < 4; ++m) { const int row = row0 + ai * HALF + m * 16; const size_t off = (size_t)row * ldc + col0;
                float ss = 0.f;
#pragma unroll
                for (int bj = 0; bj < 2; ++bj)
#pragma unroll
                    for (int n = 0; n < 2; ++n) { const f32x4 r = *(const f32x4*)(R + off + bj * HALF + n * 16); const f32x4 o = r + acc[ai][bj][m][n];
                        ss += (o[0] * o[0] + o[1] * o[1]) + (o[2] * o[2] + o[3] * o[3]);
                        u32x2 hb; hb.x = cvt_pk_bf16(o[0], o[1]); hb.y = cvt_pk_bf16(o[2], o[3]);
                        if (!dry) { *(f32x4*)(C + off + bj * HALF + n * 16) = o; *(u32x2*)(HB + off + bj * HALF + n * 16) = hb; } }
                ss += shx<16>(ss); { float x, y; swap32(ss, x, y); ss = x + y; }
                if (fq == 0 && !dry) ssq[(size_t)row * 16 + u.pn * 4 + wc] = ss;
            }
    }
};
struct EpiMla {
    static constexpr bool PERM = false, AFTER_DRAIN = false;
    bf16_t* Q; bf16_t* K; bf16_t* V; const float* sqq; const float* sqkv; const float* rope; float c2; int pn0;
    __device__ __forceinline__ void operator()(const f32x4 (&acc)[2][2][4][2], const Unit& u, int wr, int wc, int fr, int fq) const {
        const int row0 = u.pm * BM + wr * 64 + fr;
        typedef unsigned u32x2 __attribute__((ext_vector_type(2)));
#pragma unroll
        for (int ai = 0; ai < 2; ++ai)
#pragma unroll
            for (int m = 0; m < 4; ++m) {
                const int row = row0 + ai * HALF + m * 16;
                const f32x4 q0 = *(const f32x4*)(sqq + (size_t)row * 8), q1 = *(const f32x4*)(sqq + (size_t)row * 8 + 4), k0 = *(const f32x4*)(sqkv + (size_t)row * 4);
                const float rq = rsqrtf((((q0[0] + q0[1]) + (q0[2] + q0[3])) + ((q1[0] + q1[1]) + (q1[2] + q1[3]))) * (1.0f / QL) + 1e-6f), rk = rsqrtf(((k0[0] + k0[1]) + (k0[2] + k0[3])) * (1.0f / KVL) + 1e-6f);
#pragma unroll
                for (int bj = 0; bj < 2; ++bj) {
                    const int pn = u.pn + pn0; const int cg = pn * BM + bj * HALF + wc * 32;
                    f32x4 v0 = acc[ai][bj][m][0], v1 = acc[ai][bj][m][1];
                    if (pn < 3) {
                        v0 = v0 * rq; v1 = v1 * rq;
                        if (((cg >> 5) % 3) == 2) {
                            const int t = row & (SEQ - 1);
                            const f32x4 cs0 = *(const f32x4*)(rope + ((size_t)t * 16 + 4 * fq) * 2), cs1 = *(const f32x4*)(rope + ((size_t)t * 16 + 4 * fq) * 2 + 4);
                            const float c[4] = {cs0[0], cs0[2], cs1[0], cs1[2]}, sn[4] = {cs0[1], cs0[3], cs1[1], cs1[3]};
                            f32x4 o0, o1;
#pragma unroll
                            for (int j = 0; j < 4; ++j) { o0[j] = v0[j] * c[j] - v1[j] * sn[j]; o1[j] = v0[j] * sn[j] + v1[j] * c[j]; }
                            v0 = o0; v1 = o1;
                        }
                        v0 = v0 * c2; v1 = v1 * c2;
                        bf16_t* p = Q + (size_t)row * 768 + cg + 4 * fq;
                        u32x2 w0, w1; w0.x = cvt_pk_bf16(v0[0], v0[1]); w0.y = cvt_pk_bf16(v0[2], v0[3]); w1.x = cvt_pk_bf16(v1[0], v1[1]); w1.y = cvt_pk_bf16(v1[2], v1[3]);
                        *(u32x2*)p = w0; *(u32x2*)(p + 16) = w1;
                    } else {
                        v0 = v0 * rk; v1 = v1 * rk;
                        const int c = cg - 768, hh = c >> 7, d = (c & 127) + 4 * fq;
                        u32x2 w0, w1; w0.x = cvt_pk_bf16(v0[0], v0[1]); w0.y = cvt_pk_bf16(v0[2], v0[3]); w1.x = cvt_pk_bf16(v1[0], v1[1]); w1.y = cvt_pk_bf16(v1[2], v1[3]);
                        bf16_t* p = (d < 64) ? K + ((size_t)row * 8 + hh) * 96 + d : V + ((size_t)row * 8 + hh) * 64 + (d - 64);
                        *(u32x2*)p = w0; *(u32x2*)(p + 16) = w1;
                    }
                }
                asm volatile("" ::: "memory");
            }
    }
};
}

typedef float f32x4_t __attribute__((ext_vector_type(4)));
typedef unsigned u32x4_t __attribute__((ext_vector_type(4)));
template <class SRC4>
__device__ __forceinline__ void transpose_w(int K, int npad, bf16_t* WT, const SRC4& src4, float* lds) {
    const int tid = otid();
    const int tk = K / 64, tn = npad / 64;
    const int kk = tid >> 4, n4 = (tid & 15) * 4;
    const int nn = tid >> 3, k8 = (tid & 7) * 8;
    int par = 0;
    __syncthreads();
    for (int u = blockIdx.x; u < tk * tn; u += gridDim.x, par ^= 1) {
        const int k0 = (u % tk) * 64, n0 = (u / tk) * 64;
        float* tile = lds + par * (64 * 65);
        const f32x4_t v0 = src4(k0 + kk, n0 + n4), v1 = src4(k0 + kk + 32, n0 + n4);
#pragma unroll
        for (int e = 0; e < 4; ++e) { tile[kk * 65 + n4 + e] = v0[e]; tile[(kk + 32) * 65 + n4 + e] = v1[e]; }
        __syncthreads();
        u32x4_t w;
        w.x = f2bf2(tile[(k8 + 0) * 65 + nn], tile[(k8 + 1) * 65 + nn]); w.y = f2bf2(tile[(k8 + 2) * 65 + nn], tile[(k8 + 3) * 65 + nn]);
        w.z = f2bf2(tile[(k8 + 4) * 65 + nn], tile[(k8 + 5) * 65 + nn]); w.w = f2bf2(tile[(k8 + 6) * 65 + nn], tile[(k8 + 7) * 65 + nn]);
        *(u32x4_t*)(WT + (size_t)(n0 + nn) * K + k0 + k8) = w;
    }
}

template <class AL, class BL, class ST>
__device__ __forceinline__ void gemm_naive(int M, int N, int K, const AL& al, const BL& bl, const ST& st, float* lds) {
    float* As = lds;
    float* Bs = lds + 16 * 132;
    const int tid = otid(), ty = tid >> 4, tx = tid & 15;
    const int ntn = (N + 127) / 128, ntiles = (M / 128) * ntn;
    for (int u = blockIdx.x; u < ntiles; u += gridDim.x) {
        const int tm = u / ntn, tn = u % ntn;
        float acc[4][8];
#pragma unroll
        for (int i = 0; i < 4; ++i)
#pragma unroll
            for (int j = 0; j < 8; ++j) acc[i][j] = 0.f;
        for (int k0 = 0; k0 < K; k0 += 16) {
#pragma unroll
            for (int j = 0; j < 4; ++j) { const int idx = tid + j * 512, r = idx >> 4, k = idx & 15; As[k * 132 + r] = al(tm * 128 + r, k0 + k); }
#pragma unroll
            for (int j = 0; j < 4; ++j) { const int idx = tid + j * 512, k = idx >> 7, c = idx & 127; Bs[k * 132 + c] = bl(k0 + k, tn * 128 + c); }
            __syncthreads();
#pragma unroll 2
            for (int k = 0; k < 16; ++k) {
                const float4 a4 = *(const float4*)&As[k * 132 + ty * 4];
                const float4 b0 = *(const float4*)&Bs[k * 132 + tx * 8], b1 = *(const float4*)&Bs[k * 132 + tx * 8 + 4];
                const float av[4] = {a4.x, a4.y, a4.z, a4.w};
                const float bv[8] = {b0.x, b0.y, b0.z, b0.w, b1.x, b1.y, b1.z, b1.w};
#pragma unroll
                for (int i = 0; i < 4; ++i)
#pragma unroll
                    for (int j = 0; j < 8; ++j) acc[i][j] = fmaf(av[i], bv[j], acc[i][j]);
            }
            __syncthreads();
        }
#pragma unroll
        for (int i = 0; i < 4; ++i)
#pragma unroll
            for (int j = 0; j < 8; ++j) st(tm * 128 + ty * 4 + i, tn * 128 + tx * 8 + j, acc[i][j]);
    }
}

namespace rw {
typedef short bf16x8 __attribute__((ext_vector_type(8)));
typedef float f32x16 __attribute__((ext_vector_type(16)));
typedef float f32x4 __attribute__((ext_vector_type(4)));
typedef unsigned u32x2 __attribute__((ext_vector_type(2)));
typedef unsigned u32x4 __attribute__((ext_vector_type(4)));
constexpr int PB = 144, MB = 64 * PB;
constexpr int L_KKD = 0, L_RD = MB, L_BH = 2 * MB, L_KH = 3 * MB, L_BDT = 4 * MB, L_KDT = 5 * MB, L_VT = 6 * MB, L_KKDT = 7 * MB, L_BK = 8 * MB, L_WTT = 9 * MB, L_VTT = 10 * MB;
constexpr int L_AB = L_KKD, L_AK = L_BH, L_BB = L_KH, L_XWL = L_BK, L_XAL = L_WTT;
constexpr int L_F32 = 11 * MB;
constexpr int L_DEC = L_F32, L_AA = L_F32 + 17408, L_AKVT = L_F32, L_DIAG = L_F32 + 17408, L_TINV = L_DIAG + 4096;
constexpr int L_GC = L_F32 + 34816, L_SEG = L_GC + 256, L_END = L_SEG + 2048;
__device__ __forceinline__ int crow(int r, int hi) { return (r & 3) + 8 * (r >> 2) + 4 * hi; }
__device__ __forceinline__ unsigned pk2(float lo, float hi) { return f2bf2(lo, hi); }
#define RW_FRAG(base, row, ks) (*(const LAS bf16x8*)(shm + (base) + (row) * PB + (16 * (ks) + 8 * hi) * 2))
#define RW_MFMA(a, b, c) __builtin_amdgcn_mfma_f32_32x32x16_bf16(a, b, c, 0, 0, 0)

struct R1Raw { bf16_t q[5][9]; };
__device__ __forceinline__ void r1_load(R1Raw& r, const bf16_t* PROJ, const bf16_t* sava, int b, int h, int c, int tq, int lane) {
    const unsigned row0 = (unsigned)b * SEQ + (unsigned)c * 64;
    const __amdgpu_buffer_rsrc_t rs = __builtin_amdgcn_make_buffer_rsrc((void*)PROJ, 0, 0x7fffffff, 0x00020000);
    const int cols[5] = {C_R + h * 64 + lane, C_K + h * 64 + lane, C_V + h * 64 + lane, C_WL + lane, C_AL + lane};
    const unsigned rb = (unsigned)__builtin_amdgcn_readfirstlane((int)((row0 + (unsigned)tq) * (unsigned)(DIN * 2)));
    if (tq == 0) {
        const bf16_t* sav = sava + ((size_t)b * 64 + c) * 1664;
#pragma unroll
        for (int k = 0; k < 5; ++k) r.q[k][0] = (c > 0) ? sav[cols[k]] : (bf16_t)0;
    } else {
#pragma unroll
        for (int k = 0; k < 5; ++k) r.q[k][0] = (bf16_t)__builtin_amdgcn_raw_buffer_load_b16(rs, cols[k] * 2, rb - (unsigned)(DIN * 2), 0);
    }
#pragma unroll
    for (int k = 0; k < 5; ++k)
#pragma unroll
        for (int e = 0; e < 8; ++e) r.q[k][e + 1] = (bf16_t)__builtin_amdgcn_raw_buffer_load_b16(rs, cols[k] * 2, rb + (unsigned)(e * DIN * 2), 0);
}
__device__ __forceinline__ void r1_phase(int l, LAS char* shm, const bool dry = false) {
    const int tid0 = otid(), lane_o = tid0 & 63, r32o = lane_o & 31, hio = lane_o >> 5;
    const int wid = __builtin_amdgcn_readfirstlane(tid0 >> 6);
    bf16_t* PROJ = (bf16_t*)(ARG_WS + WS_PROJ);
    const bf16_t* sava = (const bf16_t*)(ARG_WS + WS_SAVA);
    const int h = blockIdx.x & 7, jw = blockIdx.x >> 3, nper = gridDim.x >> 3;
    const int ch = h * 64 + lane_o;
    const int tq = wid * 8;
    const float* mu = ARG(3) + (size_t)l * 1664;
    const float mu5[5] = {mu[C_R + ch], mu[C_K + ch], mu[C_V + ch], mu[C_WL + lane_o], mu[C_AL + lane_o]};
    const float kkc = (ARG(8) + (size_t)l * 512)[ch], kac = (ARG(9) + (size_t)l * 512)[ch], rkc = (ARG(10) + (size_t)l * 512)[ch];
    const int pB = wid >> 2, tlB = wid & 3, trB = 32 * (tlB >> 1), ncB = 32 * (tlB & 1);
    const float biasB = ((pB ? ARG(6) : ARG(4)) + (size_t)l * 512)[h * 64 + ncB + r32o];
    R1Raw cur, nxt;
    if (jw < 512) r1_load(cur, PROJ, sava, jw >> 6, h, jw & 63, tq, lane_o);
    for (int idx = jw; idx < 512; idx += nper) {
    const int tidl = otid(), lanel = tidl & 63, r32 = lanel & 31, hi = lanel >> 5;
    (void)hio;
    const int lane = lanel;
    const int b = idx >> 6, c = idx & 63;
    const size_t row0 = (size_t)b * SEQ + (size_t)c * 64;
    const int unit = (b * 8 + h) * 64 + c;
    float xr[8], xk[8];
    bf16x8 wfr[4];
    { const bf16_t* wt = (const bf16_t*)(ARG_WS + WS_W2T) + (size_t)pB * DEPTH * 512 * 64 + ((size_t)l * 512 + h * 64 + ncB + r32) * 64;
#pragma unroll
      for (int ks = 0; ks < 4; ++ks) wfr[ks] = *(const bf16x8*)(wt + 16 * ks + 8 * hi); }
    __syncthreads();
    PAMP_BEGIN(31);
    {
        auto lerp = [&](int k, float (&x)[8]) {
            const float m = mu5[k]; float prv = bf2f(cur.q[k][0]);
#pragma unroll
            for (int e = 0; e < 8; ++e) { const float cv = bf2f(cur.q[k][e + 1]); x[e] = cv + m * (prv - cv); prv = cv; }
        };
        float xv[8], xw[8], xa[8];
        lerp(0, xr); lerp(1, xk); lerp(2, xv); lerp(3, xw); lerp(4, xa);
        u32x4 vv; vv.x = pk2(xv[0], xv[1]); vv.y = pk2(xv[2], xv[3]); vv.z = pk2(xv[4], xv[5]); vv.w = pk2(xv[6], xv[7]);
        *(LAS u32x4*)(shm + L_VT + lane * PB + tq * 2) = vv;
#pragma unroll
        for (int e = 0; e < 8; ++e) {
            *(LAS bf16_t*)(shm + L_XWL + (tq + e) * PB + lane * 2) = f2bf(ftanh(xw[e]));
            *(LAS bf16_t*)(shm + L_XAL + (tq + e) * PB + lane * 2) = f2bf(xa[e]);
        }
    }
    __syncthreads();
    {
        const int p = pB, tr = trB, nc = ncB;
        f32x16 acc;
#pragma unroll
        for (int r = 0; r < 16; ++r) acc[r] = biasB;
        const int xb = p ? L_XAL : L_XWL;
#pragma unroll
        for (int ks = 0; ks < 4; ++ks) acc = RW_MFMA(RW_FRAG(xb, tr + r32, ks), wfr[ks], acc);
        LAS float* dst = (LAS float*)(shm + (p ? L_AA : L_DEC));
#pragma unroll
        for (int r = 0; r < 16; ++r) dst[(tr + crow(r, hi)) * 68 + nc + r32] = acc[r];
    }
    __syncthreads();
    PAMP_END(31);
    PAMP_BEGIN(32);
    {
        float* bon = (float*)(ARG_WS + WS_BON);
        float kkn[8], kpv[8], bbv[8], ld[8], lg[8];
        float run = 0.f;
        LAS float* zb = (LAS float*)(shm + L_KKDT) + wid * (16 * 64 + 16);
#pragma unroll
        for (int e = 0; e < 8; ++e) {
            const float dec = ((const LAS float*)(shm + L_DEC))[(tq + e) * 68 + lane], aav = ((const LAS float*)(shm + L_AA))[(tq + e) * 68 + lane];
            ld[e] = -0.6065306597126334f * sigmoidf_(dec);
            const float av = sigmoidf_(aav);
            const float kkr = xk[e] * kkc;
            kkn[e] = kkr; bbv[e] = kkr * av;
            kpv[e] = xk[e] * (1.0f + (av - 1.0f) * kac);
            zb[e * 64 + lane] = kkr * kkr;
            zb[(8 + e) * 64 + lane] = xr[e] * kpv[e] * rkc;
            run += ld[e]; lg[e] = run;
        }
        {
            const LAS f32x4* zp = (const LAS f32x4*)(zb + (lane >> 2) * 64 + (lane & 3) * 16);
            const f32x4 z0 = zp[0], z1 = zp[1], z2 = zp[2], z3 = zp[3];
            float tsum = (((z0[0] + z0[1]) + (z0[2] + z0[3])) + ((z1[0] + z1[1]) + (z1[2] + z1[3]))) + (((z2[0] + z2[1]) + (z2[2] + z2[3])) + ((z3[0] + z3[1]) + (z3[2] + z3[3])));
            tsum += dppx<0xB1>(tsum); tsum += dppx<0x4E>(tsum);
            if ((lane & 3) == 0) zb[16 * 64 + (lane >> 2)] = tsum;
            const f32x4 n0 = *(const LAS f32x4*)(zb + 16 * 64), n1 = *(const LAS f32x4*)(zb + 16 * 64 + 4);
            const float n2[8] = {n0[0], n0[1], n0[2], n0[3], n1[0], n1[1], n1[2], n1[3]};
#pragma unroll
            for (int e = 0; e < 8; ++e) { const float rn = __builtin_amdgcn_rsqf(fmaxf(n2[e], 1e-24f)); kkn[e] *= rn; bbv[e] *= rn; }
            if (lane < 8 && !dry) bon[(row0 + tq + lane) * 8 + h] = zb[16 * 64 + 8 + lane];
        }
        ((LAS float*)(shm + L_SEG))[wid * 64 + lane] = run;
        __syncthreads();
        float off = 0.f, tot = 0.f;
#pragma unroll
        for (int w = 0; w < 8; ++w) { const float sgm = ((const LAS float*)(shm + L_SEG))[w * 64 + lane]; tot += sgm; if (w < wid) off += sgm; }
        const float gct = fexp(tot);
        if (wid == 0) ((LAS float*)(shm + L_GC))[lane] = gct;
        float tb[8], tk[8], tkk[8];
        float gprev = fexp(off);
#pragma unroll
        for (int e = 0; e < 8; ++e) {
            const float L = off + lg[e];
            const float g = fexp(L), gp = gprev, ig = frcp(g), ge = gct * ig;
            gprev = g;
            const int t = tq + e;
            const float kkd = kkn[e] * gp;
            *(LAS bf16_t*)(shm + L_KKD + t * PB + lane * 2) = f2bf(kkd);
            *(LAS bf16_t*)(shm + L_RD + t * PB + lane * 2) = f2bf(xr[e] * g);
            *(LAS bf16_t*)(shm + L_BH + t * PB + lane * 2) = f2bf(bbv[e] * ig);
            *(LAS bf16_t*)(shm + L_KH + t * PB + lane * 2) = f2bf(kpv[e] * ig);
            tb[e] = bbv[e] * ge; tk[e] = kpv[e] * ge; tkk[e] = kkd;
        }
        u32x4 v;
        v.x = pk2(tb[0], tb[1]); v.y = pk2(tb[2], tb[3]); v.z = pk2(tb[4], tb[5]); v.w = pk2(tb[6], tb[7]); *(LAS u32x4*)(shm + L_BDT + lane * PB + tq * 2) = v;
        v.x = pk2(tk[0], tk[1]); v.y = pk2(tk[2], tk[3]); v.z = pk2(tk[4], tk[5]); v.w = pk2(tk[6], tk[7]); *(LAS u32x4*)(shm + L_KDT + lane * PB + tq * 2) = v;
        v.x = pk2(tkk[0], tkk[1]); v.y = pk2(tkk[2], tkk[3]); v.z = pk2(tkk[4], tkk[5]); v.w = pk2(tkk[6], tkk[7]); *(LAS u32x4*)(shm + L_KKDT + lane * PB + tq * 2) = v;
    }
    __syncthreads();
    PAMP_END(32);
    PAMP_BEGIN(33);
    {
        const int mat = wid & 3;
        const int ab = (mat < 2) ? L_KKD : L_RD, bb = (mat & 1) ? L_KH : L_BH;
        const int ob = (mat == 0) ? L_AB : (mat == 1) ? L_AK : (mat == 2) ? L_BB : L_BK;
        f32x16 acc0, acc1;
#pragma unroll
        for (int r = 0; r < 16; ++r) { acc0[r] = 0.f; acc1[r] = 0.f; }
        if (wid < 4) {
#pragma unroll
            for (int ks = 0; ks < 4; ++ks) { acc0 = RW_MFMA(RW_FRAG(ab, r32, ks), RW_FRAG(bb, r32, ks), acc0); acc1 = RW_MFMA(RW_FRAG(ab, 32 + r32, ks), RW_FRAG(bb, 32 + r32, ks), acc1); }
        } else {
#pragma unroll
            for (int ks = 0; ks < 4; ++ks) acc0 = RW_MFMA(RW_FRAG(ab, 32 + r32, ks), RW_FRAG(bb, r32, ks), acc0);
        }
        __syncthreads();
        if (wid < 4) {
            const int lim = (mat < 2) ? 1 : 0;
            LAS char* o0 = shm + ob + (4 * hi) * PB + r32 * 2; LAS char* o1 = shm + ob + (32 + 4 * hi) * PB + (32 + r32) * 2;
#pragma unroll
            for (int r = 0; r < 16; ++r) {
                const int tl_ = (r & 3) + 8 * (r >> 2);
                const bool keep = (tl_ + 4 * hi) >= (r32 + lim);
                acc0[r] = keep ? acc0[r] : 0.f; acc1[r] = keep ? acc1[r] : 0.f;
                *(LAS bf16_t*)(o0 + tl_ * PB) = f2bf(acc0[r]);
                *(LAS bf16_t*)(o1 + tl_ * PB) = f2bf(acc1[r]);
            }
            if (mat == 0) {
                const int bsel = r32 >> 4;
                LAS float* dg = (LAS float*)(shm + L_DIAG) + (r32 & 15);
#pragma unroll
                for (int rr = 0; rr < 8; ++rr) {
                    const int t16 = (rr & 3) + 8 * (rr >> 2) + 4 * hi;
                    const float v0 = bsel ? acc0[rr + 8] : acc0[rr], v1 = bsel ? acc1[rr + 8] : acc1[rr];
                    dg[(bsel) * 256 + t16 * 16] = v0; dg[(2 + bsel) * 256 + t16 * 16] = v1;
                }
            }
        } else {
            LAS char* o0 = shm + ob + (32 + 4 * hi) * PB + r32 * 2;
#pragma unroll
            for (int r = 0; r < 16; ++r) *(LAS bf16_t*)(o0 + ((r & 3) + 8 * (r >> 2)) * PB) = f2bf(acc0[r]);
        }
    }
    __syncthreads();
    PAMP_END(33);
    PAMP_BEGIN(34);
    if (wid >= 4) {
        const int tl = wid - 4, tr = 32 * (tl >> 1), ic = 32 * (tl & 1);
        f32x16 acc;
#pragma unroll
        for (int r = 0; r < 16; ++r) acc[r] = 0.f;
#pragma unroll
        for (int ks = 0; ks < 4; ++ks) if (tr > 0 || ks < 2) acc = RW_MFMA(RW_FRAG(L_AK, tr + r32, ks), RW_FRAG(L_VT, ic + r32, ks), acc);
        LAS float* dst = (LAS float*)(shm + L_AKVT) + (ic + r32) * 68;
#pragma unroll
        for (int g = 0; g < 4; ++g) *(LAS f32x4*)(dst + tr + 8 * g + 4 * hi) = (f32x4){acc[4 * g], acc[4 * g + 1], acc[4 * g + 2], acc[4 * g + 3]};
    } else if (wid == 0) {
        const int blk = lane >> 4, n = lane & 15;
        const LAS float* N = (const LAS float*)(shm + L_DIAG) + blk * 256;
        float m[16];
#pragma unroll
        for (int t = 0; t < 16; ++t) {
            float a = (t == n) ? 1.f : 0.f;
#pragma unroll
            for (int s = 0; s < t; ++s) a = fmaf(-N[t * 16 + s], m[s], a);
            m[t] = a;
            *(LAS bf16_t*)(shm + L_TINV + (blk * 256 + t * 16 + n) * 2) = f2bf(a);
        }
    }
    __syncthreads();
    if (idx + nper < 512) r1_load(nxt, PROJ, sava, (idx + nper) >> 6, h, (idx + nper) & 63, tq, lane);
    {
        const int n = lane & 15, q = lane >> 4;
        typedef float f32x4v __attribute__((ext_vector_type(4)));
        const int col = 16 * (wid & 3) + n;
        u32x2 xn[4];
#pragma unroll
        for (int blk = 0; blk < 4; ++blk) {
            f32x4v acc;
            if (wid < 4) { const u32x2 rv = *(const LAS u32x2*)(shm + L_KKDT + col * PB + (16 * blk + 4 * q) * 2);
                acc[0] = bf2f((bf16_t)(rv.x & 0xffffu)); acc[1] = bf2f((bf16_t)(rv.x >> 16)); acc[2] = bf2f((bf16_t)(rv.y & 0xffffu)); acc[3] = bf2f((bf16_t)(rv.y >> 16)); }
            else acc = *(const LAS f32x4v*)((const LAS float*)(shm + L_AKVT) + col * 68 + 16 * blk + 4 * q);
#pragma unroll
            for (int a = 0; a < blk; a += 2) {
                const u32x2 a0 = *(const LAS u32x2*)(shm + L_AB + (16 * blk + n) * PB + (16 * a + 4 * q) * 2);
                const bool two = (a + 1 < blk);
                u32x2 a1 = {0u, 0u}, b1 = {0u, 0u};
                if (two) { a1 = *(const LAS u32x2*)(shm + L_AB + (16 * blk + n) * PB + (16 * (a + 1) + 4 * q) * 2); b1 = xn[a + 1]; }
                const u32x4 af = {a0.x, a0.y, a1.x, a1.y}, bf = {xn[a].x, xn[a].y, b1.x, b1.y};
                acc = __builtin_amdgcn_mfma_f32_16x16x32_bf16(__builtin_bit_cast(bf16x8, af), __builtin_bit_cast(bf16x8, bf), acc, 0, 0, 0);
            }
            const u32x2 ti = *(const LAS u32x2*)(shm + L_TINV + (blk * 256 + n * 16 + 4 * q) * 2);
            const u32x4 af = {ti.x, ti.y, 0u, 0u}, bf = {pk2(acc[0], acc[1]), pk2(acc[2], acc[3]), 0u, 0u};
            f32x4v x = {0.f, 0.f, 0.f, 0.f};
            x = __builtin_amdgcn_mfma_f32_16x16x32_bf16(__builtin_bit_cast(bf16x8, af), __builtin_bit_cast(bf16x8, bf), x, 0, 0, 0);
            xn[blk].x = pk2(-x[0], -x[1]); xn[blk].y = pk2(-x[2], -x[3]);
            *(LAS u32x2*)(shm + ((wid < 4) ? L_WTT : L_VTT) + col * PB + (16 * blk + 4 * q) * 2) = xn[blk];
        }
    }
    __syncthreads();
    PAMP_END(34);
    PAMP_BEGIN(35);
    {
        const int tl = wid & 3, tr = 32 * (tl >> 1), cc = 32 * (tl & 1);
        f32x16 a0, a1;
        if (wid < 4) {
#pragma unroll
            for (int r = 0; r < 16; ++r) { a0[r] = bf2f(*(const LAS bf16_t*)(shm + L_RD + (tr + crow(r, hi)) * PB + (cc + r32) * 2)); a1[r] = 0.f; }
#pragma unroll
            for (int ks = 0; ks < 4; ++ks) if (tr > 0 || ks < 2) {
                const bf16x8 bbf = RW_FRAG(L_BB, tr + r32, ks);
                a0 = RW_MFMA(bbf, RW_FRAG(L_WTT, cc + r32, ks), a0);
                a1 = RW_MFMA(RW_FRAG(L_BK, tr + r32, ks), RW_FRAG(L_VT, cc + r32, ks), a1);
                a1 = RW_MFMA(bbf, RW_FRAG(L_VTT, cc + r32, ks), a1);
            }
            {
                const __amdgpu_buffer_rsrc_t rs = __builtin_amdgcn_make_buffer_rsrc((void*)PROJ, 0, 0x7fffffff, 0x00020000);
                const int vo = (4 * hi) * (DIN * 2) + (h * 64 + cc + r32) * 2;
                const unsigned so = (unsigned)__builtin_amdgcn_readfirstlane((int)((unsigned)(row0 + tr) * (unsigned)(DIN * 2)));
#pragma unroll
                for (int r = 0; r < 16; ++r) if (!dry) {
                    const unsigned sr = so + (unsigned)(((r & 3) + 8 * (r >> 2)) * (DIN * 2));
                    __builtin_amdgcn_raw_buffer_store_b16((short)f2bf(a0[r]), rs, vo + C_K * 2, sr, 0);
                    __builtin_amdgcn_raw_buffer_store_b16((short)f2bf(a1[r]), rs, vo + C_R * 2, sr, 0);
                }
            }
        } else {
#pragma unroll
            for (int r = 0; r < 16; ++r) { a0[r] = 0.f; a1[r] = 0.f; }
#pragma unroll
            for (int ks = 0; ks < 4; ++ks) {
                const bf16x8 bdf = RW_FRAG(L_BDT, tr + r32, ks);
                a0 = RW_MFMA(bdf, RW_FRAG(L_WTT, cc + r32, ks), a0);
                a1 = RW_MFMA(RW_FRAG(L_KDT, tr + r32, ks), RW_FRAG(L_VT, cc + r32, ks), a1);
                a1 = RW_MFMA(bdf, RW_FRAG(L_VTT, cc + r32, ks), a1);
            }
            bf16_t* Pm = (bf16_t*)(ARG_WS + WS_RWP) + (size_t)unit * 4096;
            bf16_t* Dt = (bf16_t*)(ARG_WS + WS_RWD) + (size_t)unit * 4096;
            const float gc = ((const LAS float*)(shm + L_GC))[cc + r32];
#pragma unroll
            for (int r = 0; r < 16; ++r) { const int jr = tr + crow(r, hi), jc = cc + r32; if (!dry) Pm[jr * 64 + jc] = f2bf(a0[r] + ((jr == jc) ? gc : 0.f)); }
#pragma unroll
            for (int g = 0; g < 4; ++g) { u32x2 w; w.x = pk2(a1[4 * g], a1[4 * g + 1]); w.y = pk2(a1[4 * g + 2], a1[4 * g + 3]); if (!dry) *(u32x2*)(Dt + (cc + r32) * 64 + tr + 8 * g + 4 * hi) = w; }
        }
        const u32x4 vv = *(const LAS u32x4*)(shm + L_VT + lane * PB + tq * 2);
        if (!dry) {
            const __amdgpu_buffer_rsrc_t rs = __builtin_amdgcn_make_buffer_rsrc((void*)PROJ, 0, 0x7fffffff, 0x00020000);
            const int vo = (C_V + ch) * 2;
            const unsigned so = (unsigned)__builtin_amdgcn_readfirstlane((int)((unsigned)(row0 + tq) * (unsigned)(DIN * 2)));
            const unsigned wv[4] = {vv.x, vv.y, vv.z, vv.w};
#pragma unroll
            for (int e = 0; e < 8; ++e) __builtin_amdgcn_raw_buffer_store_b16((short)((e & 1) ? (wv[e >> 1] >> 16) : (wv[e >> 1] & 0xffffu)), rs, vo, so + (unsigned)(e * DIN * 2), 0);
        }
    }
    PAMP_END(35);
    cur = nxt;
    }
}

__device__ __forceinline__ void r2_unit(int l, int b, int h, LAS char* shm, const bool dry = false) {
    const int tid = otid(), lane = tid & 63, n = lane & 15, q = lane >> 4;
    const int wid = __builtin_amdgcn_readfirstlane(tid >> 6);
    typedef float f32x4v __attribute__((ext_vector_type(4)));
    bf16_t* PROJ = (bf16_t*)(ARG_WS + WS_PROJ);
    const bf16_t* Pm = (const bf16_t*)(ARG_WS + WS_RWP) + (size_t)((b * 8 + h) * 64) * 4096;
    const bf16_t* Dt = (const bf16_t*)(ARG_WS + WS_RWD) + (size_t)((b * 8 + h) * 64) * 4096;
    constexpr int TPB = 144, TBUF = 64 * TPB;
    __syncthreads();
    for (int i = tid; i < 2 * TBUF / 4; i += 512) ((LAS unsigned*)shm)[i] = 0u;
    __syncthreads();
    const size_t rowb = (size_t)b * SEQ;
    if (wid < 4) {
        bf16x8 pa[2]; u32x2 dv[4];
        auto ldop = [&](int c) { const bf16_t* pp = Pm + (size_t)c * 4096 + (16 * wid + n) * 64 + 8 * q; pa[0] = *(const bf16x8*)pp; pa[1] = *(const bf16x8*)(pp + 32);
#pragma unroll
                                 for (int cg = 0; cg < 4; ++cg) dv[cg] = *(const u32x2*)(Dt + (size_t)c * 4096 + (16 * cg + n) * 64 + 16 * wid + 4 * q); };
        ldop(0);
        for (int c = 0; c < 64; ++c) {
            const bf16x8 a0 = pa[0], a1 = pa[1]; u32x2 d[4];
#pragma unroll
            for (int cg = 0; cg < 4; ++cg) d[cg] = dv[cg];
            if (c + 1 < 64) ldop(c + 1);
            const LAS char* tb = shm + (c & 1) * TBUF + n * TPB + 8 * q * 2;
            LAS char* tw_ = shm + ((c + 1) & 1) * TBUF + n * TPB + (16 * wid + 4 * q) * 2;
#pragma unroll
            for (int cg = 0; cg < 4; ++cg) {
                const bf16x8 t0 = *(const LAS bf16x8*)(tb + cg * 16 * TPB), t1 = *(const LAS bf16x8*)(tb + cg * 16 * TPB + 64);
                f32x4v acc = {bf2f((bf16_t)(d[cg].x & 0xffffu)), bf2f((bf16_t)(d[cg].x >> 16)), bf2f((bf16_t)(d[cg].y & 0xffffu)), bf2f((bf16_t)(d[cg].y >> 16))};
                acc = __builtin_amdgcn_mfma_f32_16x16x32_bf16(a0, t0, acc, 0, 0, 0);
                acc = __builtin_amdgcn_mfma_f32_16x16x32_bf16(a1, t1, acc, 0, 0, 0);
                u32x2 w; w.x = rw::pk2(acc[0], acc[1]); w.y = rw::pk2(acc[2], acc[3]);
                *(LAS u32x2*)(tw_ + cg * 16 * TPB) = w;
            }
            __syncthreads();
        }
    } else {
        const int tw = wid - 4;
        const float* lng = ARG(11) + (size_t)l * 512 + h * 64; const float* lnb = ARG(12) + (size_t)l * 512 + h * 64; const float* bon = (const float*)(ARG_WS + WS_BON);
        float gg[4][4], gb[4][4];
#pragma unroll
        for (int cg = 0; cg < 4; ++cg) { const f32x4v a4 = *(const f32x4v*)(lng + 16 * cg + 4 * q), b4 = *(const f32x4v*)(lnb + 16 * cg + 4 * q);
#pragma unroll
            for (int e = 0; e < 4; ++e) { gg[cg][e] = a4[e]; gb[cg][e] = b4[e]; } }
        bf16x8 rb[2]; u32x2 yv[4], vv[4], zv[4]; float bv;
        auto ldop = [&](int c) { const size_t row = rowb + (size_t)c * 64 + 16 * tw + n; const bf16_t* rp = PROJ + row * DIN + h * 64; rb[0] = *(const bf16x8*)(rp + C_K + 8 * q); rb[1] = *(const bf16x8*)(rp + C_K + 8 * q + 32);
                                 bv = bon[row * 8 + h];
#pragma unroll
                                 for (int cg = 0; cg < 4; ++cg) { yv[cg] = *(const u32x2*)(rp + C_R + 16 * cg + 4 * q); vv[cg] = *(const u32x2*)(rp + C_V + 16 * cg + 4 * q); zv[cg] = *(const u32x2*)(rp + C_ZA + 16 * cg + 4 * q); } };
        ldop(0);
        for (int c = 0; c < 64; ++c) {
            const bf16x8 b0 = rb[0], b1 = rb[1]; u32x2 y0[4], v0[4], z0[4]; const float bo = bv;
#pragma unroll
            for (int cg = 0; cg < 4; ++cg) { y0[cg] = yv[cg]; v0[cg] = vv[cg]; z0[cg] = zv[cg]; }
            if (c + 1 < 64) ldop(c + 1);
            const LAS char* tb = shm + (c & 1) * TBUF + n * TPB + 8 * q * 2;
            bf16_t* yp = PROJ + (rowb + (size_t)c * 64 + 16 * tw + n) * DIN + C_ZA + h * 64 + 4 * q;
            f32x4v acc[4];
#pragma unroll
            for (int cg = 0; cg < 4; ++cg) {
                const bf16x8 t0 = *(const LAS bf16x8*)(tb + cg * 16 * TPB), t1 = *(const LAS bf16x8*)(tb + cg * 16 * TPB + 64);
                acc[cg] = (f32x4v){bf2f((bf16_t)(y0[cg].x & 0xffffu)), bf2f((bf16_t)(y0[cg].x >> 16)), bf2f((bf16_t)(y0[cg].y & 0xffffu)), bf2f((bf16_t)(y0[cg].y >> 16))};
                acc[cg] = __builtin_amdgcn_mfma_f32_16x16x32_bf16(t0, b0, acc[cg], 0, 0, 0);
                acc[cg] = __builtin_amdgcn_mfma_f32_16x16x32_bf16(t1, b1, acc[cg], 0, 0, 0);
            }
            float sm = 0.f;
#pragma unroll
            for (int cg = 0; cg < 4; ++cg) sm += (acc[cg][0] + acc[cg][1]) + (acc[cg][2] + acc[cg][3]);
            sm += shx<16>(sm); { float x, y; swap32(sm, x, y); sm = x + y; }
            const float mean = sm * (1.0f / 64.0f);
            float sv = 0.f;
#pragma unroll
            for (int cg = 0; cg < 4; ++cg) { acc[cg] = acc[cg] - mean; sv += (acc[cg][0] * acc[cg][0] + acc[cg][1] * acc[cg][1]) + (acc[cg][2] * acc[cg][2] + acc[cg][3] * acc[cg][3]); }
            sv += shx<16>(sv); { float x, y; swap32(sv, x, y); sv = x + y; }
            const float rstd = rsqrtf(sv * (1.0f / 64.0f) + 64e-5f);
#pragma unroll
            for (int cg = 0; cg < 4; ++cg) {
                const float ve[4] = {bf2f((bf16_t)(v0[cg].x & 0xffffu)), bf2f((bf16_t)(v0[cg].x >> 16)), bf2f((bf16_t)(v0[cg].y & 0xffffu)), bf2f((bf16_t)(v0[cg].y >> 16))};
                const float ze[4] = {bf2f((bf16_t)(z0[cg].x & 0xffffu)), bf2f((bf16_t)(z0[cg].x >> 16)), bf2f((bf16_t)(z0[cg].y & 0xffffu)), bf2f((bf16_t)(z0[cg].y >> 16))};
                float o[4];
#pragma unroll
                for (int e = 0; e < 4; ++e) o[e] = (acc[cg][e] * rstd * gg[cg][e] + gb[cg][e] + bo * ve[e]) * siluf_(ze[e]);
                u32x2 w; w.x = rw::pk2(o[0], o[1]); w.y = rw::pk2(o[2], o[3]);
                if (!dry) *(u32x2*)(yp + 16 * cg) = w;
            }
            __syncthreads();
        }
    }
}
#undef RW_FRAG
#undef RW_MFMA
}

namespace lru {
typedef short bf16x8 __attribute__((ext_vector_type(8)));
typedef float f32x16 __attribute__((ext_vector_type(16)));
constexpr int TC = 32, XPITCH = 1040, LDS_XC = 0, LDS_OMA = 33280, LDS_BX = LDS_OMA + 32768, LDS_BYTES = LDS_BX + 32768;
__device__ __forceinline__ int crow(int r, int hi) { return (r & 3) + 8 * (r >> 2) + 4 * hi; }
__device__ __forceinline__ void carry_unit(int b, unsigned* cnt) {
    const int tid = otid();
    float2* sp = (float2*)(ARG_WS + WS_LSUM) + ((size_t)b * 128) * 512 + tid;
    float h = 0.f;
    for (int c0 = 0; c0 < 128; c0 += 16) {
        float2 ah[16];
#pragma unroll
        for (int k = 0; k < 16; ++k) ah[k] = sp[(size_t)(c0 + k) * 512];
#pragma unroll
        for (int k = 0; k < 16; ++k) { __hip_atomic_store(&sp[(size_t)(c0 + k) * 512].x, h, __ATOMIC_RELAXED, __HIP_MEMORY_SCOPE_AGENT); h = fmaf(ah[k].x, h, ah[k].y); }
    }
    asm volatile("s_waitcnt vmcnt(0)" ::: "memory");
    __syncthreads();
    if (threadIdx.x == 0) (void)xb_add(cnt, 1u);
}
constexpr int W_XC = 0, W_OMA = 4608, W_BX = 4608 + 4096, W_LDS = 4608 + 2 * 4096, L_PART = 8 * W_LDS;
template <bool FINAL>
__device__ __forceinline__ void phase(int l, LAS char* shm0, unsigned* cnt, const bool dry = false) {
    typedef unsigned u32x4 __attribute__((ext_vector_type(4)));
    typedef float f32x4 __attribute__((ext_vector_type(4)));
    const int tid0 = otid(), lane0 = tid0 & 63;
    const int hh = __builtin_amdgcn_readfirstlane(tid0 >> 6);
    bf16_t* PROJ = (bf16_t*)(ARG_WS + WS_PROJ);
    LAS char* shm = shm0 + hh * W_LDS;
    const int co0 = lane0 & 7, tg0 = lane0 >> 3;
    auto ldraw = [&](u32x4 (&raw)[7], int u) { const int b = u >> 7, t0 = (u & 127) * TC;
#pragma unroll
        for (int k = 0; k < 7; ++k) { const int t = t0 + 4 * tg0 - 3 + k; raw[k] = (t >= 0) ? *(const u32x4*)(PROJ + ((size_t)b * SEQ + t) * DIN + C_UB + hh * 64 + 8 * co0) : (u32x4){0u, 0u, 0u, 0u}; } };
    u32x4 raw[7], rawn[7];
    int parity = 0;
    if ((int)blockIdx.x < 1024) ldraw(raw, blockIdx.x);
    __syncthreads();
    for (int u = blockIdx.x; u < 1024; u += gridDim.x, parity ^= 1) {
        const int tid = otid(), lane = tid & 63, r32 = lane & 31, hi = lane >> 5, co = lane & 7, tg = lane >> 3;
        const int b = u >> 7, c = u & 127;
        const size_t row0 = (size_t)b * SEQ + (size_t)c * TC;
        const bf16_t* gat = (const bf16_t*)(ARG_WS + WS_GAT) + ((size_t)(l * 8 + hh) * 64) * 64;
        const bf16_t* gxt = gat + (size_t)DEPTH * 8 * 64 * 64;
        bf16x8 wr_[2][4], wi_[2][4];
#pragma unroll
        for (int nt = 0; nt < 2; ++nt)
#pragma unroll
            for (int ks = 0; ks < 4; ++ks) { wr_[nt][ks] = *(const bf16x8*)(gat + (size_t)(32 * nt + r32) * 64 + 16 * ks + 8 * hi); wi_[nt][ks] = *(const bf16x8*)(gxt + (size_t)(32 * nt + r32) * 64 + 16 * ks + 8 * hi); }
        {
            const float* conv_w = ARG(13) + (size_t)l * 4 * 512 + hh * 64 + 8 * co; const float* conv_b = ARG(14) + (size_t)l * 512 + hh * 64 + 8 * co;
            float cw[4][8], cb[8];
#pragma unroll
            for (int q = 0; q < 4; ++q) { const f32x4 a = *(const f32x4*)(conv_w + q * 512), bq = *(const f32x4*)(conv_w + q * 512 + 4);
                cw[q][0] = a[0]; cw[q][1] = a[1]; cw[q][2] = a[2]; cw[q][3] = a[3]; cw[q][4] = bq[0]; cw[q][5] = bq[1]; cw[q][6] = bq[2]; cw[q][7] = bq[3]; }
            { const f32x4 a = *(const f32x4*)conv_b, bq = *(const f32x4*)(conv_b + 4); cb[0] = a[0]; cb[1] = a[1]; cb[2] = a[2]; cb[3] = a[3]; cb[4] = bq[0]; cb[5] = bq[1]; cb[6] = bq[2]; cb[7] = bq[3]; }
#pragma unroll
            for (int tt = 0; tt < 4; ++tt) {
                float o[8];
#pragma unroll
                for (int e = 0; e < 8; ++e) o[e] = cb[e];
#pragma unroll
                for (int q = 0; q < 4; ++q) {
                    const u32x4 rv = raw[tt + q];
                    const unsigned wds[4] = {rv.x, rv.y, rv.z, rv.w};
#pragma unroll
                    for (int e = 0; e < 8; ++e) { const float x = bf2f((bf16_t)((e & 1) ? (wds[e >> 1] >> 16) : (wds[e >> 1] & 0xffffu))); o[e] = fmaf(x, cw[q][e], o[e]); }
                }
                u32x4 w; w.x = rw::pk2(o[0], o[1]); w.y = rw::pk2(o[2], o[3]); w.z = rw::pk2(o[4], o[5]); w.w = rw::pk2(o[6], o[7]);
                *(LAS u32x4*)(shm + W_XC + (4 * tg + tt) * 144 + co * 16) = w;
            }
        }
        if (u + (int)gridDim.x < 1024) ldraw(rawn, u + gridDim.x);
        {
            const float* ga_b = ARG(16) + (size_t)l * 512; const float* gx_b = ARG(18) + (size_t)l * 512; const float* lam = ARG(19) + (size_t)l * 512;
            f32x16 ar[2], ai[2];
#pragma unroll
            for (int nt = 0; nt < 2; ++nt)
#pragma unroll
                for (int r = 0; r < 16; ++r) { ar[nt][r] = 0.f; ai[nt][r] = 0.f; }
            const LAS char* xa = (const LAS char*)shm + W_XC + r32 * 144 + 8 * hi * 2;
#pragma unroll
            for (int ks = 0; ks < 4; ++ks) {
                const bf16x8 a = *(const LAS bf16x8*)(xa + ks * 32);
#pragma unroll
                for (int nt = 0; nt < 2; ++nt) {
                    ar[nt] = __builtin_amdgcn_mfma_f32_32x32x16_bf16(a, wr_[nt][ks], ar[nt], 0, 0, 0);
                    ai[nt] = __builtin_amdgcn_mfma_f32_32x32x16_bf16(a, wi_[nt][ks], ai[nt], 0, 0, 0);
                }
            }
            const LAS bf16_t* xc = (const LAS bf16_t*)(shm + W_XC); LAS unsigned* ob = (LAS unsigned*)(shm + W_OMA);
#pragma unroll
            for (int nt = 0; nt < 2; ++nt) {
                const int cl = 32 * nt + r32, ch = hh * 64 + cl;
                const float br = ga_b[ch], bi = gx_b[ch], c8l = -8.0f * 1.4426950408889634f * softplusf_(-lam[ch]);
#pragma unroll
                for (int r = 0; r < 16; ++r) {
                    const int t = crow(r, hi);
                    const float x = bf2f(xc[t * 72 + cl]);
                    const float om = 1.0f - __builtin_amdgcn_exp2f(sigmoidf_(ar[nt][r] + br) * c8l);
                    ob[t * 64 + cl] = f2bf2(om, __builtin_amdgcn_sqrtf(om * (2.0f - om)) * (sigmoidf_(ai[nt][r] + bi) * x));
                }
            }
        }
        {
            float2* lsum = (float2*)(ARG_WS + WS_LSUM) + ((size_t)b * 128 + c) * 512 + hh * 64 + lane;
            const LAS unsigned* ob = (const LAS unsigned*)(shm + W_OMA);
            float h = 0.f;
            if (FINAL) {
                if (lane == 0 && !dry) XB_SPIN(xb_ld(cnt) < 8u, (unsigned*)(ARG_WS + WS_CTL));
                h = __hip_atomic_load(&lsum->x, __ATOMIC_RELAXED, __HIP_MEMORY_SCOPE_AGENT);
            }
            float ap = 1.f, hv[TC];
#pragma unroll
            for (int t = 0; t < TC; ++t) {
                const unsigned pk = ob[t * 64 + lane];
                const float om = __builtin_bit_cast(float, pk << 16), bx = __builtin_bit_cast(float, pk & 0xffff0000u);
                h = fmaf(-om, h, h) + bx; ap *= (1.0f - om); hv[t] = h;
            }
            if (!FINAL) { if (!dry) *lsum = make_float2(ap, h); }
            else {
                LAS float* hb = (LAS float*)(shm + W_XC);
#pragma unroll
                for (int t = 0; t < TC; ++t) hb[t * 64 + lane] = hv[t];
                { const LAS f32x4* hp = (const LAS f32x4*)(hb + (lane >> 1) * 64 + (lane & 1) * 32);
                  float ss = 0.f;
#pragma unroll
                  for (int k = 0; k < 8; ++k) { const f32x4 v = hp[k]; ss += (v[0] * v[0] + v[1] * v[1]) + (v[2] * v[2] + v[3] * v[3]); }
                  ss += dppx<0xB1>(ss);
                  if ((lane & 1) == 0) ((LAS float*)(shm0 + L_PART))[parity * 256 + (lane >> 1) * 8 + hh] = ss; }
            }
        }
        if (FINAL) {
            __syncthreads();
            const float* go = ARG(20) + (size_t)l * 512 + hh * 64 + 8 * co;
            const f32x4 g0 = *(const f32x4*)go, g1 = *(const f32x4*)(go + 4);
            const float gg[8] = {g0[0], g0[1], g0[2], g0[3], g1[0], g1[1], g1[2], g1[3]};
            const LAS float* hb = (const LAS float*)(shm + W_XC);
#pragma unroll
            for (int tt = 0; tt < 4; ++tt) {
                const int t = 4 * tg + tt;
                const f32x4 p0 = *(const LAS f32x4*)((const LAS float*)(shm0 + L_PART) + parity * 256 + t * 8), p1 = *(const LAS f32x4*)((const LAS float*)(shm0 + L_PART) + parity * 256 + t * 8 + 4);
                const float rs = rsqrtf((((p0[0] + p0[1]) + (p0[2] + p0[3])) + ((p1[0] + p1[1]) + (p1[2] + p1[3]))) * (1.0f / 512) + 1e-6f);
                const f32x4 x0 = *(const LAS f32x4*)(hb + t * 64 + 8 * co), x1 = *(const LAS f32x4*)(hb + t * 64 + 8 * co + 4);
                const float x[8] = {x0[0], x0[1], x0[2], x0[3], x1[0], x1[1], x1[2], x1[3]};
                bf16_t* zp = PROJ + (row0 + t) * DIN + C_ZB + hh * 64 + 8 * co;
                const u32x4 zv = *(const u32x4*)zp; const unsigned zw[4] = {zv.x, zv.y, zv.z, zv.w};
                float o[8];
#pragma unroll
                for (int e = 0; e < 8; ++e) { const float z = bf2f((bf16_t)((e & 1) ? (zw[e >> 1] >> 16) : (zw[e >> 1] & 0xffffu))); o[e] = x[e] * rs * gg[e] * siluf_(z); }
                u32x4 w; w.x = rw::pk2(o[0], o[1]); w.y = rw::pk2(o[2], o[3]); w.z = rw::pk2(o[4], o[5]); w.w = rw::pk2(o[6], o[7]);
                if (!dry) *(u32x4*)zp = w;
            }
        }
#pragma unroll
        for (int k = 0; k < 7; ++k) raw[k] = rawn[k];
    }
}
}

namespace att {
typedef short bf16x8 __attribute__((ext_vector_type(8)));
typedef short s16x4 __attribute__((ext_vector_type(4)));
typedef short v4i16_t __attribute__((ext_vector_type(4)));
typedef float f32x16 __attribute__((ext_vector_type(16)));
typedef unsigned u32x4 __attribute__((ext_vector_type(4)));
typedef float f32x2_t __attribute__((ext_vector_type(2)));
typedef __bf16 bf16x2_t __attribute__((ext_vector_type(2)));
typedef LAS const char* lds_cptr;
constexpr int KSLOT = 12288, VSLOT = 8192, LDS_K = 0, LDS_V = 3 * KSLOT, LDS_WS = LDS_V + 3 * VSLOT, LDS_OST = LDS_WS + 8 * 256, LDS_BYTES = LDS_OST + 8 * 4096;
__device__ __forceinline__ int crow(int r, int hi) { return (r & 3) + 8 * (r >> 2) + 4 * hi; }
__device__ __forceinline__ void glds16(const void* gsrc, unsigned lds_dst) { unsigned keep;
    asm volatile("s_mov_b32 %0, m0\n\ts_mov_b32 m0, %2\n\ts_nop 0\n\tglobal_load_lds_dwordx4 %1, off\n\ts_mov_b32 m0, %0" : "=&s"(keep) : "v"(gsrc), "s"(lds_dst) : "memory"); }
__device__ __forceinline__ unsigned cvtpk(float lo, float hi) { f32x2_t v = {lo, hi}; bf16x2_t b = __builtin_convertvector(v, bf16x2_t); return __builtin_bit_cast(unsigned, b); }
__device__ __forceinline__ s16x4 vtr(lds_cptr p) { return __builtin_bit_cast(s16x4, __builtin_amdgcn_ds_read_tr16_b64_v4i16((LAS v4i16_t*)p)); }
#define ATT_WAITB(N) asm volatile("s_waitcnt vmcnt(" #N ") lgkmcnt(0)\n\ts_barrier" ::: "memory")
__device__ __forceinline__ float max3f(float a, float b, float c) { float r; asm volatile("v_max3_f32 %0, %1, %2, %3" : "=v"(r) : "v"(a), "v"(b), "v"(c)); return r; }
__device__ __forceinline__ float max3f_first(float a, float b, float c) { float r; asm volatile("s_nop 15\n\ts_nop 7\n\tv_max3_f32 %0, %1, %2, %3" : "=v"(r) : "v"(a), "v"(b), "v"(c)); return r; }

template <int THR>
__device__ __forceinline__ void attn_unit(bf16_t* Qb, const bf16_t* Kb, const bf16_t* Vb, int b, int h, int qb, LAS char* shm, const bool dry = false) {
    const int tid = otid(), lane = tid & 63, r32 = lane & 31, hi = lane >> 5;
    const int wid = __builtin_amdgcn_readfirstlane(tid >> 6);
    const size_t rowb = (size_t)b * SEQ; const int q0 = qb * 256;
    bf16_t* Qw = Qb + ((rowb + q0 + wid * 32) * 8 + h) * 96;
    const bf16_t* Kh = Kb + (rowb * 8 + h) * 96;
    const bf16_t* Vh = Vb + (rowb * 8 + h) * 64;
    const unsigned lds0 = (unsigned)(size_t)shm;
    LAS float* wsf = (LAS float*)(shm + LDS_WS) + wid * 64;
    const bf16_t* ksrc = Kh + (size_t)lane * 768 + wid * 8;
    const bf16_t* vsrc = Vh + (size_t)(16 * (wid & 3) + (lane >> 2)) * 512 + (wid >> 2) * 32 + (lane & 3) * 8;
    const unsigned kdst = lds0 + LDS_K + wid * 1024, vdst = lds0 + LDS_V + wid * 1024;
#define ATT_DMA(t, sl) do { glds16(ksrc + (size_t)(t) * 64 * 768, (unsigned)__builtin_amdgcn_readfirstlane(kdst + (sl) * KSLOT)); \
        if (wid < 4) glds16(ksrc + (size_t)(t) * 64 * 768 + 64, (unsigned)__builtin_amdgcn_readfirstlane(kdst + (sl) * KSLOT + 8192)); \
        glds16(vsrc + (size_t)(t) * 64 * 512, (unsigned)__builtin_amdgcn_readfirstlane(vdst + (sl) * VSLOT)); } while (0)
    const int NT = 4 * (qb + 1);
    ATT_DMA(0, 0);
    if (NT > 1) ATT_DMA(1, 1);
    bf16x8 qr[6];
#pragma unroll
    for (int d0 = 0; d0 < 6; ++d0) qr[d0] = *(const bf16x8*)(Qw + (size_t)r32 * 768 + d0 * 16 + hi * 8);
    asm volatile("s_waitcnt vmcnt(0)" : "+v"(qr[0]), "+v"(qr[1]), "+v"(qr[2]), "+v"(qr[3]), "+v"(qr[4]), "+v"(qr[5]) :: "memory");
    float m = 0.f, l = 0.f; f32x16 o[2], negm;
#pragma unroll
    for (int r = 0; r < 16; ++r) { o[0][r] = 0.f; o[1][r] = 0.f; negm[r] = 0.f; }
    const int qrel = wid * 32 + r32;
    const lds_cptr kp0 = (lds_cptr)shm + LDS_K + hi * 1024 + r32 * 16;
    const lds_cptr vp0 = (lds_cptr)shm + LDS_V + ((lane >> 4) & 1) * 32 + (lane & 3) * 8 + (4 * hi + ((lane & 15) >> 2)) * 64;
    int sl0 = 0, sl1 = 1, sl2 = 2;
    for (int t = 0; t < NT; ++t) {
        if (t + 1 < NT) { if (wid < 4) ATT_WAITB(3); else ATT_WAITB(2); } else ATT_WAITB(0);
        if (t + 2 < NT) ATT_DMA(t + 2, sl2);
        const int sl = sl0;
        sl0 = sl1; sl1 = sl2; sl2 = sl;
        const int jb = t - (NT - 4);
        if (jb >= 1 && 64 * jb > wid * 32 + 31) continue;
        f32x16 p0, p1;
        const lds_cptr kp = kp0 + sl * KSLOT;
        bf16x8 kf[12];
#pragma unroll
        for (int d0 = 0; d0 < 6; ++d0) { kf[2 * d0] = *(const LAS bf16x8*)(kp + d0 * 2048); kf[2 * d0 + 1] = *(const LAS bf16x8*)(kp + d0 * 2048 + 512); }
        __builtin_amdgcn_sched_barrier(0);
#pragma unroll
        for (int d0 = 0; d0 < 6; ++d0) {
            if (d0 == 0) { p0 = __builtin_amdgcn_mfma_f32_32x32x16_bf16(kf[0], qr[0], negm, 0, 0, 0); p1 = __builtin_amdgcn_mfma_f32_32x32x16_bf16(kf[1], qr[0], negm, 0, 0, 0); }
            else { p0 = __builtin_amdgcn_mfma_f32_32x32x16_bf16(kf[2 * d0], qr[d0], p0, 0, 0, 0); p1 = __builtin_amdgcn_mfma_f32_32x32x16_bf16(kf[2 * d0 + 1], qr[d0], p1, 0, 0, 0); }
        }
        const lds_cptr vp = vp0 + sl * VSLOT;
        s16x4 vlo[8], vhi[8];
#pragma unroll
        for (int i = 0; i < 8; ++i) { vlo[i] = vtr(vp + (i >> 2) * 4096 + (i & 3) * 1024); vhi[i] = vtr(vp + (i >> 2) * 4096 + (i & 3) * 1024 + 512); }
        __builtin_amdgcn_sched_barrier(0);
        if (jb >= 0) {
            const int kb = 64 * jb + 4 * hi;
#pragma unroll
            for (int r = 0; r < 16; ++r) { const int kv = kb + (r & 3) + 8 * (r >> 2); if (kv > qrel) p0[r] = -INFINITY; if (kv + 32 > qrel) p1[r] = -INFINITY; }
        }
        float mx = max3f_first(p0[0], p0[1], p1[0]), mb = max3f(p0[2], p0[3], p1[1]); mx = max3f(mx, p1[2], p1[3]);
#pragma unroll
        for (int r = 4; r < 16; r += 4) { mx = max3f(mx, p0[r], p0[r + 1]); mb = max3f(mb, p0[r + 2], p0[r + 3]); mx = max3f(mx, p1[r], p1[r + 1]); mb = max3f(mb, p1[r + 2], p1[r + 3]); }
        mx = fmaxf(mx, mb);
        { float x, y; swap32(mx, x, y); mx = fmaxf(x, y); }
        if (t == 0 || __any(mx > (float)THR)) {
            const float dl = (t == 0) ? mx : fmaxf(mx, 0.f);
            m += dl;
            const float alpha = __builtin_amdgcn_exp2f(-dl);
            l *= alpha;
#pragma unroll
            for (int r = 0; r < 16; ++r) { p0[r] -= dl; p1[r] -= dl; negm[r] = -m; }
            if (t > 0) {
                if (hi == 0) wsf[r32] = alpha;
#pragma unroll
                for (int r = 0; r < 16; ++r) { const float f = wsf[crow(r, hi)]; o[0][r] *= f; o[1][r] *= f; }
            }
        }
        float ps = 0.f;
#pragma unroll
        for (int r = 0; r < 16; ++r) { p0[r] = __builtin_amdgcn_exp2f(p0[r]); p1[r] = __builtin_amdgcn_exp2f(p1[r]); ps += p0[r] + p1[r]; }
        l += ps;
        u32x4 pw[4];
#pragma unroll
        for (int q = 0; q < 4; ++q) { pw[0][q] = cvtpk(p0[2 * q], p0[2 * q + 1]); pw[1][q] = cvtpk(p0[8 + 2 * q], p0[9 + 2 * q]); pw[2][q] = cvtpk(p1[2 * q], p1[2 * q + 1]); pw[3][q] = cvtpk(p1[8 + 2 * q], p1[9 + 2 * q]); }
#pragma unroll
        for (int d0 = 0; d0 < 2; ++d0)
#pragma unroll
            for (int ks = 0; ks < 4; ++ks) {
                const s16x4 lo = vlo[d0 * 4 + ks], hh = vhi[d0 * 4 + ks];
                const bf16x8 vf = (bf16x8){lo[0], lo[1], lo[2], lo[3], hh[0], hh[1], hh[2], hh[3]};
                o[d0] = __builtin_amdgcn_mfma_f32_32x32x16_bf16(__builtin_bit_cast(bf16x8, pw[ks]), vf, o[d0], 0, 0, 0);
            }
    }
    { float x, y; swap32(l, x, y); l = x + y; }
    if (hi == 0) wsf[32 + r32] = l;
    float rli[16];
#pragma unroll
    for (int r = 0; r < 16; ++r) rli[r] = 1.0f / wsf[32 + crow(r, hi)];
    LAS bf16_t* stg = (LAS bf16_t*)(shm + LDS_OST) + wid * 2048;
#pragma unroll
    for (int r = 0; r < 16; ++r) { const int orow = crow(r, hi);
#pragma unroll
        for (int d0 = 0; d0 < 2; ++d0) stg[orow * 64 + d0 * 32 + r32] = f2bf(o[d0][r] * rli[r]); }
#pragma unroll
    for (int i = 0; i < 4; ++i) { const int row = i * 8 + (lane >> 3), ch = lane & 7; const u32x4 v = *(const LAS u32x4*)(stg + row * 64 + ch * 8); if (!dry) *(u32x4*)(Qw + (size_t)row * 768 + ch * 8) = v; }
    asm volatile("s_waitcnt lgkmcnt(0)\n\ts_barrier" ::: "memory");
#undef ATT_DMA
}
}

__global__ void __launch_bounds__(512, 2) fwd_kernel(Args A) {
    extern __shared__ __attribute__((aligned(16))) unsigned char smem[];
    float* lds = (float*)smem;
    volatile LAS unsigned* xbw = (volatile LAS unsigned*)(smem + 147456 - 16);
    unsigned* ctl = (unsigned*)(ARG_WS + WS_CTL);
    const int tid = threadIdx.x;
    if (tid == 0) { xbw[0] = 0u; xbw[1] = 0u; xbw[2] = 0u; xbw[3] = 0u; }
    __syncthreads();
    XcdBarrier bar = xcd_barrier_post(ctl, xbw);
#if PROBE >= 50 && PROBE <= 52
    unsigned long long pc0 = 0, pr0 = 0, pc1 = 0, pr1 = 0;
    if (PROBE == 50) { pc0 = __builtin_amdgcn_s_memtime(); pr0 = __builtin_amdgcn_s_memrealtime(); }
#endif
    LAS int* s_unit = (LAS int*)(smem + 147456 - 32);

    bf16_t* PROJ = (bf16_t*)(ARG_WS + WS_PROJ);
    bf16_t* XN = (bf16_t*)(ARG_WS + WS_XN);
    float* rope = (float*)(ARG_WS + WS_ROPE);
    const int nwaves = gridDim.x * 8;
#define PHASE_IDS() const int ptid = otid(), lane = ptid & 63, wv = ptid >> 6, gw = blockIdx.x * 8 + wv; (void)lane; (void)gw

    PAMP_BEGIN(20);
    for (int idx = blockIdx.x * 512 + otid(); idx < SEQ * 16; idx += gridDim.x * 512) {
        const int t = idx >> 4, i = idx & 15;
        const float inv = powf(10000.0f, -((float)i * 2.0f / 32.0f));
        const float ang = (float)t * inv;
        const double twopi = 6.283185307179586476925286766559;
        double rr = (double)ang; rr -= twopi * floor(rr / twopi + 0.5);
        const double r2 = rr * rr; double ts = rr, ss = rr, tc = 1.0, cc = 1.0;
        for (int n = 1; n <= 13; ++n) { ts *= -r2 / (double)((2 * n) * (2 * n + 1)); ss += ts; tc *= -r2 / (double)((2 * n - 1) * (2 * n)); cc += tc; }
        rope[idx * 2] = (float)cc; rope[idx * 2 + 1] = (float)ss;
    }

    for (int prep = 0; prep < (PROBE == 11 ? 2 : 1); ++prep)
    for (int l = 0; l < DEPTH; ++l) {
        { const float* W = ARG(2) + (size_t)l * DM * DIN; const float* g = ARG(1) + (size_t)l * DM;
          transpose_w(DM, NPAD_IN, (bf16_t*)(ARG_WS + WS_WIN) + (size_t)l * NPAD_IN * DM, [=](int k, int n) -> f32x4_t { return n < DIN ? *(const f32x4_t*)(W + (size_t)k * DIN + orig_col(n)) * g[k] : (f32x4_t){0.f, 0.f, 0.f, 0.f}; }, lds); }
        { const float* W = ARG(26) + (size_t)l * DMIX * DM;
          transpose_w(DMIX, DM, (bf16_t*)(ARG_WS + WS_WOUT) + (size_t)l * DM * DMIX, [=](int k, int n) -> f32x4_t { return *(const f32x4_t*)(W + (size_t)k * DM + n); }, lds); }
        { const float* qg = ARG(21) + (size_t)l * QL; const float* wuq = ARG(22) + (size_t)l * QL * 768;
          const float* kg = ARG(23) + (size_t)l * KVL; const float* wukv = ARG(24) + (size_t)l * KVL * 1024;
          transpose_w(256, NMLA, (bf16_t*)(ARG_WS + WS_WMLA) + (size_t)l * NMLA * 256, [=](int k, int n) -> f32x4_t {
              if (n < 768) return *(const f32x4_t*)(wuq + (size_t)k * 768 + n) * qg[k];
              return k < KVL ? *(const f32x4_t*)(wukv + (size_t)k * 1024 + (n - 768)) * kg[k] : (f32x4_t){0.f, 0.f, 0.f, 0.f}; }, lds); }
    }
    { const float* w2 = ARG(5); const float* a2 = ARG(7);
      transpose_w(64, DEPTH * 512, (bf16_t*)(ARG_WS + WS_W2T), [=](int k, int n) -> f32x4_t { return *(const f32x4_t*)(w2 + ((size_t)(n >> 9) * 64 + k) * 512 + (n & 511)); }, lds);
      transpose_w(64, DEPTH * 512, (bf16_t*)(ARG_WS + WS_W2T) + (size_t)DEPTH * 512 * 64, [=](int k, int n) -> f32x4_t { return *(const f32x4_t*)(a2 + ((size_t)(n >> 9) * 64 + k) * 512 + (n & 511)); }, lds); }
    { const float* ga = ARG(15); const float* gx = ARG(17);
      transpose_w(64, DEPTH * 8 * 64, (bf16_t*)(ARG_WS + WS_GAT), [=](int k, int n) -> f32x4_t { return *(const f32x4_t*)(ga + ((size_t)(n >> 6) * 64 + k) * 64 + (n & 63)); }, lds);
      transpose_w(64, DEPTH * 8 * 64, (bf16_t*)(ARG_WS + WS_GAT) + (size_t)DEPTH * 8 * 64 * 64, [=](int k, int n) -> f32x4_t { return *(const f32x4_t*)(gx + ((size_t)(n >> 6) * 64 + k) * 64 + (n & 63)); }, lds); }
    {
        PHASE_IDS();
        const float* x = ARG(0); float* ssqh = (float*)(ARG_WS + WS_SSQH);
        for (int row = gw; row < MTOK; row += nwaves) {
            float4 v[4]; float ss = 0.f;
#pragma unroll
            for (int q = 0; q < 4; ++q) { v[q] = *(const float4*)&x[(size_t)row * DM + q * 256 + lane * 4]; ss += v[q].x * v[q].x + v[q].y * v[q].y + v[q].z * v[q].z + v[q].w * v[q].w; }
            ss = wave_sum(ss);
#pragma unroll
            for (int q = 0; q < 4; ++q) { ushort4 o; o.x = f2bf(v[q].x); o.y = f2bf(v[q].y); o.z = f2bf(v[q].z); o.w = f2bf(v[q].w); *(ushort4*)&XN[(size_t)row * DM + q * 256 + lane * 4] = o; }
            if (lane < 16) ssqh[(size_t)row * 16 + lane] = (lane == 0) ? ss : 0.f;
        }
    }
    PAMP_END(20);
    xcd_barrier(bar);

    for (int l = 0; l < DEPTH; ++l) {
        const float* hsrc = (l == 0) ? ARG(0) : ARG_OUT;
#if PROBE == 10
        for (int rep = 0; rep < 8; ++rep) xcd_barrier(bar);
#endif
#if PROBE == 40
        { const unsigned long long t1_ = __builtin_amdgcn_s_memrealtime(); while (__builtin_amdgcn_s_memrealtime() - t1_ < 20000ull) __builtin_amdgcn_s_sleep(8); __syncthreads(); }
#endif
        PAMP_BEGIN(21);
#if PROBE == 51 || PROBE == 52
        if (l == (PROBE == 51 ? 0 : 3)) { pc0 = __builtin_amdgcn_s_memtime(); pr0 = __builtin_amdgcn_s_memrealtime(); }
#endif
        for (int rep = 0; rep < (PROBE == 9 ? 2 : 1); ++rep) {
            pg8::Gemm g{XN, (const bf16_t*)(ARG_WS + WS_WIN) + (size_t)l * NPAD_IN * DM, MTOK, NPAD_IN, DM, DM, DM, 1 << 30, 0};
            pg8::StaticOrder S; S.init(MTOK, NPAD_IN, (int)gridDim.x, (int)blockIdx.x);
            pg8::EpiProj E{PROJ, DIN, DIN, (const float*)(ARG_WS + WS_SSQH), (float*)(ARG_WS + WS_SQQ), (float*)(ARG_WS + WS_SQKV), (bf16_t*)(ARG_WS + WS_K), rope, (bf16_t*)(ARG_WS + WS_SAVA)};
            pg8::gemm_phase<pg8::EpiProj, pg8::StaticOrder, true, true>((PG8_LAS unsigned char*)smem, g, S, E);
        }
#if PROBE == 51 || PROBE == 52
        if (l == (PROBE == 51 ? 0 : 3)) { __syncthreads(); pc1 = __builtin_amdgcn_s_memtime(); pr1 = __builtin_amdgcn_s_memrealtime(); }
#endif
        PAMP_END(21);
        xcd_barrier(bar);
        PAMP_BEGIN(22);
        for (int rep = 0; rep < (PROBE == 13 ? 2 : 1); ++rep) {
            int kmla = 256; asm volatile("" : "+s"(kmla));
            pg8::Gemm g{PROJ + C_QL, (const bf16_t*)(ARG_WS + WS_WMLA) + (size_t)l * NMLA * 256, MTOK, NMLA, kmla, DIN, 256, 3, 2 * (C_KVL - C_QL)};
            pg8::StaticOrder S; S.init(MTOK, NMLA, (int)gridDim.x, (int)blockIdx.x);
            pg8::EpiMla E{(bf16_t*)(ARG_WS + WS_Q), (bf16_t*)(ARG_WS + WS_K), (bf16_t*)(ARG_WS + WS_V), (const float*)(ARG_WS + WS_SQQ), (const float*)(ARG_WS + WS_SQKV), rope, 0.10206207261596577f * 1.4426950408889634f, 0};
            pg8::gemm_phase<pg8::EpiMla, pg8::StaticOrder, true, true>((PG8_LAS unsigned char*)smem, g, S, E);
        }
        PAMP_END(22);
#if PROBE == 1 || PROBE == 2
        {
            const bool dry = (xb_ld(ctl + CW_PROBE) == 0u);
            unsigned* qw = ctl + CW_PROBEQ + 64 * l;
            for (;;) {
                __syncthreads();
                if (threadIdx.x == 0) *s_unit = (int)atomicAdd(qw, 1u);
                __syncthreads();
                const int u = *s_unit;
#if PROBE == 1
                if (u >= 4096) break;
                (void)dry; break;
#else
                if (u >= 1024) break;
                break;
#endif
            }
        }
#endif
        PAMP_BEGIN(23);
#if PROBE == 1
        rw::r1_phase(l, (LAS char*)smem, (xb_ld(ctl + CW_PROBE) == 0u));
#endif
        rw::r1_phase(l, (LAS char*)smem);
        lru::phase<false>(l, (LAS char*)smem, ctl + CW_LCNT + 64 * l);
        PAMP_END(23);
        xcd_barrier(bar);
#if PROBE >= 3 && PROBE <= 5
        {
            const bool dry = (xb_ld(ctl + CW_PROBE) == 0u);
            unsigned* qw = ctl + CW_PROBEQ + 64 * l;
            for (;;) {
                __syncthreads();
                if (threadIdx.x == 0) *s_unit = (int)atomicAdd(qw, 1u);
                __syncthreads();
                const int u = *s_unit;
#if PROBE == 3
                if (u >= 64) break;
                rw::r2_unit(l, u >> 3, u & 7, (LAS char*)smem, dry);
#elif PROBE == 4
                if (u >= 1024) break;
                break;
#else
                if (u >= 1024) break;
                att::attn_unit<ATT_THR>((bf16_t*)(ARG_WS + WS_Q), (const bf16_t*)(ARG_WS + WS_K), (const bf16_t*)(ARG_WS + WS_V), (u & 63) >> 3, u & 7, 15 - (u >> 6), (LAS char*)smem, dry);
#endif
            }
        }
#endif
        {
            unsigned* qw = ctl + CW_QUEUE + 64 * (2 * l + 1);
            PAMP_BEGIN(24);
            for (;;) {
                __syncthreads();
                if (threadIdx.x == 0) *s_unit = (int)atomicAdd(qw, 1u);
                __syncthreads();
                const int u = *s_unit;
                if (u >= 8 + 64) break;
                if (u < 8) lru::carry_unit(u, ctl + CW_LCNT + 64 * l);
                else { const int a = u - 8; rw::r2_unit(l, a >> 3, a & 7, (LAS char*)smem); }
            }
            PAMP_END(24);
            PAMP_BEGIN(25);
            {
                const int x0 = (int)(xb_xcc_id() & 7u);
                for (int k = 0; k < 8; ++k) {
                    const int x = (x0 + k) & 7;
                    unsigned* qa = ctl + CW_ATTQ + 32 * (l * 8 + x);
                    for (;;) {
                        __syncthreads();
                        if (threadIdx.x == 0) *s_unit = (int)atomicAdd(qa, 1u);
                        __syncthreads();
                        const int u = *s_unit;
                        if (u >= 128) break;
                        const int bh = 8 * x + (u & 7), qb = 15 - (u >> 3);
                        att::attn_unit<ATT_THR>((bf16_t*)(ARG_WS + WS_Q), (const bf16_t*)(ARG_WS + WS_K), (const bf16_t*)(ARG_WS + WS_V), bh >> 3, bh & 7, qb, (LAS char*)smem);
                    }
                }
            }
            PAMP_END(25);
            PAMP_BEGIN(26);
            lru::phase<true>(l, (LAS char*)smem, ctl + CW_LCNT + 64 * l);
            PAMP_END(26);
        }
        xcd_barrier(bar);
        PAMP_BEGIN(27);
        for (int rep = 0; rep < (PROBE == 8 ? 2 : 1); ++rep) {
            const bool dry = (PROBE == 8) && (rep == 0) && (xb_ld(ctl + CW_PROBE) == 0u);
            typedef unsigned u32x4 __attribute__((ext_vector_type(4)));
            typedef float f32x4 __attribute__((ext_vector_type(4)));
            PHASE_IDS();
            const int hd = lane >> 3, c0 = hd * 64 + (lane & 7) * 8;
            const bf16_t* OATT = (const bf16_t*)(ARG_WS + WS_Q);
            float gcv[8];
            { const float* p2 = ARG(25) + (size_t)l * 512 + c0; const f32x4 d0 = *(const f32x4*)p2, d1 = *(const f32x4*)(p2 + 4);
#pragma unroll
              for (int e = 0; e < 4; ++e) { gcv[e] = d0[e]; gcv[4 + e] = d1[e]; } }
            auto unpack = [](const u32x4 v, float (&x)[8]) { const unsigned w[4] = {v.x, v.y, v.z, v.w};
#pragma unroll
                for (int e = 0; e < 4; ++e) { x[2 * e] = bf2f((bf16_t)(w[e] & 0xffffu)); x[2 * e + 1] = bf2f((bf16_t)(w[e] >> 16)); } };
#pragma unroll 4
            for (int row = gw; row < MTOK; row += nwaves) {
                bf16_t* pr = PROJ + (size_t)row * DIN;
                const u32x4 rzc = *(const u32x4*)(pr + C_ZC + c0);
                const u32x4 ro = *(const u32x4*)(OATT + ((size_t)row * 8 + hd) * 96 + (lane & 7) * 8);
                float zc[8], oa[8];
                unpack(rzc, zc); unpack(ro, oa);
                float sq = 0.f;
#pragma unroll
                for (int e = 0; e < 8; ++e) sq += oa[e] * oa[e];
                sq = wave_sum(sq);
                const float rc = rsqrtf(sq * (1.0f / 512) + 1e-6f);
                float yc[8];
#pragma unroll
                for (int e = 0; e < 8; ++e) yc[e] = oa[e] * rc * gcv[e] * siluf_(zc[e]);
                u32x4 wc;
                wc.x = rw::pk2(yc[0], yc[1]); wc.y = rw::pk2(yc[2], yc[3]); wc.z = rw::pk2(yc[4], yc[5]); wc.w = rw::pk2(yc[6], yc[7]);
                if (!dry) *(u32x4*)(pr + C_ZC + c0) = wc;
            }
        }
        PAMP_END(27);
        xcd_barrier(bar);
        PAMP_BEGIN(28);
        for (int rep = 0; rep < (PROBE == 14 ? 2 : 1); ++rep) {
            const bool odry = (PROBE == 14) && (rep == 0) && (xb_ld(ctl + CW_PROBE) == 0u);
            pg8::Gemm g{PROJ + C_ZA, (const bf16_t*)(ARG_WS + WS_WOUT) + (size_t)l * DM * DMIX, MTOK, DM, DMIX, DIN, DMIX, 1 << 30, 0};
            pg8::StaticOrder S; S.init(MTOK, DM, (int)gridDim.x, (int)blockIdx.x);
            pg8::EpiResid E{ARG_OUT, hsrc, DM, odry, XN, (float*)(ARG_WS + WS_SSQH)};
            pg8::gemm_phase<pg8::EpiResid, pg8::StaticOrder, true, true>((PG8_LAS unsigned char*)smem, g, S, E);
        }
        PAMP_END(28);
        xcd_barrier(bar);
    }
    {
        const float* g = ARG(27); const float* ssqh = (const float*)(ARG_WS + WS_SSQH);
        PHASE_IDS();
        float* out = ARG_OUT;
        for (int row = gw; row < MTOK; row += nwaves) {
            float tsum = (lane < 16) ? ssqh[(size_t)row * 16 + lane] : 0.f;
            tsum = wave_sum(tsum);
            const float rs = rsqrtf(tsum * (1.0f / DM) + 1e-6f);
#pragma unroll
            for (int q = 0; q < 4; ++q) {
                const float4 v = *(const float4*)&out[(size_t)row * DM + q * 256 + lane * 4];
                const float4 gg = *(const float4*)&g[q * 256 + lane * 4];
                float4 o; o.x = v.x * rs * gg.x; o.y = v.y * rs * gg.y; o.z = v.z * rs * gg.z; o.w = v.w * rs * gg.w;
                *(float4*)&out[(size_t)row * DM + q * 256 + lane * 4] = o;
            }
        }
    }
#if PROBE >= 50 && PROBE <= 52
    if (PROBE == 50) { __syncthreads(); pc1 = __builtin_amdgcn_s_memtime(); pr1 = __builtin_amdgcn_s_memrealtime(); }
    if (blockIdx.x == 0) {
        const unsigned long long mhz = (pc1 - pc0) * 100ull / (pr1 - pr0 + 1ull);
        const unsigned long long t1_ = __builtin_amdgcn_s_memrealtime(), d_ = mhz * 25ull;
        while (__builtin_amdgcn_s_memrealtime() - t1_ < d_) __builtin_amdgcn_s_sleep(8);
    }
#endif
}

extern "C" void kernel_launch(void* const* d_in, const int* in_sizes, int n_in, void* d_out, int out_size, void* d_ws, size_t ws_size, hipStream_t stream) {
    (void)in_sizes; (void)n_in; (void)out_size; (void)ws_size;
    constexpr int kDynLds = 147456;
    static int grid = 0;
    if (!grid) {
        int dev = 0, cus = 0;
        hipGetDevice(&dev);
        hipDeviceGetAttribute(&cus, hipDeviceAttributeMultiprocessorCount, dev);
        hipFuncSetAttribute((const void*)fwd_kernel, hipFuncAttributeMaxDynamicSharedMemorySize, kDynLds);
        int per_cu = 0;
        hipOccupancyMaxActiveBlocksPerMultiprocessor(&per_cu, fwd_kernel, 512, kDynLds);
        if (per_cu < 1) fprintf(stderr, "occupancy query says %d\n", per_cu);
        grid = cus > 0 ? cus : 256;
    }
    hipMemsetAsync(d_ws, 0, CTL_BYTES, stream);
    Args a;
    memset(&a, 0, sizeof(a));
    for (int i = 0; i < 28; ++i) a.in[i] = (const float*)d_in[i];
    a.out = (float*)d_out;
    a.ws = (unsigned char*)d_ws;
    hipLaunchKernelGGL(fwd_kernel, dim3(grid), dim3(512), kDynLds, stream, a);
}
```

```cpp
#include <hip/hip_runtime.h>
#include <stdint.h>
#include <cstdio>
#include <cstring>
#ifndef PROBE
#define PROBE 0
#endif
#define PAMP_BEGIN(id) unsigned long long pamp_t0_##id = 0; if (PROBE == (id)) pamp_t0_##id = __builtin_amdgcn_s_memrealtime()
#define PAMP_END(id) do { if (PROBE == (id)) { __syncthreads(); const unsigned long long t1_ = __builtin_amdgcn_s_memrealtime(), d_ = t1_ - pamp_t0_##id; while (__builtin_amdgcn_s_memrealtime() - t1_ < d_) __builtin_amdgcn_s_sleep(8); __syncthreads(); } } while (0)

constexpr int DM = 1024, NB = 8, SEQ = 4096, DEPTH = 4, MTOK = NB * SEQ;
constexpr int GW = 512, HD = 64, NH = 8, DMIX = 1536, DIN = 4128;
constexpr int QL = 256, KVL = 128;
constexpr int C_R = 0, C_K = 512, C_V = 1024, C_WL = 1536, C_AL = 1600, C_UB = 1664, C_QL = 2176, C_KVL = 2432, C_KR = 2560,
              C_ZA = 2592, C_ZB = 3104, C_ZC = 3616;
__device__ __forceinline__ int orig_col(int c) {
    if (c < 1664) return c;
    if (c < 2176) return c - 1664 + 2176;
    if (c < 2432) return c - 2176 + 3200;
    if (c < 2560) return c - 2432 + 3456;
    if (c < 2592) return c - 2560 + 3584;
    if (c < 3104) return c - 2592 + 1664;
    if (c < 3616) return c - 3104 + 2688;
    return c;
}
constexpr size_t MiB = 1u << 20;
constexpr size_t WS_CTL = 0, CTL_BYTES = 65536;
constexpr size_t WS_ROPE = 64 * 1024;
constexpr size_t WS_W2T = 576 * 1024;
constexpr size_t WS_SQQ = 1088 * 1024;
constexpr size_t WS_SQKV = 2112 * 1024;
constexpr size_t WS_SSQH = 10 * MiB;
constexpr size_t WS_WMLA = 3 * MiB;
constexpr size_t WS_PROJ = 16 * MiB;
constexpr size_t WS_XN = 354 * MiB;
constexpr size_t WS_K = 274 * MiB;
constexpr size_t WS_V = 322 * MiB;
constexpr size_t WS_Q = 354 * MiB;
constexpr size_t WS_BON = 8 * MiB + 512 * 1024;
constexpr size_t WS_SAVA = 14 * MiB;
constexpr size_t WS_RWD = 480 * MiB;
constexpr size_t WS_GAT = 9 * MiB + 512 * 1024;
constexpr size_t WS_LSUM = 10 * MiB;
constexpr size_t WS_RWP = 402 * MiB;
constexpr size_t WS_WIN = 434 * MiB;
constexpr size_t WS_WOUT = 468 * MiB;
constexpr size_t WS_FREE = 480 * MiB;
constexpr int NPAD_IN = 4352, NMLA = 1792, KMLA = 384;
constexpr int CW_QUEUE = 8192, CW_PROBEQ = 12288, CW_PROBE = 4000, CW_LCNT = 14336, CW_ATTQ = 15000;

#ifndef ATT_THR
#define ATT_THR 8
#endif

typedef unsigned short bf16_t;
__device__ __forceinline__ float bf2f(bf16_t v) { return __builtin_bit_cast(float, (unsigned)v << 16); }
typedef float f32x2_cv __attribute__((ext_vector_type(2)));
typedef __bf16 bf16x2_cv __attribute__((ext_vector_type(2)));
__device__ __forceinline__ unsigned f2bf2(float lo, float hi) { f32x2_cv v = {lo, hi}; bf16x2_cv b = __builtin_convertvector(v, bf16x2_cv); return __builtin_bit_cast(unsigned, b); }
__device__ __forceinline__ bf16_t f2bf(float f) { return (bf16_t)(f2bf2(f, f) & 0xffffu); }
template <int MASK> __device__ __forceinline__ float shx(float v) {
    static_assert(MASK < 32, "shx: within 32 lanes");
    return __builtin_bit_cast(float, __builtin_amdgcn_ds_swizzle(__builtin_bit_cast(int, v), (MASK << 10) | 0x1f));
}
__device__ __forceinline__ void swap32(float v, float& x, float& y) {
    auto rr = __builtin_amdgcn_permlane32_swap(__builtin_bit_cast(unsigned, v), __builtin_bit_cast(unsigned, v), false, false);
    unsigned a = rr[0], b = rr[1]; asm("" : "+v"(a), "+v"(b));
    x = __builtin_bit_cast(float, a); y = __builtin_bit_cast(float, b);
}
template <int CTRL> __device__ __forceinline__ float dppx(float v) { return __builtin_bit_cast(float, __builtin_amdgcn_mov_dpp(__builtin_bit_cast(int, v), CTRL, 0xf, 0xf, true)); }
__device__ __forceinline__ float sum8(float v) { v += dppx<0xB1>(v); v += dppx<0x4E>(v); v += dppx<0x141>(v); return v; }
__device__ __forceinline__ float wave_sum(float v) {
    v += dppx<0xB1>(v); v += dppx<0x4E>(v); v += dppx<0x141>(v); v += dppx<0x140>(v);
    v += shx<16>(v);
    float x, y; swap32(v, x, y);
    return x + y;
}
__device__ __forceinline__ float fexp(float x) { return __builtin_amdgcn_exp2f(x * 1.4426950408889634f); }
__device__ __forceinline__ float frcp(float x) { return __builtin_amdgcn_rcpf(x); }
__device__ __forceinline__ float sigmoidf_(float x) { return frcp(1.0f + fexp(-x)); }
__device__ __forceinline__ float softplusf_(float x) { return x > 20.f ? x : __builtin_amdgcn_logf(1.0f + fexp(x)) * 0.6931471805599453f; }
__device__ __forceinline__ float siluf_(float x) { return x * frcp(1.0f + fexp(-x)); }
__device__ __forceinline__ float ftanh(float x) { return 1.0f - 2.0f * frcp(1.0f + fexp(2.0f * x)); }
__device__ __forceinline__ float nexpm1(float x) { return x > -0.02f ? -x * (1.0f + x * (0.5f + x * 0.16666667f)) : 1.0f - fexp(x); }

__device__ __forceinline__ int otid() { int t = threadIdx.x; asm volatile("" : "+v"(t)); return t; }
template <int K> __device__ __forceinline__ const float* argp() {
    int k = K; asm volatile("" : "+s"(k));
    return (const float*)(((const unsigned long long*)__builtin_amdgcn_kernarg_segment_ptr())[k]);
}
#define ARG(k) argp<k>()
#define ARG_OUT ((float*)argp<28>())
#define ARG_WS ((unsigned char*)argp<29>())

#define XB_TMO      128
#define XB_XCNT(j)  (256  + 64 * (j))
#define XB_XSUB(j)  (1280 + 64 * (j))
#define XB_XGEN(j)  (2304 + 64 * (j))
#define XB_TOP      3328
#define XB_TOPGEN   3392
#define XCD_BAR_WORDS 3456
#define XB_SPIN_CAP (1u << 24)
#define LAS __attribute__((address_space(3)))

__device__ __forceinline__ unsigned xb_ld(unsigned* p)              { return __hip_atomic_load(p, __ATOMIC_RELAXED, __HIP_MEMORY_SCOPE_AGENT); }
__device__ __forceinline__ unsigned xb_add(unsigned* p, unsigned v) { return __hip_atomic_fetch_add(p, v, __ATOMIC_RELAXED, __HIP_MEMORY_SCOPE_AGENT); }
__device__ __forceinline__ unsigned xb_xcc_id() { return (unsigned)__builtin_amdgcn_s_getreg((3 << 11) | 20) & 0xFu; }
#define XB_SPIN(cond, bar) do { unsigned _sp = 0; while (cond) { __builtin_amdgcn_s_sleep(1); \
    if ((++_sp & 255u) == 0u) { if (xb_ld(&(bar)[XB_TMO])) break; if (_sp > XB_SPIN_CAP) { atomicAdd(&(bar)[XB_TMO], 1u); break; } } } } while (0)

struct XcdBarrier { unsigned* bar; unsigned x; volatile LAS unsigned* st; };

__device__ __forceinline__ XcdBarrier xcd_barrier_post(unsigned* bar, volatile LAS unsigned* st) {
    XcdBarrier b; b.bar = bar; b.x = xb_xcc_id(); b.st = st;
    if (threadIdx.x == 0) (void)xb_add(&bar[XB_XCNT(b.x)], 1u);
    return b;
}
__device__ __forceinline__ void xcd_barrier_complete(unsigned* bar, unsigned x, unsigned& nloc, unsigned& nx) {
    const unsigned G = gridDim.x * gridDim.y * gridDim.z;
    unsigned sum, cnt, mine, sp = 0u;
    for (;;) {
        sum = 0u; cnt = 0u; mine = 0u;
#pragma unroll
        for (unsigned j = 0; j < 16; ++j) { const unsigned c = xb_ld(&bar[XB_XCNT(j)]); sum += c; cnt += (c > 0u) ? 1u : 0u; mine = (j == x) ? c : mine; }
        if (sum == G) break;
        __builtin_amdgcn_s_sleep(1);
        if ((++sp & 255u) == 0u) { if (xb_ld(&bar[XB_TMO])) break; if (sp > XB_SPIN_CAP) { atomicAdd(&bar[XB_TMO], 1u); break; } }
    }
    nloc = mine > 0u ? mine : 1u; nx = cnt > 0u ? cnt : 1u;
}
__device__ __forceinline__ void xcd_barrier_raw(const XcdBarrier& b);
__device__ __forceinline__ void xcd_barrier(const XcdBarrier& b) {
#if PROBE == 30
    const unsigned long long t0_ = __builtin_amdgcn_s_memrealtime();
    xcd_barrier_raw(b);
    const unsigned long long t1_ = __builtin_amdgcn_s_memrealtime(), d_ = t1_ - t0_;
    while (__builtin_amdgcn_s_memrealtime() - t1_ < d_) __builtin_amdgcn_s_sleep(8);
    __syncthreads();
#else
    xcd_barrier_raw(b);
#endif
}
__device__ __forceinline__ void xcd_barrier_raw(const XcdBarrier& b) {
    asm volatile("s_waitcnt vmcnt(0)" ::: "memory");
    __syncthreads();
    if (threadIdx.x == 0) {
        unsigned* bar = b.bar;
        __builtin_amdgcn_s_waitcnt(0);
        const unsigned bx = (unsigned)__builtin_amdgcn_readfirstlane((int)xb_xcc_id());
        unsigned nloc = b.st[0], nx = b.st[1];
        if (nloc == 0u) { xcd_barrier_complete(bar, bx, nloc, nx); b.st[0] = nloc; b.st[1] = nx; }
        const unsigned old = xb_add(&bar[XB_XSUB(bx)], 1u);
        const unsigned gen = old / nloc;
        if (old + 1u == (gen + 1u) * nloc) {
            __builtin_amdgcn_fence(__ATOMIC_RELEASE, "agent");
            asm volatile("s_waitcnt vmcnt(0)" ::: "memory");
            const unsigned og = xb_add(&bar[XB_TOP], 1u);
            const unsigned tg = og / nx;
            if (og + 1u == (tg + 1u) * nx) xb_add(&bar[XB_TOPGEN], 1u);
            else XB_SPIN(xb_ld(&bar[XB_TOPGEN]) == tg, bar);
            __builtin_amdgcn_fence(__ATOMIC_ACQUIRE, "agent");
            xb_add(&bar[XB_XGEN(bx)], 1u);
            asm volatile("s_waitcnt vmcnt(0)" ::: "memory");
        } else {
            XB_SPIN(xb_ld(&bar[XB_XGEN(bx)]) == gen, bar);
            __builtin_amdgcn_fence(__ATOMIC_ACQUIRE, "agent");
            asm volatile("s_waitcnt vmcnt(0)" ::: "memory");
        }
    }
    __syncthreads();
}

struct Args {
    const float* in[28];
    float* out;
    unsigned char* ws;
};

namespace pg8 {
#define PG8_LAS __attribute__((address_space(3)))
typedef unsigned short bf16_t;
typedef short bf16x8 __attribute__((ext_vector_type(8)));
typedef float f32x4 __attribute__((ext_vector_type(4)));
typedef unsigned u32x4 __attribute__((ext_vector_type(4)));
constexpr int BM = 256, BK = 64, HALF = 128, HTB = HALF * BK * 2  , STAGE_BYTES = 8 * HTB, NXCD = 8, WGM = 8;

__host__ __device__ __forceinline__ int lds_byte(int r, int c) { const int st = (r >> 4) * 2 + (c >> 5), rr = r & 15, cc = c & 31, ob = rr * 64 + cc * 2; return st * 1024 + (ob ^ (((ob >> 9) & 1) << 5)); }
__host__ __device__ __forceinline__ void stage_rc(int b, int& R, int& C) { const int st = b / 1024, sb = b % 1024, swz = sb ^ (((sb >> 9) & 1) << 5); R = (st >> 1) * 16 + swz / 64; C = (st & 1) * 32 + (swz % 64) / 2; }
__host__ __device__ __forceinline__ int perm32(int rho) { const int n = rho >> 4, i = rho & 15; return 8 * (i >> 2) + 4 * n + (i & 3); }

struct Unit { int pm, pn; };
struct Gemm { const bf16_t* A; const bf16_t* Bt; int M, N, K, lda, ldb; int a_split_pn; int a_split_off; };

struct StaticOrder {
    int nM, nN, nwg, G, c;
    __host__ __device__ void init(int M, int N, int G_, int c_) { nM = M / BM; nN = N / BM; nwg = nM * nN; G = G_; c = c_; }
    __host__ __device__ bool next(int i, Unit& u) const {
        const long L = (long)i * G + c; if (L >= nwg) return false;
        int wgid = (int)L; { const int q = nwg / NXCD, r = nwg % NXCD, xcd = wgid % NXCD, off = wgid / NXCD; wgid = (xcd < r ? xcd * (q + 1) : r * (q + 1) + (xcd - r) * q) + off; }
        const int nig = WGM * nN, gid = wgid / nig, fm = gid * WGM, gsz = (nM - fm) < WGM ? (nM - fm) : WGM;
        u.pm = fm + ((wgid % nig) % gsz); u.pn = (wgid % nig) / gsz; return true;
    }
    __device__ __forceinline__ void a_ready(const Unit&, int) const {}
    __device__ __forceinline__ void done(const Unit&) const {}
};

template <int NP>
struct RowScaleOrder : StaticOrder {
    const float* part; float inv_dim; PG8_LAS float* tab;
    __device__ __forceinline__ void a_ready(const Unit& u, int seq) const {
        const int t = otid();
        if (t < 256) {
            const float* p = part + (size_t)(u.pm * BM + t) * NP;
            float sm = 0.f;
#pragma unroll
            for (int k = 0; k < NP; k += 4) { const f32x4 v = *(const f32x4*)(p + k); sm += (v[0] + v[1]) + (v[2] + v[3]); }
            tab[(seq & 1) * 256 + t] = rsqrtf(sm * inv_dim + 1e-6f);
        }
    }
};

struct MlaOrder : StaticOrder {
    const float* sqq; const float* sqkv; PG8_LAS float* tab;
    __device__ __forceinline__ void a_ready(const Unit& u, int seq) const {
        const int t = otid();
        if (t < 256) {
            const size_t row = (size_t)(u.pm * BM + t);
            const f32x4 q0 = *(const f32x4*)(sqq + row * 8), q1 = *(const f32x4*)(sqq + row * 8 + 4), k0 = *(const f32x4*)(sqkv + row * 4);
            tab[((seq & 1) * 256 + t) * 2] = rsqrtf((((q0[0] + q0[1]) + (q0[2] + q0[3])) + ((q1[0] + q1[1]) + (q1[2] + q1[3]))) * (1.0f / QL) + 1e-6f);
            tab[((seq & 1) * 256 + t) * 2 + 1] = rsqrtf(((k0[0] + k0[1]) + (k0[2] + k0[3])) * (1.0f / KVL) + 1e-6f);
        }
    }
};

__device__ __forceinline__ unsigned cvt_pk_bf16(float lo, float hi) { unsigned r; asm volatile("v_cvt_pk_bf16_f32 %0, %1, %2" : "=v"(r) : "v"(lo), "v"(hi)); return r; }
template <class Epi, class Sched, bool ALIGN_EPI = false, bool SP2 = false>
__device__ __forceinline__ void gemm_phase(PG8_LAS unsigned char* lds, const Gemm g, const Sched& S, const Epi& E) {
    const int tid = otid(), wid = __builtin_amdgcn_readfirstlane(tid >> 6), lane = tid & 63, wr = wid >> 2, wc = wid & 3, fr = lane & 15, fq = lane >> 4;
    const int K = g.K, nt = K / BK;
    unsigned voffA[2], voffB[2];
#pragma unroll
    for (int i = 0; i < 2; ++i) { int R, C; stage_rc(tid * 16 + i * 8192, R, C); const int Rb = Epi::PERM ? ((R & ~31) + perm32(R & 31)) : R;
        voffA[i] = (unsigned)(R * g.lda + C) * 2u; voffB[i] = (unsigned)(Rb * g.ldb + C) * 2u; }
    const size_t kstep = (size_t)(BK * 2);
    const size_t hstepA = (size_t)HALF * g.lda * 2, hstepB = (size_t)HALF * g.ldb * 2;
    const size_t tstepA = 2 * hstepA, tstepB = 2 * hstepB;
    const unsigned ldsw = (unsigned)wid * 1024u;
    const int aoff = lds_byte(wr * 64 + fr, fq * 8), boff = lds_byte(wc * 32 + fr, fq * 8);
#define PG8_SA(b, h) (((b) * 2 + (h)) * HTB)
#define PG8_SB(b, h) ((4 + (b) * 2 + (h)) * HTB)
#define PG8_STAGE(bufoff, gbase, voff) do { _Pragma("unroll") for (int _i = 0; _i < 2; ++_i) \
        __builtin_amdgcn_global_load_lds((const unsigned*)((const char*)(gbase) + (voff)[_i]), (PG8_LAS unsigned*)(lds + (bufoff) + ldsw + _i * 8192), 16, 0, 0); } while (0)
#define PG8_LDA(dst, b, h) do { _Pragma("unroll") for (int m = 0; m < 4; ++m) _Pragma("unroll") for (int k = 0; k < 2; ++k) dst[m][k] = *(const PG8_LAS bf16x8*)(lds + PG8_SA(b, h) + aoff + m * 2048 + k * 1024); } while (0)
#define PG8_LDB(dst, b, h) do { _Pragma("unroll") for (int n = 0; n < 2; ++n) _Pragma("unroll") for (int k = 0; k < 2; ++k) dst[n][k] = *(const PG8_LAS bf16x8*)(lds + PG8_SB(b, h) + boff + n * 2048 + k * 1024); } while (0)
#define PG8_MMA(ai, bj, At, Bt) do { __builtin_amdgcn_s_setprio(1); _Pragma("unroll") for (int m = 0; m < 4; ++m) _Pragma("unroll") for (int n = 0; n < 2; ++n) _Pragma("unroll") for (int k = 0; k < 2; ++k) \
        acc[ai][bj][m][n] = __builtin_amdgcn_mfma_f32_16x16x32_bf16(Bt[n][k], At[m][k], acc[ai][bj][m][n], 0, 0, 0); __builtin_amdgcn_s_setprio(0); } while (0)
#define PG8_WAIT_V(n) asm volatile("s_waitcnt vmcnt(" #n ")" ::: "memory")
#define PG8_WAIT_L(n) asm volatile("s_waitcnt lgkmcnt(" #n ")" ::: "memory")
#define PG8_BAR __builtin_amdgcn_s_barrier()
#define PG8_SCHED __builtin_amdgcn_sched_barrier(0)
    Unit cur, nxt; int ui = 0;
    if (!S.next(0, cur)) return;
    f32x4 acc[2][2][4][2];
#pragma unroll
    for (int a = 0; a < 2; ++a)
#pragma unroll
        for (int b = 0; b < 2; ++b)
#pragma unroll
            for (int m = 0; m < 4; ++m)
#pragma unroll
                for (int n = 0; n < 2; ++n) acc[a][b][m][n] = (f32x4){0.f, 0.f, 0.f, 0.f};
    bf16x8 At[4][2], B0[2][2], B1[2][2];
    const char* cA = (const char*)g.A + (size_t)cur.pm * tstepA + (cur.pn >= g.a_split_pn ? g.a_split_off : 0); const char* cB = (const char*)g.Bt + (size_t)cur.pn * tstepB;
    S.a_ready(cur, 0);
    if constexpr (SP2) {
        PG8_STAGE(PG8_SB(0, 0), cB, voffB); PG8_STAGE(PG8_SB(0, 1), cB + hstepB, voffB); PG8_STAGE(PG8_SA(0, 0), cA, voffA); PG8_STAGE(PG8_SA(0, 1), cA + hstepA, voffA);
        if (wr == 1) PG8_BAR;
        PG8_WAIT_V(2); PG8_BAR;
        PG8_STAGE(PG8_SB(1, 0), cB + kstep, voffB); PG8_STAGE(PG8_SA(1, 0), cA + kstep, voffA); PG8_STAGE(PG8_SB(1, 1), cB + hstepB + kstep, voffB);
        PG8_WAIT_V(6); PG8_BAR;
    } else {
        PG8_STAGE(PG8_SB(0, 0), cB, voffB); PG8_STAGE(PG8_SA(0, 0), cA, voffA); PG8_STAGE(PG8_SB(0, 1), cB + hstepB, voffB); PG8_STAGE(PG8_SA(0, 1), cA + hstepA, voffA);
        if (wr == 1) PG8_BAR;
        PG8_WAIT_V(4); PG8_BAR;
        PG8_STAGE(PG8_SB(1, 0), cB + kstep, voffB); PG8_STAGE(PG8_SA(1, 0), cA + kstep, voffA); PG8_STAGE(PG8_SB(1, 1), cB + hstepB + kstep, voffB);
        PG8_WAIT_V(6); PG8_BAR;
    }
    for (;;) {
        const bool has_next = S.next(ui + 1, nxt);
        const char* nA = has_next ? (const char*)g.A + (size_t)nxt.pm * tstepA + (nxt.pn >= g.a_split_pn ? g.a_split_off : 0) : cA; const char* nB = has_next ? (const char*)g.Bt + (size_t)nxt.pn * tstepB : cB;
        for (int t = 0; t < nt; t += 2) {
            const bool last = (t == nt - 2);
            const char* a1 = cA + (size_t)(t + 1) * kstep;
            const char* a2 = last ? nA : cA + (size_t)(t + 2) * kstep; const char* b2 = last ? nB : cB + (size_t)(t + 2) * kstep;
            const char* a3 = a2 + kstep; const char* b3 = b2 + kstep;
            if (last && has_next) S.a_ready(nxt, ui + 1);
            if constexpr (SP2) {
            PG8_LDB(B0, 0, 0); PG8_LDB(B1, 0, 1); PG8_SCHED; PG8_LDA(At, 0, 0); PG8_STAGE(PG8_SA(1, 1), a1 + hstepA, voffA);
            PG8_WAIT_V(8); PG8_WAIT_L(0); PG8_BAR; PG8_MMA(0, 0, At, B0); PG8_MMA(0, 1, At, B1); PG8_BAR; PG8_SCHED;
            PG8_LDA(At, 0, 1); PG8_STAGE(PG8_SB(0, 0), b2, voffB); PG8_STAGE(PG8_SB(0, 1), b2 + hstepB, voffB); PG8_STAGE(PG8_SA(0, 0), a2, voffA);
            PG8_WAIT_V(8); PG8_WAIT_L(0); PG8_BAR; PG8_MMA(1, 0, At, B0); PG8_MMA(1, 1, At, B1); PG8_BAR; PG8_SCHED;
            PG8_LDB(B0, 1, 0); PG8_LDB(B1, 1, 1); PG8_SCHED; PG8_LDA(At, 1, 0); PG8_STAGE(PG8_SA(0, 1), a2 + hstepA, voffA);
            PG8_WAIT_V(8); PG8_WAIT_L(0); PG8_BAR; PG8_MMA(0, 0, At, B0); PG8_MMA(0, 1, At, B1); PG8_BAR; PG8_SCHED;
            PG8_LDA(At, 1, 1); PG8_STAGE(PG8_SB(1, 0), b3, voffB); PG8_STAGE(PG8_SB(1, 1), b3 + hstepB, voffB); PG8_STAGE(PG8_SA(1, 0), a3, voffA);
            PG8_WAIT_V(8); PG8_WAIT_L(0); PG8_BAR; PG8_MMA(1, 0, At, B0); PG8_MMA(1, 1, At, B1); PG8_BAR; PG8_SCHED;
            } else {
            PG8_LDB(B0, 0, 0); PG8_SCHED; PG8_LDA(At, 0, 0); PG8_STAGE(PG8_SA(1, 1), a1 + hstepA, voffA);
            PG8_WAIT_L(8); PG8_BAR; PG8_WAIT_L(0); PG8_MMA(0, 0, At, B0); PG8_BAR; PG8_SCHED;
            PG8_LDB(B1, 0, 1); PG8_STAGE(PG8_SB(0, 0), b2, voffB);
            PG8_BAR; PG8_WAIT_L(0); PG8_MMA(0, 1, At, B1); PG8_BAR;
            PG8_LDA(At, 0, 1); PG8_STAGE(PG8_SA(0, 0), a2, voffA);
            PG8_BAR; PG8_WAIT_L(0); PG8_MMA(1, 0, At, B0); PG8_BAR; PG8_SCHED;
            PG8_STAGE(PG8_SB(0, 1), b2 + hstepB, voffB);
            PG8_WAIT_V(6); PG8_BAR; PG8_MMA(1, 1, At, B1); PG8_BAR;
            PG8_LDB(B0, 1, 0); PG8_SCHED; PG8_LDA(At, 1, 0); PG8_STAGE(PG8_SA(0, 1), a2 + hstepA, voffA);
            PG8_WAIT_L(8); PG8_BAR; PG8_WAIT_L(0); PG8_MMA(0, 0, At, B0); PG8_BAR; PG8_SCHED;
            PG8_LDB(B1, 1, 1); PG8_STAGE(PG8_SB(1, 0), b3, voffB);
            PG8_BAR; PG8_WAIT_L(0); PG8_MMA(0, 1, At, B1); PG8_BAR;
            PG8_LDA(At, 1, 1); PG8_STAGE(PG8_SA(1, 0), a3, voffA);
            PG8_BAR; PG8_WAIT_L(0); PG8_MMA(1, 0, At, B0); PG8_BAR; PG8_SCHED;
            PG8_STAGE(PG8_SB(1, 1), b3 + hstepB, voffB);
            PG8_WAIT_V(6); PG8_BAR; PG8_MMA(1, 1, At, B1); PG8_BAR;
            }
        }
        if constexpr (ALIGN_EPI) { if (wr == 0) PG8_BAR; }
        if constexpr (!Epi::AFTER_DRAIN) { E(acc, cur, wr, wc, fr, fq, ui); S.done(cur); }
        if (!has_next) break;
#pragma unroll
        for (int a = 0; a < 2; ++a)
#pragma unroll
            for (int b = 0; b < 2; ++b)
#pragma unroll
                for (int m = 0; m < 4; ++m)
#pragma unroll
                    for (int n = 0; n < 2; ++n) acc[a][b][m][n] = (f32x4){0.f, 0.f, 0.f, 0.f};
        cur = nxt; cA = nA; cB = nB; ++ui;
        if constexpr (ALIGN_EPI) { if (wr == 1) PG8_BAR; }
    }
    PG8_WAIT_V(0);
    if constexpr (!ALIGN_EPI) { if (wr == 0) PG8_BAR; }
    PG8_BAR;
    if constexpr (Epi::AFTER_DRAIN) { E.fused(acc, cur, wr, wc, fr, fq, lds, wid, lane); S.done(cur); }
#undef PG8_SA
#undef PG8_SB
#undef PG8_STAGE
#undef PG8_LDA
#undef PG8_LDB
#undef PG8_MMA
#undef PG8_WAIT_V
#undef PG8_WAIT_L
#undef PG8_BAR
#undef PG8_SCHED
}
}

namespace pg8 {
struct EpiProj {
    static constexpr bool PERM = true, AFTER_DRAIN = false;
    bf16_t* O; int ldc; int ncols; const PG8_LAS float* tab; float* sqq; float* sqkv; bf16_t* Kb; const float* rope; bf16_t* sav;
    __device__ __forceinline__ void operator()(const f32x4 (&acc)[2][2][4][2], const Unit& u, int wr, int wc, int fr, int fq, int seq) const {
        const int row0 = u.pm * BM + wr * 64 + fr, col0 = u.pn * BM + wc * 32 + 8 * fq;
        const int lane_hi = (fq >> 1);
#pragma unroll
        for (int ai = 0; ai < 2; ++ai)
#pragma unroll
            for (int m = 0; m < 4; ++m) {
                const int row = row0 + ai * HALF + m * 16;
                const float rs = tab[(seq & 1) * 256 + wr * 64 + fr + ai * HALF + m * 16];
                bf16_t* rowp = O + (size_t)row * ldc + col0;
#pragma unroll
                for (int bj = 0; bj < 2; ++bj) {
                    const f32x4 v0 = acc[ai][bj][m][0] * rs, v1 = acc[ai][bj][m][1] * rs;
                    u32x4 w; w.x = cvt_pk_bf16(v0[0], v0[1]); w.y = cvt_pk_bf16(v0[2], v0[3]); w.z = cvt_pk_bf16(v1[0], v1[1]); w.w = cvt_pk_bf16(v1[2], v1[3]);
                    const int col = col0 + bj * HALF;
                    if (col < ncols) *(u32x4*)(rowp + bj * HALF) = w;
                    if (u.pn <= 6 && m == 3 && fr == 15 && col < 1664) {
                        const int t = row & (SEQ - 1), cn = (t >> 6) + 1;
                        if (cn < 64) *(u32x4*)(sav + ((size_t)(row >> 12) * 64 + cn) * 1664 + col) = w;
                    }
                    const bool isq = (u.pn == 8 && bj == 1) || (u.pn == 9 && bj == 0), iskv = (u.pn == 9 && bj == 1);
                    if (isq || iskv) {
                        float ss = (v0[0] * v0[0] + v0[1] * v0[1]) + (v0[2] * v0[2] + v0[3] * v0[3]) + (v1[0] * v1[0] + v1[1] * v1[1]) + (v1[2] * v1[2] + v1[3] * v1[3]);
                        ss += shx<16>(ss); { float x, y; swap32(ss, x, y); ss = x + y; }
                        if (fq == 0) { if (iskv) sqkv[(size_t)row * 4 + wc] = ss; else sqq[(size_t)row * 8 + (u.pn == 8 ? 0 : 4) + wc] = ss; }
                    }
                    if (u.pn == 10 && bj == 0 && wc == 0) {
                        const int t = row & (SEQ - 1);
                        const float* rp = rope + ((size_t)t * 16 + 8 * (fq & 1)) * 2;
                        const f32x4 c0 = *(const f32x4*)rp, c1 = *(const f32x4*)(rp + 4), c2 = *(const f32x4*)(rp + 8), c3 = *(const f32x4*)(rp + 12);
                        const float cs[8] = {c0[0], c0[2], c1[0], c1[2], c2[0], c2[2], c3[0], c3[2]}, sn[8] = {c0[1], c0[3], c1[1], c1[3], c2[1], c2[3], c3[1], c3[3]};
                        const float own[8] = {v0[0], v0[1], v0[2], v0[3], v1[0], v1[1], v1[2], v1[3]};
                        float o[8];
#pragma unroll
                        for (int e = 0; e < 8; ++e) { float x, y; swap32(own[e], x, y); const float oth = lane_hi ? x : y;
                            o[e] = lane_hi ? (oth * sn[e] + own[e] * cs[e]) : (own[e] * cs[e] - oth * sn[e]); }
                        u32x4 kw; kw.x = cvt_pk_bf16(o[0], o[1]); kw.y = cvt_pk_bf16(o[2], o[3]); kw.z = cvt_pk_bf16(o[4], o[5]); kw.w = cvt_pk_bf16(o[6], o[7]);
#pragma unroll
                        for (int hh = 0; hh < 8; ++hh) *(u32x4*)(Kb + ((size_t)row * 8 + hh) * 96 + 64 + 8 * fq) = kw;
                    }
                }
                asm volatile("" ::: "memory");
            }
    }
};
struct EpiResid {
    static constexpr bool PERM = false, AFTER_DRAIN = false;
    float* C; const float* R; int ldc; bool dry; bf16_t* HB; float* ssq;
    __device__ __forceinline__ void operator()(const f32x4 (&acc)[2][2][4][2], const Unit& u, int wr, int wc, int fr, int fq, int seq) const {
        const int row0 = u.pm * BM + wr * 64 + fr, col0 = u.pn * BM + wc * 32 + 4 * fq;
        typedef unsigned u32x2 __attribute__((ext_vector_type(2)));
#pragma unroll
        for (int ai = 0; ai < 2; ++ai) {
            f32x4 rv[4][2][2];
#pragma unroll
            for (int m = 0; m < 4; ++m)
#pragma unroll
                for (int bj = 0; bj < 2; ++bj)
#pragma unroll
                    for (int n = 0; n < 2; ++n) rv[m][bj][n] = *(const f32x4*)(R + (size_t)(row0 + ai * HALF + m * 16) * ldc + col0 + bj * HALF + n * 16);
#pragma unroll
            for (int m = 0; m < 4; ++m) { const int row = row0 + ai * HALF + m * 16; const size_t off = (size_t)row * ldc + col0;
                float ss = 0.f;
#pragma unroll
                for (int bj = 0; bj < 2; ++bj)
#pragma unroll
                    for (int n = 0; n < 2; ++n) { const f32x4 o = rv[m][bj][n] + acc[ai][bj][m][n];
                        ss += (o[0] * o[0] + o[1] * o[1]) + (o[2] * o[2] + o[3] * o[3]);
                        u32x2 hb; hb.x = cvt_pk_bf16(o[0], o[1]); hb.y = cvt_pk_bf16(o[2], o[3]);
                        if (!dry) { *(f32x4*)(C + off + bj * HALF + n * 16) = o; *(u32x2*)(HB + off + bj * HALF + n * 16) = hb; } }
                ss += shx<16>(ss); { float x, y; swap32(ss, x, y); ss = x + y; }
                if (fq == 0 && !dry) ssq[(size_t)row * 16 + u.pn * 4 + wc] = ss;
            }
        }
    }
};
struct EpiMla {
    static constexpr bool PERM = false, AFTER_DRAIN = false;
    bf16_t* Q; bf16_t* K; bf16_t* V; const PG8_LAS float* tab; const float* rope; float c2; int pn0;
    __device__ __forceinline__ void operator()(const f32x4 (&acc)[2][2][4][2], const Unit& u, int wr, int wc, int fr, int fq, int seq) const {
        const int row0 = u.pm * BM + wr * 64 + fr;
        typedef unsigned u32x2 __attribute__((ext_vector_type(2)));
#pragma unroll
        for (int ai = 0; ai < 2; ++ai)
#pragma unroll
            for (int m = 0; m < 4; ++m) {
                const int row = row0 + ai * HALF + m * 16;
                const int rl = wr * 64 + fr + ai * HALF + m * 16;
                const float rq = tab[((seq & 1) * 256 + rl) * 2], rk = tab[((seq & 1) * 256 + rl) * 2 + 1];
#pragma unroll
                for (int bj = 0; bj < 2; ++bj) {
                    const int pn = u.pn + pn0; const int cg = pn * BM + bj * HALF + wc * 32;
                    f32x4 v0 = acc[ai][bj][m][0], v1 = acc[ai][bj][m][1];
                    if (pn < 3) {
                        v0 = v0 * rq; v1 = v1 * rq;
                        if (((cg >> 5) % 3) == 2) {
                            const int t = row & (SEQ - 1);
                            const f32x4 cs0 = *(const f32x4*)(rope + ((size_t)t * 16 + 4 * fq) * 2), cs1 = *(const f32x4*)(rope + ((size_t)t * 16 + 4 * fq) * 2 + 4);
                            const float c[4] = {cs0[0], cs0[2], cs1[0], cs1[2]}, sn[4] = {cs0[1], cs0[3], cs1[1], cs1[3]};
                            f32x4 o0, o1;
#pragma unroll
                            for (int j = 0; j < 4; ++j) { o0[j] = v0[j] * c[j] - v1[j] * sn[j]; o1[j] = v0[j] * sn[j] + v1[j] * c[j]; }
                            v0 = o0; v1 = o1;
                        }
                        v0 = v0 * c2; v1 = v1 * c2;
                        bf16_t* p = Q + (size_t)row * 768 + cg + 4 * fq;
                        u32x2 w0, w1; w0.x = cvt_pk_bf16(v0[0], v0[1]); w0.y = cvt_pk_bf16(v0[2], v0[3]); w1.x = cvt_pk_bf16(v1[0], v1[1]); w1.y = cvt_pk_bf16(v1[2], v1[3]);
                        *(u32x2*)p = w0; *(u32x2*)(p + 16) = w1;
                    } else {
                        v0 = v0 * rk; v1 = v1 * rk;
                        const int c = cg - 768, hh = c >> 7, d = (c & 127) + 4 * fq;
                        u32x2 w0, w1; w0.x = cvt_pk_bf16(v0[0], v0[1]); w0.y = cvt_pk_bf16(v0[2], v0[3]); w1.x = cvt_pk_bf16(v1[0], v1[1]); w1.y = cvt_pk_bf16(v1[2], v1[3]);
                        bf16_t* p = (d < 64) ? K + ((size_t)row * 8 + hh) * 96 + d : V + ((size_t)row * 8 + hh) * 64 + (d - 64);
                        *(u32x2*)p = w0; *(u32x2*)(p + 16) = w1;
                    }
                }
                asm volatile("" ::: "memory");
            }
    }
};
}

typedef float f32x4_t __attribute__((ext_vector_type(4)));
typedef unsigned u32x4_t __attribute__((ext_vector_type(4)));
template <class SRC4>
__device__ __forceinline__ void transpose_w(int K, int npad, bf16_t* WT, const SRC4& src4, float* lds) {
    const int tid = otid();
    const int tk = K / 64, tn = npad / 64;
    const int kk = tid >> 4, n4 = (tid & 15) * 4;
    const int nn = tid >> 3, k8 = (tid & 7) * 8;
    int par = 0;
    __syncthreads();
    for (int u = blockIdx.x; u < tk * tn; u += gridDim.x, par ^= 1) {
        const int k0 = (u % tk) * 64, n0 = (u / tk) * 64;
        float* tile = lds + par * (64 * 65);
        const f32x4_t v0 = src4(k0 + kk, n0 + n4), v1 = src4(k0 + kk + 32, n0 + n4);
#pragma unroll
        for (int e = 0; e < 4; ++e) { tile[kk * 65 + n4 + e] = v0[e]; tile[(kk + 32) * 65 + n4 + e] = v1[e]; }
        __syncthreads();
        u32x4_t w;
        w.x = f2bf2(tile[(k8 + 0) * 65 + nn], tile[(k8 + 1) * 65 + nn]); w.y = f2bf2(tile[(k8 + 2) * 65 + nn], tile[(k8 + 3) * 65 + nn]);
        w.z = f2bf2(tile[(k8 + 4) * 65 + nn], tile[(k8 + 5) * 65 + nn]); w.w = f2bf2(tile[(k8 + 6) * 65 + nn], tile[(k8 + 7) * 65 + nn]);
        *(u32x4_t*)(WT + (size_t)(n0 + nn) * K + k0 + k8) = w;
    }
}

template <class AL, class BL, class ST>
__device__ __forceinline__ void gemm_naive(int M, int N, int K, const AL& al, const BL& bl, const ST& st, float* lds) {
    float* As = lds;
    float* Bs = lds + 16 * 132;
    const int tid = otid(), ty = tid >> 4, tx = tid & 15;
    const int ntn = (N + 127) / 128, ntiles = (M / 128) * ntn;
    for (int u = blockIdx.x; u < ntiles; u += gridDim.x) {
        const int tm = u / ntn, tn = u % ntn;
        float acc[4][8];
#pragma unroll
        for (int i = 0; i < 4; ++i)
#pragma unroll
            for (int j = 0; j < 8; ++j) acc[i][j] = 0.f;
        for (int k0 = 0; k0 < K; k0 += 16) {
#pragma unroll
            for (int j = 0; j < 4; ++j) { const int idx = tid + j * 512, r = idx >> 4, k = idx & 15; As[k * 132 + r] = al(tm * 128 + r, k0 + k); }
#pragma unroll
            for (int j = 0; j < 4; ++j) { const int idx = tid + j * 512, k = idx >> 7, c = idx & 127; Bs[k * 132 + c] = bl(k0 + k, tn * 128 + c); }
            __syncthreads();
#pragma unroll 2
            for (int k = 0; k < 16; ++k) {
                const float4 a4 = *(const float4*)&As[k * 132 + ty * 4];
                const float4 b0 = *(const float4*)&Bs[k * 132 + tx * 8], b1 = *(const float4*)&Bs[k * 132 + tx * 8 + 4];
                const float av[4] = {a4.x, a4.y, a4.z, a4.w};
                const float bv[8] = {b0.x, b0.y, b0.z, b0.w, b1.x, b1.y, b1.z, b1.w};
#pragma unroll
                for (int i = 0; i < 4; ++i)
#pragma unroll
                    for (int j = 0; j < 8; ++j) acc[i][j] = fmaf(av[i], bv[j], acc[i][j]);
            }
            __syncthreads();
        }
#pragma unroll
        for (int i = 0; i < 4; ++i)
#pragma unroll
            for (int j = 0; j < 8; ++j) st(tm * 128 + ty * 4 + i, tn * 128 + tx * 8 + j, acc[i][j]);
    }
}

namespace rw {
typedef short bf16x8 __attribute__((ext_vector_type(8)));
typedef float f32x16 __attribute__((ext_vector_type(16)));
typedef float f32x4 __attribute__((ext_vector_type(4)));
typedef unsigned u32x2 __attribute__((ext_vector_type(2)));
typedef unsigned u32x4 __attribute__((ext_vector_type(4)));
constexpr int PB = 144, MB = 64 * PB;
constexpr int L_KKD = 0, L_RD = MB, L_BH = 2 * MB, L_KH = 3 * MB, L_BDT = 4 * MB, L_KDT = 5 * MB, L_VT = 6 * MB, L_KKDT = 7 * MB, L_BK = 8 * MB, L_WTT = 9 * MB, L_VTT = 10 * MB;
constexpr int L_AB = L_KKD, L_AK = L_BH, L_BB = L_KH, L_XWL = L_BK, L_XAL = L_WTT;
constexpr int L_F32 = 11 * MB;
constexpr int L_DEC = L_F32, L_AA = L_F32 + 17408, L_AKVT = L_F32, L_DIAG = L_F32 + 17408, L_TINV = L_DIAG + 4096;
constexpr int L_GC = L_F32 + 34816, L_SEG = L_GC + 256, L_END = L_SEG + 2048;
__device__ __forceinline__ int crow(int r, int hi) { return (r & 3) + 8 * (r >> 2) + 4 * hi; }
__device__ __forceinline__ unsigned pk2(float lo, float hi) { return f2bf2(lo, hi); }
#define RW_FRAG(base, row, ks) (*(const LAS bf16x8*)(shm + (base) + (row) * PB + (16 * (ks) + 8 * hi) * 2))
#define RW_MFMA(a, b, c) __builtin_amdgcn_mfma_f32_32x32x16_bf16(a, b, c, 0, 0, 0)

struct R1Raw { bf16_t q[5][9]; };
__device__ __forceinline__ void r1_load(R1Raw& r, const bf16_t* PROJ, const bf16_t* sava, int b, int h, int c, int tq, int lane) {
    const unsigned row0 = (unsigned)b * SEQ + (unsigned)c * 64;
    const __amdgpu_buffer_rsrc_t rs = __builtin_amdgcn_make_buffer_rsrc((void*)PROJ, 0, 0x7fffffff, 0x00020000);
    const int cols[5] = {C_R + h * 64 + lane, C_K + h * 64 + lane, C_V + h * 64 + lane, C_WL + lane, C_AL + lane};
    const unsigned rb = (unsigned)__builtin_amdgcn_readfirstlane((int)((row0 + (unsigned)tq) * (unsigned)(DIN * 2)));
    if (tq == 0) {
        const bf16_t* sav = sava + ((size_t)b * 64 + c) * 1664;
#pragma unroll
        for (int k = 0; k < 5; ++k) r.q[k][0] = (c > 0) ? sav[cols[k]] : (bf16_t)0;
    } else {
#pragma unroll
        for (int k = 0; k < 5; ++k) r.q[k][0] = (bf16_t)__builtin_amdgcn_raw_buffer_load_b16(rs, cols[k] * 2, rb - (unsigned)(DIN * 2), 0);
    }
#pragma unroll
    for (int k = 0; k < 5; ++k)
#pragma unroll
        for (int e = 0; e < 8; ++e) r.q[k][e + 1] = (bf16_t)__builtin_amdgcn_raw_buffer_load_b16(rs, cols[k] * 2, rb + (unsigned)(e * DIN * 2), 0);
}
__device__ __forceinline__ void r1_phase(int l, LAS char* shm, const bool dry = false) {
    const int tid0 = otid(), lane_o = tid0 & 63, r32o = lane_o & 31, hio = lane_o >> 5;
    const int wid = __builtin_amdgcn_readfirstlane(tid0 >> 6);
    bf16_t* PROJ = (bf16_t*)(ARG_WS + WS_PROJ);
    const bf16_t* sava = (const bf16_t*)(ARG_WS + WS_SAVA);
    const int h = blockIdx.x & 7, jw = blockIdx.x >> 3, nper = gridDim.x >> 3;
    const int ch = h * 64 + lane_o;
    const int tq = wid * 8;
    const float* mu = ARG(3) + (size_t)l * 1664;
    const float mu5[5] = {mu[C_R + ch], mu[C_K + ch], mu[C_V + ch], mu[C_WL + lane_o], mu[C_AL + lane_o]};
    const float kkc = (ARG(8) + (size_t)l * 512)[ch], kac = (ARG(9) + (size_t)l * 512)[ch], rkc = (ARG(10) + (size_t)l * 512)[ch];
    const int pB = wid >> 2, tlB = wid & 3, trB = 32 * (tlB >> 1), ncB = 32 * (tlB & 1);
    const float biasB = ((pB ? ARG(6) : ARG(4)) + (size_t)l * 512)[h * 64 + ncB + r32o];
    R1Raw cur, nxt;
    if (jw < 512) r1_load(cur, PROJ, sava, jw >> 6, h, jw & 63, tq, lane_o);
    for (int idx = jw; idx < 512; idx += nper) {
    const int tidl = otid(), lanel = tidl & 63, r32 = lanel & 31, hi = lanel >> 5;
    (void)hio;
    const int lane = lanel;
    const int b = idx >> 6, c = idx & 63;
    const size_t row0 = (size_t)b * SEQ + (size_t)c * 64;
    const int unit = (b * 8 + h) * 64 + c;
    float xr[8], xk[8];
    bf16x8 wfr[4];
    { const bf16_t* wt = (const bf16_t*)(ARG_WS + WS_W2T) + (size_t)pB * DEPTH * 512 * 64 + ((size_t)l * 512 + h * 64 + ncB + r32) * 64;
#pragma unroll
      for (int ks = 0; ks < 4; ++ks) wfr[ks] = *(const bf16x8*)(wt + 16 * ks + 8 * hi); }
    __syncthreads();
    PAMP_BEGIN(31);
    {
        auto lerp = [&](int k, float (&x)[8]) {
            const float m = mu5[k]; float prv = bf2f(cur.q[k][0]);
#pragma unroll
            for (int e = 0; e < 8; ++e) { const float cv = bf2f(cur.q[k][e + 1]); x[e] = cv + m * (prv - cv); prv = cv; }
        };
        float xv[8], xw[8], xa[8];
        lerp(0, xr); lerp(1, xk); lerp(2, xv); lerp(3, xw); lerp(4, xa);
        u32x4 vv; vv.x = pk2(xv[0], xv[1]); vv.y = pk2(xv[2], xv[3]); vv.z = pk2(xv[4], xv[5]); vv.w = pk2(xv[6], xv[7]);
        *(LAS u32x4*)(shm + L_VT + lane * PB + tq * 2) = vv;
#pragma unroll
        for (int e = 0; e < 8; ++e) {
            *(LAS bf16_t*)(shm + L_XWL + (tq + e) * PB + lane * 2) = f2bf(ftanh(xw[e]));
            *(LAS bf16_t*)(shm + L_XAL + (tq + e) * PB + lane * 2) = f2bf(xa[e]);
        }
    }
    __syncthreads();
    {
        const int p = pB, tr = trB, nc = ncB;
        f32x16 acc;
#pragma unroll
        for (int r = 0; r < 16; ++r) acc[r] = biasB;
        const int xb = p ? L_XAL : L_XWL;
#pragma unroll
        for (int ks = 0; ks < 4; ++ks) acc = RW_MFMA(RW_FRAG(xb, tr + r32, ks), wfr[ks], acc);
        LAS float* dst = (LAS float*)(shm + (p ? L_AA : L_DEC));
#pragma unroll
        for (int r = 0; r < 16; ++r) dst[(tr + crow(r, hi)) * 68 + nc + r32] = acc[r];
    }
    __syncthreads();
    PAMP_END(31);
    PAMP_BEGIN(32);
    {
        float* bon = (float*)(ARG_WS + WS_BON);
        float kkn[8], kpv[8], bbv[8], ld[8], lg[8];
        float run = 0.f;
        LAS float* zb = (LAS float*)(shm + L_KKDT) + wid * (16 * 64 + 16);
#pragma unroll
        for (int e = 0; e < 8; ++e) {
            const float dec = ((const LAS float*)(shm + L_DEC))[(tq + e) * 68 + lane], aav = ((const LAS float*)(shm + L_AA))[(tq + e) * 68 + lane];
            ld[e] = -0.6065306597126334f * sigmoidf_(dec);
            const float av = sigmoidf_(aav);
            const float kkr = xk[e] * kkc;
            kkn[e] = kkr; bbv[e] = kkr * av;
            kpv[e] = xk[e] * (1.0f + (av - 1.0f) * kac);
            zb[e * 64 + lane] = kkr * kkr;
            zb[(8 + e) * 64 + lane] = xr[e] * kpv[e] * rkc;
            run += ld[e]; lg[e] = run;
        }
        {
            const LAS f32x4* zp = (const LAS f32x4*)(zb + (lane >> 2) * 64 + (lane & 3) * 16);
            const f32x4 z0 = zp[0], z1 = zp[1], z2 = zp[2], z3 = zp[3];
            float tsum = (((z0[0] + z0[1]) + (z0[2] + z0[3])) + ((z1[0] + z1[1]) + (z1[2] + z1[3]))) + (((z2[0] + z2[1]) + (z2[2] + z2[3])) + ((z3[0] + z3[1]) + (z3[2] + z3[3])));
            tsum += dppx<0xB1>(tsum); tsum += dppx<0x4E>(tsum);
            if ((lane & 3) == 0) zb[16 * 64 + (lane >> 2)] = tsum;
            const f32x4 n0 = *(const LAS f32x4*)(zb + 16 * 64), n1 = *(const LAS f32x4*)(zb + 16 * 64 + 4);
            const float n2[8] = {n0[0], n0[1], n0[2], n0[3], n1[0], n1[1], n1[2], n1[3]};
#pragma unroll
            for (int e = 0; e < 8; ++e) { const float rn = __builtin_amdgcn_rsqf(fmaxf(n2[e], 1e-24f)); kkn[e] *= rn; bbv[e] *= rn; }
            if (lane < 8 && !dry) bon[(row0 + tq + lane) * 8 + h] = zb[16 * 64 + 8 + lane];
        }
        ((LAS float*)(shm + L_SEG))[wid * 64 + lane] = run;
        __syncthreads();
        float off = 0.f, tot = 0.f;
#pragma unroll
        for (int w = 0; w < 8; ++w) { const float sgm = ((const LAS float*)(shm + L_SEG))[w * 64 + lane]; tot += sgm; if (w < wid) off += sgm; }
        const float gct = fexp(tot);
        if (wid == 0) ((LAS float*)(shm + L_GC))[lane] = gct;
        float tb[8], tk[8], tkk[8];
        float gprev = fexp(off);
#pragma unroll
        for (int e = 0; e < 8; ++e) {
            const float L = off + lg[e];
            const float g = fexp(L), gp = gprev, ig = frcp(g), ge = gct * ig;
            gprev = g;
            const int t = tq + e;
            const float kkd = kkn[e] * gp;
            *(LAS bf16_t*)(shm + L_KKD + t * PB + lane * 2) = f2bf(kkd);
            *(LAS bf16_t*)(shm + L_RD + t * PB + lane * 2) = f2bf(xr[e] * g);
            *(LAS bf16_t*)(shm + L_BH + t * PB + lane * 2) = f2bf(bbv[e] * ig);
            *(LAS bf16_t*)(shm + L_KH + t * PB + lane * 2) = f2bf(kpv[e] * ig);
            tb[e] = bbv[e] * ge; tk[e] = kpv[e] * ge; tkk[e] = kkd;
        }
        u32x4 v;
        v.x = pk2(tb[0], tb[1]); v.y = pk2(tb[2], tb[3]); v.z = pk2(tb[4], tb[5]); v.w = pk2(tb[6], tb[7]); *(LAS u32x4*)(shm + L_BDT + lane * PB + tq * 2) = v;
        v.x = pk2(tk[0], tk[1]); v.y = pk2(tk[2], tk[3]); v.z = pk2(tk[4], tk[5]); v.w = pk2(tk[6], tk[7]); *(LAS u32x4*)(shm + L_KDT + lane * PB + tq * 2) = v;
        v.x = pk2(tkk[0], tkk[1]); v.y = pk2(tkk[2], tkk[3]); v.z = pk2(tkk[4], tkk[5]); v.w = pk2(tkk[6], tkk[7]); *(LAS u32x4*)(shm + L_KKDT + lane * PB + tq * 2) = v;
    }
    __syncthreads();
    PAMP_END(32);
    PAMP_BEGIN(33);
    {
        const int mat = wid & 3;
        const int ab = (mat < 2) ? L_KKD : L_RD, bb = (mat & 1) ? L_KH : L_BH;
        const int ob = (mat == 0) ? L_AB : (mat == 1) ? L_AK : (mat == 2) ? L_BB : L_BK;
        f32x16 acc0, acc1;
#pragma unroll
        for (int r = 0; r < 16; ++r) { acc0[r] = 0.f; acc1[r] = 0.f; }
        if (wid < 4) {
#pragma unroll
            for (int ks = 0; ks < 4; ++ks) { acc0 = RW_MFMA(RW_FRAG(ab, r32, ks), RW_FRAG(bb, r32, ks), acc0); acc1 = RW_MFMA(RW_FRAG(ab, 32 + r32, ks), RW_FRAG(bb, 32 + r32, ks), acc1); }
        } else {
#pragma unroll
            for (int ks = 0; ks < 4; ++ks) acc0 = RW_MFMA(RW_FRAG(ab, 32 + r32, ks), RW_FRAG(bb, r32, ks), acc0);
        }
        __syncthreads();
        if (wid < 4) {
            const int lim = (mat < 2) ? 1 : 0;
            LAS char* o0 = shm + ob + (4 * hi) * PB + r32 * 2; LAS char* o1 = shm + ob + (32 + 4 * hi) * PB + (32 + r32) * 2;
#pragma unroll
            for (int r = 0; r < 16; ++r) {
                const int tl_ = (r & 3) + 8 * (r >> 2);
                const bool keep = (tl_ + 4 * hi) >= (r32 + lim);
                acc0[r] = keep ? acc0[r] : 0.f; acc1[r] = keep ? acc1[r] : 0.f;
                *(LAS bf16_t*)(o0 + tl_ * PB) = f2bf(acc0[r]);
                *(LAS bf16_t*)(o1 + tl_ * PB) = f2bf(acc1[r]);
            }
            if (mat == 0) {
                const int bsel = r32 >> 4;
                LAS float* dg = (LAS float*)(shm + L_DIAG) + (r32 & 15);
#pragma unroll
                for (int rr = 0; rr < 8; ++rr) {
                    const int t16 = (rr & 3) + 8 * (rr >> 2) + 4 * hi;
                    const float v0 = bsel ? acc0[rr + 8] : acc0[rr], v1 = bsel ? acc1[rr + 8] : acc1[rr];
                    dg[(bsel) * 256 + t16 * 16] = v0; dg[(2 + bsel) * 256 + t16 * 16] = v1;
                }
            }
        } else {
            LAS char* o0 = shm + ob + (32 + 4 * hi) * PB + r32 * 2;
#pragma unroll
            for (int r = 0; r < 16; ++r) *(LAS bf16_t*)(o0 + ((r & 3) + 8 * (r >> 2)) * PB) = f2bf(acc0[r]);
        }
    }
    __syncthreads();
    PAMP_END(33);
    PAMP_BEGIN(34);
    if (wid >= 4) {
        const int tl = wid - 4, tr = 32 * (tl >> 1), ic = 32 * (tl & 1);
        f32x16 acc;
#pragma unroll
        for (int r = 0; r < 16; ++r) acc[r] = 0.f;
#pragma unroll
        for (int ks = 0; ks < 4; ++ks) if (tr > 0 || ks < 2) acc = RW_MFMA(RW_FRAG(L_AK, tr + r32, ks), RW_FRAG(L_VT, ic + r32, ks), acc);
        LAS float* dst = (LAS float*)(shm + L_AKVT) + (ic + r32) * 68;
#pragma unroll
        for (int g = 0; g < 4; ++g) *(LAS f32x4*)(dst + tr + 8 * g + 4 * hi) = (f32x4){acc[4 * g], acc[4 * g + 1], acc[4 * g + 2], acc[4 * g + 3]};
    } else if (wid == 0) {
        const int blk = lane >> 4, n = lane & 15;
        const LAS float* N = (const LAS float*)(shm + L_DIAG) + blk * 256;
        float m[16];
#pragma unroll
        for (int t = 0; t < 16; ++t) {
            float a = (t == n) ? 1.f : 0.f;
#pragma unroll
            for (int s = 0; s < t; ++s) a = fmaf(-N[t * 16 + s], m[s], a);
            m[t] = a;
            *(LAS bf16_t*)(shm + L_TINV + (blk * 256 + t * 16 + n) * 2) = f2bf(a);
        }
    }
    __syncthreads();
    if (idx + nper < 512) r1_load(nxt, PROJ, sava, (idx + nper) >> 6, h, (idx + nper) & 63, tq, lane);
    {
        const int n = lane & 15, q = lane >> 4;
        typedef float f32x4v __attribute__((ext_vector_type(4)));
        const int col = 16 * (wid & 3) + n;
        u32x2 xn[4];
#pragma unroll
        for (int blk = 0; blk < 4; ++blk) {
            f32x4v acc;
            if (wid < 4) { const u32x2 rv = *(const LAS u32x2*)(shm + L_KKDT + col * PB + (16 * blk + 4 * q) * 2);
                acc[0] = bf2f((bf16_t)(rv.x & 0xffffu)); acc[1] = bf2f((bf16_t)(rv.x >> 16)); acc[2] = bf2f((bf16_t)(rv.y & 0xffffu)); acc[3] = bf2f((bf16_t)(rv.y >> 16)); }
            else acc = *(const LAS f32x4v*)((const LAS float*)(shm + L_AKVT) + col * 68 + 16 * blk + 4 * q);
#pragma unroll
            for (int a = 0; a < blk; a += 2) {
                const u32x2 a0 = *(const LAS u32x2*)(shm + L_AB + (16 * blk + n) * PB + (16 * a + 4 * q) * 2);
                const bool two = (a + 1 < blk);
                u32x2 a1 = {0u, 0u}, b1 = {0u, 0u};
                if (two) { a1 = *(const LAS u32x2*)(shm + L_AB + (16 * blk + n) * PB + (16 * (a + 1) + 4 * q) * 2); b1 = xn[a + 1]; }
                const u32x4 af = {a0.x, a0.y, a1.x, a1.y}, bf = {xn[a].x, xn[a].y, b1.x, b1.y};
                acc = __builtin_amdgcn_mfma_f32_16x16x32_bf16(__builtin_bit_cast(bf16x8, af), __builtin_bit_cast(bf16x8, bf), acc, 0, 0, 0);
            }
            const u32x2 ti = *(const LAS u32x2*)(shm + L_TINV + (blk * 256 + n * 16 + 4 * q) * 2);
            const u32x4 af = {ti.x, ti.y, 0u, 0u}, bf = {pk2(acc[0], acc[1]), pk2(acc[2], acc[3]), 0u, 0u};
            f32x4v x = {0.f, 0.f, 0.f, 0.f};
            x = __builtin_amdgcn_mfma_f32_16x16x32_bf16(__builtin_bit_cast(bf16x8, af), __builtin_bit_cast(bf16x8, bf), x, 0, 0, 0);
            xn[blk].x = pk2(-x[0], -x[1]); xn[blk].y = pk2(-x[2], -x[3]);
            *(LAS u32x2*)(shm + ((wid < 4) ? L_WTT : L_VTT) + col * PB + (16 * blk + 4 * q) * 2) = xn[blk];
        }
    }
    __syncthreads();
    PAMP_END(34);
    PAMP_BEGIN(35);
    {
        const int tl = wid & 3, tr = 32 * (tl >> 1), cc = 32 * (tl & 1);
        f32x16 a0, a1;
        if (wid < 4) {
#pragma unroll
            for (int r = 0; r < 16; ++r) { a0[r] = bf2f(*(const LAS bf16_t*)(shm + L_RD + (tr + crow(r, hi)) * PB + (cc + r32) * 2)); a1[r] = 0.f; }
#pragma unroll
            for (int ks = 0; ks < 4; ++ks) if (tr > 0 || ks < 2) {
                const bf16x8 bbf = RW_FRAG(L_BB, tr + r32, ks);
                a0 = RW_MFMA(bbf, RW_FRAG(L_WTT, cc + r32, ks), a0);
                a1 = RW_MFMA(RW_FRAG(L_BK, tr + r32, ks), RW_FRAG(L_VT, cc + r32, ks), a1);
                a1 = RW_MFMA(bbf, RW_FRAG(L_VTT, cc + r32, ks), a1);
            }
            {
                const __amdgpu_buffer_rsrc_t rs = __builtin_amdgcn_make_buffer_rsrc((void*)PROJ, 0, 0x7fffffff, 0x00020000);
                const int vo = (4 * hi) * (DIN * 2) + (h * 64 + cc + r32) * 2;
                const unsigned so = (unsigned)__builtin_amdgcn_readfirstlane((int)((unsigned)(row0 + tr) * (unsigned)(DIN * 2)));
#pragma unroll
                for (int r = 0; r < 16; ++r) if (!dry) {
                    const unsigned sr = so + (unsigned)(((r & 3) + 8 * (r >> 2)) * (DIN * 2));
                    __builtin_amdgcn_raw_buffer_store_b16((short)f2bf(a0[r]), rs, vo + C_K * 2, sr, 0);
                    __builtin_amdgcn_raw_buffer_store_b16((short)f2bf(a1[r]), rs, vo + C_R * 2, sr, 0);
                }
            }
        } else {
#pragma unroll
            for (int r = 0; r < 16; ++r) { a0[r] = 0.f; a1[r] = 0.f; }
#pragma unroll
            for (int ks = 0; ks < 4; ++ks) {
                const bf16x8 bdf = RW_FRAG(L_BDT, tr + r32, ks);
                a0 = RW_MFMA(bdf, RW_FRAG(L_WTT, cc + r32, ks), a0);
                a1 = RW_MFMA(RW_FRAG(L_KDT, tr + r32, ks), RW_FRAG(L_VT, cc + r32, ks), a1);
                a1 = RW_MFMA(bdf, RW_FRAG(L_VTT, cc + r32, ks), a1);
            }
            bf16_t* Pm = (bf16_t*)(ARG_WS + WS_RWP) + (size_t)unit * 4096;
            bf16_t* Dt = (bf16_t*)(ARG_WS + WS_RWD) + (size_t)unit * 4096;
            const float gc = ((const LAS float*)(shm + L_GC))[cc + r32];
#pragma unroll
            for (int r = 0; r < 16; ++r) { const int jr = tr + crow(r, hi), jc = cc + r32; if (!dry) Pm[jr * 64 + jc] = f2bf(a0[r] + ((jr == jc) ? gc : 0.f)); }
#pragma unroll
            for (int g = 0; g < 4; ++g) { u32x2 w; w.x = pk2(a1[4 * g], a1[4 * g + 1]); w.y = pk2(a1[4 * g + 2], a1[4 * g + 3]); if (!dry) *(u32x2*)(Dt + (cc + r32) * 64 + tr + 8 * g + 4 * hi) = w; }
        }
        const u32x4 vv = *(const LAS u32x4*)(shm + L_VT + lane * PB + tq * 2);
        if (!dry) {
            const __amdgpu_buffer_rsrc_t rs = __builtin_amdgcn_make_buffer_rsrc((void*)PROJ, 0, 0x7fffffff, 0x00020000);
            const int vo = (C_V + ch) * 2;
            const unsigned so = (unsigned)__builtin_amdgcn_readfirstlane((int)((unsigned)(row0 + tq) * (unsigned)(DIN * 2)));
            const unsigned wv[4] = {vv.x, vv.y, vv.z, vv.w};
#pragma unroll
            for (int e = 0; e < 8; ++e) __builtin_amdgcn_raw_buffer_store_b16((short)((e & 1) ? (wv[e >> 1] >> 16) : (wv[e >> 1] & 0xffffu)), rs, vo, so + (unsigned)(e * DIN * 2), 0);
        }
    }
    PAMP_END(35);
    cur = nxt;
    }
}

__device__ __forceinline__ void r2_unit(int l, int b, int h, LAS char* shm, const bool dry = false) {
    const int tid = otid(), lane = tid & 63, n = lane & 15, q = lane >> 4;
    const int wid = __builtin_amdgcn_readfirstlane(tid >> 6);
    typedef float f32x4v __attribute__((ext_vector_type(4)));
    bf16_t* PROJ = (bf16_t*)(ARG_WS + WS_PROJ);
    const bf16_t* Pm = (const bf16_t*)(ARG_WS + WS_RWP) + (size_t)((b * 8 + h) * 64) * 4096;
    const bf16_t* Dt = (const bf16_t*)(ARG_WS + WS_RWD) + (size_t)((b * 8 + h) * 64) * 4096;
    constexpr int TPB = 144, TBUF = 64 * TPB;
    __syncthreads();
    for (int i = tid; i < 2 * TBUF / 4; i += 512) ((LAS unsigned*)shm)[i] = 0u;
    __syncthreads();
    const size_t rowb = (size_t)b * SEQ;
    if (wid < 4) {
        bf16x8 pa[2]; u32x2 dv[4];
        auto ldop = [&](int c) { const bf16_t* pp = Pm + (size_t)c * 4096 + (16 * wid + n) * 64 + 8 * q; pa[0] = *(const bf16x8*)pp; pa[1] = *(const bf16x8*)(pp + 32);
#pragma unroll
                                 for (int cg = 0; cg < 4; ++cg) dv[cg] = *(const u32x2*)(Dt + (size_t)c * 4096 + (16 * cg + n) * 64 + 16 * wid + 4 * q); };
        ldop(0);
        for (int c = 0; c < 64; ++c) {
            const bf16x8 a0 = pa[0], a1 = pa[1]; u32x2 d[4];
#pragma unroll
            for (int cg = 0; cg < 4; ++cg) d[cg] = dv[cg];
            if (c + 1 < 64) ldop(c + 1);
            const LAS char* tb = shm + (c & 1) * TBUF + n * TPB + 8 * q * 2;
            LAS char* tw_ = shm + ((c + 1) & 1) * TBUF + n * TPB + (16 * wid + 4 * q) * 2;
#pragma unroll
            for (int cg = 0; cg < 4; ++cg) {
                const bf16x8 t0 = *(const LAS bf16x8*)(tb + cg * 16 * TPB), t1 = *(const LAS bf16x8*)(tb + cg * 16 * TPB + 64);
                f32x4v acc = {bf2f((bf16_t)(d[cg].x & 0xffffu)), bf2f((bf16_t)(d[cg].x >> 16)), bf2f((bf16_t)(d[cg].y & 0xffffu)), bf2f((bf16_t)(d[cg].y >> 16))};
                acc = __builtin_amdgcn_mfma_f32_16x16x32_bf16(a0, t0, acc, 0, 0, 0);
                acc = __builtin_amdgcn_mfma_f32_16x16x32_bf16(a1, t1, acc, 0, 0, 0);
                u32x2 w; w.x = rw::pk2(acc[0], acc[1]); w.y = rw::pk2(acc[2], acc[3]);
                *(LAS u32x2*)(tw_ + cg * 16 * TPB) = w;
            }
            __syncthreads();
        }
    } else {
        const int tw = wid - 4;
        const float* lng = ARG(11) + (size_t)l * 512 + h * 64; const float* lnb = ARG(12) + (size_t)l * 512 + h * 64; const float* bon = (const float*)(ARG_WS + WS_BON);
        float gg[4][4], gb[4][4];
#pragma unroll
        for (int cg = 0; cg < 4; ++cg) { const f32x4v a4 = *(const f32x4v*)(lng + 16 * cg + 4 * q), b4 = *(const f32x4v*)(lnb + 16 * cg + 4 * q);
#pragma unroll
            for (int e = 0; e < 4; ++e) { gg[cg][e] = a4[e]; gb[cg][e] = b4[e]; } }
        bf16x8 rb[2]; u32x2 yv[4], vv[4], zv[4]; float bv;
        auto ldop = [&](int c) { const size_t row = rowb + (size_t)c * 64 + 16 * tw + n; const bf16_t* rp = PROJ + row * DIN + h * 64; rb[0] = *(const bf16x8*)(rp + C_K + 8 * q); rb[1] = *(const bf16x8*)(rp + C_K + 8 * q + 32);
                                 bv = bon[row * 8 + h];
#pragma unroll
                                 for (int cg = 0; cg < 4; ++cg) { yv[cg] = *(const u32x2*)(rp + C_R + 16 * cg + 4 * q); vv[cg] = *(const u32x2*)(rp + C_V + 16 * cg + 4 * q); zv[cg] = *(const u32x2*)(rp + C_ZA + 16 * cg + 4 * q); } };
        ldop(0);
        for (int c = 0; c < 64; ++c) {
            const bf16x8 b0 = rb[0], b1 = rb[1]; u32x2 y0[4], v0[4], z0[4]; const float bo = bv;
#pragma unroll
            for (int cg = 0; cg < 4; ++cg) { y0[cg] = yv[cg]; v0[cg] = vv[cg]; z0[cg] = zv[cg]; }
            if (c + 1 < 64) ldop(c + 1);
            const LAS char* tb = shm + (c & 1) * TBUF + n * TPB + 8 * q * 2;
            bf16_t* yp = PROJ + (rowb + (size_t)c * 64 + 16 * tw + n) * DIN + C_ZA + h * 64 + 4 * q;
            f32x4v acc[4];
#pragma unroll
            for (int cg = 0; cg < 4; ++cg) {
                const bf16x8 t0 = *(const LAS bf16x8*)(tb + cg * 16 * TPB), t1 = *(const LAS bf16x8*)(tb + cg * 16 * TPB + 64);
                acc[cg] = (f32x4v){bf2f((bf16_t)(y0[cg].x & 0xffffu)), bf2f((bf16_t)(y0[cg].x >> 16)), bf2f((bf16_t)(y0[cg].y & 0xffffu)), bf2f((bf16_t)(y0[cg].y >> 16))};
                acc[cg] = __builtin_amdgcn_mfma_f32_16x16x32_bf16(t0, b0, acc[cg], 0, 0, 0);
                acc[cg] = __builtin_amdgcn_mfma_f32_16x16x32_bf16(t1, b1, acc[cg], 0, 0, 0);
            }
            float sm = 0.f;
#pragma unroll
            for (int cg = 0; cg < 4; ++cg) sm += (acc[cg][0] + acc[cg][1]) + (acc[cg][2] + acc[cg][3]);
            sm += shx<16>(sm); { float x, y; swap32(sm, x, y); sm = x + y; }
            const float mean = sm * (1.0f / 64.0f);
            float sv = 0.f;
#pragma unroll
            for (int cg = 0; cg < 4; ++cg) { acc[cg] = acc[cg] - mean; sv += (acc[cg][0] * acc[cg][0] + acc[cg][1] * acc[cg][1]) + (acc[cg][2] * acc[cg][2] + acc[cg][3] * acc[cg][3]); }
            sv += shx<16>(sv); { float x, y; swap32(sv, x, y); sv = x + y; }
            const float rstd = rsqrtf(sv * (1.0f / 64.0f) + 64e-5f);
#pragma unroll
            for (int cg = 0; cg < 4; ++cg) {
                const float ve[4] = {bf2f((bf16_t)(v0[cg].x & 0xffffu)), bf2f((bf16_t)(v0[cg].x >> 16)), bf2f((bf16_t)(v0[cg].y & 0xffffu)), bf2f((bf16_t)(v0[cg].y >> 16))};
                const float ze[4] = {bf2f((bf16_t)(z0[cg].x & 0xffffu)), bf2f((bf16_t)(z0[cg].x >> 16)), bf2f((bf16_t)(z0[cg].y & 0xffffu)), bf2f((bf16_t)(z0[cg].y >> 16))};
                float o[4];
#pragma unroll
                for (int e = 0; e < 4; ++e) o[e] = (acc[cg][e] * rstd * gg[cg][e] + gb[cg][e] + bo * ve[e]) * siluf_(ze[e]);
                u32x2 w; w.x = rw::pk2(o[0], o[1]); w.y = rw::pk2(o[2], o[3]);
                if (!dry) *(u32x2*)(yp + 16 * cg) = w;
            }
            __syncthreads();
        }
    }
}
#undef RW_FRAG
#undef RW_MFMA
}

namespace lru {
typedef short bf16x8 __attribute__((ext_vector_type(8)));
typedef float f32x16 __attribute__((ext_vector_type(16)));
constexpr int TC = 32, XPITCH = 1040, LDS_XC = 0, LDS_OMA = 33280, LDS_BX = LDS_OMA + 32768, LDS_BYTES = LDS_BX + 32768;
__device__ __forceinline__ int crow(int r, int hi) { return (r & 3) + 8 * (r >> 2) + 4 * hi; }
__device__ __forceinline__ void carry_unit(int b, unsigned* cnt) {
    const int tid = otid();
    float2* sp = (float2*)(ARG_WS + WS_LSUM) + ((size_t)b * 128) * 512 + tid;
    float h = 0.f;
    for (int c0 = 0; c0 < 128; c0 += 16) {
        float2 ah[16];
#pragma unroll
        for (int k = 0; k < 16; ++k) ah[k] = sp[(size_t)(c0 + k) * 512];
#pragma unroll
        for (int k = 0; k < 16; ++k) { __hip_atomic_store(&sp[(size_t)(c0 + k) * 512].x, h, __ATOMIC_RELAXED, __HIP_MEMORY_SCOPE_AGENT); h = fmaf(ah[k].x, h, ah[k].y); }
    }
    asm volatile("s_waitcnt vmcnt(0)" ::: "memory");
    __syncthreads();
    if (threadIdx.x == 0) (void)xb_add(cnt, 1u);
}
constexpr int W_XC = 0, W_OMA = 4608, W_BX = 4608 + 4096, W_LDS = 4608 + 2 * 4096, L_PART = 8 * W_LDS;
template <bool FINAL>
__device__ __forceinline__ void phase(int l, LAS char* shm0, unsigned* cnt, const bool dry = false) {
    typedef unsigned u32x4 __attribute__((ext_vector_type(4)));
    typedef float f32x4 __attribute__((ext_vector_type(4)));
    const int tid0 = otid(), lane0 = tid0 & 63;
    const int hh = __builtin_amdgcn_readfirstlane(tid0 >> 6);
    bf16_t* PROJ = (bf16_t*)(ARG_WS + WS_PROJ);
    LAS char* shm = shm0 + hh * W_LDS;
    const int co0 = lane0 & 7, tg0 = lane0 >> 3;
    auto ldraw = [&](u32x4 (&raw)[7], int u) { const int b = u >> 7, t0 = (u & 127) * TC;
#pragma unroll
        for (int k = 0; k < 7; ++k) { const int t = t0 + 4 * tg0 - 3 + k; raw[k] = (t >= 0) ? *(const u32x4*)(PROJ + ((size_t)b * SEQ + t) * DIN + C_UB + hh * 64 + 8 * co0) : (u32x4){0u, 0u, 0u, 0u}; } };
    u32x4 raw[7], rawn[7];
    int parity = 0;
    if ((int)blockIdx.x < 1024) ldraw(raw, blockIdx.x);
    __syncthreads();
    for (int u = blockIdx.x; u < 1024; u += gridDim.x, parity ^= 1) {
        const int tid = otid(), lane = tid & 63, r32 = lane & 31, hi = lane >> 5, co = lane & 7, tg = lane >> 3;
        const int b = u >> 7, c = u & 127;
        const size_t row0 = (size_t)b * SEQ + (size_t)c * TC;
        const bf16_t* gat = (const bf16_t*)(ARG_WS + WS_GAT) + ((size_t)(l * 8 + hh) * 64) * 64;
        const bf16_t* gxt = gat + (size_t)DEPTH * 8 * 64 * 64;
        bf16x8 wr_[2][4], wi_[2][4];
#pragma unroll
        for (int nt = 0; nt < 2; ++nt)
#pragma unroll
            for (int ks = 0; ks < 4; ++ks) { wr_[nt][ks] = *(const bf16x8*)(gat + (size_t)(32 * nt + r32) * 64 + 16 * ks + 8 * hi); wi_[nt][ks] = *(const bf16x8*)(gxt + (size_t)(32 * nt + r32) * 64 + 16 * ks + 8 * hi); }
        {
            const float* conv_w = ARG(13) + (size_t)l * 4 * 512 + hh * 64 + 8 * co; const float* conv_b = ARG(14) + (size_t)l * 512 + hh * 64 + 8 * co;
            float cw[4][8], cb[8];
#pragma unroll
            for (int q = 0; q < 4; ++q) { const f32x4 a = *(const f32x4*)(conv_w + q * 512), bq = *(const f32x4*)(conv_w + q * 512 + 4);
                cw[q][0] = a[0]; cw[q][1] = a[1]; cw[q][2] = a[2]; cw[q][3] = a[3]; cw[q][4] = bq[0]; cw[q][5] = bq[1]; cw[q][6] = bq[2]; cw[q][7] = bq[3]; }
            { const f32x4 a = *(const f32x4*)conv_b, bq = *(const f32x4*)(conv_b + 4); cb[0] = a[0]; cb[1] = a[1]; cb[2] = a[2]; cb[3] = a[3]; cb[4] = bq[0]; cb[5] = bq[1]; cb[6] = bq[2]; cb[7] = bq[3]; }
#pragma unroll
            for (int tt = 0; tt < 4; ++tt) {
                float o[8];
#pragma unroll
                for (int e = 0; e < 8; ++e) o[e] = cb[e];
#pragma unroll
                for (int q = 0; q < 4; ++q) {
                    const u32x4 rv = raw[tt + q];
                    const unsigned wds[4] = {rv.x, rv.y, rv.z, rv.w};
#pragma unroll
                    for (int e = 0; e < 8; ++e) { const float x = bf2f((bf16_t)((e & 1) ? (wds[e >> 1] >> 16) : (wds[e >> 1] & 0xffffu))); o[e] = fmaf(x, cw[q][e], o[e]); }
                }
                u32x4 w; w.x = rw::pk2(o[0], o[1]); w.y = rw::pk2(o[2], o[3]); w.z = rw::pk2(o[4], o[5]); w.w = rw::pk2(o[6], o[7]);
                *(LAS u32x4*)(shm + W_XC + (4 * tg + tt) * 144 + co * 16) = w;
            }
        }
        if (u + (int)gridDim.x < 1024) ldraw(rawn, u + gridDim.x);
        {
            const float* ga_b = ARG(16) + (size_t)l * 512; const float* gx_b = ARG(18) + (size_t)l * 512; const float* lam = ARG(19) + (size_t)l * 512;
            f32x16 ar[2], ai[2];
#pragma unroll
            for (int nt = 0; nt < 2; ++nt)
#pragma unroll
                for (int r = 0; r < 16; ++r) { ar[nt][r] = 0.f; ai[nt][r] = 0.f; }
            const LAS char* xa = (const LAS char*)shm + W_XC + r32 * 144 + 8 * hi * 2;
#pragma unroll
            for (int ks = 0; ks < 4; ++ks) {
                const bf16x8 a = *(const LAS bf16x8*)(xa + ks * 32);
#pragma unroll
                for (int nt = 0; nt < 2; ++nt) {
                    ar[nt] = __builtin_amdgcn_mfma_f32_32x32x16_bf16(a, wr_[nt][ks], ar[nt], 0, 0, 0);
                    ai[nt] = __builtin_amdgcn_mfma_f32_32x32x16_bf16(a, wi_[nt][ks], ai[nt], 0, 0, 0);
                }
            }
            const LAS bf16_t* xc = (const LAS bf16_t*)(shm + W_XC); LAS unsigned* ob = (LAS unsigned*)(shm + W_OMA);
#pragma unroll
            for (int nt = 0; nt < 2; ++nt) {
                const int cl = 32 * nt + r32, ch = hh * 64 + cl;
                const float br = ga_b[ch], bi = gx_b[ch], c8l = -8.0f * 1.4426950408889634f * softplusf_(-lam[ch]);
#pragma unroll
                for (int r = 0; r < 16; ++r) {
                    const int t = crow(r, hi);
                    const float x = bf2f(xc[t * 72 + cl]);
                    const float om = 1.0f - __builtin_amdgcn_exp2f(sigmoidf_(ar[nt][r] + br) * c8l);
                    ob[t * 64 + cl] = f2bf2(om, __builtin_amdgcn_sqrtf(om * (2.0f - om)) * (sigmoidf_(ai[nt][r] + bi) * x));
                }
            }
        }
        {
            float2* lsum = (float2*)(ARG_WS + WS_LSUM) + ((size_t)b * 128 + c) * 512 + hh * 64 + lane;
            const LAS unsigned* ob = (const LAS unsigned*)(shm + W_OMA);
            float h = 0.f;
            if (FINAL) {
                if (lane == 0 && !dry) XB_SPIN(xb_ld(cnt) < 8u, (unsigned*)(ARG_WS + WS_CTL));
                h = __hip_atomic_load(&lsum->x, __ATOMIC_RELAXED, __HIP_MEMORY_SCOPE_AGENT);
            }
            float ap = 1.f, hv[TC];
#pragma unroll
            for (int t = 0; t < TC; ++t) {
                const unsigned pk = ob[t * 64 + lane];
                const float om = __builtin_bit_cast(float, pk << 16), bx = __builtin_bit_cast(float, pk & 0xffff0000u);
                h = fmaf(-om, h, h) + bx; ap *= (1.0f - om); hv[t] = h;
            }
            if (!FINAL) { if (!dry) *lsum = make_float2(ap, h); }
            else {
                LAS float* hb = (LAS float*)(shm + W_XC);
#pragma unroll
                for (int t = 0; t < TC; ++t) hb[t * 64 + lane] = hv[t];
                { const LAS f32x4* hp = (const LAS f32x4*)(hb + (lane >> 1) * 64 + (lane & 1) * 32);
                  float ss = 0.f;
#pragma unroll
                  for (int k = 0; k < 8; ++k) { const f32x4 v = hp[k]; ss += (v[0] * v[0] + v[1] * v[1]) + (v[2] * v[2] + v[3] * v[3]); }
                  ss += dppx<0xB1>(ss);
                  if ((lane & 1) == 0) ((LAS float*)(shm0 + L_PART))[parity * 256 + (lane >> 1) * 8 + hh] = ss; }
            }
        }
        if (FINAL) {
            __syncthreads();
            const float* go = ARG(20) + (size_t)l * 512 + hh * 64 + 8 * co;
            const f32x4 g0 = *(const f32x4*)go, g1 = *(const f32x4*)(go + 4);
            const float gg[8] = {g0[0], g0[1], g0[2], g0[3], g1[0], g1[1], g1[2], g1[3]};
            const LAS float* hb = (const LAS float*)(shm + W_XC);
            u32x4 zvv[4];
#pragma unroll
            for (int tt = 0; tt < 4; ++tt) zvv[tt] = *(const u32x4*)(PROJ + (row0 + 4 * tg + tt) * DIN + C_ZB + hh * 64 + 8 * co);
#pragma unroll
            for (int tt = 0; tt < 4; ++tt) {
                const int t = 4 * tg + tt;
                const f32x4 p0 = *(const LAS f32x4*)((const LAS float*)(shm0 + L_PART) + parity * 256 + t * 8), p1 = *(const LAS f32x4*)((const LAS float*)(shm0 + L_PART) + parity * 256 + t * 8 + 4);
                const float rs = rsqrtf((((p0[0] + p0[1]) + (p0[2] + p0[3])) + ((p1[0] + p1[1]) + (p1[2] + p1[3]))) * (1.0f / 512) + 1e-6f);
                const f32x4 x0 = *(const LAS f32x4*)(hb + t * 64 + 8 * co), x1 = *(const LAS f32x4*)(hb + t * 64 + 8 * co + 4);
                const float x[8] = {x0[0], x0[1], x0[2], x0[3], x1[0], x1[1], x1[2], x1[3]};
                bf16_t* zp = PROJ + (row0 + t) * DIN + C_ZB + hh * 64 + 8 * co;
                const u32x4 zv = zvv[tt]; const unsigned zw[4] = {zv.x, zv.y, zv.z, zv.w};
                float o[8];
#pragma unroll
                for (int e = 0; e < 8; ++e) { const float z = bf2f((bf16_t)((e & 1) ? (zw[e >> 1] >> 16) : (zw[e >> 1] & 0xffffu))); o[e] = x[e] * rs * gg[e] * siluf_(z); }
                u32x4 w; w.x = rw::pk2(o[0], o[1]); w.y = rw::pk2(o[2], o[3]); w.z = rw::pk2(o[4], o[5]); w.w = rw::pk2(o[6], o[7]);
                if (!dry) *(u32x4*)zp = w;
            }
        }
#pragma unroll
        for (int k = 0; k < 7; ++k) raw[k] = rawn[k];
    }
}
}

namespace att {
typedef short bf16x8 __attribute__((ext_vector_type(8)));
typedef short s16x4 __attribute__((ext_vector_type(4)));
typedef short v4i16_t __attribute__((ext_vector_type(4)));
typedef float f32x16 __attribute__((ext_vector_type(16)));
typedef unsigned u32x4 __attribute__((ext_vector_type(4)));
typedef float f32x2_t __attribute__((ext_vector_type(2)));
typedef __bf16 bf16x2_t __attribute__((ext_vector_type(2)));
typedef LAS const char* lds_cptr;
constexpr int KSLOT = 12288, VSLOT = 8192, LDS_K = 0, LDS_V = 3 * KSLOT, LDS_WS = LDS_V + 3 * VSLOT, LDS_OST = LDS_WS + 8 * 256, LDS_BYTES = LDS_OST + 8 * 4096;
__device__ __forceinline__ int crow(int r, int hi) { return (r & 3) + 8 * (r >> 2) + 4 * hi; }
__device__ __forceinline__ void glds16(const void* gsrc, unsigned lds_dst) { unsigned keep;
    asm volatile("s_mov_b32 %0, m0\n\ts_mov_b32 m0, %2\n\ts_nop 0\n\tglobal_load_lds_dwordx4 %1, off\n\ts_mov_b32 m0, %0" : "=&s"(keep) : "v"(gsrc), "s"(lds_dst) : "memory"); }
__device__ __forceinline__ unsigned cvtpk(float lo, float hi) { f32x2_t v = {lo, hi}; bf16x2_t b = __builtin_convertvector(v, bf16x2_t); return __builtin_bit_cast(unsigned, b); }
__device__ __forceinline__ s16x4 vtr(lds_cptr p) { return __builtin_bit_cast(s16x4, __builtin_amdgcn_ds_read_tr16_b64_v4i16((LAS v4i16_t*)p)); }
#define ATT_WAITB(N) asm volatile("s_waitcnt vmcnt(" #N ") lgkmcnt(0)\n\ts_barrier" ::: "memory")
__device__ __forceinline__ float max3f(float a, float b, float c) { float r; asm volatile("v_max3_f32 %0, %1, %2, %3" : "=v"(r) : "v"(a), "v"(b), "v"(c)); return r; }
__device__ __forceinline__ float max3f_first(float a, float b, float c) { float r; asm volatile("s_nop 15\n\ts_nop 7\n\tv_max3_f32 %0, %1, %2, %3" : "=v"(r) : "v"(a), "v"(b), "v"(c)); return r; }

template <int THR>
__device__ __forceinline__ void attn_unit(bf16_t* Qb, const bf16_t* Kb, const bf16_t* Vb, int b, int h, int qb, LAS char* shm, const bool dry = false) {
    const int tid = otid(), lane = tid & 63, r32 = lane & 31, hi = lane >> 5;
    const int wid = __builtin_amdgcn_readfirstlane(tid >> 6);
    const size_t rowb = (size_t)b * SEQ; const int q0 = qb * 256;
    bf16_t* Qw = Qb + ((rowb + q0 + wid * 32) * 8 + h) * 96;
    const bf16_t* Kh = Kb + (rowb * 8 + h) * 96;
    const bf16_t* Vh = Vb + (rowb * 8 + h) * 64;
    const unsigned lds0 = (unsigned)(size_t)shm;
    LAS float* wsf = (LAS float*)(shm + LDS_WS) + wid * 64;
    const bf16_t* ksrc = Kh + (size_t)lane * 768 + wid * 8;
    const bf16_t* vsrc = Vh + (size_t)(16 * (wid & 3) + (lane >> 2)) * 512 + (wid >> 2) * 32 + (lane & 3) * 8;
    const unsigned kdst = lds0 + LDS_K + wid * 1024, vdst = lds0 + LDS_V + wid * 1024;
#define ATT_DMA(t, sl) do { glds16(ksrc + (size_t)(t) * 64 * 768, (unsigned)__builtin_amdgcn_readfirstlane(kdst + (sl) * KSLOT)); \
        if (wid < 4) glds16(ksrc + (size_t)(t) * 64 * 768 + 64, (unsigned)__builtin_amdgcn_readfirstlane(kdst + (sl) * KSLOT + 8192)); \
        glds16(vsrc + (size_t)(t) * 64 * 512, (unsigned)__builtin_amdgcn_readfirstlane(vdst + (sl) * VSLOT)); } while (0)
    const int NT = 4 * (qb + 1);
    ATT_DMA(0, 0);
    if (NT > 1) ATT_DMA(1, 1);
    bf16x8 qr[6];
#pragma unroll
    for (int d0 = 0; d0 < 6; ++d0) qr[d0] = *(const bf16x8*)(Qw + (size_t)r32 * 768 + d0 * 16 + hi * 8);
    asm volatile("s_waitcnt vmcnt(0)" : "+v"(qr[0]), "+v"(qr[1]), "+v"(qr[2]), "+v"(qr[3]), "+v"(qr[4]), "+v"(qr[5]) :: "memory");
    float m = 0.f, l = 0.f; f32x16 o[2], negm;
#pragma unroll
    for (int r = 0; r < 16; ++r) { o[0][r] = 0.f; o[1][r] = 0.f; negm[r] = 0.f; }
    const int qrel = wid * 32 + r32;
    const lds_cptr kp0 = (lds_cptr)shm + LDS_K + hi * 1024 + r32 * 16;
    const lds_cptr vp0 = (lds_cptr)shm + LDS_V + ((lane >> 4) & 1) * 32 + (lane & 3) * 8 + (4 * hi + ((lane & 15) >> 2)) * 64;
    int sl0 = 0, sl1 = 1, sl2 = 2;
    for (int t = 0; t < NT; ++t) {
        if (t + 1 < NT) { if (wid < 4) ATT_WAITB(3); else ATT_WAITB(2); } else ATT_WAITB(0);
        if (t + 2 < NT) ATT_DMA(t + 2, sl2);
        const int sl = sl0;
        sl0 = sl1; sl1 = sl2; sl2 = sl;
        const int jb = t - (NT - 4);
        if (jb >= 1 && 64 * jb > wid * 32 + 31) continue;
        f32x16 p0, p1;
        const lds_cptr kp = kp0 + sl * KSLOT;
        bf16x8 kf[12];
#pragma unroll
        for (int d0 = 0; d0 < 6; ++d0) { kf[2 * d0] = *(const LAS bf16x8*)(kp + d0 * 2048); kf[2 * d0 + 1] = *(const LAS bf16x8*)(kp + d0 * 2048 + 512); }
        __builtin_amdgcn_sched_barrier(0);
#pragma unroll
        for (int d0 = 0; d0 < 6; ++d0) {
            if (d0 == 0) { p0 = __builtin_amdgcn_mfma_f32_32x32x16_bf16(kf[0], qr[0], negm, 0, 0, 0); p1 = __builtin_amdgcn_mfma_f32_32x32x16_bf16(kf[1], qr[0], negm, 0, 0, 0); }
            else { p0 = __builtin_amdgcn_mfma_f32_32x32x16_bf16(kf[2 * d0], qr[d0], p0, 0, 0, 0); p1 = __builtin_amdgcn_mfma_f32_32x32x16_bf16(kf[2 * d0 + 1], qr[d0], p1, 0, 0, 0); }
        }
        const lds_cptr vp = vp0 + sl * VSLOT;
        s16x4 vlo[8], vhi[8];
#pragma unroll
        for (int i = 0; i < 8; ++i) { vlo[i] = vtr(vp + (i >> 2) * 4096 + (i & 3) * 1024); vhi[i] = vtr(vp + (i >> 2) * 4096 + (i & 3) * 1024 + 512); }
        __builtin_amdgcn_sched_barrier(0);
        if (jb >= 0) {
            const int kb = 64 * jb + 4 * hi;
#pragma unroll
            for (int r = 0; r < 16; ++r) { const int kv = kb + (r & 3) + 8 * (r >> 2); if (kv > qrel) p0[r] = -INFINITY; if (kv + 32 > qrel) p1[r] = -INFINITY; }
        }
        float mx = max3f_first(p0[0], p0[1], p1[0]), mb = max3f(p0[2], p0[3], p1[1]); mx = max3f(mx, p1[2], p1[3]);
#pragma unroll
        for (int r = 4; r < 16; r += 4) { mx = max3f(mx, p0[r], p0[r + 1]); mb = max3f(mb, p0[r + 2], p0[r + 3]); mx = max3f(mx, p1[r], p1[r + 1]); mb = max3f(mb, p1[r + 2], p1[r + 3]); }
        mx = fmaxf(mx, mb);
        { float x, y; swap32(mx, x, y); mx = fmaxf(x, y); }
        if (t == 0 || __any(mx > (float)THR)) {
            const float dl = (t == 0) ? mx : fmaxf(mx, 0.f);
            m += dl;
            const float alpha = __builtin_amdgcn_exp2f(-dl);
            l *= alpha;
#pragma unroll
            for (int r = 0; r < 16; ++r) { p0[r] -= dl; p1[r] -= dl; negm[r] = -m; }
            if (t > 0) {
                if (hi == 0) wsf[r32] = alpha;
#pragma unroll
                for (int r = 0; r < 16; ++r) { const float f = wsf[crow(r, hi)]; o[0][r] *= f; o[1][r] *= f; }
            }
        }
        float ps = 0.f;
#pragma unroll
        for (int r = 0; r < 16; ++r) { p0[r] = __builtin_amdgcn_exp2f(p0[r]); p1[r] = __builtin_amdgcn_exp2f(p1[r]); ps += p0[r] + p1[r]; }
        l += ps;
        u32x4 pw[4];
#pragma unroll
        for (int q = 0; q < 4; ++q) { pw[0][q] = cvtpk(p0[2 * q], p0[2 * q + 1]); pw[1][q] = cvtpk(p0[8 + 2 * q], p0[9 + 2 * q]); pw[2][q] = cvtpk(p1[2 * q], p1[2 * q + 1]); pw[3][q] = cvtpk(p1[8 + 2 * q], p1[9 + 2 * q]); }
#pragma unroll
        for (int d0 = 0; d0 < 2; ++d0)
#pragma unroll
            for (int ks = 0; ks < 4; ++ks) {
                const s16x4 lo = vlo[d0 * 4 + ks], hh = vhi[d0 * 4 + ks];
                const bf16x8 vf = (bf16x8){lo[0], lo[1], lo[2], lo[3], hh[0], hh[1], hh[2], hh[3]};
                o[d0] = __builtin_amdgcn_mfma_f32_32x32x16_bf16(__builtin_bit_cast(bf16x8, pw[ks]), vf, o[d0], 0, 0, 0);
            }
    }
    { float x, y; swap32(l, x, y); l = x + y; }
    if (hi == 0) wsf[32 + r32] = l;
    float rli[16];
#pragma unroll
    for (int r = 0; r < 16; ++r) rli[r] = 1.0f / wsf[32 + crow(r, hi)];
    LAS bf16_t* stg = (LAS bf16_t*)(shm + LDS_OST) + wid * 2048;
#pragma unroll
    for (int r = 0; r < 16; ++r) { const int orow = crow(r, hi);
#pragma unroll
        for (int d0 = 0; d0 < 2; ++d0) stg[orow * 64 + d0 * 32 + r32] = f2bf(o[d0][r] * rli[r]); }
#pragma unroll
    for (int i = 0; i < 4; ++i) { const int row = i * 8 + (lane >> 3), ch = lane & 7; const u32x4 v = *(const LAS u32x4*)(stg + row * 64 + ch * 8); if (!dry) *(u32x4*)(Qw + (size_t)row * 768 + ch * 8) = v; }
    asm volatile("s_waitcnt lgkmcnt(0)\n\ts_barrier" ::: "memory");
#undef ATT_DMA
}
}

__global__ void __launch_bounds__(512, 2) fwd_kernel(Args A) {
    extern __shared__ __attribute__((aligned(16))) unsigned char smem[];
    float* lds = (float*)smem;
    volatile LAS unsigned* xbw = (volatile LAS unsigned*)(smem + 147456 - 16);
    unsigned* ctl = (unsigned*)(ARG_WS + WS_CTL);
    const int tid = threadIdx.x;
    if (tid == 0) { xbw[0] = 0u; xbw[1] = 0u; xbw[2] = 0u; xbw[3] = 0u; }
    __syncthreads();
    XcdBarrier bar = xcd_barrier_post(ctl, xbw);
#if PROBE >= 50 && PROBE <= 52
    unsigned long long pc0 = 0, pr0 = 0, pc1 = 0, pr1 = 0;
    if (PROBE == 50) { pc0 = __builtin_amdgcn_s_memtime(); pr0 = __builtin_amdgcn_s_memrealtime(); }
#endif
    LAS int* s_unit = (LAS int*)(smem + 147456 - 32);

    bf16_t* PROJ = (bf16_t*)(ARG_WS + WS_PROJ);
    bf16_t* XN = (bf16_t*)(ARG_WS + WS_XN);
    float* rope = (float*)(ARG_WS + WS_ROPE);
    const int nwaves = gridDim.x * 8;
#define PHASE_IDS() const int ptid = otid(), lane = ptid & 63, wv = ptid >> 6, gw = blockIdx.x * 8 + wv; (void)lane; (void)gw

    PAMP_BEGIN(20);
    for (int idx = blockIdx.x * 512 + otid(); idx < SEQ * 16; idx += gridDim.x * 512) {
        const int t = idx >> 4, i = idx & 15;
        const float inv = powf(10000.0f, -((float)i * 2.0f / 32.0f));
        const float ang = (float)t * inv;
        const double twopi = 6.283185307179586476925286766559;
        double rr = (double)ang; rr -= twopi * floor(rr / twopi + 0.5);
        const double r2 = rr * rr; double ts = rr, ss = rr, tc = 1.0, cc = 1.0;
        for (int n = 1; n <= 13; ++n) { ts *= -r2 / (double)((2 * n) * (2 * n + 1)); ss += ts; tc *= -r2 / (double)((2 * n - 1) * (2 * n)); cc += tc; }
        rope[idx * 2] = (float)cc; rope[idx * 2 + 1] = (float)ss;
    }

    for (int prep = 0; prep < (PROBE == 11 ? 2 : 1); ++prep)
    for (int l = 0; l < DEPTH; ++l) {
        { const float* W = ARG(2) + (size_t)l * DM * DIN; const float* g = ARG(1) + (size_t)l * DM;
          transpose_w(DM, NPAD_IN, (bf16_t*)(ARG_WS + WS_WIN) + (size_t)l * NPAD_IN * DM, [=](int k, int n) -> f32x4_t { return n < DIN ? *(const f32x4_t*)(W + (size_t)k * DIN + orig_col(n)) * g[k] : (f32x4_t){0.f, 0.f, 0.f, 0.f}; }, lds); }
        { const float* W = ARG(26) + (size_t)l * DMIX * DM;
          transpose_w(DMIX, DM, (bf16_t*)(ARG_WS + WS_WOUT) + (size_t)l * DM * DMIX, [=](int k, int n) -> f32x4_t { return *(const f32x4_t*)(W + (size_t)k * DM + n); }, lds); }
        { const float* qg = ARG(21) + (size_t)l * QL; const float* wuq = ARG(22) + (size_t)l * QL * 768;
          const float* kg = ARG(23) + (size_t)l * KVL; const float* wukv = ARG(24) + (size_t)l * KVL * 1024;
          transpose_w(256, NMLA, (bf16_t*)(ARG_WS + WS_WMLA) + (size_t)l * NMLA * 256, [=](int k, int n) -> f32x4_t {
              if (n < 768) return *(const f32x4_t*)(wuq + (size_t)k * 768 + n) * qg[k];
              return k < KVL ? *(const f32x4_t*)(wukv + (size_t)k * 1024 + (n - 768)) * kg[k] : (f32x4_t){0.f, 0.f, 0.f, 0.f}; }, lds); }
    }
    { const float* w2 = ARG(5); const float* a2 = ARG(7);
      transpose_w(64, DEPTH * 512, (bf16_t*)(ARG_WS + WS_W2T), [=](int k, int n) -> f32x4_t { return *(const f32x4_t*)(w2 + ((size_t)(n >> 9) * 64 + k) * 512 + (n & 511)); }, lds);
      transpose_w(64, DEPTH * 512, (bf16_t*)(ARG_WS + WS_W2T) + (size_t)DEPTH * 512 * 64, [=](int k, int n) -> f32x4_t { return *(const f32x4_t*)(a2 + ((size_t)(n >> 9) * 64 + k) * 512 + (n & 511)); }, lds); }
    { const float* ga = ARG(15); const float* gx = ARG(17);
      transpose_w(64, DEPTH * 8 * 64, (bf16_t*)(ARG_WS + WS_GAT), [=](int k, int n) -> f32x4_t { return *(const f32x4_t*)(ga + ((size_t)(n >> 6) * 64 + k) * 64 + (n & 63)); }, lds);
      transpose_w(64, DEPTH * 8 * 64, (bf16_t*)(ARG_WS + WS_GAT) + (size_t)DEPTH * 8 * 64 * 64, [=](int k, int n) -> f32x4_t { return *(const f32x4_t*)(gx + ((size_t)(n >> 6) * 64 + k) * 64 + (n & 63)); }, lds); }
    {
        PHASE_IDS();
        const float* x = ARG(0); float* ssqh = (float*)(ARG_WS + WS_SSQH);
        for (int row = gw; row < MTOK; row += nwaves) {
            float4 v[4]; float ss = 0.f;
#pragma unroll
            for (int q = 0; q < 4; ++q) { v[q] = *(const float4*)&x[(size_t)row * DM + q * 256 + lane * 4]; ss += v[q].x * v[q].x + v[q].y * v[q].y + v[q].z * v[q].z + v[q].w * v[q].w; }
            ss = wave_sum(ss);
#pragma unroll
            for (int q = 0; q < 4; ++q) { ushort4 o; o.x = f2bf(v[q].x); o.y = f2bf(v[q].y); o.z = f2bf(v[q].z); o.w = f2bf(v[q].w); *(ushort4*)&XN[(size_t)row * DM + q * 256 + lane * 4] = o; }
            if (lane < 16) ssqh[(size_t)row * 16 + lane] = (lane == 0) ? ss : 0.f;
        }
    }
    PAMP_END(20);
    xcd_barrier(bar);

    for (int l = 0; l < DEPTH; ++l) {
        const float* hsrc = (l == 0) ? ARG(0) : ARG_OUT;
#if PROBE == 10
        for (int rep = 0; rep < 8; ++rep) xcd_barrier(bar);
#endif
#if PROBE == 40
        { const unsigned long long t1_ = __builtin_amdgcn_s_memrealtime(); while (__builtin_amdgcn_s_memrealtime() - t1_ < 20000ull) __builtin_amdgcn_s_sleep(8); __syncthreads(); }
#endif
        PAMP_BEGIN(21);
#if PROBE == 51 || PROBE == 52
        if (l == (PROBE == 51 ? 0 : 3)) { pc0 = __builtin_amdgcn_s_memtime(); pr0 = __builtin_amdgcn_s_memrealtime(); }
#endif
        for (int rep = 0; rep < (PROBE == 9 ? 2 : 1); ++rep) {
            pg8::Gemm g{XN, (const bf16_t*)(ARG_WS + WS_WIN) + (size_t)l * NPAD_IN * DM, MTOK, NPAD_IN, DM, DM, DM, 1 << 30, 0};
            pg8::RowScaleOrder<16> S; S.init(MTOK, NPAD_IN, (int)gridDim.x, (int)blockIdx.x);
            S.part = (const float*)(ARG_WS + WS_SSQH); S.inv_dim = 1.0f / DM; S.tab = (PG8_LAS float*)(smem + 131072);
            pg8::EpiProj E{PROJ, DIN, DIN, (const PG8_LAS float*)(smem + 131072), (float*)(ARG_WS + WS_SQQ), (float*)(ARG_WS + WS_SQKV), (bf16_t*)(ARG_WS + WS_K), rope, (bf16_t*)(ARG_WS + WS_SAVA)};
            pg8::gemm_phase<pg8::EpiProj, pg8::RowScaleOrder<16>, true, true>((PG8_LAS unsigned char*)smem, g, S, E);
        }
#if PROBE == 51 || PROBE == 52
        if (l == (PROBE == 51 ? 0 : 3)) { __syncthreads(); pc1 = __builtin_amdgcn_s_memtime(); pr1 = __builtin_amdgcn_s_memrealtime(); }
#endif
        PAMP_END(21);
        xcd_barrier(bar);
        PAMP_BEGIN(22);
        for (int rep = 0; rep < (PROBE == 13 ? 2 : 1); ++rep) {
            int kmla = 256; asm volatile("" : "+s"(kmla));
            pg8::Gemm g{PROJ + C_QL, (const bf16_t*)(ARG_WS + WS_WMLA) + (size_t)l * NMLA * 256, MTOK, NMLA, kmla, DIN, 256, 3, 2 * (C_KVL - C_QL)};
            pg8::MlaOrder S; S.init(MTOK, NMLA, (int)gridDim.x, (int)blockIdx.x);
            S.sqq = (const float*)(ARG_WS + WS_SQQ); S.sqkv = (const float*)(ARG_WS + WS_SQKV); S.tab = (PG8_LAS float*)(smem + 131072 + 2048);
            pg8::EpiMla E{(bf16_t*)(ARG_WS + WS_Q), (bf16_t*)(ARG_WS + WS_K), (bf16_t*)(ARG_WS + WS_V), (const PG8_LAS float*)(smem + 131072 + 2048), rope, 0.10206207261596577f * 1.4426950408889634f, 0};
            pg8::gemm_phase<pg8::EpiMla, pg8::MlaOrder, true, true>((PG8_LAS unsigned char*)smem, g, S, E);
        }
        PAMP_END(22);
#if PROBE == 1 || PROBE == 2
        {
            const bool dry = (xb_ld(ctl + CW_PROBE) == 0u);
            unsigned* qw = ctl + CW_PROBEQ + 64 * l;
            for (;;) {
                __syncthreads();
                if (threadIdx.x == 0) *s_unit = (int)atomicAdd(qw, 1u);
                __syncthreads();
                const int u = *s_unit;
#if PROBE == 1
                if (u >= 4096) break;
                (void)dry; break;
#else
                if (u >= 1024) break;
                break;
#endif
            }
        }
#endif
        PAMP_BEGIN(23);
#if PROBE == 1
        rw::r1_phase(l, (LAS char*)smem, (xb_ld(ctl + CW_PROBE) == 0u));
#endif
        rw::r1_phase(l, (LAS char*)smem);
        lru::phase<false>(l, (LAS char*)smem, ctl + CW_LCNT + 64 * l);
        PAMP_END(23);
        xcd_barrier(bar);
#if PROBE >= 3 && PROBE <= 5
        {
            const bool dry = (xb_ld(ctl + CW_PROBE) == 0u);
            unsigned* qw = ctl + CW_PROBEQ + 64 * l;
            for (;;) {
                __syncthreads();
                if (threadIdx.x == 0) *s_unit = (int)atomicAdd(qw, 1u);
                __syncthreads();
                const int u = *s_unit;
#if PROBE == 3
                if (u >= 64) break;
                rw::r2_unit(l, u >> 3, u & 7, (LAS char*)smem, dry);
#elif PROBE == 4
                if (u >= 1024) break;
                break;
#else
                if (u >= 1024) break;
                att::attn_unit<ATT_THR>((bf16_t*)(ARG_WS + WS_Q), (const bf16_t*)(ARG_WS + WS_K), (const bf16_t*)(ARG_WS + WS_V), (u & 63) >> 3, u & 7, 15 - (u >> 6), (LAS char*)smem, dry);
#endif
            }
        }
#endif
        {
            unsigned* qw = ctl + CW_QUEUE + 64 * (2 * l + 1);
            PAMP_BEGIN(24);
            for (;;) {
                __syncthreads();
                if (threadIdx.x == 0) *s_unit = (int)atomicAdd(qw, 1u);
                __syncthreads();
                const int u = *s_unit;
                if (u >= 8 + 64) break;
                if (u < 8) lru::carry_unit(u, ctl + CW_LCNT + 64 * l);
                else { const int a = u - 8; rw::r2_unit(l, a >> 3, a & 7, (LAS char*)smem); }
            }
            PAMP_END(24);
            PAMP_BEGIN(25);
            {
                const int x0 = (int)(xb_xcc_id() & 7u);
                for (int k = 0; k < 8; ++k) {
                    const int x = (x0 + k) & 7;
                    unsigned* qa = ctl + CW_ATTQ + 32 * (l * 8 + x);
                    for (;;) {
                        __syncthreads();
                        if (threadIdx.x == 0) *s_unit = (int)atomicAdd(qa, 1u);
                        __syncthreads();
                        const int u = *s_unit;
                        if (u >= 128) break;
                        const int bh = 8 * x + (u & 7), qb = 15 - (u >> 3);
                        att::attn_unit<ATT_THR>((bf16_t*)(ARG_WS + WS_Q), (const bf16_t*)(ARG_WS + WS_K), (const bf16_t*)(ARG_WS + WS_V), bh >> 3, bh & 7, qb, (LAS char*)smem);
                    }
                }
            }
            PAMP_END(25);
            PAMP_BEGIN(26);
            lru::phase<true>(l, (LAS char*)smem, ctl + CW_LCNT + 64 * l);
            PAMP_END(26);
        }
        xcd_barrier(bar);
        PAMP_BEGIN(27);
        for (int rep = 0; rep < (PROBE == 8 ? 2 : 1); ++rep) {
            const bool dry = (PROBE == 8) && (rep == 0) && (xb_ld(ctl + CW_PROBE) == 0u);
            typedef unsigned u32x4 __attribute__((ext_vector_type(4)));
            typedef float f32x4 __attribute__((ext_vector_type(4)));
            PHASE_IDS();
            const int hd = lane >> 3, c0 = hd * 64 + (lane & 7) * 8;
            const bf16_t* OATT = (const bf16_t*)(ARG_WS + WS_Q);
            float gcv[8];
            { const float* p2 = ARG(25) + (size_t)l * 512 + c0; const f32x4 d0 = *(const f32x4*)p2, d1 = *(const f32x4*)(p2 + 4);
#pragma unroll
              for (int e = 0; e < 4; ++e) { gcv[e] = d0[e]; gcv[4 + e] = d1[e]; } }
            auto unpack = [](const u32x4 v, float (&x)[8]) { const unsigned w[4] = {v.x, v.y, v.z, v.w};
#pragma unroll
                for (int e = 0; e < 4; ++e) { x[2 * e] = bf2f((bf16_t)(w[e] & 0xffffu)); x[2 * e + 1] = bf2f((bf16_t)(w[e] >> 16)); } };
            for (int row = gw; row < MTOK; row += 4 * nwaves) {
                u32x4 rzc[4], ro[4];
#pragma unroll
                for (int k = 0; k < 4; ++k) { const size_t rr = (size_t)row + (size_t)k * nwaves; rzc[k] = *(const u32x4*)(PROJ + rr * DIN + C_ZC + c0); ro[k] = *(const u32x4*)(OATT + (rr * 8 + hd) * 96 + (lane & 7) * 8); }
#pragma unroll
                for (int k = 0; k < 4; ++k) {
                    const size_t rr = (size_t)row + (size_t)k * nwaves;
                    float zc[8], oa[8];
                    unpack(rzc[k], zc); unpack(ro[k], oa);
                    float sq = 0.f;
#pragma unroll
                    for (int e = 0; e < 8; ++e) sq += oa[e] * oa[e];
                    sq = wave_sum(sq);
                    const float rc = rsqrtf(sq * (1.0f / 512) + 1e-6f);
                    float yc[8];
#pragma unroll
                    for (int e = 0; e < 8; ++e) yc[e] = oa[e] * rc * gcv[e] * siluf_(zc[e]);
                    u32x4 wc;
                    wc.x = rw::pk2(yc[0], yc[1]); wc.y = rw::pk2(yc[2], yc[3]); wc.z = rw::pk2(yc[4], yc[5]); wc.w = rw::pk2(yc[6], yc[7]);
                    if (!dry) *(u32x4*)(PROJ + rr * DIN + C_ZC + c0) = wc;
                }
            }
        }
        PAMP_END(27);
        xcd_barrier(bar);
        PAMP_BEGIN(28);
        for (int rep = 0; rep < (PROBE == 14 ? 2 : 1); ++rep) {
            const bool odry = (PROBE == 14) && (rep == 0) && (xb_ld(ctl + CW_PROBE) == 0u);
            pg8::Gemm g{PROJ + C_ZA, (const bf16_t*)(ARG_WS + WS_WOUT) + (size_t)l * DM * DMIX, MTOK, DM, DMIX, DIN, DMIX, 1 << 30, 0};
            pg8::StaticOrder S; S.init(MTOK, DM, (int)gridDim.x, (int)blockIdx.x);
            pg8::EpiResid E{ARG_OUT, hsrc, DM, odry, XN, (float*)(ARG_WS + WS_SSQH)};
            pg8::gemm_phase<pg8::EpiResid, pg8::StaticOrder, true, true>((PG8_LAS unsigned char*)smem, g, S, E);
        }
        PAMP_END(28);
        xcd_barrier(bar);
    }
    {
        const float* g = ARG(27); const float* ssqh = (const float*)(ARG_WS + WS_SSQH);
        PHASE_IDS();
        float* out = ARG_OUT;
        for (int row = gw; row < MTOK; row += nwaves) {
            float tsum = (lane < 16) ? ssqh[(size_t)row * 16 + lane] : 0.f;
            tsum = wave_sum(tsum);
            const float rs = rsqrtf(tsum * (1.0f / DM) + 1e-6f);
            float4 v[4];
#pragma unroll
            for (int q = 0; q < 4; ++q) v[q] = *(const float4*)&out[(size_t)row * DM + q * 256 + lane * 4];
#pragma unroll
            for (int q = 0; q < 4; ++q) {
                const float4 gg = *(const float4*)&g[q * 256 + lane * 4];
                float4 o; o.x = v[q].x * rs * gg.x; o.y = v[q].y * rs * gg.y; o.z = v[q].z * rs * gg.z; o.w = v[q].w * rs * gg.w;
                *(float4*)&out[(size_t)row * DM + q * 256 + lane * 4] = o;
            }
        }
    }
#if PROBE >= 50 && PROBE <= 52
    if (PROBE == 50) { __syncthreads(); pc1 = __builtin_amdgcn_s_memtime(); pr1 = __builtin_amdgcn_s_memrealtime(); }
    if (blockIdx.x == 0) {
        const unsigned long long mhz = (pc1 - pc0) * 100ull / (pr1 - pr0 + 1ull);
        const unsigned long long t1_ = __builtin_amdgcn_s_memrealtime(), d_ = mhz * 25ull;
        while (__builtin_amdgcn_s_memrealtime() - t1_ < d_) __builtin_amdgcn_s_sleep(8);
    }
#endif
}

extern "C" void kernel_launch(void* const* d_in, const int* in_sizes, int n_in, void* d_out, int out_size, void* d_ws, size_t ws_size, hipStream_t stream) {
    (void)in_sizes; (void)n_in; (void)out_size; (void)ws_size;
    constexpr int kDynLds = 147456;
    static int grid = 0;
    if (!grid) {
        int dev = 0, cus = 0;
        hipGetDevice(&dev);
        hipDeviceGetAttribute(&cus, hipDeviceAttributeMultiprocessorCount, dev);
        hipFuncSetAttribute((const void*)fwd_kernel, hipFuncAttributeMaxDynamicSharedMemorySize, kDynLds);
        int per_cu = 0;
        hipOccupancyMaxActiveBlocksPerMultiprocessor(&per_cu, fwd_kernel, 512, kDynLds);
        if (per_cu < 1) fprintf(stderr, "occupancy query says %d\n", per_cu);
        grid = cus > 0 ? cus : 256;
    }
    hipMemsetAsync(d_ws, 0, CTL_BYTES, stream);
    Args a;
    memset(&a, 0, sizeof(a));
    for (int i = 0; i < 28; ++i) a.in[i] = (const float*)d_in[i];
    a.out = (float*)d_out;
    a.ws = (unsigned char*)d_ws;
    hipLaunchKernelGGL(fwd_kernel, dim3(grid), dim3(512), kDynLds, stream, a);
}
```

```cpp
#include <hip/hip_runtime.h>
#include <stdint.h>
#include <cstdio>
#include <cstring>
#ifndef PROBE
#define PROBE 0
#endif
#define PAMP_BEGIN(id) unsigned long long pamp_t0_##id = 0; if (PROBE == (id)) pamp_t0_##id = __builtin_amdgcn_s_memrealtime()
#define PAMP_END(id) do { if (PROBE == (id)) { __syncthreads(); const unsigned long long t1_ = __builtin_amdgcn_s_memrealtime(), d_ = t1_ - pamp_t0_##id; while (__builtin_amdgcn_s_memrealtime() - t1_ < d_) __builtin_amdgcn_s_sleep(8); __syncthreads(); } } while (0)

constexpr int DM = 1024, NB = 8, SEQ = 4096, DEPTH = 4, MTOK = NB * SEQ;
constexpr int GW = 512, HD = 64, NH = 8, DMIX = 1536, DIN = 4128;
constexpr int QL = 256, KVL = 128;
constexpr int C_R = 0, C_K = 512, C_V = 1024, C_WL = 1536, C_AL = 1600, C_UB = 1664, C_QL = 2176, C_KVL = 2432, C_KR = 2560,
              C_ZA = 2592, C_ZB = 3104, C_ZC = 3616;
__device__ __forceinline__ int orig_col(int c) {
    if (c < 1664) return c;
    if (c < 2176) return c - 1664 + 2176;
    if (c < 2432) return c - 2176 + 3200;
    if (c < 2560) return c - 2432 + 3456;
    if (c < 2592) return c - 2560 + 3584;
    if (c < 3104) return c - 2592 + 1664;
    if (c < 3616) return c - 3104 + 2688;
    return c;
}
constexpr size_t MiB = 1u << 20;
constexpr size_t WS_CTL = 0, CTL_BYTES = 65536;
constexpr size_t WS_ROPE = 64 * 1024;
constexpr size_t WS_W2T = 576 * 1024;
constexpr size_t WS_SQQ = 1088 * 1024;
constexpr size_t WS_SQKV = 2112 * 1024;
constexpr size_t WS_SSQH = 10 * MiB;
constexpr size_t WS_WMLA = 3 * MiB;
constexpr size_t WS_PROJ = 16 * MiB;
constexpr size_t WS_XN = 354 * MiB;
constexpr size_t WS_K = 274 * MiB;
constexpr size_t WS_V = 322 * MiB;
constexpr size_t WS_BON = 8 * MiB + 512 * 1024;
constexpr size_t WS_SAVA = 14 * MiB;
constexpr size_t WS_RWD = 480 * MiB;
constexpr size_t WS_GAT = 9 * MiB + 512 * 1024;
constexpr size_t WS_LSUM = 10 * MiB;
constexpr size_t WS_WIN = 434 * MiB;
constexpr size_t WS_WOUT = 468 * MiB;
constexpr size_t WS_FREE = 480 * MiB;
constexpr int NPAD_IN = 4352, NMLA = 1792, KMLA = 384;
constexpr int CW_QUEUE = 8192, CW_PROBEQ = 12288, CW_PROBE = 4000, CW_LCNT = 14336, CW_ATTQ = 15000;

#ifndef ATT_THR
#define ATT_THR 8
#endif

typedef unsigned short bf16_t;
__device__ __forceinline__ float bf2f(bf16_t v) { return __builtin_bit_cast(float, (unsigned)v << 16); }
typedef float f32x2_cv __attribute__((ext_vector_type(2)));
typedef __bf16 bf16x2_cv __attribute__((ext_vector_type(2)));
__device__ __forceinline__ unsigned f2bf2(float lo, float hi) { f32x2_cv v = {lo, hi}; bf16x2_cv b = __builtin_convertvector(v, bf16x2_cv); return __builtin_bit_cast(unsigned, b); }
__device__ __forceinline__ bf16_t f2bf(float f) { return (bf16_t)(f2bf2(f, f) & 0xffffu); }
template <int MASK> __device__ __forceinline__ float shx(float v) {
    static_assert(MASK < 32, "shx: within 32 lanes");
    return __builtin_bit_cast(float, __builtin_amdgcn_ds_swizzle(__builtin_bit_cast(int, v), (MASK << 10) | 0x1f));
}
__device__ __forceinline__ void swap32(float v, float& x, float& y) {
    auto rr = __builtin_amdgcn_permlane32_swap(__builtin_bit_cast(unsigned, v), __builtin_bit_cast(unsigned, v), false, false);
    unsigned a = rr[0], b = rr[1]; asm("" : "+v"(a), "+v"(b));
    x = __builtin_bit_cast(float, a); y = __builtin_bit_cast(float, b);
}
template <int CTRL> __device__ __forceinline__ float dppx(float v) { return __builtin_bit_cast(float, __builtin_amdgcn_mov_dpp(__builtin_bit_cast(int, v), CTRL, 0xf, 0xf, true)); }
__device__ __forceinline__ float sum8(float v) { v += dppx<0xB1>(v); v += dppx<0x4E>(v); v += dppx<0x141>(v); return v; }
__device__ __forceinline__ float wave_sum(float v) {
    v += dppx<0xB1>(v); v += dppx<0x4E>(v); v += dppx<0x141>(v); v += dppx<0x140>(v);
    v += shx<16>(v);
    float x, y; swap32(v, x, y);
    return x + y;
}
__device__ __forceinline__ float fexp(float x) { return __builtin_amdgcn_exp2f(x * 1.4426950408889634f); }
__device__ __forceinline__ float frcp(float x) { return __builtin_amdgcn_rcpf(x); }
__device__ __forceinline__ float sigmoidf_(float x) { return frcp(1.0f + fexp(-x)); }
__device__ __forceinline__ float softplusf_(float x) { return x > 20.f ? x : __builtin_amdgcn_logf(1.0f + fexp(x)) * 0.6931471805599453f; }
__device__ __forceinline__ float siluf_(float x) { return x * frcp(1.0f + fexp(-x)); }
__device__ __forceinline__ float ftanh(float x) { return 1.0f - 2.0f * frcp(1.0f + fexp(2.0f * x)); }
__device__ __forceinline__ float nexpm1(float x) { return x > -0.02f ? -x * (1.0f + x * (0.5f + x * 0.16666667f)) : 1.0f - fexp(x); }

__device__ __forceinline__ int otid() { int t = threadIdx.x; asm volatile("" : "+v"(t)); return t; }
template <int K> __device__ __forceinline__ const float* argp() {
    int k = K; asm volatile("" : "+s"(k));
    return (const float*)(((const unsigned long long*)__builtin_amdgcn_kernarg_segment_ptr())[k]);
}
#define ARG(k) argp<k>()
#define ARG_OUT ((float*)argp<28>())
#define ARG_WS ((unsigned char*)argp<29>())
#define DO_Q ((unsigned char*)argp<28>())
#define DO_RWP ((unsigned char*)argp<28>() + 48 * MiB)

#define XB_TMO      128
#define XB_XCNT(j)  (256  + 64 * (j))
#define XB_XSUB(j)  (1280 + 64 * (j))
#define XB_XGEN(j)  (2304 + 64 * (j))
#define XB_TOP      3328
#define XB_TOPGEN   3392
#define XCD_BAR_WORDS 3456
#define XB_SPIN_CAP (1u << 24)
#define LAS __attribute__((address_space(3)))

__device__ __forceinline__ unsigned xb_ld(unsigned* p)              { return __hip_atomic_load(p, __ATOMIC_RELAXED, __HIP_MEMORY_SCOPE_AGENT); }
__device__ __forceinline__ unsigned xb_add(unsigned* p, unsigned v) { return __hip_atomic_fetch_add(p, v, __ATOMIC_RELAXED, __HIP_MEMORY_SCOPE_AGENT); }
__device__ __forceinline__ unsigned xb_xcc_id() { return (unsigned)__builtin_amdgcn_s_getreg((3 << 11) | 20) & 0xFu; }
#define XB_SPIN(cond, bar) do { unsigned _sp = 0; while (cond) { __builtin_amdgcn_s_sleep(1); \
    if ((++_sp & 255u) == 0u) { if (xb_ld(&(bar)[XB_TMO])) break; if (_sp > XB_SPIN_CAP) { atomicAdd(&(bar)[XB_TMO], 1u); break; } } } } while (0)

struct XcdBarrier { unsigned* bar; unsigned x; volatile LAS unsigned* st; };

__device__ __forceinline__ XcdBarrier xcd_barrier_post(unsigned* bar, volatile LAS unsigned* st) {
    XcdBarrier b; b.bar = bar; b.x = xb_xcc_id(); b.st = st;
    if (threadIdx.x == 0) (void)xb_add(&bar[XB_XCNT(b.x)], 1u);
    return b;
}
__device__ __forceinline__ void xcd_barrier_complete(unsigned* bar, unsigned x, unsigned& nloc, unsigned& nx) {
    const unsigned G = gridDim.x * gridDim.y * gridDim.z;
    unsigned sum, cnt, mine, sp = 0u;
    for (;;) {
        sum = 0u; cnt = 0u; mine = 0u;
#pragma unroll
        for (unsigned j = 0; j < 16; ++j) { const unsigned c = xb_ld(&bar[XB_XCNT(j)]); sum += c; cnt += (c > 0u) ? 1u : 0u; mine = (j == x) ? c : mine; }
        if (sum == G) break;
        __builtin_amdgcn_s_sleep(1);
        if ((++sp & 255u) == 0u) { if (xb_ld(&bar[XB_TMO])) break; if (sp > XB_SPIN_CAP) { atomicAdd(&bar[XB_TMO], 1u); break; } }
    }
    nloc = mine > 0u ? mine : 1u; nx = cnt > 0u ? cnt : 1u;
}
__device__ __forceinline__ void xcd_barrier_raw(const XcdBarrier& b);
__device__ __forceinline__ void xcd_barrier(const XcdBarrier& b) {
#if PROBE == 30
    const unsigned long long t0_ = __builtin_amdgcn_s_memrealtime();
    xcd_barrier_raw(b);
    const unsigned long long t1_ = __builtin_amdgcn_s_memrealtime(), d_ = t1_ - t0_;
    while (__builtin_amdgcn_s_memrealtime() - t1_ < d_) __builtin_amdgcn_s_sleep(8);
    __syncthreads();
#else
    xcd_barrier_raw(b);
#endif
}
__device__ __forceinline__ void xcd_barrier_raw(const XcdBarrier& b) {
    asm volatile("s_waitcnt vmcnt(0)" ::: "memory");
    __syncthreads();
    if (threadIdx.x == 0) {
        unsigned* bar = b.bar;
        __builtin_amdgcn_s_waitcnt(0);
        const unsigned bx = (unsigned)__builtin_amdgcn_readfirstlane((int)xb_xcc_id());
        unsigned nloc = b.st[0], nx = b.st[1];
        if (nloc == 0u) { xcd_barrier_complete(bar, bx, nloc, nx); b.st[0] = nloc; b.st[1] = nx; }
        const unsigned old = xb_add(&bar[XB_XSUB(bx)], 1u);
        const unsigned gen = old / nloc;
        if (old + 1u == (gen + 1u) * nloc) {
            __builtin_amdgcn_fence(__ATOMIC_RELEASE, "agent");
            asm volatile("s_waitcnt vmcnt(0)" ::: "memory");
            const unsigned og = xb_add(&bar[XB_TOP], 1u);
            const unsigned tg = og / nx;
            if (og + 1u == (tg + 1u) * nx) xb_add(&bar[XB_TOPGEN], 1u);
            else XB_SPIN(xb_ld(&bar[XB_TOPGEN]) == tg, bar);
            __builtin_amdgcn_fence(__ATOMIC_ACQUIRE, "agent");
            xb_add(&bar[XB_XGEN(bx)], 1u);
            asm volatile("s_waitcnt vmcnt(0)" ::: "memory");
        } else {
            XB_SPIN(xb_ld(&bar[XB_XGEN(bx)]) == gen, bar);
            __builtin_amdgcn_fence(__ATOMIC_ACQUIRE, "agent");
            asm volatile("s_waitcnt vmcnt(0)" ::: "memory");
        }
    }
    __syncthreads();
}

struct Args {
    const float* in[28];
    float* out;
    unsigned char* ws;
};

namespace pg8 {
#define PG8_LAS __attribute__((address_space(3)))
typedef unsigned short bf16_t;
typedef short bf16x8 __attribute__((ext_vector_type(8)));
typedef float f32x4 __attribute__((ext_vector_type(4)));
typedef unsigned u32x4 __attribute__((ext_vector_type(4)));
constexpr int BM = 256, BK = 64, HALF = 128, HTB = HALF * BK * 2  , STAGE_BYTES = 8 * HTB, NXCD = 8, WGM = 8;

__host__ __device__ __forceinline__ int lds_byte(int r, int c) { const int st = (r >> 4) * 2 + (c >> 5), rr = r & 15, cc = c & 31, ob = rr * 64 + cc * 2; return st * 1024 + (ob ^ (((ob >> 9) & 1) << 5)); }
__host__ __device__ __forceinline__ void stage_rc(int b, int& R, int& C) { const int st = b / 1024, sb = b % 1024, swz = sb ^ (((sb >> 9) & 1) << 5); R = (st >> 1) * 16 + swz / 64; C = (st & 1) * 32 + (swz % 64) / 2; }
__host__ __device__ __forceinline__ int perm32(int rho) { const int n = rho >> 4, i = rho & 15; return 8 * (i >> 2) + 4 * n + (i & 3); }

struct Unit { int pm, pn; };
struct Gemm { const bf16_t* A; const bf16_t* Bt; int M, N, K, lda, ldb; int a_split_pn; int a_split_off; };

struct StaticOrder {
    int nM, nN, nwg, G, c;
    __host__ __device__ void init(int M, int N, int G_, int c_) { nM = M / BM; nN = N / BM; nwg = nM * nN; G = G_; c = c_; }
    __host__ __device__ bool next(int i, Unit& u) const {
        const long L = (long)i * G + c; if (L >= nwg) return false;
        int wgid = (int)L; { const int q = nwg / NXCD, r = nwg % NXCD, xcd = wgid % NXCD, off = wgid / NXCD; wgid = (xcd < r ? xcd * (q + 1) : r * (q + 1) + (xcd - r) * q) + off; }
        const int nig = WGM * nN, gid = wgid / nig, fm = gid * WGM, gsz = (nM - fm) < WGM ? (nM - fm) : WGM;
        u.pm = fm + ((wgid % nig) % gsz); u.pn = (wgid % nig) / gsz; return true;
    }
    __device__ __forceinline__ void a_ready(const Unit&, int) const {}
    __device__ __forceinline__ void done(const Unit&) const {}
};

template <int NP>
struct RowScaleOrder : StaticOrder {
    const float* part; float inv_dim; PG8_LAS float* tab;
    __device__ __forceinline__ void a_ready(const Unit& u, int seq) const {
        const int t = otid();
        if (t < 256) {
            const float* p = part + (size_t)(u.pm * BM + t) * NP;
            float sm = 0.f;
#pragma unroll
            for (int k = 0; k < NP; k += 4) { const f32x4 v = *(const f32x4*)(p + k); sm += (v[0] + v[1]) + (v[2] + v[3]); }
            tab[(seq & 1) * 256 + t] = rsqrtf(sm * inv_dim + 1e-6f);
        }
    }
};

struct MlaOrder : StaticOrder {
    const float* sqq; const float* sqkv; PG8_LAS float* tab;
    __device__ __forceinline__ void a_ready(const Unit& u, int seq) const {
        const int t = otid();
        if (t < 256) {
            const size_t row = (size_t)(u.pm * BM + t);
            const f32x4 q0 = *(const f32x4*)(sqq + row * 8), q1 = *(const f32x4*)(sqq + row * 8 + 4), k0 = *(const f32x4*)(sqkv + row * 4);
            tab[((seq & 1) * 256 + t) * 2] = rsqrtf((((q0[0] + q0[1]) + (q0[2] + q0[3])) + ((q1[0] + q1[1]) + (q1[2] + q1[3]))) * (1.0f / QL) + 1e-6f);
            tab[((seq & 1) * 256 + t) * 2 + 1] = rsqrtf(((k0[0] + k0[1]) + (k0[2] + k0[3])) * (1.0f / KVL) + 1e-6f);
        }
    }
};

__device__ __forceinline__ unsigned cvt_pk_bf16(float lo, float hi) { unsigned r; asm volatile("v_cvt_pk_bf16_f32 %0, %1, %2" : "=v"(r) : "v"(lo), "v"(hi)); return r; }
template <class Epi, class Sched, bool ALIGN_EPI = false, bool SP2 = false>
__device__ __forceinline__ void gemm_phase(PG8_LAS unsigned char* lds, const Gemm g, const Sched& S, const Epi& E) {
    const int tid = otid(), wid = __builtin_amdgcn_readfirstlane(tid >> 6), lane = tid & 63, wr = wid >> 2, wc = wid & 3, fr = lane & 15, fq = lane >> 4;
    const int K = g.K, nt = K / BK;
    unsigned voffA[2], voffB[2];
#pragma unroll
    for (int i = 0; i < 2; ++i) { int R, C; stage_rc(tid * 16 + i * 8192, R, C); const int Rb = Epi::PERM ? ((R & ~31) + perm32(R & 31)) : R;
        voffA[i] = (unsigned)(R * g.lda + C) * 2u; voffB[i] = (unsigned)(Rb * g.ldb + C) * 2u; }
    const size_t kstep = (size_t)(BK * 2);
    const size_t hstepA = (size_t)HALF * g.lda * 2, hstepB = (size_t)HALF * g.ldb * 2;
    const size_t tstepA = 2 * hstepA, tstepB = 2 * hstepB;
    const unsigned ldsw = (unsigned)wid * 1024u;
    const int aoff = lds_byte(wr * 64 + fr, fq * 8), boff = lds_byte(wc * 32 + fr, fq * 8);
#define PG8_SA(b, h) (((b) * 2 + (h)) * HTB)
#define PG8_SB(b, h) ((4 + (b) * 2 + (h)) * HTB)
#define PG8_STAGE(bufoff, gbase, voff) do { _Pragma("unroll") for (int _i = 0; _i < 2; ++_i) \
        __builtin_amdgcn_global_load_lds((const unsigned*)((const char*)(gbase) + (voff)[_i]), (PG8_LAS unsigned*)(lds + (bufoff) + ldsw + _i * 8192), 16, 0, 0); } while (0)
#define PG8_LDA(dst, b, h) do { _Pragma("unroll") for (int m = 0; m < 4; ++m) _Pragma("unroll") for (int k = 0; k < 2; ++k) dst[m][k] = *(const PG8_LAS bf16x8*)(lds + PG8_SA(b, h) + aoff + m * 2048 + k * 1024); } while (0)
#define PG8_LDB(dst, b, h) do { _Pragma("unroll") for (int n = 0; n < 2; ++n) _Pragma("unroll") for (int k = 0; k < 2; ++k) dst[n][k] = *(const PG8_LAS bf16x8*)(lds + PG8_SB(b, h) + boff + n * 2048 + k * 1024); } while (0)
#define PG8_MMA(ai, bj, At, Bt) do { __builtin_amdgcn_s_setprio(1); _Pragma("unroll") for (int m = 0; m < 4; ++m) _Pragma("unroll") for (int n = 0; n < 2; ++n) _Pragma("unroll") for (int k = 0; k < 2; ++k) \
        acc[ai][bj][m][n] = __builtin_amdgcn_mfma_f32_16x16x32_bf16(Bt[n][k], At[m][k], acc[ai][bj][m][n], 0, 0, 0); __builtin_amdgcn_s_setprio(0); } while (0)
#define PG8_WAIT_V(n) asm volatile("s_waitcnt vmcnt(" #n ")" ::: "memory")
#define PG8_WAIT_L(n) asm volatile("s_waitcnt lgkmcnt(" #n ")" ::: "memory")
#define PG8_BAR __builtin_amdgcn_s_barrier()
#define PG8_SCHED __builtin_amdgcn_sched_barrier(0)
    Unit cur, nxt; int ui = 0;
    if (!S.next(0, cur)) return;
    f32x4 acc[2][2][4][2];
#pragma unroll
    for (int a = 0; a < 2; ++a)
#pragma unroll
        for (int b = 0; b < 2; ++b)
#pragma unroll
            for (int m = 0; m < 4; ++m)
#pragma unroll
                for (int n = 0; n < 2; ++n) acc[a][b][m][n] = (f32x4){0.f, 0.f, 0.f, 0.f};
    bf16x8 At[4][2], B0[2][2], B1[2][2];
    const char* cA = (const char*)g.A + (size_t)cur.pm * tstepA + (cur.pn >= g.a_split_pn ? g.a_split_off : 0); const char* cB = (const char*)g.Bt + (size_t)cur.pn * tstepB;
    S.a_ready(cur, 0);
    if constexpr (SP2) {
        PG8_STAGE(PG8_SB(0, 0), cB, voffB); PG8_STAGE(PG8_SB(0, 1), cB + hstepB, voffB); PG8_STAGE(PG8_SA(0, 0), cA, voffA); PG8_STAGE(PG8_SA(0, 1), cA + hstepA, voffA);
        if (wr == 1) PG8_BAR;
        PG8_WAIT_V(2); PG8_BAR;
        PG8_STAGE(PG8_SB(1, 0), cB + kstep, voffB); PG8_STAGE(PG8_SA(1, 0), cA + kstep, voffA); PG8_STAGE(PG8_SB(1, 1), cB + hstepB + kstep, voffB);
        PG8_WAIT_V(6); PG8_BAR;
    } else {
        PG8_STAGE(PG8_SB(0, 0), cB, voffB); PG8_STAGE(PG8_SA(0, 0), cA, voffA); PG8_STAGE(PG8_SB(0, 1), cB + hstepB, voffB); PG8_STAGE(PG8_SA(0, 1), cA + hstepA, voffA);
        if (wr == 1) PG8_BAR;
        PG8_WAIT_V(4); PG8_BAR;
        PG8_STAGE(PG8_SB(1, 0), cB + kstep, voffB); PG8_STAGE(PG8_SA(1, 0), cA + kstep, voffA); PG8_STAGE(PG8_SB(1, 1), cB + hstepB + kstep, voffB);
        PG8_WAIT_V(6); PG8_BAR;
    }
    for (;;) {
        const bool has_next = S.next(ui + 1, nxt);
        const char* nA = has_next ? (const char*)g.A + (size_t)nxt.pm * tstepA + (nxt.pn >= g.a_split_pn ? g.a_split_off : 0) : cA; const char* nB = has_next ? (const char*)g.Bt + (size_t)nxt.pn * tstepB : cB;
        for (int t = 0; t < nt; t += 2) {
            const bool last = (t == nt - 2);
            const char* a1 = cA + (size_t)(t + 1) * kstep;
            const char* a2 = last ? nA : cA + (size_t)(t + 2) * kstep; const char* b2 = last ? nB : cB + (size_t)(t + 2) * kstep;
            const char* a3 = a2 + kstep; const char* b3 = b2 + kstep;
            if (last && has_next) S.a_ready(nxt, ui + 1);
            if constexpr (SP2) {
            PG8_LDB(B0, 0, 0); PG8_LDB(B1, 0, 1); PG8_SCHED; PG8_LDA(At, 0, 0); PG8_STAGE(PG8_SA(1, 1), a1 + hstepA, voffA);
            PG8_WAIT_V(8); PG8_WAIT_L(0); PG8_BAR; PG8_MMA(0, 0, At, B0); PG8_MMA(0, 1, At, B1); PG8_BAR; PG8_SCHED;
            PG8_LDA(At, 0, 1); PG8_STAGE(PG8_SB(0, 0), b2, voffB); PG8_STAGE(PG8_SB(0, 1), b2 + hstepB, voffB); PG8_STAGE(PG8_SA(0, 0), a2, voffA);
            PG8_WAIT_V(8); PG8_WAIT_L(0); PG8_BAR; PG8_MMA(1, 0, At, B0); PG8_MMA(1, 1, At, B1); PG8_BAR; PG8_SCHED;
            PG8_LDB(B0, 1, 0); PG8_LDB(B1, 1, 1); PG8_SCHED; PG8_LDA(At, 1, 0); PG8_STAGE(PG8_SA(0, 1), a2 + hstepA, voffA);
            PG8_WAIT_V(8); PG8_WAIT_L(0); PG8_BAR; PG8_MMA(0, 0, At, B0); PG8_MMA(0, 1, At, B1); PG8_BAR; PG8_SCHED;
            PG8_LDA(At, 1, 1); PG8_STAGE(PG8_SB(1, 0), b3, voffB); PG8_STAGE(PG8_SB(1, 1), b3 + hstepB, voffB); PG8_STAGE(PG8_SA(1, 0), a3, voffA);
            PG8_WAIT_V(8); PG8_WAIT_L(0); PG8_BAR; PG8_MMA(1, 0, At, B0); PG8_MMA(1, 1, At, B1); PG8_BAR; PG8_SCHED;
            } else {
            PG8_LDB(B0, 0, 0); PG8_SCHED; PG8_LDA(At, 0, 0); PG8_STAGE(PG8_SA(1, 1), a1 + hstepA, voffA);
            PG8_WAIT_L(8); PG8_BAR; PG8_WAIT_L(0); PG8_MMA(0, 0, At, B0); PG8_BAR; PG8_SCHED;
            PG8_LDB(B1, 0, 1); PG8_STAGE(PG8_SB(0, 0), b2, voffB);
            PG8_BAR; PG8_WAIT_L(0); PG8_MMA(0, 1, At, B1); PG8_BAR;
            PG8_LDA(At, 0, 1); PG8_STAGE(PG8_SA(0, 0), a2, voffA);
            PG8_BAR; PG8_WAIT_L(0); PG8_MMA(1, 0, At, B0); PG8_BAR; PG8_SCHED;
            PG8_STAGE(PG8_SB(0, 1), b2 + hstepB, voffB);
            PG8_WAIT_V(6); PG8_BAR; PG8_MMA(1, 1, At, B1); PG8_BAR;
            PG8_LDB(B0, 1, 0); PG8_SCHED; PG8_LDA(At, 1, 0); PG8_STAGE(PG8_SA(0, 1), a2 + hstepA, voffA);
            PG8_WAIT_L(8); PG8_BAR; PG8_WAIT_L(0); PG8_MMA(0, 0, At, B0); PG8_BAR; PG8_SCHED;
            PG8_LDB(B1, 1, 1); PG8_STAGE(PG8_SB(1, 0), b3, voffB);
            PG8_BAR; PG8_WAIT_L(0); PG8_MMA(0, 1, At, B1); PG8_BAR;
            PG8_LDA(At, 1, 1); PG8_STAGE(PG8_SA(1, 0), a3, voffA);
            PG8_BAR; PG8_WAIT_L(0); PG8_MMA(1, 0, At, B0); PG8_BAR; PG8_SCHED;
            PG8_STAGE(PG8_SB(1, 1), b3 + hstepB, voffB);
            PG8_WAIT_V(6); PG8_BAR; PG8_MMA(1, 1, At, B1); PG8_BAR;
            }
        }
        if constexpr (ALIGN_EPI) { if (wr == 0) PG8_BAR; }
        if constexpr (!Epi::AFTER_DRAIN) { E(acc, cur, wr, wc, fr, fq, ui); S.done(cur); }
        if (!has_next) break;
#pragma unroll
        for (int a = 0; a < 2; ++a)
#pragma unroll
            for (int b = 0; b < 2; ++b)
#pragma unroll
                for (int m = 0; m < 4; ++m)
#pragma unroll
                    for (int n = 0; n < 2; ++n) acc[a][b][m][n] = (f32x4){0.f, 0.f, 0.f, 0.f};
        cur = nxt; cA = nA; cB = nB; ++ui;
        if constexpr (ALIGN_EPI) { if (wr == 1) PG8_BAR; }
    }
    PG8_WAIT_V(0);
    if constexpr (!ALIGN_EPI) { if (wr == 0) PG8_BAR; }
    PG8_BAR;
    if constexpr (Epi::AFTER_DRAIN) { E.fused(acc, cur, wr, wc, fr, fq, lds, wid, lane); S.done(cur); }
#undef PG8_SA
#undef PG8_SB
#undef PG8_STAGE
#undef PG8_LDA
#undef PG8_LDB
#undef PG8_MMA
#undef PG8_WAIT_V
#undef PG8_WAIT_L
#undef PG8_BAR
#undef PG8_SCHED
}
}

namespace pg8 {
struct EpiProj {
    static constexpr bool PERM = true, AFTER_DRAIN = false;
    bf16_t* O; int ldc; int ncols; const PG8_LAS float* tab; float* sqq; float* sqkv; bf16_t* Kb; const float* rope; bf16_t* sav;
    __device__ __forceinline__ void operator()(const f32x4 (&acc)[2][2][4][2], const Unit& u, int wr, int wc, int fr, int fq, int seq) const {
        const int row0 = u.pm * BM + wr * 64 + fr, col0 = u.pn * BM + wc * 32 + 8 * fq;
        const int lane_hi = (fq >> 1);
#pragma unroll
        for (int ai = 0; ai < 2; ++ai)
#pragma unroll
            for (int m = 0; m < 4; ++m) {
                const int row = row0 + ai * HALF + m * 16;
                const float rs = tab[(seq & 1) * 256 + wr * 64 + fr + ai * HALF + m * 16];
                bf16_t* rowp = O + (size_t)row * ldc + col0;
#pragma unroll
                for (int bj = 0; bj < 2; ++bj) {
                    const f32x4 v0 = acc[ai][bj][m][0] * rs, v1 = acc[ai][bj][m][1] * rs;
                    u32x4 w; w.x = cvt_pk_bf16(v0[0], v0[1]); w.y = cvt_pk_bf16(v0[2], v0[3]); w.z = cvt_pk_bf16(v1[0], v1[1]); w.w = cvt_pk_bf16(v1[2], v1[3]);
                    const int col = col0 + bj * HALF;
                    if (col < ncols) *(u32x4*)(rowp + bj * HALF) = w;
                    if (u.pn <= 6 && m == 3 && fr == 15 && col < 1664) {
                        const int t = row & (SEQ - 1), cn = (t >> 6) + 1;
                        if (cn < 64) *(u32x4*)(sav + ((size_t)(row >> 12) * 64 + cn) * 1664 + col) = w;
                    }
                    const bool isq = (u.pn == 8 && bj == 1) || (u.pn == 9 && bj == 0), iskv = (u.pn == 9 && bj == 1);
                    if (isq || iskv) {
                        float ss = (v0[0] * v0[0] + v0[1] * v0[1]) + (v0[2] * v0[2] + v0[3] * v0[3]) + (v1[0] * v1[0] + v1[1] * v1[1]) + (v1[2] * v1[2] + v1[3] * v1[3]);
                        ss += shx<16>(ss); { float x, y; swap32(ss, x, y); ss = x + y; }
                        if (fq == 0) { if (iskv) sqkv[(size_t)row * 4 + wc] = ss; else sqq[(size_t)row * 8 + (u.pn == 8 ? 0 : 4) + wc] = ss; }
                    }
                    if (u.pn == 10 && bj == 0 && wc == 0) {
                        const int t = row & (SEQ - 1);
                        const float* rp = rope + ((size_t)t * 16 + 8 * (fq & 1)) * 2;
                        const f32x4 c0 = *(const f32x4*)rp, c1 = *(const f32x4*)(rp + 4), c2 = *(const f32x4*)(rp + 8), c3 = *(const f32x4*)(rp + 12);
                        const float cs[8] = {c0[0], c0[2], c1[0], c1[2], c2[0], c2[2], c3[0], c3[2]}, sn[8] = {c0[1], c0[3], c1[1], c1[3], c2[1], c2[3], c3[1], c3[3]};
                        const float own[8] = {v0[0], v0[1], v0[2], v0[3], v1[0], v1[1], v1[2], v1[3]};
                        float o[8];
#pragma unroll
                        for (int e = 0; e < 8; ++e) { float x, y; swap32(own[e], x, y); const float oth = lane_hi ? x : y;
                            o[e] = lane_hi ? (oth * sn[e] + own[e] * cs[e]) : (own[e] * cs[e] - oth * sn[e]); }
                        u32x4 kw; kw.x = cvt_pk_bf16(o[0], o[1]); kw.y = cvt_pk_bf16(o[2], o[3]); kw.z = cvt_pk_bf16(o[4], o[5]); kw.w = cvt_pk_bf16(o[6], o[7]);
#pragma unroll
                        for (int hh = 0; hh < 8; ++hh) *(u32x4*)(Kb + ((size_t)row * 8 + hh) * 96 + 64 + 8 * fq) = kw;
                    }
                }
                asm volatile("" ::: "memory");
            }
    }
};
struct EpiResid {
    static constexpr bool PERM = false, AFTER_DRAIN = false;
    int ldc; bool dry; bf16_t* HB; float* ssq;
    __device__ __forceinline__ void operator()(const f32x4 (&acc)[2][2][4][2], const Unit& u, int wr, int wc, int fr, int fq, int seq) const {
        const int row0 = u.pm * BM + wr * 64 + fr, col0 = u.pn * BM + wc * 32 + 4 * fq;
        typedef unsigned u32x2 __attribute__((ext_vector_type(2)));
#pragma unroll
        for (int ai = 0; ai < 2; ++ai) {
            u32x2 rv[4][2][2];
#pragma unroll
            for (int m = 0; m < 4; ++m)
#pragma unroll
                for (int bj = 0; bj < 2; ++bj)
#pragma unroll
                    for (int n = 0; n < 2; ++n) rv[m][bj][n] = *(const u32x2*)(HB + (size_t)(row0 + ai * HALF + m * 16) * ldc + col0 + bj * HALF + n * 16);
#pragma unroll
            for (int m = 0; m < 4; ++m) { const int row = row0 + ai * HALF + m * 16; const size_t off = (size_t)row * ldc + col0;
                float ss = 0.f;
#pragma unroll
                for (int bj = 0; bj < 2; ++bj)
#pragma unroll
                    for (int n = 0; n < 2; ++n) { const u32x2 r = rv[m][bj][n]; f32x4 o = acc[ai][bj][m][n];
                        o[0] += __uint_as_float(r.x << 16); o[1] += __uint_as_float(r.x & 0xffff0000u); o[2] += __uint_as_float(r.y << 16); o[3] += __uint_as_float(r.y & 0xffff0000u);
                        ss += (o[0] * o[0] + o[1] * o[1]) + (o[2] * o[2] + o[3] * o[3]);
                        u32x2 hb; hb.x = cvt_pk_bf16(o[0], o[1]); hb.y = cvt_pk_bf16(o[2], o[3]);
                        if (!dry) *(u32x2*)(HB + off + bj * HALF + n * 16) = hb; }
                ss += shx<16>(ss); { float x, y; swap32(ss, x, y); ss = x + y; }
                if (fq == 0 && !dry) ssq[(size_t)row * 16 + u.pn * 4 + wc] = ss;
            }
        }
    }
};
struct EpiMla {
    static constexpr bool PERM = false, AFTER_DRAIN = false;
    bf16_t* Q; bf16_t* K; bf16_t* V; const PG8_LAS float* tab; const float* rope; float c2; int pn0;
    __device__ __forceinline__ void operator()(const f32x4 (&acc)[2][2][4][2], const Unit& u, int wr, int wc, int fr, int fq, int seq) const {
        const int row0 = u.pm * BM + wr * 64 + fr;
        typedef unsigned u32x2 __attribute__((ext_vector_type(2)));
#pragma unroll
        for (int ai = 0; ai < 2; ++ai)
#pragma unroll
            for (int m = 0; m < 4; ++m) {
                const int row = row0 + ai * HALF + m * 16;
                const int rl = wr * 64 + fr + ai * HALF + m * 16;
                const float rq = tab[((seq & 1) * 256 + rl) * 2], rk = tab[((seq & 1) * 256 + rl) * 2 + 1];
#pragma unroll
                for (int bj = 0; bj < 2; ++bj) {
                    const int pn = u.pn + pn0; const int cg = pn * BM + bj * HALF + wc * 32;
                    f32x4 v0 = acc[ai][bj][m][0], v1 = acc[ai][bj][m][1];
                    if (pn < 3) {
                        v0 = v0 * rq; v1 = v1 * rq;
                        if (((cg >> 5) % 3) == 2) {
                            const int t = row & (SEQ - 1);
                            const f32x4 cs0 = *(const f32x4*)(rope + ((size_t)t * 16 + 4 * fq) * 2), cs1 = *(const f32x4*)(rope + ((size_t)t * 16 + 4 * fq) * 2 + 4);
                            const float c[4] = {cs0[0], cs0[2], cs1[0], cs1[2]}, sn[4] = {cs0[1], cs0[3], cs1[1], cs1[3]};
                            f32x4 o0, o1;
#pragma unroll
                            for (int j = 0; j < 4; ++j) { o0[j] = v0[j] * c[j] - v1[j] * sn[j]; o1[j] = v0[j] * sn[j] + v1[j] * c[j]; }
                            v0 = o0; v1 = o1;
                        }
                        v0 = v0 * c2; v1 = v1 * c2;
                        bf16_t* p = Q + (size_t)row * 768 + cg + 4 * fq;
                        u32x2 w0, w1; w0.x = cvt_pk_bf16(v0[0], v0[1]); w0.y = cvt_pk_bf16(v0[2], v0[3]); w1.x = cvt_pk_bf16(v1[0], v1[1]); w1.y = cvt_pk_bf16(v1[2], v1[3]);
                        *(u32x2*)p = w0; *(u32x2*)(p + 16) = w1;
                    } else {
                        v0 = v0 * rk; v1 = v1 * rk;
                        const int c = cg - 768, hh = c >> 7, d = (c & 127) + 4 * fq;
                        u32x2 w0, w1; w0.x = cvt_pk_bf16(v0[0], v0[1]); w0.y = cvt_pk_bf16(v0[2], v0[3]); w1.x = cvt_pk_bf16(v1[0], v1[1]); w1.y = cvt_pk_bf16(v1[2], v1[3]);
                        bf16_t* p = (d < 64) ? K + ((size_t)row * 8 + hh) * 96 + d : V + ((size_t)row * 8 + hh) * 64 + (d - 64);
                        *(u32x2*)p = w0; *(u32x2*)(p + 16) = w1;
                    }
                }
                asm volatile("" ::: "memory");
            }
    }
};
}

typedef float f32x4_t __attribute__((ext_vector_type(4)));
typedef unsigned u32x4_t __attribute__((ext_vector_type(4)));
template <class SRC4>
__device__ __forceinline__ void transpose_w(int K, int npad, bf16_t* WT, const SRC4& src4, float* lds) {
    const int tid = otid();
    const int tk = K / 64, tn = npad / 64;
    const int kk = tid >> 4, n4 = (tid & 15) * 4;
    const int nn = tid >> 3, k8 = (tid & 7) * 8;
    int par = 0;
    __syncthreads();
    for (int u = blockIdx.x; u < tk * tn; u += gridDim.x, par ^= 1) {
        const int k0 = (u % tk) * 64, n0 = (u / tk) * 64;
        float* tile = lds + par * (64 * 65);
        const f32x4_t v0 = src4(k0 + kk, n0 + n4), v1 = src4(k0 + kk + 32, n0 + n4);
#pragma unroll
        for (int e = 0; e < 4; ++e) { tile[kk * 65 + n4 + e] = v0[e]; tile[(kk + 32) * 65 + n4 + e] = v1[e]; }
        __syncthreads();
        u32x4_t w;
        w.x = f2bf2(tile[(k8 + 0) * 65 + nn], tile[(k8 + 1) * 65 + nn]); w.y = f2bf2(tile[(k8 + 2) * 65 + nn], tile[(k8 + 3) * 65 + nn]);
        w.z = f2bf2(tile[(k8 + 4) * 65 + nn], tile[(k8 + 5) * 65 + nn]); w.w = f2bf2(tile[(k8 + 6) * 65 + nn], tile[(k8 + 7) * 65 + nn]);
        *(u32x4_t*)(WT + (size_t)(n0 + nn) * K + k0 + k8) = w;
    }
}

template <class AL, class BL, class ST>
__device__ __forceinline__ void gemm_naive(int M, int N, int K, const AL& al, const BL& bl, const ST& st, float* lds) {
    float* As = lds;
    float* Bs = lds + 16 * 132;
    const int tid = otid(), ty = tid >> 4, tx = tid & 15;
    const int ntn = (N + 127) / 128, ntiles = (M / 128) * ntn;
    for (int u = blockIdx.x; u < ntiles; u += gridDim.x) {
        const int tm = u / ntn, tn = u % ntn;
        float acc[4][8];
#pragma unroll
        for (int i = 0; i < 4; ++i)
#pragma unroll
            for (int j = 0; j < 8; ++j) acc[i][j] = 0.f;
        for (int k0 = 0; k0 < K; k0 += 16) {
#pragma unroll
            for (int j = 0; j < 4; ++j) { const int idx = tid + j * 512, r = idx >> 4, k = idx & 15; As[k * 132 + r] = al(tm * 128 + r, k0 + k); }
#pragma unroll
            for (int j = 0; j < 4; ++j) { const int idx = tid + j * 512, k = idx >> 7, c = idx & 127; Bs[k * 132 + c] = bl(k0 + k, tn * 128 + c); }
            __syncthreads();
#pragma unroll 2
            for (int k = 0; k < 16; ++k) {
                const float4 a4 = *(const float4*)&As[k * 132 + ty * 4];
                const float4 b0 = *(const float4*)&Bs[k * 132 + tx * 8], b1 = *(const float4*)&Bs[k * 132 + tx * 8 + 4];
                const float av[4] = {a4.x, a4.y, a4.z, a4.w};
                const float bv[8] = {b0.x, b0.y, b0.z, b0.w, b1.x, b1.y, b1.z, b1.w};
#pragma unroll
                for (int i = 0; i < 4; ++i)
#pragma unroll
                    for (int j = 0; j < 8; ++j) acc[i][j] = fmaf(av[i], bv[j], acc[i][j]);
            }
            __syncthreads();
        }
#pragma unroll
        for (int i = 0; i < 4; ++i)
#pragma unroll
            for (int j = 0; j < 8; ++j) st(tm * 128 + ty * 4 + i, tn * 128 + tx * 8 + j, acc[i][j]);
    }
}

namespace rw {
typedef short bf16x8 __attribute__((ext_vector_type(8)));
typedef float f32x16 __attribute__((ext_vector_type(16)));
typedef float f32x4 __attribute__((ext_vector_type(4)));
typedef unsigned u32x2 __attribute__((ext_vector_type(2)));
typedef unsigned u32x4 __attribute__((ext_vector_type(4)));
constexpr int PB = 144, MB = 64 * PB;
constexpr int L_KKD = 0, L_RD = MB, L_BH = 2 * MB, L_KH = 3 * MB, L_BDT = 4 * MB, L_KDT = 5 * MB, L_VT = 6 * MB, L_KKDT = 7 * MB, L_BK = 8 * MB, L_WTT = 9 * MB, L_VTT = 10 * MB;
constexpr int L_AB = L_KKD, L_AK = L_BH, L_BB = L_KH, L_XWL = L_BK, L_XAL = L_WTT;
constexpr int L_F32 = 11 * MB;
constexpr int L_DEC = L_F32, L_AA = L_F32 + 17408, L_AKVT = L_F32, L_DIAG = L_F32 + 17408, L_TINV = L_DIAG + 4096;
constexpr int L_GC = L_F32 + 34816, L_SEG = L_GC + 256, L_END = L_SEG + 2048;
__device__ __forceinline__ int crow(int r, int hi) { return (r & 3) + 8 * (r >> 2) + 4 * hi; }
__device__ __forceinline__ unsigned pk2(float lo, float hi) { return f2bf2(lo, hi); }
#define RW_FRAG(base, row, ks) (*(const LAS bf16x8*)(shm + (base) + (row) * PB + (16 * (ks) + 8 * hi) * 2))
#define RW_MFMA(a, b, c) __builtin_amdgcn_mfma_f32_32x32x16_bf16(a, b, c, 0, 0, 0)

struct R1Raw { bf16_t q[5][9]; };
__device__ __forceinline__ void r1_load(R1Raw& r, const bf16_t* PROJ, const bf16_t* sava, int b, int h, int c, int tq, int lane) {
    const unsigned row0 = (unsigned)b * SEQ + (unsigned)c * 64;
    const __amdgpu_buffer_rsrc_t rs = __builtin_amdgcn_make_buffer_rsrc((void*)PROJ, 0, 0x7fffffff, 0x00020000);
    const int cols[5] = {C_R + h * 64 + lane, C_K + h * 64 + lane, C_V + h * 64 + lane, C_WL + lane, C_AL + lane};
    const unsigned rb = (unsigned)__builtin_amdgcn_readfirstlane((int)((row0 + (unsigned)tq) * (unsigned)(DIN * 2)));
    if (tq == 0) {
        const bf16_t* sav = sava + ((size_t)b * 64 + c) * 1664;
#pragma unroll
        for (int k = 0; k < 5; ++k) r.q[k][0] = (c > 0) ? sav[cols[k]] : (bf16_t)0;
    } else {
#pragma unroll
        for (int k = 0; k < 5; ++k) r.q[k][0] = (bf16_t)__builtin_amdgcn_raw_buffer_load_b16(rs, cols[k] * 2, rb - (unsigned)(DIN * 2), 0);
    }
#pragma unroll
    for (int k = 0; k < 5; ++k)
#pragma unroll
        for (int e = 0; e < 8; ++e) r.q[k][e + 1] = (bf16_t)__builtin_amdgcn_raw_buffer_load_b16(rs, cols[k] * 2, rb + (unsigned)(e * DIN * 2), 0);
}
__device__ __forceinline__ void r1_phase(int l, LAS char* shm, const bool dry = false) {
    const int tid0 = otid(), lane_o = tid0 & 63, r32o = lane_o & 31, hio = lane_o >> 5;
    const int wid = __builtin_amdgcn_readfirstlane(tid0 >> 6);
    bf16_t* PROJ = (bf16_t*)(ARG_WS + WS_PROJ);
    const bf16_t* sava = (const bf16_t*)(ARG_WS + WS_SAVA);
    const int h = blockIdx.x & 7, jw = blockIdx.x >> 3, nper = gridDim.x >> 3;
    const int ch = h * 64 + lane_o;
    const int tq = wid * 8;
    const float* mu = ARG(3) + (size_t)l * 1664;
    const float mu5[5] = {mu[C_R + ch], mu[C_K + ch], mu[C_V + ch], mu[C_WL + lane_o], mu[C_AL + lane_o]};
    const float kkc = (ARG(8) + (size_t)l * 512)[ch], kac = (ARG(9) + (size_t)l * 512)[ch], rkc = (ARG(10) + (size_t)l * 512)[ch];
    const int pB = wid >> 2, tlB = wid & 3, trB = 32 * (tlB >> 1), ncB = 32 * (tlB & 1);
    const float biasB = ((pB ? ARG(6) : ARG(4)) + (size_t)l * 512)[h * 64 + ncB + r32o];
    R1Raw cur, nxt;
    if (jw < 512) r1_load(cur, PROJ, sava, jw >> 6, h, jw & 63, tq, lane_o);
    for (int idx = jw; idx < 512; idx += nper) {
    const int tidl = otid(), lanel = tidl & 63, r32 = lanel & 31, hi = lanel >> 5;
    (void)hio;
    const int lane = lanel;
    const int b = idx >> 6, c = idx & 63;
    const size_t row0 = (size_t)b * SEQ + (size_t)c * 64;
    const int unit = (b * 8 + h) * 64 + c;
    float xr[8], xk[8];
    bf16x8 wfr[4];
    { const bf16_t* wt = (const bf16_t*)(ARG_WS + WS_W2T) + (size_t)pB * DEPTH * 512 * 64 + ((size_t)l * 512 + h * 64 + ncB + r32) * 64;
#pragma unroll
      for (int ks = 0; ks < 4; ++ks) wfr[ks] = *(const bf16x8*)(wt + 16 * ks + 8 * hi); }
    __syncthreads();
    PAMP_BEGIN(31);
    {
        auto lerp = [&](int k, float (&x)[8]) {
            const float m = mu5[k]; float prv = bf2f(cur.q[k][0]);
#pragma unroll
            for (int e = 0; e < 8; ++e) { const float cv = bf2f(cur.q[k][e + 1]); x[e] = cv + m * (prv - cv); prv = cv; }
        };
        float xv[8], xw[8], xa[8];
        lerp(0, xr); lerp(1, xk); lerp(2, xv); lerp(3, xw); lerp(4, xa);
        u32x4 vv; vv.x = pk2(xv[0], xv[1]); vv.y = pk2(xv[2], xv[3]); vv.z = pk2(xv[4], xv[5]); vv.w = pk2(xv[6], xv[7]);
        *(LAS u32x4*)(shm + L_VT + lane * PB + tq * 2) = vv;
#pragma unroll
        for (int e = 0; e < 8; ++e) {
            *(LAS bf16_t*)(shm + L_XWL + (tq + e) * PB + lane * 2) = f2bf(ftanh(xw[e]));
            *(LAS bf16_t*)(shm + L_XAL + (tq + e) * PB + lane * 2) = f2bf(xa[e]);
        }
    }
    __syncthreads();
    {
        const int p = pB, tr = trB, nc = ncB;
        f32x16 acc;
#pragma unroll
        for (int r = 0; r < 16; ++r) acc[r] = biasB;
        const int xb = p ? L_XAL : L_XWL;
#pragma unroll
        for (int ks = 0; ks < 4; ++ks) acc = RW_MFMA(RW_FRAG(xb, tr + r32, ks), wfr[ks], acc);
        LAS float* dst = (LAS float*)(shm + (p ? L_AA : L_DEC));
#pragma unroll
        for (int r = 0; r < 16; ++r) dst[(tr + crow(r, hi)) * 68 + nc + r32] = acc[r];
    }
    __syncthreads();
    PAMP_END(31);
    PAMP_BEGIN(32);
    {
        float* bon = (float*)(ARG_WS + WS_BON);
        float kkn[8], kpv[8], bbv[8], ld[8], lg[8];
        float run = 0.f;
        LAS float* zb = (LAS float*)(shm + L_KKDT) + wid * (16 * 64 + 16);
#pragma unroll
        for (int e = 0; e < 8; ++e) {
            const float dec = ((const LAS float*)(shm + L_DEC))[(tq + e) * 68 + lane], aav = ((const LAS float*)(shm + L_AA))[(tq + e) * 68 + lane];
            ld[e] = -0.6065306597126334f * sigmoidf_(dec);
            const float av = sigmoidf_(aav);
            const float kkr = xk[e] * kkc;
            kkn[e] = kkr; bbv[e] = kkr * av;
            kpv[e] = xk[e] * (1.0f + (av - 1.0f) * kac);
            zb[e * 64 + lane] = kkr * kkr;
            zb[(8 + e) * 64 + lane] = xr[e] * kpv[e] * rkc;
            run += ld[e]; lg[e] = run;
        }
        {
            const LAS f32x4* zp = (const LAS f32x4*)(zb + (lane >> 2) * 64 + (lane & 3) * 16);
            const f32x4 z0 = zp[0], z1 = zp[1], z2 = zp[2], z3 = zp[3];
            float tsum = (((z0[0] + z0[1]) + (z0[2] + z0[3])) + ((z1[0] + z1[1]) + (z1[2] + z1[3]))) + (((z2[0] + z2[1]) + (z2[2] + z2[3])) + ((z3[0] + z3[1]) + (z3[2] + z3[3])));
            tsum += dppx<0xB1>(tsum); tsum += dppx<0x4E>(tsum);
            if ((lane & 3) == 0) zb[16 * 64 + (lane >> 2)] = tsum;
            const f32x4 n0 = *(const LAS f32x4*)(zb + 16 * 64), n1 = *(const LAS f32x4*)(zb + 16 * 64 + 4);
            const float n2[8] = {n0[0], n0[1], n0[2], n0[3], n1[0], n1[1], n1[2], n1[3]};
#pragma unroll
            for (int e = 0; e < 8; ++e) { const float rn = __builtin_amdgcn_rsqf(fmaxf(n2[e], 1e-24f)); kkn[e] *= rn; bbv[e] *= rn; }
            if (lane < 8 && !dry) bon[(row0 + tq + lane) * 8 + h] = zb[16 * 64 + 8 + lane];
        }
        ((LAS float*)(shm + L_SEG))[wid * 64 + lane] = run;
        __syncthreads();
        float off = 0.f, tot = 0.f;
#pragma unroll
        for (int w = 0; w < 8; ++w) { const float sgm = ((const LAS float*)(shm + L_SEG))[w * 64 + lane]; tot += sgm; if (w < wid) off += sgm; }
        const float gct = fexp(tot);
        if (wid == 0) ((LAS float*)(shm + L_GC))[lane] = gct;
        float tb[8], tk[8], tkk[8];
        float gprev = fexp(off);
#pragma unroll
        for (int e = 0; e < 8; ++e) {
            const float L = off + lg[e];
            const float g = fexp(L), gp = gprev, ig = frcp(g), ge = gct * ig;
            gprev = g;
            const int t = tq + e;
            const float kkd = kkn[e] * gp;
            *(LAS bf16_t*)(shm + L_KKD + t * PB + lane * 2) = f2bf(kkd);
            *(LAS bf16_t*)(shm + L_RD + t * PB + lane * 2) = f2bf(xr[e] * g);
            *(LAS bf16_t*)(shm + L_BH + t * PB + lane * 2) = f2bf(bbv[e] * ig);
            *(LAS bf16_t*)(shm + L_KH + t * PB + lane * 2) = f2bf(kpv[e] * ig);
            tb[e] = bbv[e] * ge; tk[e] = kpv[e] * ge; tkk[e] = kkd;
        }
        u32x4 v;
        v.x = pk2(tb[0], tb[1]); v.y = pk2(tb[2], tb[3]); v.z = pk2(tb[4], tb[5]); v.w = pk2(tb[6], tb[7]); *(LAS u32x4*)(shm + L_BDT + lane * PB + tq * 2) = v;
        v.x = pk2(tk[0], tk[1]); v.y = pk2(tk[2], tk[3]); v.z = pk2(tk[4], tk[5]); v.w = pk2(tk[6], tk[7]); *(LAS u32x4*)(shm + L_KDT + lane * PB + tq * 2) = v;
        v.x = pk2(tkk[0], tkk[1]); v.y = pk2(tkk[2], tkk[3]); v.z = pk2(tkk[4], tkk[5]); v.w = pk2(tkk[6], tkk[7]); *(LAS u32x4*)(shm + L_KKDT + lane * PB + tq * 2) = v;
    }
    __syncthreads();
    PAMP_END(32);
    PAMP_BEGIN(33);
    {
        const int mat = wid & 3;
        const int ab = (mat < 2) ? L_KKD : L_RD, bb = (mat & 1) ? L_KH : L_BH;
        const int ob = (mat == 0) ? L_AB : (mat == 1) ? L_AK : (mat == 2) ? L_BB : L_BK;
        f32x16 acc0, acc1;
#pragma unroll
        for (int r = 0; r < 16; ++r) { acc0[r] = 0.f; acc1[r] = 0.f; }
        if (wid < 4) {
#pragma unroll
            for (int ks = 0; ks < 4; ++ks) { acc0 = RW_MFMA(RW_FRAG(ab, r32, ks), RW_FRAG(bb, r32, ks), acc0); acc1 = RW_MFMA(RW_FRAG(ab, 32 + r32, ks), RW_FRAG(bb, 32 + r32, ks), acc1); }
        } else {
#pragma unroll
            for (int ks = 0; ks < 4; ++ks) acc0 = RW_MFMA(RW_FRAG(ab, 32 + r32, ks), RW_FRAG(bb, r32, ks), acc0);
        }
        __syncthreads();
        if (wid < 4) {
            const int lim = (mat < 2) ? 1 : 0;
            LAS char* o0 = shm + ob + (4 * hi) * PB + r32 * 2; LAS char* o1 = shm + ob + (32 + 4 * hi) * PB + (32 + r32) * 2;
#pragma unroll
            for (int r = 0; r < 16; ++r) {
                const int tl_ = (r & 3) + 8 * (r >> 2);
                const bool keep = (tl_ + 4 * hi) >= (r32 + lim);
                acc0[r] = keep ? acc0[r] : 0.f; acc1[r] = keep ? acc1[r] : 0.f;
                *(LAS bf16_t*)(o0 + tl_ * PB) = f2bf(acc0[r]);
                *(LAS bf16_t*)(o1 + tl_ * PB) = f2bf(acc1[r]);
            }
            if (mat == 0) {
                const int bsel = r32 >> 4;
                LAS float* dg = (LAS float*)(shm + L_DIAG) + (r32 & 15);
#pragma unroll
                for (int rr = 0; rr < 8; ++rr) {
                    const int t16 = (rr & 3) + 8 * (rr >> 2) + 4 * hi;
                    const float v0 = bsel ? acc0[rr + 8] : acc0[rr], v1 = bsel ? acc1[rr + 8] : acc1[rr];
                    dg[(bsel) * 256 + t16 * 16] = v0; dg[(2 + bsel) * 256 + t16 * 16] = v1;
                }
            }
        } else {
            LAS char* o0 = shm + ob + (32 + 4 * hi) * PB + r32 * 2;
#pragma unroll
            for (int r = 0; r < 16; ++r) *(LAS bf16_t*)(o0 + ((r & 3) + 8 * (r >> 2)) * PB) = f2bf(acc0[r]);
        }
    }
    __syncthreads();
    PAMP_END(33);
    PAMP_BEGIN(34);
    if (wid >= 4) {
        const int tl = wid - 4, tr = 32 * (tl >> 1), ic = 32 * (tl & 1);
        f32x16 acc;
#pragma unroll
        for (int r = 0; r < 16; ++r) acc[r] = 0.f;
#pragma unroll
        for (int ks = 0; ks < 4; ++ks) if (tr > 0 || ks < 2) acc = RW_MFMA(RW_FRAG(L_AK, tr + r32, ks), RW_FRAG(L_VT, ic + r32, ks), acc);
        LAS float* dst = (LAS float*)(shm + L_AKVT) + (ic + r32) * 68;
#pragma unroll
        for (int g = 0; g < 4; ++g) *(LAS f32x4*)(dst + tr + 8 * g + 4 * hi) = (f32x4){acc[4 * g], acc[4 * g + 1], acc[4 * g + 2], acc[4 * g + 3]};
    } else if (wid == 0) {
        const int blk = lane >> 4, n = lane & 15;
        const LAS float* N = (const LAS float*)(shm + L_DIAG) + blk * 256;
        float m[16];
#pragma unroll
        for (int t = 0; t < 16; ++t) {
            float a = (t == n) ? 1.f : 0.f;
#pragma unroll
            for (int s = 0; s < t; ++s) a = fmaf(-N[t * 16 + s], m[s], a);
            m[t] = a;
            *(LAS bf16_t*)(shm + L_TINV + (blk * 256 + t * 16 + n) * 2) = f2bf(a);
        }
    }
    __syncthreads();
    if (idx + nper < 512) r1_load(nxt, PROJ, sava, (idx + nper) >> 6, h, (idx + nper) & 63, tq, lane);
    {
        const int n = lane & 15, q = lane >> 4;
        typedef float f32x4v __attribute__((ext_vector_type(4)));
        const int col = 16 * (wid & 3) + n;
        u32x2 xn[4];
#pragma unroll
        for (int blk = 0; blk < 4; ++blk) {
            f32x4v acc;
            if (wid < 4) { const u32x2 rv = *(const LAS u32x2*)(shm + L_KKDT + col * PB + (16 * blk + 4 * q) * 2);
                acc[0] = bf2f((bf16_t)(rv.x & 0xffffu)); acc[1] = bf2f((bf16_t)(rv.x >> 16)); acc[2] = bf2f((bf16_t)(rv.y & 0xffffu)); acc[3] = bf2f((bf16_t)(rv.y >> 16)); }
            else acc = *(const LAS f32x4v*)((const LAS float*)(shm + L_AKVT) + col * 68 + 16 * blk + 4 * q);
#pragma unroll
            for (int a = 0; a < blk; a += 2) {
                const u32x2 a0 = *(const LAS u32x2*)(shm + L_AB + (16 * blk + n) * PB + (16 * a + 4 * q) * 2);
                const bool two = (a + 1 < blk);
                u32x2 a1 = {0u, 0u}, b1 = {0u, 0u};
                if (two) { a1 = *(const LAS u32x2*)(shm + L_AB + (16 * blk + n) * PB + (16 * (a + 1) + 4 * q) * 2); b1 = xn[a + 1]; }
                const u32x4 af = {a0.x, a0.y, a1.x, a1.y}, bf = {xn[a].x, xn[a].y, b1.x, b1.y};
                acc = __builtin_amdgcn_mfma_f32_16x16x32_bf16(__builtin_bit_cast(bf16x8, af), __builtin_bit_cast(bf16x8, bf), acc, 0, 0, 0);
            }
            const u32x2 ti = *(const LAS u32x2*)(shm + L_TINV + (blk * 256 + n * 16 + 4 * q) * 2);
            const u32x4 af = {ti.x, ti.y, 0u, 0u}, bf = {pk2(acc[0], acc[1]), pk2(acc[2], acc[3]), 0u, 0u};
            f32x4v x = {0.f, 0.f, 0.f, 0.f};
            x = __builtin_amdgcn_mfma_f32_16x16x32_bf16(__builtin_bit_cast(bf16x8, af), __builtin_bit_cast(bf16x8, bf), x, 0, 0, 0);
            xn[blk].x = pk2(-x[0], -x[1]); xn[blk].y = pk2(-x[2], -x[3]);
            *(LAS u32x2*)(shm + ((wid < 4) ? L_WTT : L_VTT) + col * PB + (16 * blk + 4 * q) * 2) = xn[blk];
        }
    }
    __syncthreads();
    PAMP_END(34);
    PAMP_BEGIN(35);
    {
        const int tl = wid & 3, tr = 32 * (tl >> 1), cc = 32 * (tl & 1);
        f32x16 a0, a1;
        if (wid < 4) {
#pragma unroll
            for (int r = 0; r < 16; ++r) { a0[r] = bf2f(*(const LAS bf16_t*)(shm + L_RD + (tr + crow(r, hi)) * PB + (cc + r32) * 2)); a1[r] = 0.f; }
#pragma unroll
            for (int ks = 0; ks < 4; ++ks) if (tr > 0 || ks < 2) {
                const bf16x8 bbf = RW_FRAG(L_BB, tr + r32, ks);
                a0 = RW_MFMA(bbf, RW_FRAG(L_WTT, cc + r32, ks), a0);
                a1 = RW_MFMA(RW_FRAG(L_BK, tr + r32, ks), RW_FRAG(L_VT, cc + r32, ks), a1);
                a1 = RW_MFMA(bbf, RW_FRAG(L_VTT, cc + r32, ks), a1);
            }
            {
                const __amdgpu_buffer_rsrc_t rs = __builtin_amdgcn_make_buffer_rsrc((void*)PROJ, 0, 0x7fffffff, 0x00020000);
                const int vo = (4 * hi) * (DIN * 2) + (h * 64 + cc + r32) * 2;
                const unsigned so = (unsigned)__builtin_amdgcn_readfirstlane((int)((unsigned)(row0 + tr) * (unsigned)(DIN * 2)));
#pragma unroll
                for (int r = 0; r < 16; ++r) if (!dry) {
                    const unsigned sr = so + (unsigned)(((r & 3) + 8 * (r >> 2)) * (DIN * 2));
                    __builtin_amdgcn_raw_buffer_store_b16((short)f2bf(a0[r]), rs, vo + C_K * 2, sr, 0);
                    __builtin_amdgcn_raw_buffer_store_b16((short)f2bf(a1[r]), rs, vo + C_R * 2, sr, 0);
                }
            }
        } else {
#pragma unroll
            for (int r = 0; r < 16; ++r) { a0[r] = 0.f; a1[r] = 0.f; }
#pragma unroll
            for (int ks = 0; ks < 4; ++ks) {
                const bf16x8 bdf = RW_FRAG(L_BDT, tr + r32, ks);
                a0 = RW_MFMA(bdf, RW_FRAG(L_WTT, cc + r32, ks), a0);
                a1 = RW_MFMA(RW_FRAG(L_KDT, tr + r32, ks), RW_FRAG(L_VT, cc + r32, ks), a1);
                a1 = RW_MFMA(bdf, RW_FRAG(L_VTT, cc + r32, ks), a1);
            }
            bf16_t* Pm = (bf16_t*)(DO_RWP) + (size_t)unit * 4096;
            bf16_t* Dt = (bf16_t*)(ARG_WS + WS_RWD) + (size_t)unit * 4096;
            const float gc = ((const LAS float*)(shm + L_GC))[cc + r32];
#pragma unroll
            for (int r = 0; r < 16; ++r) { const int jr = tr + crow(r, hi), jc = cc + r32; if (!dry) Pm[jr * 64 + jc] = f2bf(a0[r] + ((jr == jc) ? gc : 0.f)); }
#pragma unroll
            for (int g = 0; g < 4; ++g) { u32x2 w; w.x = pk2(a1[4 * g], a1[4 * g + 1]); w.y = pk2(a1[4 * g + 2], a1[4 * g + 3]); if (!dry) *(u32x2*)(Dt + (cc + r32) * 64 + tr + 8 * g + 4 * hi) = w; }
        }
        const u32x4 vv = *(const LAS u32x4*)(shm + L_VT + lane * PB + tq * 2);
        if (!dry) {
            const __amdgpu_buffer_rsrc_t rs = __builtin_amdgcn_make_buffer_rsrc((void*)PROJ, 0, 0x7fffffff, 0x00020000);
            const int vo = (C_V + ch) * 2;
            const unsigned so = (unsigned)__builtin_amdgcn_readfirstlane((int)((unsigned)(row0 + tq) * (unsigned)(DIN * 2)));
            const unsigned wv[4] = {vv.x, vv.y, vv.z, vv.w};
#pragma unroll
            for (int e = 0; e < 8; ++e) __builtin_amdgcn_raw_buffer_store_b16((short)((e & 1) ? (wv[e >> 1] >> 16) : (wv[e >> 1] & 0xffffu)), rs, vo, so + (unsigned)(e * DIN * 2), 0);
        }
    }
    PAMP_END(35);
    cur = nxt;
    }
}

__device__ __forceinline__ void r2_unit(int l, int b, int h, LAS char* shm, const bool dry = false) {
    const int tid = otid(), lane = tid & 63, n = lane & 15, q = lane >> 4;
    const int wid = __builtin_amdgcn_readfirstlane(tid >> 6);
    typedef float f32x4v __attribute__((ext_vector_type(4)));
    bf16_t* PROJ = (bf16_t*)(ARG_WS + WS_PROJ);
    const bf16_t* Pm = (const bf16_t*)(DO_RWP) + (size_t)((b * 8 + h) * 64) * 4096;
    const bf16_t* Dt = (const bf16_t*)(ARG_WS + WS_RWD) + (size_t)((b * 8 + h) * 64) * 4096;
    constexpr int TPB = 144, TBUF = 64 * TPB;
    __syncthreads();
    for (int i = tid; i < 2 * TBUF / 4; i += 512) ((LAS unsigned*)shm)[i] = 0u;
    __syncthreads();
    const size_t rowb = (size_t)b * SEQ;
    if (wid < 4) {
        bf16x8 pa[2]; u32x2 dv[4];
        auto ldop = [&](int c) { const bf16_t* pp = Pm + (size_t)c * 4096 + (16 * wid + n) * 64 + 8 * q; pa[0] = *(const bf16x8*)pp; pa[1] = *(const bf16x8*)(pp + 32);
#pragma unroll
                                 for (int cg = 0; cg < 4; ++cg) dv[cg] = *(const u32x2*)(Dt + (size_t)c * 4096 + (16 * cg + n) * 64 + 16 * wid + 4 * q); };
        ldop(0);
        for (int c = 0; c < 64; ++c) {
            const bf16x8 a0 = pa[0], a1 = pa[1]; u32x2 d[4];
#pragma unroll
            for (int cg = 0; cg < 4; ++cg) d[cg] = dv[cg];
            if (c + 1 < 64) ldop(c + 1);
            const LAS char* tb = shm + (c & 1) * TBUF + n * TPB + 8 * q * 2;
            LAS char* tw_ = shm + ((c + 1) & 1) * TBUF + n * TPB + (16 * wid + 4 * q) * 2;
#pragma unroll
            for (int cg = 0; cg < 4; ++cg) {
                const bf16x8 t0 = *(const LAS bf16x8*)(tb + cg * 16 * TPB), t1 = *(const LAS bf16x8*)(tb + cg * 16 * TPB + 64);
                f32x4v acc = {bf2f((bf16_t)(d[cg].x & 0xffffu)), bf2f((bf16_t)(d[cg].x >> 16)), bf2f((bf16_t)(d[cg].y & 0xffffu)), bf2f((bf16_t)(d[cg].y >> 16))};
                acc = __builtin_amdgcn_mfma_f32_16x16x32_bf16(a0, t0, acc, 0, 0, 0);
                acc = __builtin_amdgcn_mfma_f32_16x16x32_bf16(a1, t1, acc, 0, 0, 0);
                u32x2 w; w.x = rw::pk2(acc[0], acc[1]); w.y = rw::pk2(acc[2], acc[3]);
                *(LAS u32x2*)(tw_ + cg * 16 * TPB) = w;
            }
            __syncthreads();
        }
    } else {
        const int tw = wid - 4;
        const float* lng = ARG(11) + (size_t)l * 512 + h * 64; const float* lnb = ARG(12) + (size_t)l * 512 + h * 64; const float* bon = (const float*)(ARG_WS + WS_BON);
        float gg[4][4], gb[4][4];
#pragma unroll
        for (int cg = 0; cg < 4; ++cg) { const f32x4v a4 = *(const f32x4v*)(lng + 16 * cg + 4 * q), b4 = *(const f32x4v*)(lnb + 16 * cg + 4 * q);
#pragma unroll
            for (int e = 0; e < 4; ++e) { gg[cg][e] = a4[e]; gb[cg][e] = b4[e]; } }
        bf16x8 rb[2]; u32x2 yv[4], vv[4], zv[4]; float bv;
        auto ldop = [&](int c) { const size_t row = rowb + (size_t)c * 64 + 16 * tw + n; const bf16_t* rp = PROJ + row * DIN + h * 64; rb[0] = *(const bf16x8*)(rp + C_K + 8 * q); rb[1] = *(const bf16x8*)(rp + C_K + 8 * q + 32);
                                 bv = bon[row * 8 + h];
#pragma unroll
                                 for (int cg = 0; cg < 4; ++cg) { yv[cg] = *(const u32x2*)(rp + C_R + 16 * cg + 4 * q); vv[cg] = *(const u32x2*)(rp + C_V + 16 * cg + 4 * q); zv[cg] = *(const u32x2*)(rp + C_ZA + 16 * cg + 4 * q); } };
        ldop(0);
        for (int c = 0; c < 64; ++c) {
            const bf16x8 b0 = rb[0], b1 = rb[1]; u32x2 y0[4], v0[4], z0[4]; const float bo = bv;
#pragma unroll
            for (int cg = 0; cg < 4; ++cg) { y0[cg] = yv[cg]; v0[cg] = vv[cg]; z0[cg] = zv[cg]; }
            if (c + 1 < 64) ldop(c + 1);
            const LAS char* tb = shm + (c & 1) * TBUF + n * TPB + 8 * q * 2;
            bf16_t* yp = PROJ + (rowb + (size_t)c * 64 + 16 * tw + n) * DIN + C_ZA + h * 64 + 4 * q;
            f32x4v acc[4];
#pragma unroll
            for (int cg = 0; cg < 4; ++cg) {
                const bf16x8 t0 = *(const LAS bf16x8*)(tb + cg * 16 * TPB), t1 = *(const LAS bf16x8*)(tb + cg * 16 * TPB + 64);
                acc[cg] = (f32x4v){bf2f((bf16_t)(y0[cg].x & 0xffffu)), bf2f((bf16_t)(y0[cg].x >> 16)), bf2f((bf16_t)(y0[cg].y & 0xffffu)), bf2f((bf16_t)(y0[cg].y >> 16))};
                acc[cg] = __builtin_amdgcn_mfma_f32_16x16x32_bf16(t0, b0, acc[cg], 0, 0, 0);
                acc[cg] = __builtin_amdgcn_mfma_f32_16x16x32_bf16(t1, b1, acc[cg], 0, 0, 0);
            }
            float sm = 0.f;
#pragma unroll
            for (int cg = 0; cg < 4; ++cg) sm += (acc[cg][0] + acc[cg][1]) + (acc[cg][2] + acc[cg][3]);
            sm += shx<16>(sm); { float x, y; swap32(sm, x, y); sm = x + y; }
            const float mean = sm * (1.0f / 64.0f);
            float sv = 0.f;
#pragma unroll
            for (int cg = 0; cg < 4; ++cg) { acc[cg] = acc[cg] - mean; sv += (acc[cg][0] * acc[cg][0] + acc[cg][1] * acc[cg][1]) + (acc[cg][2] * acc[cg][2] + acc[cg][3] * acc[cg][3]); }
            sv += shx<16>(sv); { float x, y; swap32(sv, x, y); sv = x + y; }
            const float rstd = rsqrtf(sv * (1.0f / 64.0f) + 64e-5f);
#pragma unroll
            for (int cg = 0; cg < 4; ++cg) {
                const float ve[4] = {bf2f((bf16_t)(v0[cg].x & 0xffffu)), bf2f((bf16_t)(v0[cg].x >> 16)), bf2f((bf16_t)(v0[cg].y & 0xffffu)), bf2f((bf16_t)(v0[cg].y >> 16))};
                const float ze[4] = {bf2f((bf16_t)(z0[cg].x & 0xffffu)), bf2f((bf16_t)(z0[cg].x >> 16)), bf2f((bf16_t)(z0[cg].y & 0xffffu)), bf2f((bf16_t)(z0[cg].y >> 16))};
                float o[4];
#pragma unroll
                for (int e = 0; e < 4; ++e) o[e] = (acc[cg][e] * rstd * gg[cg][e] + gb[cg][e] + bo * ve[e]) * siluf_(ze[e]);
                u32x2 w; w.x = rw::pk2(o[0], o[1]); w.y = rw::pk2(o[2], o[3]);
                if (!dry) *(u32x2*)(yp + 16 * cg) = w;
            }
            __syncthreads();
        }
    }
}
#undef RW_FRAG
#undef RW_MFMA
}

namespace lru {
typedef short bf16x8 __attribute__((ext_vector_type(8)));
typedef float f32x16 __attribute__((ext_vector_type(16)));
constexpr int TC = 32, XPITCH = 1040, LDS_XC = 0, LDS_OMA = 33280, LDS_BX = LDS_OMA + 32768, LDS_BYTES = LDS_BX + 32768;
__device__ __forceinline__ int crow(int r, int hi) { return (r & 3) + 8 * (r >> 2) + 4 * hi; }
__device__ __forceinline__ void carry_unit(int b, unsigned* cnt) {
    const int tid = otid();
    float2* sp = (float2*)(ARG_WS + WS_LSUM) + ((size_t)b * 128) * 512 + tid;
    float h = 0.f;
    for (int c0 = 0; c0 < 128; c0 += 16) {
        float2 ah[16];
#pragma unroll
        for (int k = 0; k < 16; ++k) ah[k] = sp[(size_t)(c0 + k) * 512];
#pragma unroll
        for (int k = 0; k < 16; ++k) { __hip_atomic_store(&sp[(size_t)(c0 + k) * 512].x, h, __ATOMIC_RELAXED, __HIP_MEMORY_SCOPE_AGENT); h = fmaf(ah[k].x, h, ah[k].y); }
    }
    asm volatile("s_waitcnt vmcnt(0)" ::: "memory");
    __syncthreads();
    if (threadIdx.x == 0) (void)xb_add(cnt, 1u);
}
constexpr int W_XC = 0, W_OMA = 4608, W_BX = 4608 + 4096, W_LDS = 4608 + 2 * 4096, L_PART = 8 * W_LDS;
template <bool FINAL>
__device__ __forceinline__ void phase(int l, LAS char* shm0, unsigned* cnt, const bool dry = false) {
    typedef unsigned u32x4 __attribute__((ext_vector_type(4)));
    typedef float f32x4 __attribute__((ext_vector_type(4)));
    const int tid0 = otid(), lane0 = tid0 & 63;
    const int hh = __builtin_amdgcn_readfirstlane(tid0 >> 6);
    bf16_t* PROJ = (bf16_t*)(ARG_WS + WS_PROJ);
    LAS char* shm = shm0 + hh * W_LDS;
    const int co0 = lane0 & 7, tg0 = lane0 >> 3;
    auto ldraw = [&](u32x4 (&raw)[7], int u) { const int b = u >> 7, t0 = (u & 127) * TC;
#pragma unroll
        for (int k = 0; k < 7; ++k) { const int t = t0 + 4 * tg0 - 3 + k; raw[k] = (t >= 0) ? *(const u32x4*)(PROJ + ((size_t)b * SEQ + t) * DIN + C_UB + hh * 64 + 8 * co0) : (u32x4){0u, 0u, 0u, 0u}; } };
    u32x4 raw[7], rawn[7];
    int parity = 0;
    if ((int)blockIdx.x < 1024) ldraw(raw, blockIdx.x);
    __syncthreads();
    for (int u = blockIdx.x; u < 1024; u += gridDim.x, parity ^= 1) {
        const int tid = otid(), lane = tid & 63, r32 = lane & 31, hi = lane >> 5, co = lane & 7, tg = lane >> 3;
        const int b = u >> 7, c = u & 127;
        const size_t row0 = (size_t)b * SEQ + (size_t)c * TC;
        const bf16_t* gat = (const bf16_t*)(ARG_WS + WS_GAT) + ((size_t)(l * 8 + hh) * 64) * 64;
        const bf16_t* gxt = gat + (size_t)DEPTH * 8 * 64 * 64;
        bf16x8 wr_[2][4], wi_[2][4];
#pragma unroll
        for (int nt = 0; nt < 2; ++nt)
#pragma unroll
            for (int ks = 0; ks < 4; ++ks) { wr_[nt][ks] = *(const bf16x8*)(gat + (size_t)(32 * nt + r32) * 64 + 16 * ks + 8 * hi); wi_[nt][ks] = *(const bf16x8*)(gxt + (size_t)(32 * nt + r32) * 64 + 16 * ks + 8 * hi); }
        {
            const float* conv_w = ARG(13) + (size_t)l * 4 * 512 + hh * 64 + 8 * co; const float* conv_b = ARG(14) + (size_t)l * 512 + hh * 64 + 8 * co;
            float cw[4][8], cb[8];
#pragma unroll
            for (int q = 0; q < 4; ++q) { const f32x4 a = *(const f32x4*)(conv_w + q * 512), bq = *(const f32x4*)(conv_w + q * 512 + 4);
                cw[q][0] = a[0]; cw[q][1] = a[1]; cw[q][2] = a[2]; cw[q][3] = a[3]; cw[q][4] = bq[0]; cw[q][5] = bq[1]; cw[q][6] = bq[2]; cw[q][7] = bq[3]; }
            { const f32x4 a = *(const f32x4*)conv_b, bq = *(const f32x4*)(conv_b + 4); cb[0] = a[0]; cb[1] = a[1]; cb[2] = a[2]; cb[3] = a[3]; cb[4] = bq[0]; cb[5] = bq[1]; cb[6] = bq[2]; cb[7] = bq[3]; }
#pragma unroll
            for (int tt = 0; tt < 4; ++tt) {
                float o[8];
#pragma unroll
                for (int e = 0; e < 8; ++e) o[e] = cb[e];
#pragma unroll
                for (int q = 0; q < 4; ++q) {
                    const u32x4 rv = raw[tt + q];
                    const unsigned wds[4] = {rv.x, rv.y, rv.z, rv.w};
#pragma unroll
                    for (int e = 0; e < 8; ++e) { const float x = bf2f((bf16_t)((e & 1) ? (wds[e >> 1] >> 16) : (wds[e >> 1] & 0xffffu))); o[e] = fmaf(x, cw[q][e], o[e]); }
                }
                u32x4 w; w.x = rw::pk2(o[0], o[1]); w.y = rw::pk2(o[2], o[3]); w.z = rw::pk2(o[4], o[5]); w.w = rw::pk2(o[6], o[7]);
                *(LAS u32x4*)(shm + W_XC + (4 * tg + tt) * 144 + co * 16) = w;
            }
        }
        if (u + (int)gridDim.x < 1024) ldraw(rawn, u + gridDim.x);
        {
            const float* ga_b = ARG(16) + (size_t)l * 512; const float* gx_b = ARG(18) + (size_t)l * 512; const float* lam = ARG(19) + (size_t)l * 512;
            f32x16 ar[2], ai[2];
#pragma unroll
            for (int nt = 0; nt < 2; ++nt)
#pragma unroll
                for (int r = 0; r < 16; ++r) { ar[nt][r] = 0.f; ai[nt][r] = 0.f; }
            const LAS char* xa = (const LAS char*)shm + W_XC + r32 * 144 + 8 * hi * 2;
#pragma unroll
            for (int ks = 0; ks < 4; ++ks) {
                const bf16x8 a = *(const LAS bf16x8*)(xa + ks * 32);
#pragma unroll
                for (int nt = 0; nt < 2; ++nt) {
                    ar[nt] = __builtin_amdgcn_mfma_f32_32x32x16_bf16(a, wr_[nt][ks], ar[nt], 0, 0, 0);
                    ai[nt] = __builtin_amdgcn_mfma_f32_32x32x16_bf16(a, wi_[nt][ks], ai[nt], 0, 0, 0);
                }
            }
            const LAS bf16_t* xc = (const LAS bf16_t*)(shm + W_XC); LAS unsigned* ob = (LAS unsigned*)(shm + W_OMA);
#pragma unroll
            for (int nt = 0; nt < 2; ++nt) {
                const int cl = 32 * nt + r32, ch = hh * 64 + cl;
                const float br = ga_b[ch], bi = gx_b[ch], c8l = -8.0f * 1.4426950408889634f * softplusf_(-lam[ch]);
#pragma unroll
                for (int r = 0; r < 16; ++r) {
                    const int t = crow(r, hi);
                    const float x = bf2f(xc[t * 72 + cl]);
                    const float om = 1.0f - __builtin_amdgcn_exp2f(sigmoidf_(ar[nt][r] + br) * c8l);
                    ob[t * 64 + cl] = f2bf2(om, __builtin_amdgcn_sqrtf(om * (2.0f - om)) * (sigmoidf_(ai[nt][r] + bi) * x));
                }
            }
        }
        {
            float2* lsum = (float2*)(ARG_WS + WS_LSUM) + ((size_t)b * 128 + c) * 512 + hh * 64 + lane;
            const LAS unsigned* ob = (const LAS unsigned*)(shm + W_OMA);
            float h = 0.f;
            if (FINAL) {
                if (lane == 0 && !dry) XB_SPIN(xb_ld(cnt) < 8u, (unsigned*)(ARG_WS + WS_CTL));
                h = __hip_atomic_load(&lsum->x, __ATOMIC_RELAXED, __HIP_MEMORY_SCOPE_AGENT);
            }
            float ap = 1.f, hv[TC];
#pragma unroll
            for (int t = 0; t < TC; ++t) {
                const unsigned pk = ob[t * 64 + lane];
                const float om = __builtin_bit_cast(float, pk << 16), bx = __builtin_bit_cast(float, pk & 0xffff0000u);
                h = fmaf(-om, h, h) + bx; ap *= (1.0f - om); hv[t] = h;
            }
            if (!FINAL) { if (!dry) *lsum = make_float2(ap, h); }
            else {
                LAS float* hb = (LAS float*)(shm + W_XC);
#pragma unroll
                for (int t = 0; t < TC; ++t) hb[t * 64 + lane] = hv[t];
                { const LAS f32x4* hp = (const LAS f32x4*)(hb + (lane >> 1) * 64 + (lane & 1) * 32);
                  float ss = 0.f;
#pragma unroll
                  for (int k = 0; k < 8; ++k) { const f32x4 v = hp[k]; ss += (v[0] * v[0] + v[1] * v[1]) + (v[2] * v[2] + v[3] * v[3]); }
                  ss += dppx<0xB1>(ss);
                  if ((lane & 1) == 0) ((LAS float*)(shm0 + L_PART))[parity * 256 + (lane >> 1) * 8 + hh] = ss; }
            }
        }
        if (FINAL) {
            __syncthreads();
            const float* go = ARG(20) + (size_t)l * 512 + hh * 64 + 8 * co;
            const f32x4 g0 = *(const f32x4*)go, g1 = *(const f32x4*)(go + 4);
            const float gg[8] = {g0[0], g0[1], g0[2], g0[3], g1[0], g1[1], g1[2], g1[3]};
            const LAS float* hb = (const LAS float*)(shm + W_XC);
            u32x4 zvv[4];
#pragma unroll
            for (int tt = 0; tt < 4; ++tt) zvv[tt] = *(const u32x4*)(PROJ + (row0 + 4 * tg + tt) * DIN + C_ZB + hh * 64 + 8 * co);
#pragma unroll
            for (int tt = 0; tt < 4; ++tt) {
                const int t = 4 * tg + tt;
                const f32x4 p0 = *(const LAS f32x4*)((const LAS float*)(shm0 + L_PART) + parity * 256 + t * 8), p1 = *(const LAS f32x4*)((const LAS float*)(shm0 + L_PART) + parity * 256 + t * 8 + 4);
                const float rs = rsqrtf((((p0[0] + p0[1]) + (p0[2] + p0[3])) + ((p1[0] + p1[1]) + (p1[2] + p1[3]))) * (1.0f / 512) + 1e-6f);
                const f32x4 x0 = *(const LAS f32x4*)(hb + t * 64 + 8 * co), x1 = *(const LAS f32x4*)(hb + t * 64 + 8 * co + 4);
                const float x[8] = {x0[0], x0[1], x0[2], x0[3], x1[0], x1[1], x1[2], x1[3]};
                bf16_t* zp = PROJ + (row0 + t) * DIN + C_ZB + hh * 64 + 8 * co;
                const u32x4 zv = zvv[tt]; const unsigned zw[4] = {zv.x, zv.y, zv.z, zv.w};
                float o[8];
#pragma unroll
                for (int e = 0; e < 8; ++e) { const float z = bf2f((bf16_t)((e & 1) ? (zw[e >> 1] >> 16) : (zw[e >> 1] & 0xffffu))); o[e] = x[e] * rs * gg[e] * siluf_(z); }
                u32x4 w; w.x = rw::pk2(o[0], o[1]); w.y = rw::pk2(o[2], o[3]); w.z = rw::pk2(o[4], o[5]); w.w = rw::pk2(o[6], o[7]);
                if (!dry) *(u32x4*)zp = w;
            }
        }
#pragma unroll
        for (int k = 0; k < 7; ++k) raw[k] = rawn[k];
    }
}
}

namespace att {
typedef short bf16x8 __attribute__((ext_vector_type(8)));
typedef short s16x4 __attribute__((ext_vector_type(4)));
typedef short v4i16_t __attribute__((ext_vector_type(4)));
typedef float f32x16 __attribute__((ext_vector_type(16)));
typedef unsigned u32x4 __attribute__((ext_vector_type(4)));
typedef float f32x2_t __attribute__((ext_vector_type(2)));
typedef __bf16 bf16x2_t __attribute__((ext_vector_type(2)));
typedef LAS const char* lds_cptr;
constexpr int KSLOT = 12288, VSLOT = 8192, LDS_K = 0, LDS_V = 3 * KSLOT, LDS_WS = LDS_V + 3 * VSLOT, LDS_OST = LDS_WS + 8 * 256, LDS_BYTES = LDS_OST + 8 * 4096;
__device__ __forceinline__ int crow(int r, int hi) { return (r & 3) + 8 * (r >> 2) + 4 * hi; }
__device__ __forceinline__ void glds16(const void* gsrc, unsigned lds_dst) { unsigned keep;
    asm volatile("s_mov_b32 %0, m0\n\ts_mov_b32 m0, %2\n\ts_nop 0\n\tglobal_load_lds_dwordx4 %1, off\n\ts_mov_b32 m0, %0" : "=&s"(keep) : "v"(gsrc), "s"(lds_dst) : "memory"); }
__device__ __forceinline__ unsigned cvtpk(float lo, float hi) { f32x2_t v = {lo, hi}; bf16x2_t b = __builtin_convertvector(v, bf16x2_t); return __builtin_bit_cast(unsigned, b); }
__device__ __forceinline__ s16x4 vtr(lds_cptr p) { return __builtin_bit_cast(s16x4, __builtin_amdgcn_ds_read_tr16_b64_v4i16((LAS v4i16_t*)p)); }
#define ATT_WAITB(N) asm volatile("s_waitcnt vmcnt(" #N ") lgkmcnt(0)\n\ts_barrier" ::: "memory")
__device__ __forceinline__ float max3f(float a, float b, float c) { float r; asm volatile("v_max3_f32 %0, %1, %2, %3" : "=v"(r) : "v"(a), "v"(b), "v"(c)); return r; }
__device__ __forceinline__ float max3f_first(float a, float b, float c) { float r; asm volatile("s_nop 15\n\ts_nop 7\n\tv_max3_f32 %0, %1, %2, %3" : "=v"(r) : "v"(a), "v"(b), "v"(c)); return r; }

template <int THR>
__device__ __forceinline__ void attn_unit(bf16_t* Qb, const bf16_t* Kb, const bf16_t* Vb, int b, int h, int qb, LAS char* shm, const bool dry = false) {
    const int tid = otid(), lane = tid & 63, r32 = lane & 31, hi = lane >> 5;
    const int wid = __builtin_amdgcn_readfirstlane(tid >> 6);
    const size_t rowb = (size_t)b * SEQ; const int q0 = qb * 256;
    bf16_t* Qw = Qb + ((rowb + q0 + wid * 32) * 8 + h) * 96;
    const bf16_t* Kh = Kb + (rowb * 8 + h) * 96;
    const bf16_t* Vh = Vb + (rowb * 8 + h) * 64;
    const unsigned lds0 = (unsigned)(size_t)shm;
    LAS float* wsf = (LAS float*)(shm + LDS_WS) + wid * 64;
    const bf16_t* ksrc = Kh + (size_t)lane * 768 + wid * 8;
    const bf16_t* vsrc = Vh + (size_t)(16 * (wid & 3) + (lane >> 2)) * 512 + (wid >> 2) * 32 + (lane & 3) * 8;
    const unsigned kdst = lds0 + LDS_K + wid * 1024, vdst = lds0 + LDS_V + wid * 1024;
#define ATT_DMA(t, sl) do { glds16(ksrc + (size_t)(t) * 64 * 768, (unsigned)__builtin_amdgcn_readfirstlane(kdst + (sl) * KSLOT)); \
        if (wid < 4) glds16(ksrc + (size_t)(t) * 64 * 768 + 64, (unsigned)__builtin_amdgcn_readfirstlane(kdst + (sl) * KSLOT + 8192)); \
        glds16(vsrc + (size_t)(t) * 64 * 512, (unsigned)__builtin_amdgcn_readfirstlane(vdst + (sl) * VSLOT)); } while (0)
    const int NT = 4 * (qb + 1);
    ATT_DMA(0, 0);
    if (NT > 1) ATT_DMA(1, 1);
    bf16x8 qr[6];
#pragma unroll
    for (int d0 = 0; d0 < 6; ++d0) qr[d0] = *(const bf16x8*)(Qw + (size_t)r32 * 768 + d0 * 16 + hi * 8);
    asm volatile("s_waitcnt vmcnt(0)" : "+v"(qr[0]), "+v"(qr[1]), "+v"(qr[2]), "+v"(qr[3]), "+v"(qr[4]), "+v"(qr[5]) :: "memory");
    float m = 0.f, l = 0.f; f32x16 o[2], negm;
#pragma unroll
    for (int r = 0; r < 16; ++r) { o[0][r] = 0.f; o[1][r] = 0.f; negm[r] = 0.f; }
    const int qrel = wid * 32 + r32;
    const lds_cptr kp0 = (lds_cptr)shm + LDS_K + hi * 1024 + r32 * 16;
    const lds_cptr vp0 = (lds_cptr)shm + LDS_V + ((lane >> 4) & 1) * 32 + (lane & 3) * 8 + (4 * hi + ((lane & 15) >> 2)) * 64;
    int sl0 = 0, sl1 = 1, sl2 = 2;
    for (int t = 0; t < NT; ++t) {
        if (t + 1 < NT) { if (wid < 4) ATT_WAITB(3); else ATT_WAITB(2); } else ATT_WAITB(0);
        if (t + 2 < NT) ATT_DMA(t + 2, sl2);
        const int sl = sl0;
        sl0 = sl1; sl1 = sl2; sl2 = sl;
        const int jb = t - (NT - 4);
        if (jb >= 1 && 64 * jb > wid * 32 + 31) continue;
        f32x16 p0, p1;
        const lds_cptr kp = kp0 + sl * KSLOT;
        bf16x8 kf[12];
#pragma unroll
        for (int d0 = 0; d0 < 6; ++d0) { kf[2 * d0] = *(const LAS bf16x8*)(kp + d0 * 2048); kf[2 * d0 + 1] = *(const LAS bf16x8*)(kp + d0 * 2048 + 512); }
        __builtin_amdgcn_sched_barrier(0);
#pragma unroll
        for (int d0 = 0; d0 < 6; ++d0) {
            if (d0 == 0) { p0 = __builtin_amdgcn_mfma_f32_32x32x16_bf16(kf[0], qr[0], negm, 0, 0, 0); p1 = __builtin_amdgcn_mfma_f32_32x32x16_bf16(kf[1], qr[0], negm, 0, 0, 0); }
            else { p0 = __builtin_amdgcn_mfma_f32_32x32x16_bf16(kf[2 * d0], qr[d0], p0, 0, 0, 0); p1 = __builtin_amdgcn_mfma_f32_32x32x16_bf16(kf[2 * d0 + 1], qr[d0], p1, 0, 0, 0); }
        }
        const lds_cptr vp = vp0 + sl * VSLOT;
        s16x4 vlo[8], vhi[8];
#pragma unroll
        for (int i = 0; i < 8; ++i) { vlo[i] = vtr(vp + (i >> 2) * 4096 + (i & 3) * 1024); vhi[i] = vtr(vp + (i >> 2) * 4096 + (i & 3) * 1024 + 512); }
        __builtin_amdgcn_sched_barrier(0);
        if (jb >= 0) {
            const int kb = 64 * jb + 4 * hi;
#pragma unroll
            for (int r = 0; r < 16; ++r) { const int kv = kb + (r & 3) + 8 * (r >> 2); if (kv > qrel) p0[r] = -INFINITY; if (kv + 32 > qrel) p1[r] = -INFINITY; }
        }
        float mx = max3f_first(p0[0], p0[1], p1[0]), mb = max3f(p0[2], p0[3], p1[1]); mx = max3f(mx, p1[2], p1[3]);
#pragma unroll
        for (int r = 4; r < 16; r += 4) { mx = max3f(mx, p0[r], p0[r + 1]); mb = max3f(mb, p0[r + 2], p0[r + 3]); mx = max3f(mx, p1[r], p1[r + 1]); mb = max3f(mb, p1[r + 2], p1[r + 3]); }
        mx = fmaxf(mx, mb);
        { float x, y; swap32(mx, x, y); mx = fmaxf(x, y); }
        if (t == 0 || __any(mx > (float)THR)) {
            const float dl = (t == 0) ? mx : fmaxf(mx, 0.f);
            m += dl;
            const float alpha = __builtin_amdgcn_exp2f(-dl);
            l *= alpha;
#pragma unroll
            for (int r = 0; r < 16; ++r) { p0[r] -= dl; p1[r] -= dl; negm[r] = -m; }
            if (t > 0) {
                if (hi == 0) wsf[r32] = alpha;
#pragma unroll
                for (int r = 0; r < 16; ++r) { const float f = wsf[crow(r, hi)]; o[0][r] *= f; o[1][r] *= f; }
            }
        }
        float ps = 0.f;
#pragma unroll
        for (int r = 0; r < 16; ++r) { p0[r] = __builtin_amdgcn_exp2f(p0[r]); p1[r] = __builtin_amdgcn_exp2f(p1[r]); ps += p0[r] + p1[r]; }
        l += ps;
        u32x4 pw[4];
#pragma unroll
        for (int q = 0; q < 4; ++q) { pw[0][q] = cvtpk(p0[2 * q], p0[2 * q + 1]); pw[1][q] = cvtpk(p0[8 + 2 * q], p0[9 + 2 * q]); pw[2][q] = cvtpk(p1[2 * q], p1[2 * q + 1]); pw[3][q] = cvtpk(p1[8 + 2 * q], p1[9 + 2 * q]); }
#pragma unroll
        for (int d0 = 0; d0 < 2; ++d0)
#pragma unroll
            for (int ks = 0; ks < 4; ++ks) {
                const s16x4 lo = vlo[d0 * 4 + ks], hh = vhi[d0 * 4 + ks];
                const bf16x8 vf = (bf16x8){lo[0], lo[1], lo[2], lo[3], hh[0], hh[1], hh[2], hh[3]};
                o[d0] = __builtin_amdgcn_mfma_f32_32x32x16_bf16(__builtin_bit_cast(bf16x8, pw[ks]), vf, o[d0], 0, 0, 0);
            }
    }
    { float x, y; swap32(l, x, y); l = x + y; }
    if (hi == 0) wsf[32 + r32] = l;
    float rli[16];
#pragma unroll
    for (int r = 0; r < 16; ++r) rli[r] = 1.0f / wsf[32 + crow(r, hi)];
    LAS bf16_t* stg = (LAS bf16_t*)(shm + LDS_OST) + wid * 2048;
#pragma unroll
    for (int r = 0; r < 16; ++r) { const int orow = crow(r, hi);
#pragma unroll
        for (int d0 = 0; d0 < 2; ++d0) stg[orow * 64 + d0 * 32 + r32] = f2bf(o[d0][r] * rli[r]); }
#pragma unroll
    for (int i = 0; i < 4; ++i) { const int row = i * 8 + (lane >> 3), ch = lane & 7; const u32x4 v = *(const LAS u32x4*)(stg + row * 64 + ch * 8); if (!dry) *(u32x4*)(Qw + (size_t)row * 768 + ch * 8) = v; }
    asm volatile("s_waitcnt lgkmcnt(0)\n\ts_barrier" ::: "memory");
#undef ATT_DMA
}
}

__global__ void __launch_bounds__(512, 2) fwd_kernel(Args A) {
    extern __shared__ __attribute__((aligned(16))) unsigned char smem[];
    float* lds = (float*)smem;
    volatile LAS unsigned* xbw = (volatile LAS unsigned*)(smem + 147456 - 16);
    unsigned* ctl = (unsigned*)(ARG_WS + WS_CTL);
    const int tid = threadIdx.x;
    if (tid == 0) { xbw[0] = 0u; xbw[1] = 0u; xbw[2] = 0u; xbw[3] = 0u; }
    __syncthreads();
    XcdBarrier bar = xcd_barrier_post(ctl, xbw);
#if PROBE >= 50 && PROBE <= 52
    unsigned long long pc0 = 0, pr0 = 0, pc1 = 0, pr1 = 0;
    if (PROBE == 50) { pc0 = __builtin_amdgcn_s_memtime(); pr0 = __builtin_amdgcn_s_memrealtime(); }
#endif
    LAS int* s_unit = (LAS int*)(smem + 147456 - 32);

    bf16_t* PROJ = (bf16_t*)(ARG_WS + WS_PROJ);
    bf16_t* XN = (bf16_t*)(ARG_WS + WS_XN);
    float* rope = (float*)(ARG_WS + WS_ROPE);
    const int nwaves = gridDim.x * 8;
#define PHASE_IDS() const int ptid = otid(), lane = ptid & 63, wv = ptid >> 6, gw = blockIdx.x * 8 + wv; (void)lane; (void)gw

    PAMP_BEGIN(20);
    for (int idx = blockIdx.x * 512 + otid(); idx < SEQ * 16; idx += gridDim.x * 512) {
        const int t = idx >> 4, i = idx & 15;
        const float inv = powf(10000.0f, -((float)i * 2.0f / 32.0f));
        const float ang = (float)t * inv;
        const double twopi = 6.283185307179586476925286766559;
        double rr = (double)ang; rr -= twopi * floor(rr / twopi + 0.5);
        const double r2 = rr * rr; double ts = rr, ss = rr, tc = 1.0, cc = 1.0;
        for (int n = 1; n <= 13; ++n) { ts *= -r2 / (double)((2 * n) * (2 * n + 1)); ss += ts; tc *= -r2 / (double)((2 * n - 1) * (2 * n)); cc += tc; }
        rope[idx * 2] = (float)cc; rope[idx * 2 + 1] = (float)ss;
    }

    for (int prep = 0; prep < (PROBE == 11 ? 2 : 1); ++prep)
    for (int l = 0; l < DEPTH; ++l) {
        { const float* W = ARG(2) + (size_t)l * DM * DIN; const float* g = ARG(1) + (size_t)l * DM;
          transpose_w(DM, NPAD_IN, (bf16_t*)(ARG_WS + WS_WIN) + (size_t)l * NPAD_IN * DM, [=](int k, int n) -> f32x4_t { return n < DIN ? *(const f32x4_t*)(W + (size_t)k * DIN + orig_col(n)) * g[k] : (f32x4_t){0.f, 0.f, 0.f, 0.f}; }, lds); }
        { const float* W = ARG(26) + (size_t)l * DMIX * DM;
          transpose_w(DMIX, DM, (bf16_t*)(ARG_WS + WS_WOUT) + (size_t)l * DM * DMIX, [=](int k, int n) -> f32x4_t { return *(const f32x4_t*)(W + (size_t)k * DM + n); }, lds); }
        { const float* qg = ARG(21) + (size_t)l * QL; const float* wuq = ARG(22) + (size_t)l * QL * 768;
          const float* kg = ARG(23) + (size_t)l * KVL; const float* wukv = ARG(24) + (size_t)l * KVL * 1024;
          transpose_w(256, NMLA, (bf16_t*)(ARG_WS + WS_WMLA) + (size_t)l * NMLA * 256, [=](int k, int n) -> f32x4_t {
              if (n < 768) return *(const f32x4_t*)(wuq + (size_t)k * 768 + n) * qg[k];
              return k < KVL ? *(const f32x4_t*)(wukv + (size_t)k * 1024 + (n - 768)) * kg[k] : (f32x4_t){0.f, 0.f, 0.f, 0.f}; }, lds); }
    }
    { const float* w2 = ARG(5); const float* a2 = ARG(7);
      transpose_w(64, DEPTH * 512, (bf16_t*)(ARG_WS + WS_W2T), [=](int k, int n) -> f32x4_t { return *(const f32x4_t*)(w2 + ((size_t)(n >> 9) * 64 + k) * 512 + (n & 511)); }, lds);
      transpose_w(64, DEPTH * 512, (bf16_t*)(ARG_WS + WS_W2T) + (size_t)DEPTH * 512 * 64, [=](int k, int n) -> f32x4_t { return *(const f32x4_t*)(a2 + ((size_t)(n >> 9) * 64 + k) * 512 + (n & 511)); }, lds); }
    { const float* ga = ARG(15); const float* gx = ARG(17);
      transpose_w(64, DEPTH * 8 * 64, (bf16_t*)(ARG_WS + WS_GAT), [=](int k, int n) -> f32x4_t { return *(const f32x4_t*)(ga + ((size_t)(n >> 6) * 64 + k) * 64 + (n & 63)); }, lds);
      transpose_w(64, DEPTH * 8 * 64, (bf16_t*)(ARG_WS + WS_GAT) + (size_t)DEPTH * 8 * 64 * 64, [=](int k, int n) -> f32x4_t { return *(const f32x4_t*)(gx + ((size_t)(n >> 6) * 64 + k) * 64 + (n & 63)); }, lds); }
    {
        PHASE_IDS();
        const float* x = ARG(0); float* ssqh = (float*)(ARG_WS + WS_SSQH);
        for (int row = gw; row < MTOK; row += nwaves) {
            float4 v[4]; float ss = 0.f;
#pragma unroll
            for (int q = 0; q < 4; ++q) { v[q] = *(const float4*)&x[(size_t)row * DM + q * 256 + lane * 4]; ss += v[q].x * v[q].x + v[q].y * v[q].y + v[q].z * v[q].z + v[q].w * v[q].w; }
            ss = wave_sum(ss);
#pragma unroll
            for (int q = 0; q < 4; ++q) { ushort4 o; o.x = f2bf(v[q].x); o.y = f2bf(v[q].y); o.z = f2bf(v[q].z); o.w = f2bf(v[q].w); *(ushort4*)&XN[(size_t)row * DM + q * 256 + lane * 4] = o; }
            if (lane < 16) ssqh[(size_t)row * 16 + lane] = (lane == 0) ? ss : 0.f;
        }
    }
    PAMP_END(20);
    xcd_barrier(bar);

    for (int l = 0; l < DEPTH; ++l) {
#if PROBE == 10
        for (int rep = 0; rep < 8; ++rep) xcd_barrier(bar);
#endif
#if PROBE == 40
        { const unsigned long long t1_ = __builtin_amdgcn_s_memrealtime(); while (__builtin_amdgcn_s_memrealtime() - t1_ < 20000ull) __builtin_amdgcn_s_sleep(8); __syncthreads(); }
#endif
        PAMP_BEGIN(21);
#if PROBE == 51 || PROBE == 52
        if (l == (PROBE == 51 ? 0 : 3)) { pc0 = __builtin_amdgcn_s_memtime(); pr0 = __builtin_amdgcn_s_memrealtime(); }
#endif
        for (int rep = 0; rep < (PROBE == 9 ? 2 : 1); ++rep) {
            pg8::Gemm g{XN, (const bf16_t*)(ARG_WS + WS_WIN) + (size_t)l * NPAD_IN * DM, MTOK, NPAD_IN, DM, DM, DM, 1 << 30, 0};
            pg8::RowScaleOrder<16> S; S.init(MTOK, NPAD_IN, (int)gridDim.x, (int)blockIdx.x);
            S.part = (const float*)(ARG_WS + WS_SSQH); S.inv_dim = 1.0f / DM; S.tab = (PG8_LAS float*)(smem + 131072);
            pg8::EpiProj E{PROJ, DIN, DIN, (const PG8_LAS float*)(smem + 131072), (float*)(ARG_WS + WS_SQQ), (float*)(ARG_WS + WS_SQKV), (bf16_t*)(ARG_WS + WS_K), rope, (bf16_t*)(ARG_WS + WS_SAVA)};
            pg8::gemm_phase<pg8::EpiProj, pg8::RowScaleOrder<16>, true, true>((PG8_LAS unsigned char*)smem, g, S, E);
        }
#if PROBE == 51 || PROBE == 52
        if (l == (PROBE == 51 ? 0 : 3)) { __syncthreads(); pc1 = __builtin_amdgcn_s_memtime(); pr1 = __builtin_amdgcn_s_memrealtime(); }
#endif
        PAMP_END(21);
        xcd_barrier(bar);
        PAMP_BEGIN(22);
        for (int rep = 0; rep < (PROBE == 13 ? 2 : 1); ++rep) {
            int kmla = 256; asm volatile("" : "+s"(kmla));
            pg8::Gemm g{PROJ + C_QL, (const bf16_t*)(ARG_WS + WS_WMLA) + (size_t)l * NMLA * 256, MTOK, NMLA, kmla, DIN, 256, 3, 2 * (C_KVL - C_QL)};
            pg8::MlaOrder S; S.init(MTOK, NMLA, (int)gridDim.x, (int)blockIdx.x);
            S.sqq = (const float*)(ARG_WS + WS_SQQ); S.sqkv = (const float*)(ARG_WS + WS_SQKV); S.tab = (PG8_LAS float*)(smem + 131072 + 2048);
            pg8::EpiMla E{(bf16_t*)(DO_Q), (bf16_t*)(ARG_WS + WS_K), (bf16_t*)(ARG_WS + WS_V), (const PG8_LAS float*)(smem + 131072 + 2048), rope, 0.10206207261596577f * 1.4426950408889634f, 0};
            pg8::gemm_phase<pg8::EpiMla, pg8::MlaOrder, true, true>((PG8_LAS unsigned char*)smem, g, S, E);
        }
        PAMP_END(22);
#if PROBE == 1 || PROBE == 2
        {
            const bool dry = (xb_ld(ctl + CW_PROBE) == 0u);
            unsigned* qw = ctl + CW_PROBEQ + 64 * l;
            for (;;) {
                __syncthreads();
                if (threadIdx.x == 0) *s_unit = (int)atomicAdd(qw, 1u);
                __syncthreads();
                const int u = *s_unit;
#if PROBE == 1
                if (u >= 4096) break;
                (void)dry; break;
#else
                if (u >= 1024) break;
                break;
#endif
            }
        }
#endif
        PAMP_BEGIN(23);
#if PROBE == 1
        rw::r1_phase(l, (LAS char*)smem, (xb_ld(ctl + CW_PROBE) == 0u));
#endif
        rw::r1_phase(l, (LAS char*)smem);
        lru::phase<false>(l, (LAS char*)smem, ctl + CW_LCNT + 64 * l);
        PAMP_END(23);
        xcd_barrier(bar);
#if PROBE >= 3 && PROBE <= 5
        {
            const bool dry = (xb_ld(ctl + CW_PROBE) == 0u);
            unsigned* qw = ctl + CW_PROBEQ + 64 * l;
            for (;;) {
                __syncthreads();
                if (threadIdx.x == 0) *s_unit = (int)atomicAdd(qw, 1u);
                __syncthreads();
                const int u = *s_unit;
#if PROBE == 3
                if (u >= 64) break;
                rw::r2_unit(l, u >> 3, u & 7, (LAS char*)smem, dry);
#elif PROBE == 4
                if (u >= 1024) break;
                break;
#else
                if (u >= 1024) break;
                att::attn_unit<ATT_THR>((bf16_t*)(DO_Q), (const bf16_t*)(ARG_WS + WS_K), (const bf16_t*)(ARG_WS + WS_V), (u & 63) >> 3, u & 7, 15 - (u >> 6), (LAS char*)smem, dry);
#endif
            }
        }
#endif
        {
            unsigned* qw = ctl + CW_QUEUE + 64 * (2 * l + 1);
            PAMP_BEGIN(24);
            for (;;) {
                __syncthreads();
                if (threadIdx.x == 0) *s_unit = (int)atomicAdd(qw, 1u);
                __syncthreads();
                const int u = *s_unit;
                if (u >= 8 + 64) break;
                if (u < 8) lru::carry_unit(u, ctl + CW_LCNT + 64 * l);
                else { const int a = u - 8; rw::r2_unit(l, a >> 3, a & 7, (LAS char*)smem); }
            }
            PAMP_END(24);
            PAMP_BEGIN(25);
            {
                const int x0 = (int)(xb_xcc_id() & 7u);
                for (int k = 0; k < 8; ++k) {
                    const int x = (x0 + k) & 7;
                    unsigned* qa = ctl + CW_ATTQ + 32 * (l * 8 + x);
                    for (;;) {
                        __syncthreads();
                        if (threadIdx.x == 0) *s_unit = (int)atomicAdd(qa, 1u);
                        __syncthreads();
                        const int u = *s_unit;
                        if (u >= 128) break;
                        const int bh = 8 * x + (u & 7), qb = 15 - (u >> 3);
                        att::attn_unit<ATT_THR>((bf16_t*)(DO_Q), (const bf16_t*)(ARG_WS + WS_K), (const bf16_t*)(ARG_WS + WS_V), bh >> 3, bh & 7, qb, (LAS char*)smem);
                    }
                }
            }
            PAMP_END(25);
            PAMP_BEGIN(26);
            lru::phase<true>(l, (LAS char*)smem, ctl + CW_LCNT + 64 * l);
            PAMP_END(26);
        }
        xcd_barrier(bar);
        PAMP_BEGIN(27);
        for (int rep = 0; rep < (PROBE == 8 ? 2 : 1); ++rep) {
            const bool dry = (PROBE == 8) && (rep == 0) && (xb_ld(ctl + CW_PROBE) == 0u);
            typedef unsigned u32x4 __attribute__((ext_vector_type(4)));
            typedef float f32x4 __attribute__((ext_vector_type(4)));
            PHASE_IDS();
            const int hd = lane >> 3, c0 = hd * 64 + (lane & 7) * 8;
            const bf16_t* OATT = (const bf16_t*)(DO_Q);
            float gcv[8];
            { const float* p2 = ARG(25) + (size_t)l * 512 + c0; const f32x4 d0 = *(const f32x4*)p2, d1 = *(const f32x4*)(p2 + 4);
#pragma unroll
              for (int e = 0; e < 4; ++e) { gcv[e] = d0[e]; gcv[4 + e] = d1[e]; } }
            auto unpack = [](const u32x4 v, float (&x)[8]) { const unsigned w[4] = {v.x, v.y, v.z, v.w};
#pragma unroll
                for (int e = 0; e < 4; ++e) { x[2 * e] = bf2f((bf16_t)(w[e] & 0xffffu)); x[2 * e + 1] = bf2f((bf16_t)(w[e] >> 16)); } };
            for (int row = gw; row < MTOK; row += 4 * nwaves) {
                u32x4 rzc[4], ro[4];
#pragma unroll
                for (int k = 0; k < 4; ++k) { const size_t rr = (size_t)row + (size_t)k * nwaves; rzc[k] = *(const u32x4*)(PROJ + rr * DIN + C_ZC + c0); ro[k] = *(const u32x4*)(OATT + (rr * 8 + hd) * 96 + (lane & 7) * 8); }
#pragma unroll
                for (int k = 0; k < 4; ++k) {
                    const size_t rr = (size_t)row + (size_t)k * nwaves;
                    float zc[8], oa[8];
                    unpack(rzc[k], zc); unpack(ro[k], oa);
                    float sq = 0.f;
#pragma unroll
                    for (int e = 0; e < 8; ++e) sq += oa[e] * oa[e];
                    sq = wave_sum(sq);
                    const float rc = rsqrtf(sq * (1.0f / 512) + 1e-6f);
                    float yc[8];
#pragma unroll
                    for (int e = 0; e < 8; ++e) yc[e] = oa[e] * rc * gcv[e] * siluf_(zc[e]);
                    u32x4 wc;
                    wc.x = rw::pk2(yc[0], yc[1]); wc.y = rw::pk2(yc[2], yc[3]); wc.z = rw::pk2(yc[4], yc[5]); wc.w = rw::pk2(yc[6], yc[7]);
                    if (!dry) *(u32x4*)(PROJ + rr * DIN + C_ZC + c0) = wc;
                }
            }
        }
        PAMP_END(27);
        xcd_barrier(bar);
        PAMP_BEGIN(28);
        for (int rep = 0; rep < (PROBE == 14 ? 2 : 1); ++rep) {
            const bool odry = (PROBE == 14) && (rep == 0) && (xb_ld(ctl + CW_PROBE) == 0u);
            pg8::Gemm g{PROJ + C_ZA, (const bf16_t*)(ARG_WS + WS_WOUT) + (size_t)l * DM * DMIX, MTOK, DM, DMIX, DIN, DMIX, 1 << 30, 0};
            pg8::StaticOrder S; S.init(MTOK, DM, (int)gridDim.x, (int)blockIdx.x);
            pg8::EpiResid E{DM, odry, XN, (float*)(ARG_WS + WS_SSQH)};
            pg8::gemm_phase<pg8::EpiResid, pg8::StaticOrder, true, true>((PG8_LAS unsigned char*)smem, g, S, E);
        }
        PAMP_END(28);
        xcd_barrier(bar);
    }
    {
        const float* g = ARG(27); const float* ssqh = (const float*)(ARG_WS + WS_SSQH);
        PHASE_IDS();
        float* out = ARG_OUT;
        for (int row = gw; row < MTOK; row += nwaves) {
            float tsum = (lane < 16) ? ssqh[(size_t)row * 16 + lane] : 0.f;
            tsum = wave_sum(tsum);
            const float rs = rsqrtf(tsum * (1.0f / DM) + 1e-6f);
            typedef unsigned u32x4 __attribute__((ext_vector_type(4))); u32x4 v[2];
#pragma unroll
            for (int q = 0; q < 2; ++q) v[q] = *(const u32x4*)(XN + (size_t)row * DM + q * 512 + lane * 8);
#pragma unroll
            for (int q = 0; q < 2; ++q) {
                const float4 g0 = *(const float4*)&g[q * 512 + lane * 8], g1 = *(const float4*)&g[q * 512 + lane * 8 + 4];
                float4 o0, o1;
                o0.x = __uint_as_float(v[q].x << 16) * rs * g0.x; o0.y = __uint_as_float(v[q].x & 0xffff0000u) * rs * g0.y;
                o0.z = __uint_as_float(v[q].y << 16) * rs * g0.z; o0.w = __uint_as_float(v[q].y & 0xffff0000u) * rs * g0.w;
                o1.x = __uint_as_float(v[q].z << 16) * rs * g1.x; o1.y = __uint_as_float(v[q].z & 0xffff0000u) * rs * g1.y;
                o1.z = __uint_as_float(v[q].w << 16) * rs * g1.z; o1.w = __uint_as_float(v[q].w & 0xffff0000u) * rs * g1.w;
                *(float4*)&out[(size_t)row * DM + q * 512 + lane * 8] = o0;
                *(float4*)&out[(size_t)row * DM + q * 512 + lane * 8 + 4] = o1;
            }
        }
    }
#if PROBE >= 50 && PROBE <= 52
    if (PROBE == 50) { __syncthreads(); pc1 = __builtin_amdgcn_s_memtime(); pr1 = __builtin_amdgcn_s_memrealtime(); }
    if (blockIdx.x == 0) {
        const unsigned long long mhz = (pc1 - pc0) * 100ull / (pr1 - pr0 + 1ull);
        const unsigned long long t1_ = __builtin_amdgcn_s_memrealtime(), d_ = mhz * 25ull;
        while (__builtin_amdgcn_s_memrealtime() - t1_ < d_) __builtin_amdgcn_s_sleep(8);
    }
#endif
}

extern "C" void kernel_launch(void* const* d_in, const int* in_sizes, int n_in, void* d_out, int out_size, void* d_ws, size_t ws_size, hipStream_t stream) {
    (void)in_sizes; (void)n_in; (void)out_size; (void)ws_size;
    constexpr int kDynLds = 147456;
    static int grid = 0;
    if (!grid) {
        int dev = 0, cus = 0;
        hipGetDevice(&dev);
        hipDeviceGetAttribute(&cus, hipDeviceAttributeMultiprocessorCount, dev);
        hipFuncSetAttribute((const void*)fwd_kernel, hipFuncAttributeMaxDynamicSharedMemorySize, kDynLds);
        int per_cu = 0;
        hipOccupancyMaxActiveBlocksPerMultiprocessor(&per_cu, fwd_kernel, 512, kDynLds);
        if (per_cu < 1) fprintf(stderr, "occupancy query says %d\n", per_cu);
        grid = cus > 0 ? cus : 256;
    }
    hipMemsetAsync(d_ws, 0, CTL_BYTES, stream);
    Args a;
    memset(&a, 0, sizeof(a));
    for (int i = 0; i < 28; ++i) a.in[i] = (const float*)d_in[i];
    a.out = (float*)d_out;
    a.ws = (unsigned char*)d_ws;
    hipLaunchKernelGGL(fwd_kernel, dim3(grid), dim3(512), kDynLds, stream, a);
}
```

```cpp
#include <hip/hip_runtime.h>
#include <stdint.h>
#include <cstdio>
#include <cstring>
#ifndef PROBE
#define PROBE 0
#endif
#define PAMP_BEGIN(id) unsigned long long pamp_t0_##id = 0; if (PROBE == (id)) pamp_t0_##id = __builtin_amdgcn_s_memrealtime()
#define PAMP_END(id) do { if (PROBE == (id)) { __syncthreads(); const unsigned long long t1_ = __builtin_amdgcn_s_memrealtime(), d_ = t1_ - pamp_t0_##id; while (__builtin_amdgcn_s_memrealtime() - t1_ < d_) __builtin_amdgcn_s_sleep(8); __syncthreads(); } } while (0)

constexpr int DM = 1024, NB = 8, SEQ = 4096, DEPTH = 4, MTOK = NB * SEQ;
constexpr int GW = 512, HD = 64, NH = 8, DMIX = 1536, DIN = 4128;
constexpr int QL = 256, KVL = 128;
constexpr int C_R = 0, C_K = 512, C_V = 1024, C_WL = 1536, C_AL = 1600, C_UB = 1664, C_QL = 2176, C_KVL = 2432, C_KR = 2560,
              C_ZA = 2592, C_ZB = 3104, C_ZC = 3616;
__device__ __forceinline__ int orig_col(int c) {
    if (c < 1664) return c;
    if (c < 2176) return c - 1664 + 2176;
    if (c < 2432) return c - 2176 + 3200;
    if (c < 2560) return c - 2432 + 3456;
    if (c < 2592) return c - 2560 + 3584;
    if (c < 3104) return c - 2592 + 1664;
    if (c < 3616) return c - 3104 + 2688;
    return c;
}
constexpr size_t MiB = 1u << 20;
constexpr size_t WS_CTL = 0, CTL_BYTES = 65536;
constexpr size_t WS_ROPE = 64 * 1024;
constexpr size_t WS_W2T = 576 * 1024;
constexpr size_t WS_SQQ = 1088 * 1024;
constexpr size_t WS_SQKV = 2112 * 1024;
constexpr size_t WS_SSQH = 10 * MiB;
constexpr size_t WS_WMLA = 3 * MiB;
constexpr size_t WS_PROJ = 16 * MiB;
constexpr size_t WS_XN = 354 * MiB;
constexpr size_t WS_K = 274 * MiB;
constexpr size_t WS_V = 322 * MiB;
constexpr size_t WS_BON = 8 * MiB + 512 * 1024;
constexpr size_t WS_SAVA = 14 * MiB;
constexpr size_t WS_RWD = 480 * MiB;
constexpr size_t WS_GAT = 9 * MiB + 512 * 1024;
constexpr size_t WS_LSUM = 10 * MiB;
constexpr size_t WS_WIN = 434 * MiB;
constexpr size_t WS_WOUT = 468 * MiB;
constexpr size_t WS_FREE = 480 * MiB;
constexpr int NPAD_IN = 4352, NMLA = 1792, KMLA = 384;
constexpr int CW_QUEUE = 8192, CW_PROBEQ = 12288, CW_PROBE = 4000, CW_LCNT = 14336, CW_ATTQ = 15000;

#ifndef ATT_THR
#define ATT_THR 8
#endif

typedef unsigned short bf16_t;
__device__ __forceinline__ float bf2f(bf16_t v) { return __builtin_bit_cast(float, (unsigned)v << 16); }
typedef float f32x2_cv __attribute__((ext_vector_type(2)));
typedef __bf16 bf16x2_cv __attribute__((ext_vector_type(2)));
__device__ __forceinline__ unsigned f2bf2(float lo, float hi) { f32x2_cv v = {lo, hi}; bf16x2_cv b = __builtin_convertvector(v, bf16x2_cv); return __builtin_bit_cast(unsigned, b); }
__device__ __forceinline__ bf16_t f2bf(float f) { return (bf16_t)(f2bf2(f, f) & 0xffffu); }
template <int MASK> __device__ __forceinline__ float shx(float v) {
    static_assert(MASK < 32, "shx: within 32 lanes");
    return __builtin_bit_cast(float, __builtin_amdgcn_ds_swizzle(__builtin_bit_cast(int, v), (MASK << 10) | 0x1f));
}
__device__ __forceinline__ void swap32(float v, float& x, float& y) {
    auto rr = __builtin_amdgcn_permlane32_swap(__builtin_bit_cast(unsigned, v), __builtin_bit_cast(unsigned, v), false, false);
    unsigned a = rr[0], b = rr[1]; asm("" : "+v"(a), "+v"(b));
    x = __builtin_bit_cast(float, a); y = __builtin_bit_cast(float, b);
}
template <int CTRL> __device__ __forceinline__ float dppx(float v) { return __builtin_bit_cast(float, __builtin_amdgcn_mov_dpp(__builtin_bit_cast(int, v), CTRL, 0xf, 0xf, true)); }
__device__ __forceinline__ float sum8(float v) { v += dppx<0xB1>(v); v += dppx<0x4E>(v); v += dppx<0x141>(v); return v; }
__device__ __forceinline__ float wave_sum(float v) {
    v += dppx<0xB1>(v); v += dppx<0x4E>(v); v += dppx<0x141>(v); v += dppx<0x140>(v);
    v += shx<16>(v);
    float x, y; swap32(v, x, y);
    return x + y;
}
__device__ __forceinline__ float fexp(float x) { return __builtin_amdgcn_exp2f(x * 1.4426950408889634f); }
__device__ __forceinline__ float frcp(float x) { return __builtin_amdgcn_rcpf(x); }
__device__ __forceinline__ float sigmoidf_(float x) { return frcp(1.0f + fexp(-x)); }
__device__ __forceinline__ float softplusf_(float x) { return x > 20.f ? x : __builtin_amdgcn_logf(1.0f + fexp(x)) * 0.6931471805599453f; }
__device__ __forceinline__ float siluf_(float x) { return x * frcp(1.0f + fexp(-x)); }
__device__ __forceinline__ float ftanh(float x) { return 1.0f - 2.0f * frcp(1.0f + fexp(2.0f * x)); }
__device__ __forceinline__ float nexpm1(float x) { return x > -0.02f ? -x * (1.0f + x * (0.5f + x * 0.16666667f)) : 1.0f - fexp(x); }

__device__ __forceinline__ int otid() { int t = threadIdx.x; asm volatile("" : "+v"(t)); return t; }
template <int K> __device__ __forceinline__ const float* argp() {
    int k = K; asm volatile("" : "+s"(k));
    return (const float*)(((const unsigned long long*)__builtin_amdgcn_kernarg_segment_ptr())[k]);
}
#define ARG(k) argp<k>()
#define ARG_OUT ((float*)argp<28>())
#define ARG_WS ((unsigned char*)argp<29>())
#define DO_Q ((unsigned char*)argp<28>())
#define DO_RWP ((unsigned char*)argp<28>() + 48 * MiB)

#define XB_TMO      128
#define XB_XCNT(j)  (256  + 64 * (j))
#define XB_XSUB(j)  (1280 + 64 * (j))
#define XB_XGEN(j)  (2304 + 64 * (j))
#define XB_TOP      3328
#define XB_TOPGEN   3392
#define XCD_BAR_WORDS 3456
#define XB_SPIN_CAP (1u << 24)
#define LAS __attribute__((address_space(3)))

__device__ __forceinline__ unsigned xb_ld(unsigned* p)              { return __hip_atomic_load(p, __ATOMIC_RELAXED, __HIP_MEMORY_SCOPE_AGENT); }
__device__ __forceinline__ unsigned xb_add(unsigned* p, unsigned v) { return __hip_atomic_fetch_add(p, v, __ATOMIC_RELAXED, __HIP_MEMORY_SCOPE_AGENT); }
__device__ __forceinline__ unsigned xb_xcc_id() { return (unsigned)__builtin_amdgcn_s_getreg((3 << 11) | 20) & 0xFu; }
#define XB_SPIN(cond, bar) do { unsigned _sp = 0; while (cond) { __builtin_amdgcn_s_sleep(1); \
    if ((++_sp & 255u) == 0u) { if (xb_ld(&(bar)[XB_TMO])) break; if (_sp > XB_SPIN_CAP) { atomicAdd(&(bar)[XB_TMO], 1u); break; } } } } while (0)

struct XcdBarrier { unsigned* bar; unsigned x; volatile LAS unsigned* st; };

__device__ __forceinline__ XcdBarrier xcd_barrier_post(unsigned* bar, volatile LAS unsigned* st) {
    XcdBarrier b; b.bar = bar; b.x = xb_xcc_id(); b.st = st;
    if (threadIdx.x == 0) (void)xb_add(&bar[XB_XCNT(b.x)], 1u);
    return b;
}
__device__ __forceinline__ void xcd_barrier_complete(unsigned* bar, unsigned x, unsigned& nloc, unsigned& nx) {
    const unsigned G = gridDim.x * gridDim.y * gridDim.z;
    unsigned sum, cnt, mine, sp = 0u;
    for (;;) {
        sum = 0u; cnt = 0u; mine = 0u;
#pragma unroll
        for (unsigned j = 0; j < 16; ++j) { const unsigned c = xb_ld(&bar[XB_XCNT(j)]); sum += c; cnt += (c > 0u) ? 1u : 0u; mine = (j == x) ? c : mine; }
        if (sum == G) break;
        __builtin_amdgcn_s_sleep(1);
        if ((++sp & 255u) == 0u) { if (xb_ld(&bar[XB_TMO])) break; if (sp > XB_SPIN_CAP) { atomicAdd(&bar[XB_TMO], 1u); break; } }
    }
    nloc = mine > 0u ? mine : 1u; nx = cnt > 0u ? cnt : 1u;
}
__device__ __forceinline__ void xcd_barrier_raw(const XcdBarrier& b);
__device__ __forceinline__ void xcd_barrier(const XcdBarrier& b) {
#if PROBE == 30
    const unsigned long long t0_ = __builtin_amdgcn_s_memrealtime();
    xcd_barrier_raw(b);
    const unsigned long long t1_ = __builtin_amdgcn_s_memrealtime(), d_ = t1_ - t0_;
    while (__builtin_amdgcn_s_memrealtime() - t1_ < d_) __builtin_amdgcn_s_sleep(8);
    __syncthreads();
#else
    xcd_barrier_raw(b);
#endif
}
__device__ __forceinline__ void xcd_barrier_raw(const XcdBarrier& b) {
    asm volatile("s_waitcnt vmcnt(0)" ::: "memory");
    __syncthreads();
    if (threadIdx.x == 0) {
        unsigned* bar = b.bar;
        __builtin_amdgcn_s_waitcnt(0);
        const unsigned bx = (unsigned)__builtin_amdgcn_readfirstlane((int)xb_xcc_id());
        unsigned nloc = b.st[0], nx = b.st[1];
        if (nloc == 0u) { xcd_barrier_complete(bar, bx, nloc, nx); b.st[0] = nloc; b.st[1] = nx; }
        const unsigned old = xb_add(&bar[XB_XSUB(bx)], 1u);
        const unsigned gen = old / nloc;
        if (old + 1u == (gen + 1u) * nloc) {
            __builtin_amdgcn_fence(__ATOMIC_RELEASE, "agent");
            asm volatile("s_waitcnt vmcnt(0)" ::: "memory");
            const unsigned og = xb_add(&bar[XB_TOP], 1u);
            const unsigned tg = og / nx;
            if (og + 1u == (tg + 1u) * nx) xb_add(&bar[XB_TOPGEN], 1u);
            else XB_SPIN(xb_ld(&bar[XB_TOPGEN]) == tg, bar);
            __builtin_amdgcn_fence(__ATOMIC_ACQUIRE, "agent");
            xb_add(&bar[XB_XGEN(bx)], 1u);
            asm volatile("s_waitcnt vmcnt(0)" ::: "memory");
        } else {
            XB_SPIN(xb_ld(&bar[XB_XGEN(bx)]) == gen, bar);
            __builtin_amdgcn_fence(__ATOMIC_ACQUIRE, "agent");
            asm volatile("s_waitcnt vmcnt(0)" ::: "memory");
        }
    }
    __syncthreads();
}

struct Args {
    const float* in[28];
    float* out;
    unsigned char* ws;
};

namespace pg8 {
#define PG8_LAS __attribute__((address_space(3)))
typedef unsigned short bf16_t;
typedef short bf16x8 __attribute__((ext_vector_type(8)));
typedef float f32x4 __attribute__((ext_vector_type(4)));
typedef unsigned u32x4 __attribute__((ext_vector_type(4)));
constexpr int BM = 256, BK = 64, HALF = 128, HTB = HALF * BK * 2  , STAGE_BYTES = 8 * HTB, NXCD = 8, WGM = 8;

__host__ __device__ __forceinline__ int lds_byte(int r, int c) { const int st = (r >> 4) * 2 + (c >> 5), rr = r & 15, cc = c & 31, ob = rr * 64 + cc * 2; return st * 1024 + (ob ^ (((ob >> 9) & 1) << 5)); }
__host__ __device__ __forceinline__ void stage_rc(int b, int& R, int& C) { const int st = b / 1024, sb = b % 1024, swz = sb ^ (((sb >> 9) & 1) << 5); R = (st >> 1) * 16 + swz / 64; C = (st & 1) * 32 + (swz % 64) / 2; }
__host__ __device__ __forceinline__ int perm32(int rho) { const int n = rho >> 4, i = rho & 15; return 8 * (i >> 2) + 4 * n + (i & 3); }

struct Unit { int pm, pn; };
struct Gemm { const bf16_t* A; const bf16_t* Bt; int M, N, K, lda, ldb; int a_split_pn; int a_split_off; };

struct StaticOrder {
    int nM, nN, nwg, G, c;
    __host__ __device__ void init(int M, int N, int G_, int c_) { nM = M / BM; nN = N / BM; nwg = nM * nN; G = G_; c = c_; }
    __host__ __device__ bool next(int i, Unit& u) const {
        const long L = (long)i * G + c; if (L >= nwg) return false;
        int wgid = (int)L; { const int q = nwg / NXCD, r = nwg % NXCD, xcd = wgid % NXCD, off = wgid / NXCD; wgid = (xcd < r ? xcd * (q + 1) : r * (q + 1) + (xcd - r) * q) + off; }
        const int nig = WGM * nN, gid = wgid / nig, fm = gid * WGM, gsz = (nM - fm) < WGM ? (nM - fm) : WGM;
        u.pm = fm + ((wgid % nig) % gsz); u.pn = (wgid % nig) / gsz; return true;
    }
    __device__ __forceinline__ void a_ready(const Unit&, int) const {}
    __device__ __forceinline__ void done(const Unit&) const {}
};

template <int NP>
struct RowScaleOrder : StaticOrder {
    const float* part; float inv_dim; PG8_LAS float* tab;
    __device__ __forceinline__ void a_ready(const Unit& u, int seq) const {
        const int t = otid();
        if (t < 256) {
            const float* p = part + (size_t)(u.pm * BM + t) * NP;
            float sm = 0.f;
#pragma unroll
            for (int k = 0; k < NP; k += 4) { const f32x4 v = *(const f32x4*)(p + k); sm += (v[0] + v[1]) + (v[2] + v[3]); }
            tab[(seq & 1) * 256 + t] = rsqrtf(sm * inv_dim + 1e-6f);
        }
    }
};

struct MlaOrder : StaticOrder {
    const float* sqq; const float* sqkv; PG8_LAS float* tab;
    __device__ __forceinline__ void a_ready(const Unit& u, int seq) const {
        const int t = otid();
        if (t < 256) {
            const size_t row = (size_t)(u.pm * BM + t);
            const f32x4 q0 = *(const f32x4*)(sqq + row * 8), q1 = *(const f32x4*)(sqq + row * 8 + 4), k0 = *(const f32x4*)(sqkv + row * 4);
            tab[((seq & 1) * 256 + t) * 2] = rsqrtf((((q0[0] + q0[1]) + (q0[2] + q0[3])) + ((q1[0] + q1[1]) + (q1[2] + q1[3]))) * (1.0f / QL) + 1e-6f);
            tab[((seq & 1) * 256 + t) * 2 + 1] = rsqrtf(((k0[0] + k0[1]) + (k0[2] + k0[3])) * (1.0f / KVL) + 1e-6f);
        }
    }
};

__device__ __forceinline__ unsigned cvt_pk_bf16(float lo, float hi) { unsigned r; asm volatile("v_cvt_pk_bf16_f32 %0, %1, %2" : "=v"(r) : "v"(lo), "v"(hi)); return r; }
template <class Epi, class Sched, bool ALIGN_EPI = false, bool SP2 = false>
__device__ __forceinline__ void gemm_phase(PG8_LAS unsigned char* lds, const Gemm g, const Sched& S, const Epi& E) {
    const int tid = otid(), wid = __builtin_amdgcn_readfirstlane(tid >> 6), lane = tid & 63, wr = wid >> 2, wc = wid & 3, fr = lane & 15, fq = lane >> 4;
    const int K = g.K, nt = K / BK;
    unsigned voffA[2], voffB[2];
#pragma unroll
    for (int i = 0; i < 2; ++i) { int R, C; stage_rc(tid * 16 + i * 8192, R, C); const int Rb = Epi::PERM ? ((R & ~31) + perm32(R & 31)) : R;
        voffA[i] = (unsigned)(R * g.lda + C) * 2u; voffB[i] = (unsigned)(Rb * g.ldb + C) * 2u; }
    const size_t kstep = (size_t)(BK * 2);
    const size_t hstepA = (size_t)HALF * g.lda * 2, hstepB = (size_t)HALF * g.ldb * 2;
    const size_t tstepA = 2 * hstepA, tstepB = 2 * hstepB;
    const unsigned ldsw = (unsigned)wid * 1024u;
    const int aoff = lds_byte(wr * 64 + fr, fq * 8), boff = lds_byte(wc * 32 + fr, fq * 8);
#define PG8_SA(b, h) (((b) * 2 + (h)) * HTB)
#define PG8_SB(b, h) ((4 + (b) * 2 + (h)) * HTB)
#define PG8_STAGE(bufoff, gbase, voff) do { _Pragma("unroll") for (int _i = 0; _i < 2; ++_i) \
        __builtin_amdgcn_global_load_lds((const unsigned*)((const char*)(gbase) + (voff)[_i]), (PG8_LAS unsigned*)(lds + (bufoff) + ldsw + _i * 8192), 16, 0, 0); } while (0)
#define PG8_LDA(dst, b, h) do { _Pragma("unroll") for (int m = 0; m < 4; ++m) _Pragma("unroll") for (int k = 0; k < 2; ++k) dst[m][k] = *(const PG8_LAS bf16x8*)(lds + PG8_SA(b, h) + aoff + m * 2048 + k * 1024); } while (0)
#define PG8_LDB(dst, b, h) do { _Pragma("unroll") for (int n = 0; n < 2; ++n) _Pragma("unroll") for (int k = 0; k < 2; ++k) dst[n][k] = *(const PG8_LAS bf16x8*)(lds + PG8_SB(b, h) + boff + n * 2048 + k * 1024); } while (0)
#define PG8_MMA(ai, bj, At, Bt) do { __builtin_amdgcn_s_setprio(1); _Pragma("unroll") for (int m = 0; m < 4; ++m) _Pragma("unroll") for (int n = 0; n < 2; ++n) _Pragma("unroll") for (int k = 0; k < 2; ++k) \
        acc[ai][bj][m][n] = __builtin_amdgcn_mfma_f32_16x16x32_bf16(Bt[n][k], At[m][k], acc[ai][bj][m][n], 0, 0, 0); __builtin_amdgcn_s_setprio(0); } while (0)
#define PG8_WAIT_V(n) asm volatile("s_waitcnt vmcnt(" #n ")" ::: "memory")
#define PG8_WAIT_L(n) asm volatile("s_waitcnt lgkmcnt(" #n ")" ::: "memory")
#define PG8_BAR __builtin_amdgcn_s_barrier()
#define PG8_SCHED __builtin_amdgcn_sched_barrier(0)
    Unit cur, nxt; int ui = 0;
    if (!S.next(0, cur)) return;
    f32x4 acc[2][2][4][2];
#pragma unroll
    for (int a = 0; a < 2; ++a)
#pragma unroll
        for (int b = 0; b < 2; ++b)
#pragma unroll
            for (int m = 0; m < 4; ++m)
#pragma unroll
                for (int n = 0; n < 2; ++n) acc[a][b][m][n] = (f32x4){0.f, 0.f, 0.f, 0.f};
    bf16x8 At[4][2], B0[2][2], B1[2][2];
    const char* cA = (const char*)g.A + (size_t)cur.pm * tstepA + (cur.pn >= g.a_split_pn ? g.a_split_off : 0); const char* cB = (const char*)g.Bt + (size_t)cur.pn * tstepB;
    S.a_ready(cur, 0);
    if constexpr (SP2) {
        PG8_STAGE(PG8_SB(0, 0), cB, voffB); PG8_STAGE(PG8_SB(0, 1), cB + hstepB, voffB); PG8_STAGE(PG8_SA(0, 0), cA, voffA); PG8_STAGE(PG8_SA(0, 1), cA + hstepA, voffA);
        if (wr == 1) PG8_BAR;
        PG8_WAIT_V(2); PG8_BAR;
        PG8_STAGE(PG8_SB(1, 0), cB + kstep, voffB); PG8_STAGE(PG8_SA(1, 0), cA + kstep, voffA); PG8_STAGE(PG8_SB(1, 1), cB + hstepB + kstep, voffB);
        PG8_WAIT_V(6); PG8_BAR;
    } else {
        PG8_STAGE(PG8_SB(0, 0), cB, voffB); PG8_STAGE(PG8_SA(0, 0), cA, voffA); PG8_STAGE(PG8_SB(0, 1), cB + hstepB, voffB); PG8_STAGE(PG8_SA(0, 1), cA + hstepA, voffA);
        if (wr == 1) PG8_BAR;
        PG8_WAIT_V(4); PG8_BAR;
        PG8_STAGE(PG8_SB(1, 0), cB + kstep, voffB); PG8_STAGE(PG8_SA(1, 0), cA + kstep, voffA); PG8_STAGE(PG8_SB(1, 1), cB + hstepB + kstep, voffB);
        PG8_WAIT_V(6); PG8_BAR;
    }
    for (;;) {
        const bool has_next = S.next(ui + 1, nxt);
        const char* nA = has_next ? (const char*)g.A + (size_t)nxt.pm * tstepA + (nxt.pn >= g.a_split_pn ? g.a_split_off : 0) : cA; const char* nB = has_next ? (const char*)g.Bt + (size_t)nxt.pn * tstepB : cB;
        for (int t = 0; t < nt; t += 2) {
            const bool last = (t == nt - 2);
            const char* a1 = cA + (size_t)(t + 1) * kstep;
            const char* a2 = last ? nA : cA + (size_t)(t + 2) * kstep; const char* b2 = last ? nB : cB + (size_t)(t + 2) * kstep;
            const char* a3 = a2 + kstep; const char* b3 = b2 + kstep;
            if (last && has_next) S.a_ready(nxt, ui + 1);
            if constexpr (SP2) {
            PG8_LDB(B0, 0, 0); PG8_LDB(B1, 0, 1); PG8_SCHED; PG8_LDA(At, 0, 0); PG8_STAGE(PG8_SA(1, 1), a1 + hstepA, voffA);
            PG8_WAIT_V(8); PG8_WAIT_L(0); PG8_BAR; PG8_MMA(0, 0, At, B0); PG8_MMA(0, 1, At, B1); PG8_BAR; PG8_SCHED;
            PG8_LDA(At, 0, 1); PG8_STAGE(PG8_SB(0, 0), b2, voffB); PG8_STAGE(PG8_SB(0, 1), b2 + hstepB, voffB); PG8_STAGE(PG8_SA(0, 0), a2, voffA);
            PG8_WAIT_V(8); PG8_WAIT_L(0); PG8_BAR; PG8_MMA(1, 0, At, B0); PG8_MMA(1, 1, At, B1); PG8_BAR; PG8_SCHED;
            PG8_LDB(B0, 1, 0); PG8_LDB(B1, 1, 1); PG8_SCHED; PG8_LDA(At, 1, 0); PG8_STAGE(PG8_SA(0, 1), a2 + hstepA, voffA);
            PG8_WAIT_V(8); PG8_WAIT_L(0); PG8_BAR; PG8_MMA(0, 0, At, B0); PG8_MMA(0, 1, At, B1); PG8_BAR; PG8_SCHED;
            PG8_LDA(At, 1, 1); PG8_STAGE(PG8_SB(1, 0), b3, voffB); PG8_STAGE(PG8_SB(1, 1), b3 + hstepB, voffB); PG8_STAGE(PG8_SA(1, 0), a3, voffA);
            PG8_WAIT_V(8); PG8_WAIT_L(0); PG8_BAR; PG8_MMA(1, 0, At, B0); PG8_MMA(1, 1, At, B1); PG8_BAR; PG8_SCHED;
            } else {
            PG8_LDB(B0, 0, 0); PG8_SCHED; PG8_LDA(At, 0, 0); PG8_STAGE(PG8_SA(1, 1), a1 + hstepA, voffA);
            PG8_WAIT_L(8); PG8_BAR; PG8_WAIT_L(0); PG8_MMA(0, 0, At, B0); PG8_BAR; PG8_SCHED;
            PG8_LDB(B1, 0, 1); PG8_STAGE(PG8_SB(0, 0), b2, voffB);
            PG8_BAR; PG8_WAIT_L(0); PG8_MMA(0, 1, At, B1); PG8_BAR;
            PG8_LDA(At, 0, 1); PG8_STAGE(PG8_SA(0, 0), a2, voffA);
            PG8_BAR; PG8_WAIT_L(0); PG8_MMA(1, 0, At, B0); PG8_BAR; PG8_SCHED;
            PG8_STAGE(PG8_SB(0, 1), b2 + hstepB, voffB);
            PG8_WAIT_V(6); PG8_BAR; PG8_MMA(1, 1, At, B1); PG8_BAR;
            PG8_LDB(B0, 1, 0); PG8_SCHED; PG8_LDA(At, 1, 0); PG8_STAGE(PG8_SA(0, 1), a2 + hstepA, voffA);
            PG8_WAIT_L(8); PG8_BAR; PG8_WAIT_L(0); PG8_MMA(0, 0, At, B0); PG8_BAR; PG8_SCHED;
            PG8_LDB(B1, 1, 1); PG8_STAGE(PG8_SB(1, 0), b3, voffB);
            PG8_BAR; PG8_WAIT_L(0); PG8_MMA(0, 1, At, B1); PG8_BAR;
            PG8_LDA(At, 1, 1); PG8_STAGE(PG8_SA(1, 0), a3, voffA);
            PG8_BAR; PG8_WAIT_L(0); PG8_MMA(1, 0, At, B0); PG8_BAR; PG8_SCHED;
            PG8_STAGE(PG8_SB(1, 1), b3 + hstepB, voffB);
            PG8_WAIT_V(6); PG8_BAR; PG8_MMA(1, 1, At, B1); PG8_BAR;
            }
        }
        if constexpr (ALIGN_EPI) { if (wr == 0) PG8_BAR; }
        if constexpr (!Epi::AFTER_DRAIN) { E(acc, cur, wr, wc, fr, fq, ui); S.done(cur); }
        if (!has_next) break;
#pragma unroll
        for (int a = 0; a < 2; ++a)
#pragma unroll
            for (int b = 0; b < 2; ++b)
#pragma unroll
                for (int m = 0; m < 4; ++m)
#pragma unroll
                    for (int n = 0; n < 2; ++n) acc[a][b][m][n] = (f32x4){0.f, 0.f, 0.f, 0.f};
        cur = nxt; cA = nA; cB = nB; ++ui;
        if constexpr (ALIGN_EPI) { if (wr == 1) PG8_BAR; }
    }
    PG8_WAIT_V(0);
    if constexpr (!ALIGN_EPI) { if (wr == 0) PG8_BAR; }
    PG8_BAR;
    if constexpr (Epi::AFTER_DRAIN) { E.fused(acc, cur, wr, wc, fr, fq, lds, wid, lane); S.done(cur); }
#undef PG8_SA
#undef PG8_SB
#undef PG8_STAGE
#undef PG8_LDA
#undef PG8_LDB
#undef PG8_MMA
#undef PG8_WAIT_V
#undef PG8_WAIT_L
#undef PG8_BAR
#undef PG8_SCHED
}
}

namespace pg8 {
struct EpiProj {
    static constexpr bool PERM = true, AFTER_DRAIN = false;
    bf16_t* O; int ldc; int ncols; const PG8_LAS float* tab; float* sqq; float* sqkv; bf16_t* Kb; const float* rope; bf16_t* sav;
    __device__ __forceinline__ void operator()(const f32x4 (&acc)[2][2][4][2], const Unit& u, int wr, int wc, int fr, int fq, int seq) const {
        const int row0 = u.pm * BM + wr * 64 + fr, col0 = u.pn * BM + wc * 32 + 8 * fq;
        const int lane_hi = (fq >> 1);
#pragma unroll
        for (int ai = 0; ai < 2; ++ai)
#pragma unroll
            for (int m = 0; m < 4; ++m) {
                const int row = row0 + ai * HALF + m * 16;
                const float rs = tab[(seq & 1) * 256 + wr * 64 + fr + ai * HALF + m * 16];
                bf16_t* rowp = O + (size_t)row * ldc + col0;
#pragma unroll
                for (int bj = 0; bj < 2; ++bj) {
                    const f32x4 v0 = acc[ai][bj][m][0] * rs, v1 = acc[ai][bj][m][1] * rs;
                    u32x4 w; w.x = cvt_pk_bf16(v0[0], v0[1]); w.y = cvt_pk_bf16(v0[2], v0[3]); w.z = cvt_pk_bf16(v1[0], v1[1]); w.w = cvt_pk_bf16(v1[2], v1[3]);
                    const int col = col0 + bj * HALF;
                    if (col < ncols) *(u32x4*)(rowp + bj * HALF) = w;
                    if (u.pn <= 6 && m == 3 && fr == 15 && col < 1664) {
                        const int t = row & (SEQ - 1), cn = (t >> 6) + 1;
                        if (cn < 64) *(u32x4*)(sav + ((size_t)(row >> 12) * 64 + cn) * 1664 + col) = w;
                    }
                    const bool isq = (u.pn == 8 && bj == 1) || (u.pn == 9 && bj == 0), iskv = (u.pn == 9 && bj == 1);
                    if (isq || iskv) {
                        float ss = (v0[0] * v0[0] + v0[1] * v0[1]) + (v0[2] * v0[2] + v0[3] * v0[3]) + (v1[0] * v1[0] + v1[1] * v1[1]) + (v1[2] * v1[2] + v1[3] * v1[3]);
                        ss += shx<16>(ss); { float x, y; swap32(ss, x, y); ss = x + y; }
                        if (fq == 0) { if (iskv) sqkv[(size_t)row * 4 + wc] = ss; else sqq[(size_t)row * 8 + (u.pn == 8 ? 0 : 4) + wc] = ss; }
                    }
                    if (u.pn == 10 && bj == 0 && wc == 0) {
                        const int t = row & (SEQ - 1);
                        const float* rp = rope + ((size_t)t * 16 + 8 * (fq & 1)) * 2;
                        const f32x4 c0 = *(const f32x4*)rp, c1 = *(const f32x4*)(rp + 4), c2 = *(const f32x4*)(rp + 8), c3 = *(const f32x4*)(rp + 12);
                        const float cs[8] = {c0[0], c0[2], c1[0], c1[2], c2[0], c2[2], c3[0], c3[2]}, sn[8] = {c0[1], c0[3], c1[1], c1[3], c2[1], c2[3], c3[1], c3[3]};
                        const float own[8] = {v0[0], v0[1], v0[2], v0[3], v1[0], v1[1], v1[2], v1[3]};
                        float o[8];
#pragma unroll
                        for (int e = 0; e < 8; ++e) { float x, y; swap32(own[e], x, y); const float oth = lane_hi ? x : y;
                            o[e] = lane_hi ? (oth * sn[e] + own[e] * cs[e]) : (own[e] * cs[e] - oth * sn[e]); }
                        u32x4 kw; kw.x = cvt_pk_bf16(o[0], o[1]); kw.y = cvt_pk_bf16(o[2], o[3]); kw.z = cvt_pk_bf16(o[4], o[5]); kw.w = cvt_pk_bf16(o[6], o[7]);
#pragma unroll
                        for (int hh = 0; hh < 8; ++hh) *(u32x4*)(Kb + ((size_t)row * 8 + hh) * 96 + 64 + 8 * fq) = kw;
                    }
                }
                asm volatile("" ::: "memory");
            }
    }
};
struct EpiResid {
    static constexpr bool PERM = true, AFTER_DRAIN = false;
    int ldc; bool dry; bf16_t* HB; float* ssq;
    __device__ __forceinline__ void operator()(const f32x4 (&acc)[2][2][4][2], const Unit& u, int wr, int wc, int fr, int fq, int seq) const {
        const int row0 = u.pm * BM + wr * 64 + fr, col0 = u.pn * BM + wc * 32 + 8 * fq;
#pragma unroll
        for (int ai = 0; ai < 2; ++ai) {
            u32x4 rv[4][2];
#pragma unroll
            for (int m = 0; m < 4; ++m)
#pragma unroll
                for (int bj = 0; bj < 2; ++bj) rv[m][bj] = *(const u32x4*)(HB + (size_t)(row0 + ai * HALF + m * 16) * ldc + col0 + bj * HALF);
#pragma unroll
            for (int m = 0; m < 4; ++m) { const int row = row0 + ai * HALF + m * 16; const size_t off = (size_t)row * ldc + col0;
                float ss = 0.f;
#pragma unroll
                for (int bj = 0; bj < 2; ++bj) { const u32x4 r = rv[m][bj]; f32x4 o0 = acc[ai][bj][m][0], o1 = acc[ai][bj][m][1];
                    o0[0] += __uint_as_float(r.x << 16); o0[1] += __uint_as_float(r.x & 0xffff0000u); o0[2] += __uint_as_float(r.y << 16); o0[3] += __uint_as_float(r.y & 0xffff0000u);
                    o1[0] += __uint_as_float(r.z << 16); o1[1] += __uint_as_float(r.z & 0xffff0000u); o1[2] += __uint_as_float(r.w << 16); o1[3] += __uint_as_float(r.w & 0xffff0000u);
                    ss += ((o0[0] * o0[0] + o0[1] * o0[1]) + (o0[2] * o0[2] + o0[3] * o0[3])) + ((o1[0] * o1[0] + o1[1] * o1[1]) + (o1[2] * o1[2] + o1[3] * o1[3]));
                    u32x4 hb; hb.x = cvt_pk_bf16(o0[0], o0[1]); hb.y = cvt_pk_bf16(o0[2], o0[3]); hb.z = cvt_pk_bf16(o1[0], o1[1]); hb.w = cvt_pk_bf16(o1[2], o1[3]);
                    if (!dry) *(u32x4*)(HB + off + bj * HALF) = hb; }
                ss += shx<16>(ss); { float x, y; swap32(ss, x, y); ss = x + y; }
                if (fq == 0 && !dry) ssq[(size_t)row * 16 + u.pn * 4 + wc] = ss;
            }
        }
    }
};
struct EpiMla {
    static constexpr bool PERM = true, AFTER_DRAIN = false;
    bf16_t* Q; bf16_t* K; bf16_t* V; const PG8_LAS float* tab; const float* rope; float c2; int pn0;
    __device__ __forceinline__ void operator()(const f32x4 (&acc)[2][2][4][2], const Unit& u, int wr, int wc, int fr, int fq, int seq) const {
        const int row0 = u.pm * BM + wr * 64 + fr;
        const int lane_hi = (fq >> 1);
#pragma unroll
        for (int ai = 0; ai < 2; ++ai)
#pragma unroll
            for (int m = 0; m < 4; ++m) {
                const int row = row0 + ai * HALF + m * 16;
                const int rl = wr * 64 + fr + ai * HALF + m * 16;
                const float rq = tab[((seq & 1) * 256 + rl) * 2], rk = tab[((seq & 1) * 256 + rl) * 2 + 1];
#pragma unroll
                for (int bj = 0; bj < 2; ++bj) {
                    const int pn = u.pn + pn0; const int cg = pn * BM + bj * HALF + wc * 32;
                    f32x4 v0 = acc[ai][bj][m][0], v1 = acc[ai][bj][m][1];
                    if (pn < 3) {
                        v0 = v0 * rq; v1 = v1 * rq;
                        if (((cg >> 5) % 3) == 2) {
                            const int t = row & (SEQ - 1);
                            const float* rp = rope + ((size_t)t * 16 + 8 * (fq & 1)) * 2;
                            const f32x4 c0 = *(const f32x4*)rp, c1 = *(const f32x4*)(rp + 4), c2_ = *(const f32x4*)(rp + 8), c3 = *(const f32x4*)(rp + 12);
                            const float cs[8] = {c0[0], c0[2], c1[0], c1[2], c2_[0], c2_[2], c3[0], c3[2]}, sn[8] = {c0[1], c0[3], c1[1], c1[3], c2_[1], c2_[3], c3[1], c3[3]};
                            const float own[8] = {v0[0], v0[1], v0[2], v0[3], v1[0], v1[1], v1[2], v1[3]};
                            float o[8];
#pragma unroll
                            for (int e = 0; e < 8; ++e) { float x, y; swap32(own[e], x, y); const float oth = lane_hi ? x : y;
                                o[e] = lane_hi ? (oth * sn[e] + own[e] * cs[e]) : (own[e] * cs[e] - oth * sn[e]); }
                            v0 = (f32x4){o[0], o[1], o[2], o[3]}; v1 = (f32x4){o[4], o[5], o[6], o[7]};
                        }
                        v0 = v0 * c2; v1 = v1 * c2;
                        u32x4 w; w.x = cvt_pk_bf16(v0[0], v0[1]); w.y = cvt_pk_bf16(v0[2], v0[3]); w.z = cvt_pk_bf16(v1[0], v1[1]); w.w = cvt_pk_bf16(v1[2], v1[3]);
                        *(u32x4*)(Q + (size_t)row * 768 + cg + 8 * fq) = w;
                    } else {
                        v0 = v0 * rk; v1 = v1 * rk;
                        const int c = cg - 768, hh = c >> 7, d = (c & 127) + 8 * fq;
                        u32x4 w; w.x = cvt_pk_bf16(v0[0], v0[1]); w.y = cvt_pk_bf16(v0[2], v0[3]); w.z = cvt_pk_bf16(v1[0], v1[1]); w.w = cvt_pk_bf16(v1[2], v1[3]);
                        bf16_t* p = (d < 64) ? K + ((size_t)row * 8 + hh) * 96 + d : V + ((size_t)row * 8 + hh) * 64 + (d - 64);
                        *(u32x4*)p = w;
                    }
                }
                asm volatile("" ::: "memory");
            }
    }
};
}

typedef float f32x4_t __attribute__((ext_vector_type(4)));
typedef unsigned u32x4_t __attribute__((ext_vector_type(4)));
template <class SRC4>
__device__ __forceinline__ void transpose_w(int K, int npad, bf16_t* WT, const SRC4& src4, float* lds) {
    const int tid = otid();
    const int tk = K / 64, tn = npad / 64;
    const int kk = tid >> 4, n4 = (tid & 15) * 4;
    const int nn = tid >> 3, k8 = (tid & 7) * 8;
    int par = 0;
    __syncthreads();
    for (int u = blockIdx.x; u < tk * tn; u += gridDim.x, par ^= 1) {
        const int k0 = (u % tk) * 64, n0 = (u / tk) * 64;
        float* tile = lds + par * (64 * 65);
        const f32x4_t v0 = src4(k0 + kk, n0 + n4), v1 = src4(k0 + kk + 32, n0 + n4);
#pragma unroll
        for (int e = 0; e < 4; ++e) { tile[kk * 65 + n4 + e] = v0[e]; tile[(kk + 32) * 65 + n4 + e] = v1[e]; }
        __syncthreads();
        u32x4_t w;
        w.x = f2bf2(tile[(k8 + 0) * 65 + nn], tile[(k8 + 1) * 65 + nn]); w.y = f2bf2(tile[(k8 + 2) * 65 + nn], tile[(k8 + 3) * 65 + nn]);
        w.z = f2bf2(tile[(k8 + 4) * 65 + nn], tile[(k8 + 5) * 65 + nn]); w.w = f2bf2(tile[(k8 + 6) * 65 + nn], tile[(k8 + 7) * 65 + nn]);
        *(u32x4_t*)(WT + (size_t)(n0 + nn) * K + k0 + k8) = w;
    }
}

template <class AL, class BL, class ST>
__device__ __forceinline__ void gemm_naive(int M, int N, int K, const AL& al, const BL& bl, const ST& st, float* lds) {
    float* As = lds;
    float* Bs = lds + 16 * 132;
    const int tid = otid(), ty = tid >> 4, tx = tid & 15;
    const int ntn = (N + 127) / 128, ntiles = (M / 128) * ntn;
    for (int u = blockIdx.x; u < ntiles; u += gridDim.x) {
        const int tm = u / ntn, tn = u % ntn;
        float acc[4][8];
#pragma unroll
        for (int i = 0; i < 4; ++i)
#pragma unroll
            for (int j = 0; j < 8; ++j) acc[i][j] = 0.f;
        for (int k0 = 0; k0 < K; k0 += 16) {
#pragma unroll
            for (int j = 0; j < 4; ++j) { const int idx = tid + j * 512, r = idx >> 4, k = idx & 15; As[k * 132 + r] = al(tm * 128 + r, k0 + k); }
#pragma unroll
            for (int j = 0; j < 4; ++j) { const int idx = tid + j * 512, k = idx >> 7, c = idx & 127; Bs[k * 132 + c] = bl(k0 + k, tn * 128 + c); }
            __syncthreads();
#pragma unroll 2
            for (int k = 0; k < 16; ++k) {
                const float4 a4 = *(const float4*)&As[k * 132 + ty * 4];
                const float4 b0 = *(const float4*)&Bs[k * 132 + tx * 8], b1 = *(const float4*)&Bs[k * 132 + tx * 8 + 4];
                const float av[4] = {a4.x, a4.y, a4.z, a4.w};
                const float bv[8] = {b0.x, b0.y, b0.z, b0.w, b1.x, b1.y, b1.z, b1.w};
#pragma unroll
                for (int i = 0; i < 4; ++i)
#pragma unroll
                    for (int j = 0; j < 8; ++j) acc[i][j] = fmaf(av[i], bv[j], acc[i][j]);
            }
            __syncthreads();
        }
#pragma unroll
        for (int i = 0; i < 4; ++i)
#pragma unroll
            for (int j = 0; j < 8; ++j) st(tm * 128 + ty * 4 + i, tn * 128 + tx * 8 + j, acc[i][j]);
    }
}

namespace rw {
typedef short bf16x8 __attribute__((ext_vector_type(8)));
typedef float f32x16 __attribute__((ext_vector_type(16)));
typedef float f32x4 __attribute__((ext_vector_type(4)));
typedef unsigned u32x2 __attribute__((ext_vector_type(2)));
typedef unsigned u32x4 __attribute__((ext_vector_type(4)));
constexpr int PB = 144, MB = 64 * PB;
constexpr int L_KKD = 0, L_RD = MB, L_BH = 2 * MB, L_KH = 3 * MB, L_BDT = 4 * MB, L_KDT = 5 * MB, L_VT = 6 * MB, L_KKDT = 7 * MB, L_BK = 8 * MB, L_WTT = 9 * MB, L_VTT = 10 * MB;
constexpr int L_AB = L_KKD, L_AK = L_BH, L_BB = L_KH, L_XWL = L_BK, L_XAL = L_WTT;
constexpr int L_F32 = 11 * MB;
constexpr int L_DEC = L_F32, L_AA = L_F32 + 17408, L_AKVT = L_F32, L_DIAG = L_F32 + 17408, L_TINV = L_DIAG + 4096;
constexpr int L_GC = L_F32 + 34816, L_SEG = L_GC + 256, L_END = L_SEG + 2048;
__device__ __forceinline__ int crow(int r, int hi) { return (r & 3) + 8 * (r >> 2) + 4 * hi; }
__device__ __forceinline__ unsigned pk2(float lo, float hi) { return f2bf2(lo, hi); }
#define RW_FRAG(base, row, ks) (*(const LAS bf16x8*)(shm + (base) + (row) * PB + (16 * (ks) + 8 * hi) * 2))
#define RW_MFMA(a, b, c) __builtin_amdgcn_mfma_f32_32x32x16_bf16(a, b, c, 0, 0, 0)

struct R1Raw { bf16_t q[5][9]; };
__device__ __forceinline__ void r1_load(R1Raw& r, const bf16_t* PROJ, const bf16_t* sava, int b, int h, int c, int tq, int lane) {
    const unsigned row0 = (unsigned)b * SEQ + (unsigned)c * 64;
    const __amdgpu_buffer_rsrc_t rs = __builtin_amdgcn_make_buffer_rsrc((void*)PROJ, 0, 0x7fffffff, 0x00020000);
    const int cols[5] = {C_R + h * 64 + lane, C_K + h * 64 + lane, C_V + h * 64 + lane, C_WL + lane, C_AL + lane};
    const unsigned rb = (unsigned)__builtin_amdgcn_readfirstlane((int)((row0 + (unsigned)tq) * (unsigned)(DIN * 2)));
    if (tq == 0) {
        const bf16_t* sav = sava + ((size_t)b * 64 + c) * 1664;
#pragma unroll
        for (int k = 0; k < 5; ++k) r.q[k][0] = (c > 0) ? sav[cols[k]] : (bf16_t)0;
    } else {
#pragma unroll
        for (int k = 0; k < 5; ++k) r.q[k][0] = (bf16_t)__builtin_amdgcn_raw_buffer_load_b16(rs, cols[k] * 2, rb - (unsigned)(DIN * 2), 0);
    }
#pragma unroll
    for (int k = 0; k < 5; ++k)
#pragma unroll
        for (int e = 0; e < 8; ++e) r.q[k][e + 1] = (bf16_t)__builtin_amdgcn_raw_buffer_load_b16(rs, cols[k] * 2, rb + (unsigned)(e * DIN * 2), 0);
}
__device__ __forceinline__ void r1_phase(int l, LAS char* shm, const bool dry = false) {
    const int tid0 = otid(), lane_o = tid0 & 63, r32o = lane_o & 31, hio = lane_o >> 5;
    const int wid = __builtin_amdgcn_readfirstlane(tid0 >> 6);
    bf16_t* PROJ = (bf16_t*)(ARG_WS + WS_PROJ);
    const bf16_t* sava = (const bf16_t*)(ARG_WS + WS_SAVA);
    const int h = blockIdx.x & 7, jw = blockIdx.x >> 3, nper = gridDim.x >> 3;
    const int ch = h * 64 + lane_o;
    const int tq = wid * 8;
    const float* mu = ARG(3) + (size_t)l * 1664;
    const float mu5[5] = {mu[C_R + ch], mu[C_K + ch], mu[C_V + ch], mu[C_WL + lane_o], mu[C_AL + lane_o]};
    const float kkc = (ARG(8) + (size_t)l * 512)[ch], kac = (ARG(9) + (size_t)l * 512)[ch], rkc = (ARG(10) + (size_t)l * 512)[ch];
    const int pB = wid >> 2, tlB = wid & 3, trB = 32 * (tlB >> 1), ncB = 32 * (tlB & 1);
    const float biasB = ((pB ? ARG(6) : ARG(4)) + (size_t)l * 512)[h * 64 + ncB + r32o];
    R1Raw cur, nxt;
    if (jw < 512) r1_load(cur, PROJ, sava, jw >> 6, h, jw & 63, tq, lane_o);
    for (int idx = jw; idx < 512; idx += nper) {
    const int tidl = otid(), lanel = tidl & 63, r32 = lanel & 31, hi = lanel >> 5;
    (void)hio;
    const int lane = lanel;
    const int b = idx >> 6, c = idx & 63;
    const size_t row0 = (size_t)b * SEQ + (size_t)c * 64;
    const int unit = (b * 8 + h) * 64 + c;
    float xr[8], xk[8];
    bf16x8 wfr[4];
    { const bf16_t* wt = (const bf16_t*)(ARG_WS + WS_W2T) + (size_t)pB * DEPTH * 512 * 64 + ((size_t)l * 512 + h * 64 + ncB + r32) * 64;
#pragma unroll
      for (int ks = 0; ks < 4; ++ks) wfr[ks] = *(const bf16x8*)(wt + 16 * ks + 8 * hi); }
    __syncthreads();
    PAMP_BEGIN(31);
    {
        auto lerp = [&](int k, float (&x)[8]) {
            const float m = mu5[k]; float prv = bf2f(cur.q[k][0]);
#pragma unroll
            for (int e = 0; e < 8; ++e) { const float cv = bf2f(cur.q[k][e + 1]); x[e] = cv + m * (prv - cv); prv = cv; }
        };
        float xv[8], xw[8], xa[8];
        lerp(0, xr); lerp(1, xk); lerp(2, xv); lerp(3, xw); lerp(4, xa);
        u32x4 vv; vv.x = pk2(xv[0], xv[1]); vv.y = pk2(xv[2], xv[3]); vv.z = pk2(xv[4], xv[5]); vv.w = pk2(xv[6], xv[7]);
        *(LAS u32x4*)(shm + L_VT + lane * PB + tq * 2) = vv;
#pragma unroll
        for (int e = 0; e < 8; ++e) {
            *(LAS bf16_t*)(shm + L_XWL + (tq + e) * PB + lane * 2) = f2bf(ftanh(xw[e]));
            *(LAS bf16_t*)(shm + L_XAL + (tq + e) * PB + lane * 2) = f2bf(xa[e]);
        }
    }
    __syncthreads();
    {
        const int p = pB, tr = trB, nc = ncB;
        f32x16 acc;
#pragma unroll
        for (int r = 0; r < 16; ++r) acc[r] = biasB;
        const int xb = p ? L_XAL : L_XWL;
#pragma unroll
        for (int ks = 0; ks < 4; ++ks) acc = RW_MFMA(RW_FRAG(xb, tr + r32, ks), wfr[ks], acc);
        LAS float* dst = (LAS float*)(shm + (p ? L_AA : L_DEC));
#pragma unroll
        for (int r = 0; r < 16; ++r) dst[(tr + crow(r, hi)) * 68 + nc + r32] = acc[r];
    }
    __syncthreads();
    PAMP_END(31);
    PAMP_BEGIN(32);
    {
        float* bon = (float*)(ARG_WS + WS_BON);
        float kkn[8], kpv[8], bbv[8], ld[8], lg[8];
        float run = 0.f;
        LAS float* zb = (LAS float*)(shm + L_KKDT) + wid * (16 * 64 + 16);
#pragma unroll
        for (int e = 0; e < 8; ++e) {
            const float dec = ((const LAS float*)(shm + L_DEC))[(tq + e) * 68 + lane], aav = ((const LAS float*)(shm + L_AA))[(tq + e) * 68 + lane];
            ld[e] = -0.6065306597126334f * sigmoidf_(dec);
            const float av = sigmoidf_(aav);
            const float kkr = xk[e] * kkc;
            kkn[e] = kkr; bbv[e] = kkr * av;
            kpv[e] = xk[e] * (1.0f + (av - 1.0f) * kac);
            zb[e * 64 + lane] = kkr * kkr;
            zb[(8 + e) * 64 + lane] = xr[e] * kpv[e] * rkc;
            run += ld[e]; lg[e] = run;
        }
        {
            const LAS f32x4* zp = (const LAS f32x4*)(zb + (lane >> 2) * 64 + (lane & 3) * 16);
            const f32x4 z0 = zp[0], z1 = zp[1], z2 = zp[2], z3 = zp[3];
            float tsum = (((z0[0] + z0[1]) + (z0[2] + z0[3])) + ((z1[0] + z1[1]) + (z1[2] + z1[3]))) + (((z2[0] + z2[1]) + (z2[2] + z2[3])) + ((z3[0] + z3[1]) + (z3[2] + z3[3])));
            tsum += dppx<0xB1>(tsum); tsum += dppx<0x4E>(tsum);
            if ((lane & 3) == 0) zb[16 * 64 + (lane >> 2)] = tsum;
            const f32x4 n0 = *(const LAS f32x4*)(zb + 16 * 64), n1 = *(const LAS f32x4*)(zb + 16 * 64 + 4);
            const float n2[8] = {n0[0], n0[1], n0[2], n0[3], n1[0], n1[1], n1[2], n1[3]};
#pragma unroll
            for (int e = 0; e < 8; ++e) { const float rn = __builtin_amdgcn_rsqf(fmaxf(n2[e], 1e-24f)); kkn[e] *= rn; bbv[e] *= rn; }
            if (lane < 8 && !dry) bon[(row0 + tq + lane) * 8 + h] = zb[16 * 64 + 8 + lane];
        }
        ((LAS float*)(shm + L_SEG))[wid * 64 + lane] = run;
        __syncthreads();
        float off = 0.f, tot = 0.f;
#pragma unroll
        for (int w = 0; w < 8; ++w) { const float sgm = ((const LAS float*)(shm + L_SEG))[w * 64 + lane]; tot += sgm; if (w < wid) off += sgm; }
        const float gct = fexp(tot);
        if (wid == 0) ((LAS float*)(shm + L_GC))[lane] = gct;
        float tb[8], tk[8], tkk[8];
        float gprev = fexp(off);
#pragma unroll
        for (int e = 0; e < 8; ++e) {
            const float L = off + lg[e];
            const float g = fexp(L), gp = gprev, ig = frcp(g), ge = gct * ig;
            gprev = g;
            const int t = tq + e;
            const float kkd = kkn[e] * gp;
            *(LAS bf16_t*)(shm + L_KKD + t * PB + lane * 2) = f2bf(kkd);
            *(LAS bf16_t*)(shm + L_RD + t * PB + lane * 2) = f2bf(xr[e] * g);
            *(LAS bf16_t*)(shm + L_BH + t * PB + lane * 2) = f2bf(bbv[e] * ig);
            *(LAS bf16_t*)(shm + L_KH + t * PB + lane * 2) = f2bf(kpv[e] * ig);
            tb[e] = bbv[e] * ge; tk[e] = kpv[e] * ge; tkk[e] = kkd;
        }
        u32x4 v;
        v.x = pk2(tb[0], tb[1]); v.y = pk2(tb[2], tb[3]); v.z = pk2(tb[4], tb[5]); v.w = pk2(tb[6], tb[7]); *(LAS u32x4*)(shm + L_BDT + lane * PB + tq * 2) = v;
        v.x = pk2(tk[0], tk[1]); v.y = pk2(tk[2], tk[3]); v.z = pk2(tk[4], tk[5]); v.w = pk2(tk[6], tk[7]); *(LAS u32x4*)(shm + L_KDT + lane * PB + tq * 2) = v;
        v.x = pk2(tkk[0], tkk[1]); v.y = pk2(tkk[2], tkk[3]); v.z = pk2(tkk[4], tkk[5]); v.w = pk2(tkk[6], tkk[7]); *(LAS u32x4*)(shm + L_KKDT + lane * PB + tq * 2) = v;
    }
    __syncthreads();
    PAMP_END(32);
    PAMP_BEGIN(33);
    {
        const int mat = wid & 3;
        const int ab = (mat < 2) ? L_KKD : L_RD, bb = (mat & 1) ? L_KH : L_BH;
        const int ob = (mat == 0) ? L_AB : (mat == 1) ? L_AK : (mat == 2) ? L_BB : L_BK;
        f32x16 acc0, acc1;
#pragma unroll
        for (int r = 0; r < 16; ++r) { acc0[r] = 0.f; acc1[r] = 0.f; }
        if (wid < 4) {
#pragma unroll
            for (int ks = 0; ks < 4; ++ks) { acc0 = RW_MFMA(RW_FRAG(ab, r32, ks), RW_FRAG(bb, r32, ks), acc0); acc1 = RW_MFMA(RW_FRAG(ab, 32 + r32, ks), RW_FRAG(bb, 32 + r32, ks), acc1); }
        } else {
#pragma unroll
            for (int ks = 0; ks < 4; ++ks) acc0 = RW_MFMA(RW_FRAG(ab, 32 + r32, ks), RW_FRAG(bb, r32, ks), acc0);
        }
        __syncthreads();
        if (wid < 4) {
            const int lim = (mat < 2) ? 1 : 0;
            LAS char* o0 = shm + ob + (4 * hi) * PB + r32 * 2; LAS char* o1 = shm + ob + (32 + 4 * hi) * PB + (32 + r32) * 2;
#pragma unroll
            for (int r = 0; r < 16; ++r) {
                const int tl_ = (r & 3) + 8 * (r >> 2);
                const bool keep = (tl_ + 4 * hi) >= (r32 + lim);
                acc0[r] = keep ? acc0[r] : 0.f; acc1[r] = keep ? acc1[r] : 0.f;
                *(LAS bf16_t*)(o0 + tl_ * PB) = f2bf(acc0[r]);
                *(LAS bf16_t*)(o1 + tl_ * PB) = f2bf(acc1[r]);
            }
            if (mat == 0) {
                const int bsel = r32 >> 4;
                LAS float* dg = (LAS float*)(shm + L_DIAG) + (r32 & 15);
#pragma unroll
                for (int rr = 0; rr < 8; ++rr) {
                    const int t16 = (rr & 3) + 8 * (rr >> 2) + 4 * hi;
                    const float v0 = bsel ? acc0[rr + 8] : acc0[rr], v1 = bsel ? acc1[rr + 8] : acc1[rr];
                    dg[(bsel) * 256 + t16 * 16] = v0; dg[(2 + bsel) * 256 + t16 * 16] = v1;
                }
            }
        } else {
            LAS char* o0 = shm + ob + (32 + 4 * hi) * PB + r32 * 2;
#pragma unroll
            for (int r = 0; r < 16; ++r) *(LAS bf16_t*)(o0 + ((r & 3) + 8 * (r >> 2)) * PB) = f2bf(acc0[r]);
        }
    }
    __syncthreads();
    PAMP_END(33);
    PAMP_BEGIN(34);
    if (wid >= 4) {
        const int tl = wid - 4, tr = 32 * (tl >> 1), ic = 32 * (tl & 1);
        f32x16 acc;
#pragma unroll
        for (int r = 0; r < 16; ++r) acc[r] = 0.f;
#pragma unroll
        for (int ks = 0; ks < 4; ++ks) if (tr > 0 || ks < 2) acc = RW_MFMA(RW_FRAG(L_AK, tr + r32, ks), RW_FRAG(L_VT, ic + r32, ks), acc);
        LAS float* dst = (LAS float*)(shm + L_AKVT) + (ic + r32) * 68;
#pragma unroll
        for (int g = 0; g < 4; ++g) *(LAS f32x4*)(dst + tr + 8 * g + 4 * hi) = (f32x4){acc[4 * g], acc[4 * g + 1], acc[4 * g + 2], acc[4 * g + 3]};
    } else if (wid == 0) {
        const int blk = lane >> 4, n = lane & 15;
        const LAS float* N = (const LAS float*)(shm + L_DIAG) + blk * 256;
        float m[16];
#pragma unroll
        for (int t = 0; t < 16; ++t) {
            float a = (t == n) ? 1.f : 0.f;
#pragma unroll
            for (int s = 0; s < t; ++s) a = fmaf(-N[t * 16 + s], m[s], a);
            m[t] = a;
            *(LAS bf16_t*)(shm + L_TINV + (blk * 256 + t * 16 + n) * 2) = f2bf(a);
        }
    }
    __syncthreads();
    if (idx + nper < 512) r1_load(nxt, PROJ, sava, (idx + nper) >> 6, h, (idx + nper) & 63, tq, lane);
    {
        const int n = lane & 15, q = lane >> 4;
        typedef float f32x4v __attribute__((ext_vector_type(4)));
        const int col = 16 * (wid & 3) + n;
        u32x2 xn[4];
#pragma unroll
        for (int blk = 0; blk < 4; ++blk) {
            f32x4v acc;
            if (wid < 4) { const u32x2 rv = *(const LAS u32x2*)(shm + L_KKDT + col * PB + (16 * blk + 4 * q) * 2);
                acc[0] = bf2f((bf16_t)(rv.x & 0xffffu)); acc[1] = bf2f((bf16_t)(rv.x >> 16)); acc[2] = bf2f((bf16_t)(rv.y & 0xffffu)); acc[3] = bf2f((bf16_t)(rv.y >> 16)); }
            else acc = *(const LAS f32x4v*)((const LAS float*)(shm + L_AKVT) + col * 68 + 16 * blk + 4 * q);
#pragma unroll
            for (int a = 0; a < blk; a += 2) {
                const u32x2 a0 = *(const LAS u32x2*)(shm + L_AB + (16 * blk + n) * PB + (16 * a + 4 * q) * 2);
                const bool two = (a + 1 < blk);
                u32x2 a1 = {0u, 0u}, b1 = {0u, 0u};
                if (two) { a1 = *(const LAS u32x2*)(shm + L_AB + (16 * blk + n) * PB + (16 * (a + 1) + 4 * q) * 2); b1 = xn[a + 1]; }
                const u32x4 af = {a0.x, a0.y, a1.x, a1.y}, bf = {xn[a].x, xn[a].y, b1.x, b1.y};
                acc = __builtin_amdgcn_mfma_f32_16x16x32_bf16(__builtin_bit_cast(bf16x8, af), __builtin_bit_cast(bf16x8, bf), acc, 0, 0, 0);
            }
            const u32x2 ti = *(const LAS u32x2*)(shm + L_TINV + (blk * 256 + n * 16 + 4 * q) * 2);
            const u32x4 af = {ti.x, ti.y, 0u, 0u}, bf = {pk2(acc[0], acc[1]), pk2(acc[2], acc[3]), 0u, 0u};
            f32x4v x = {0.f, 0.f, 0.f, 0.f};
            x = __builtin_amdgcn_mfma_f32_16x16x32_bf16(__builtin_bit_cast(bf16x8, af), __builtin_bit_cast(bf16x8, bf), x, 0, 0, 0);
            xn[blk].x = pk2(-x[0], -x[1]); xn[blk].y = pk2(-x[2], -x[3]);
            *(LAS u32x2*)(shm + ((wid < 4) ? L_WTT : L_VTT) + col * PB + (16 * blk + 4 * q) * 2) = xn[blk];
        }
    }
    __syncthreads();
    PAMP_END(34);
    PAMP_BEGIN(35);
    {
        const int tl = wid & 3, tr = 32 * (tl >> 1), cc = 32 * (tl & 1);
        f32x16 a0, a1;
        if (wid < 4) {
#pragma unroll
            for (int r = 0; r < 16; ++r) { a0[r] = bf2f(*(const LAS bf16_t*)(shm + L_RD + (tr + crow(r, hi)) * PB + (cc + r32) * 2)); a1[r] = 0.f; }
#pragma unroll
            for (int ks = 0; ks < 4; ++ks) if (tr > 0 || ks < 2) {
                const bf16x8 bbf = RW_FRAG(L_BB, tr + r32, ks);
                a0 = RW_MFMA(bbf, RW_FRAG(L_WTT, cc + r32, ks), a0);
                a1 = RW_MFMA(RW_FRAG(L_BK, tr + r32, ks), RW_FRAG(L_VT, cc + r32, ks), a1);
                a1 = RW_MFMA(bbf, RW_FRAG(L_VTT, cc + r32, ks), a1);
            }
            {
                const __amdgpu_buffer_rsrc_t rs = __builtin_amdgcn_make_buffer_rsrc((void*)PROJ, 0, 0x7fffffff, 0x00020000);
                const int vo = (4 * hi) * (DIN * 2) + (h * 64 + cc + r32) * 2;
                const unsigned so = (unsigned)__builtin_amdgcn_readfirstlane((int)((unsigned)(row0 + tr) * (unsigned)(DIN * 2)));
#pragma unroll
                for (int r = 0; r < 16; ++r) if (!dry) {
                    const unsigned sr = so + (unsigned)(((r & 3) + 8 * (r >> 2)) * (DIN * 2));
                    __builtin_amdgcn_raw_buffer_store_b16((short)f2bf(a0[r]), rs, vo + C_K * 2, sr, 0);
                    __builtin_amdgcn_raw_buffer_store_b16((short)f2bf(a1[r]), rs, vo + C_R * 2, sr, 0);
                }
            }
        } else {
#pragma unroll
            for (int r = 0; r < 16; ++r) { a0[r] = 0.f; a1[r] = 0.f; }
#pragma unroll
            for (int ks = 0; ks < 4; ++ks) {
                const bf16x8 bdf = RW_FRAG(L_BDT, tr + r32, ks);
                a0 = RW_MFMA(bdf, RW_FRAG(L_WTT, cc + r32, ks), a0);
                a1 = RW_MFMA(RW_FRAG(L_KDT, tr + r32, ks), RW_FRAG(L_VT, cc + r32, ks), a1);
                a1 = RW_MFMA(bdf, RW_FRAG(L_VTT, cc + r32, ks), a1);
            }
            bf16_t* Pm = (bf16_t*)(DO_RWP) + (size_t)unit * 4096;
            bf16_t* Dt = (bf16_t*)(ARG_WS + WS_RWD) + (size_t)unit * 4096;
            const float gc = ((const LAS float*)(shm + L_GC))[cc + r32];
#pragma unroll
            for (int r = 0; r < 16; ++r) { const int jr = tr + crow(r, hi), jc = cc + r32; if (!dry) Pm[jr * 64 + jc] = f2bf(a0[r] + ((jr == jc) ? gc : 0.f)); }
#pragma unroll
            for (int g = 0; g < 4; ++g) { u32x2 w; w.x = pk2(a1[4 * g], a1[4 * g + 1]); w.y = pk2(a1[4 * g + 2], a1[4 * g + 3]); if (!dry) *(u32x2*)(Dt + (cc + r32) * 64 + tr + 8 * g + 4 * hi) = w; }
        }
        const u32x4 vv = *(const LAS u32x4*)(shm + L_VT + lane * PB + tq * 2);
        if (!dry) {
            const __amdgpu_buffer_rsrc_t rs = __builtin_amdgcn_make_buffer_rsrc((void*)PROJ, 0, 0x7fffffff, 0x00020000);
            const int vo = (C_V + ch) * 2;
            const unsigned so = (unsigned)__builtin_amdgcn_readfirstlane((int)((unsigned)(row0 + tq) * (unsigned)(DIN * 2)));
            const unsigned wv[4] = {vv.x, vv.y, vv.z, vv.w};
#pragma unroll
            for (int e = 0; e < 8; ++e) __builtin_amdgcn_raw_buffer_store_b16((short)((e & 1) ? (wv[e >> 1] >> 16) : (wv[e >> 1] & 0xffffu)), rs, vo, so + (unsigned)(e * DIN * 2), 0);
        }
    }
    PAMP_END(35);
    cur = nxt;
    }
}

__device__ __forceinline__ void r2_unit(int l, int b, int h, LAS char* shm, const bool dry = false) {
    const int tid = otid(), lane = tid & 63, n = lane & 15, q = lane >> 4;
    const int wid = __builtin_amdgcn_readfirstlane(tid >> 6);
    typedef float f32x4v __attribute__((ext_vector_type(4)));
    bf16_t* PROJ = (bf16_t*)(ARG_WS + WS_PROJ);
    const bf16_t* Pm = (const bf16_t*)(DO_RWP) + (size_t)((b * 8 + h) * 64) * 4096;
    const bf16_t* Dt = (const bf16_t*)(ARG_WS + WS_RWD) + (size_t)((b * 8 + h) * 64) * 4096;
    constexpr int TPB = 144, TBUF = 64 * TPB;
    __syncthreads();
    for (int i = tid; i < 2 * TBUF / 4; i += 512) ((LAS unsigned*)shm)[i] = 0u;
    __syncthreads();
    const size_t rowb = (size_t)b * SEQ;
    if (wid < 4) {
        bf16x8 pa[2]; u32x2 dv[4];
        auto ldop = [&](int c) { const bf16_t* pp = Pm + (size_t)c * 4096 + (16 * wid + n) * 64 + 8 * q; pa[0] = *(const bf16x8*)pp; pa[1] = *(const bf16x8*)(pp + 32);
#pragma unroll
                                 for (int cg = 0; cg < 4; ++cg) dv[cg] = *(const u32x2*)(Dt + (size_t)c * 4096 + (16 * cg + n) * 64 + 16 * wid + 4 * q); };
        ldop(0);
        for (int c = 0; c < 64; ++c) {
            const bf16x8 a0 = pa[0], a1 = pa[1]; u32x2 d[4];
#pragma unroll
            for (int cg = 0; cg < 4; ++cg) d[cg] = dv[cg];
            if (c + 1 < 64) ldop(c + 1);
            const LAS char* tb = shm + (c & 1) * TBUF + n * TPB + 8 * q * 2;
            LAS char* tw_ = shm + ((c + 1) & 1) * TBUF + n * TPB + (16 * wid + 4 * q) * 2;
#pragma unroll
            for (int cg = 0; cg < 4; ++cg) {
                const bf16x8 t0 = *(const LAS bf16x8*)(tb + cg * 16 * TPB), t1 = *(const LAS bf16x8*)(tb + cg * 16 * TPB + 64);
                f32x4v acc = {bf2f((bf16_t)(d[cg].x & 0xffffu)), bf2f((bf16_t)(d[cg].x >> 16)), bf2f((bf16_t)(d[cg].y & 0xffffu)), bf2f((bf16_t)(d[cg].y >> 16))};
                acc = __builtin_amdgcn_mfma_f32_16x16x32_bf16(a0, t0, acc, 0, 0, 0);
                acc = __builtin_amdgcn_mfma_f32_16x16x32_bf16(a1, t1, acc, 0, 0, 0);
                u32x2 w; w.x = rw::pk2(acc[0], acc[1]); w.y = rw::pk2(acc[2], acc[3]);
                *(LAS u32x2*)(tw_ + cg * 16 * TPB) = w;
            }
            __syncthreads();
        }
    } else {
        const int tw = wid - 4;
        const float* lng = ARG(11) + (size_t)l * 512 + h * 64; const float* lnb = ARG(12) + (size_t)l * 512 + h * 64; const float* bon = (const float*)(ARG_WS + WS_BON);
        float gg[4][4], gb[4][4];
#pragma unroll
        for (int cg = 0; cg < 4; ++cg) { const f32x4v a4 = *(const f32x4v*)(lng + 16 * cg + 4 * q), b4 = *(const f32x4v*)(lnb + 16 * cg + 4 * q);
#pragma unroll
            for (int e = 0; e < 4; ++e) { gg[cg][e] = a4[e]; gb[cg][e] = b4[e]; } }
        bf16x8 rb[2]; u32x2 yv[4], vv[4], zv[4]; float bv;
        auto ldop = [&](int c) { const size_t row = rowb + (size_t)c * 64 + 16 * tw + n; const bf16_t* rp = PROJ + row * DIN + h * 64; rb[0] = *(const bf16x8*)(rp + C_K + 8 * q); rb[1] = *(const bf16x8*)(rp + C_K + 8 * q + 32);
                                 bv = bon[row * 8 + h];
#pragma unroll
                                 for (int cg = 0; cg < 4; ++cg) { yv[cg] = *(const u32x2*)(rp + C_R + 16 * cg + 4 * q); vv[cg] = *(const u32x2*)(rp + C_V + 16 * cg + 4 * q); zv[cg] = *(const u32x2*)(rp + C_ZA + 16 * cg + 4 * q); } };
        ldop(0);
        for (int c = 0; c < 64; ++c) {
            const bf16x8 b0 = rb[0], b1 = rb[1]; u32x2 y0[4], v0[4], z0[4]; const float bo = bv;
#pragma unroll
            for (int cg = 0; cg < 4; ++cg) { y0[cg] = yv[cg]; v0[cg] = vv[cg]; z0[cg] = zv[cg]; }
            if (c + 1 < 64) ldop(c + 1);
            const LAS char* tb = shm + (c & 1) * TBUF + n * TPB + 8 * q * 2;
            bf16_t* yp = PROJ + (rowb + (size_t)c * 64 + 16 * tw + n) * DIN + C_ZA + h * 64 + 4 * q;
            f32x4v acc[4];
#pragma unroll
            for (int cg = 0; cg < 4; ++cg) {
                const bf16x8 t0 = *(const LAS bf16x8*)(tb + cg * 16 * TPB), t1 = *(const LAS bf16x8*)(tb + cg * 16 * TPB + 64);
                acc[cg] = (f32x4v){bf2f((bf16_t)(y0[cg].x & 0xffffu)), bf2f((bf16_t)(y0[cg].x >> 16)), bf2f((bf16_t)(y0[cg].y & 0xffffu)), bf2f((bf16_t)(y0[cg].y >> 16))};
                acc[cg] = __builtin_amdgcn_mfma_f32_16x16x32_bf16(t0, b0, acc[cg], 0, 0, 0);
                acc[cg] = __builtin_amdgcn_mfma_f32_16x16x32_bf16(t1, b1, acc[cg], 0, 0, 0);
            }
            float sm = 0.f;
#pragma unroll
            for (int cg = 0; cg < 4; ++cg) sm += (acc[cg][0] + acc[cg][1]) + (acc[cg][2] + acc[cg][3]);
            sm += shx<16>(sm); { float x, y; swap32(sm, x, y); sm = x + y; }
            const float mean = sm * (1.0f / 64.0f);
            float sv = 0.f;
#pragma unroll
            for (int cg = 0; cg < 4; ++cg) { acc[cg] = acc[cg] - mean; sv += (acc[cg][0] * acc[cg][0] + acc[cg][1] * acc[cg][1]) + (acc[cg][2] * acc[cg][2] + acc[cg][3] * acc[cg][3]); }
            sv += shx<16>(sv); { float x, y; swap32(sv, x, y); sv = x + y; }
            const float rstd = rsqrtf(sv * (1.0f / 64.0f) + 64e-5f);
#pragma unroll
            for (int cg = 0; cg < 4; ++cg) {
                const float ve[4] = {bf2f((bf16_t)(v0[cg].x & 0xffffu)), bf2f((bf16_t)(v0[cg].x >> 16)), bf2f((bf16_t)(v0[cg].y & 0xffffu)), bf2f((bf16_t)(v0[cg].y >> 16))};
                const float ze[4] = {bf2f((bf16_t)(z0[cg].x & 0xffffu)), bf2f((bf16_t)(z0[cg].x >> 16)), bf2f((bf16_t)(z0[cg].y & 0xffffu)), bf2f((bf16_t)(z0[cg].y >> 16))};
                float o[4];
#pragma unroll
                for (int e = 0; e < 4; ++e) o[e] = (acc[cg][e] * rstd * gg[cg][e] + gb[cg][e] + bo * ve[e]) * siluf_(ze[e]);
                u32x2 w; w.x = rw::pk2(o[0], o[1]); w.y = rw::pk2(o[2], o[3]);
                if (!dry) *(u32x2*)(yp + 16 * cg) = w;
            }
            __syncthreads();
        }
    }
}
#undef RW_FRAG
#undef RW_MFMA
}

namespace lru {
typedef short bf16x8 __attribute__((ext_vector_type(8)));
typedef float f32x16 __attribute__((ext_vector_type(16)));
constexpr int TC = 32, XPITCH = 1040, LDS_XC = 0, LDS_OMA = 33280, LDS_BX = LDS_OMA + 32768, LDS_BYTES = LDS_BX + 32768;
__device__ __forceinline__ int crow(int r, int hi) { return (r & 3) + 8 * (r >> 2) + 4 * hi; }
__device__ __forceinline__ void carry_unit(int b, unsigned* cnt) {
    const int tid = otid();
    float2* sp = (float2*)(ARG_WS + WS_LSUM) + ((size_t)b * 128) * 512 + tid;
    float h = 0.f;
    for (int c0 = 0; c0 < 128; c0 += 16) {
        float2 ah[16];
#pragma unroll
        for (int k = 0; k < 16; ++k) ah[k] = sp[(size_t)(c0 + k) * 512];
#pragma unroll
        for (int k = 0; k < 16; ++k) { __hip_atomic_store(&sp[(size_t)(c0 + k) * 512].x, h, __ATOMIC_RELAXED, __HIP_MEMORY_SCOPE_AGENT); h = fmaf(ah[k].x, h, ah[k].y); }
    }
    asm volatile("s_waitcnt vmcnt(0)" ::: "memory");
    __syncthreads();
    if (threadIdx.x == 0) (void)xb_add(cnt, 1u);
}
constexpr int W_XC = 0, W_OMA = 4608, W_BX = 4608 + 4096, W_LDS = 4608 + 2 * 4096, L_PART = 8 * W_LDS;
template <bool FINAL>
__device__ __forceinline__ void phase(int l, LAS char* shm0, unsigned* cnt, const bool dry = false) {
    typedef unsigned u32x4 __attribute__((ext_vector_type(4)));
    typedef float f32x4 __attribute__((ext_vector_type(4)));
    const int tid0 = otid(), lane0 = tid0 & 63;
    const int hh = __builtin_amdgcn_readfirstlane(tid0 >> 6);
    bf16_t* PROJ = (bf16_t*)(ARG_WS + WS_PROJ);
    LAS char* shm = shm0 + hh * W_LDS;
    const int co0 = lane0 & 7, tg0 = lane0 >> 3;
    auto ldraw = [&](u32x4 (&raw)[7], int u) { const int b = u >> 7, t0 = (u & 127) * TC;
#pragma unroll
        for (int k = 0; k < 7; ++k) { const int t = t0 + 4 * tg0 - 3 + k; raw[k] = (t >= 0) ? *(const u32x4*)(PROJ + ((size_t)b * SEQ + t) * DIN + C_UB + hh * 64 + 8 * co0) : (u32x4){0u, 0u, 0u, 0u}; } };
    u32x4 raw[7], rawn[7];
    int parity = 0;
    if ((int)blockIdx.x < 1024) ldraw(raw, blockIdx.x);
    __syncthreads();
    for (int u = blockIdx.x; u < 1024; u += gridDim.x, parity ^= 1) {
        const int tid = otid(), lane = tid & 63, r32 = lane & 31, hi = lane >> 5, co = lane & 7, tg = lane >> 3;
        const int b = u >> 7, c = u & 127;
        const size_t row0 = (size_t)b * SEQ + (size_t)c * TC;
        const bf16_t* gat = (const bf16_t*)(ARG_WS + WS_GAT) + ((size_t)(l * 8 + hh) * 64) * 64;
        const bf16_t* gxt = gat + (size_t)DEPTH * 8 * 64 * 64;
        bf16x8 wr_[2][4], wi_[2][4];
#pragma unroll
        for (int nt = 0; nt < 2; ++nt)
#pragma unroll
            for (int ks = 0; ks < 4; ++ks) { wr_[nt][ks] = *(const bf16x8*)(gat + (size_t)(32 * nt + r32) * 64 + 16 * ks + 8 * hi); wi_[nt][ks] = *(const bf16x8*)(gxt + (size_t)(32 * nt + r32) * 64 + 16 * ks + 8 * hi); }
        {
            const float* conv_w = ARG(13) + (size_t)l * 4 * 512 + hh * 64 + 8 * co; const float* conv_b = ARG(14) + (size_t)l * 512 + hh * 64 + 8 * co;
            float cw[4][8], cb[8];
#pragma unroll
            for (int q = 0; q < 4; ++q) { const f32x4 a = *(const f32x4*)(conv_w + q * 512), bq = *(const f32x4*)(conv_w + q * 512 + 4);
                cw[q][0] = a[0]; cw[q][1] = a[1]; cw[q][2] = a[2]; cw[q][3] = a[3]; cw[q][4] = bq[0]; cw[q][5] = bq[1]; cw[q][6] = bq[2]; cw[q][7] = bq[3]; }
            { const f32x4 a = *(const f32x4*)conv_b, bq = *(const f32x4*)(conv_b + 4); cb[0] = a[0]; cb[1] = a[1]; cb[2] = a[2]; cb[3] = a[3]; cb[4] = bq[0]; cb[5] = bq[1]; cb[6] = bq[2]; cb[7] = bq[3]; }
#pragma unroll
            for (int tt = 0; tt < 4; ++tt) {
                float o[8];
#pragma unroll
                for (int e = 0; e < 8; ++e) o[e] = cb[e];
#pragma unroll
                for (int q = 0; q < 4; ++q) {
                    const u32x4 rv = raw[tt + q];
                    const unsigned wds[4] = {rv.x, rv.y, rv.z, rv.w};
#pragma unroll
                    for (int e = 0; e < 8; ++e) { const float x = bf2f((bf16_t)((e & 1) ? (wds[e >> 1] >> 16) : (wds[e >> 1] & 0xffffu))); o[e] = fmaf(x, cw[q][e], o[e]); }
                }
                u32x4 w; w.x = rw::pk2(o[0], o[1]); w.y = rw::pk2(o[2], o[3]); w.z = rw::pk2(o[4], o[5]); w.w = rw::pk2(o[6], o[7]);
                *(LAS u32x4*)(shm + W_XC + (4 * tg + tt) * 144 + co * 16) = w;
            }
        }
        if (u + (int)gridDim.x < 1024) ldraw(rawn, u + gridDim.x);
        {
            const float* ga_b = ARG(16) + (size_t)l * 512; const float* gx_b = ARG(18) + (size_t)l * 512; const float* lam = ARG(19) + (size_t)l * 512;
            f32x16 ar[2], ai[2];
#pragma unroll
            for (int nt = 0; nt < 2; ++nt)
#pragma unroll
                for (int r = 0; r < 16; ++r) { ar[nt][r] = 0.f; ai[nt][r] = 0.f; }
            const LAS char* xa = (const LAS char*)shm + W_XC + r32 * 144 + 8 * hi * 2;
#pragma unroll
            for (int ks = 0; ks < 4; ++ks) {
                const bf16x8 a = *(const LAS bf16x8*)(xa + ks * 32);
#pragma unroll
                for (int nt = 0; nt < 2; ++nt) {
                    ar[nt] = __builtin_amdgcn_mfma_f32_32x32x16_bf16(a, wr_[nt][ks], ar[nt], 0, 0, 0);
                    ai[nt] = __builtin_amdgcn_mfma_f32_32x32x16_bf16(a, wi_[nt][ks], ai[nt], 0, 0, 0);
                }
            }
            const LAS bf16_t* xc = (const LAS bf16_t*)(shm + W_XC); LAS unsigned* ob = (LAS unsigned*)(shm + W_OMA);
#pragma unroll
            for (int nt = 0; nt < 2; ++nt) {
                const int cl = 32 * nt + r32, ch = hh * 64 + cl;
                const float br = ga_b[ch], bi = gx_b[ch], c8l = -8.0f * 1.4426950408889634f * softplusf_(-lam[ch]);
#pragma unroll
                for (int r = 0; r < 16; ++r) {
                    const int t = crow(r, hi);
                    const float x = bf2f(xc[t * 72 + cl]);
                    const float om = 1.0f - __builtin_amdgcn_exp2f(sigmoidf_(ar[nt][r] + br) * c8l);
                    ob[t * 64 + cl] = f2bf2(om, __builtin_amdgcn_sqrtf(om * (2.0f - om)) * (sigmoidf_(ai[nt][r] + bi) * x));
                }
            }
        }
        {
            float2* lsum = (float2*)(ARG_WS + WS_LSUM) + ((size_t)b * 128 + c) * 512 + hh * 64 + lane;
            const LAS unsigned* ob = (const LAS unsigned*)(shm + W_OMA);
            float h = 0.f;
            if (FINAL) {
                if (lane == 0 && !dry) XB_SPIN(xb_ld(cnt) < 8u, (unsigned*)(ARG_WS + WS_CTL));
                h = __hip_atomic_load(&lsum->x, __ATOMIC_RELAXED, __HIP_MEMORY_SCOPE_AGENT);
            }
            float ap = 1.f, hv[TC];
#pragma unroll
            for (int t = 0; t < TC; ++t) {
                const unsigned pk = ob[t * 64 + lane];
                const float om = __builtin_bit_cast(float, pk << 16), bx = __builtin_bit_cast(float, pk & 0xffff0000u);
                h = fmaf(-om, h, h) + bx; ap *= (1.0f - om); hv[t] = h;
            }
            if (!FINAL) { if (!dry) *lsum = make_float2(ap, h); }
            else {
                LAS float* hb = (LAS float*)(shm + W_XC);
#pragma unroll
                for (int t = 0; t < TC; ++t) hb[t * 64 + lane] = hv[t];
                { const LAS f32x4* hp = (const LAS f32x4*)(hb + (lane >> 1) * 64 + (lane & 1) * 32);
                  float ss = 0.f;
#pragma unroll
                  for (int k = 0; k < 8; ++k) { const f32x4 v = hp[k]; ss += (v[0] * v[0] + v[1] * v[1]) + (v[2] * v[2] + v[3] * v[3]); }
                  ss += dppx<0xB1>(ss);
                  if ((lane & 1) == 0) ((LAS float*)(shm0 + L_PART))[parity * 256 + (lane >> 1) * 8 + hh] = ss; }
            }
        }
        if (FINAL) {
            __syncthreads();
            const float* go = ARG(20) + (size_t)l * 512 + hh * 64 + 8 * co;
            const f32x4 g0 = *(const f32x4*)go, g1 = *(const f32x4*)(go + 4);
            const float gg[8] = {g0[0], g0[1], g0[2], g0[3], g1[0], g1[1], g1[2], g1[3]};
            const LAS float* hb = (const LAS float*)(shm + W_XC);
            u32x4 zvv[4];
#pragma unroll
            for (int tt = 0; tt < 4; ++tt) zvv[tt] = *(const u32x4*)(PROJ + (row0 + 4 * tg + tt) * DIN + C_ZB + hh * 64 + 8 * co);
#pragma unroll
            for (int tt = 0; tt < 4; ++tt) {
                const int t = 4 * tg + tt;
                const f32x4 p0 = *(const LAS f32x4*)((const LAS float*)(shm0 + L_PART) + parity * 256 + t * 8), p1 = *(const LAS f32x4*)((const LAS float*)(shm0 + L_PART) + parity * 256 + t * 8 + 4);
                const float rs = rsqrtf((((p0[0] + p0[1]) + (p0[2] + p0[3])) + ((p1[0] + p1[1]) + (p1[2] + p1[3]))) * (1.0f / 512) + 1e-6f);
                const f32x4 x0 = *(const LAS f32x4*)(hb + t * 64 + 8 * co), x1 = *(const LAS f32x4*)(hb + t * 64 + 8 * co + 4);
                const float x[8] = {x0[0], x0[1], x0[2], x0[3], x1[0], x1[1], x1[2], x1[3]};
                bf16_t* zp = PROJ + (row0 + t) * DIN + C_ZB + hh * 64 + 8 * co;
                const u32x4 zv = zvv[tt]; const unsigned zw[4] = {zv.x, zv.y, zv.z, zv.w};
                float o[8];
#pragma unroll
                for (int e = 0; e < 8; ++e) { const float z = bf2f((bf16_t)((e & 1) ? (zw[e >> 1] >> 16) : (zw[e >> 1] & 0xffffu))); o[e] = x[e] * rs * gg[e] * siluf_(z); }
                u32x4 w; w.x = rw::pk2(o[0], o[1]); w.y = rw::pk2(o[2], o[3]); w.z = rw::pk2(o[4], o[5]); w.w = rw::pk2(o[6], o[7]);
                if (!dry) *(u32x4*)zp = w;
            }
        }
#pragma unroll
        for (int k = 0; k < 7; ++k) raw[k] = rawn[k];
    }
}
}

namespace att {
typedef short bf16x8 __attribute__((ext_vector_type(8)));
typedef short s16x4 __attribute__((ext_vector_type(4)));
typedef short v4i16_t __attribute__((ext_vector_type(4)));
typedef float f32x16 __attribute__((ext_vector_type(16)));
typedef unsigned u32x4 __attribute__((ext_vector_type(4)));
typedef float f32x2_t __attribute__((ext_vector_type(2)));
typedef __bf16 bf16x2_t __attribute__((ext_vector_type(2)));
typedef LAS const char* lds_cptr;
constexpr int KSLOT = 12288, VSLOT = 8192, LDS_K = 0, LDS_V = 3 * KSLOT, LDS_WS = LDS_V + 3 * VSLOT, LDS_OST = LDS_WS + 8 * 256, LDS_BYTES = LDS_OST + 8 * 4096;
__device__ __forceinline__ int crow(int r, int hi) { return (r & 3) + 8 * (r >> 2) + 4 * hi; }
__device__ __forceinline__ void glds16(const void* gsrc, unsigned lds_dst) { unsigned keep;
    asm volatile("s_mov_b32 %0, m0\n\ts_mov_b32 m0, %2\n\ts_nop 0\n\tglobal_load_lds_dwordx4 %1, off\n\ts_mov_b32 m0, %0" : "=&s"(keep) : "v"(gsrc), "s"(lds_dst) : "memory"); }
__device__ __forceinline__ unsigned cvtpk(float lo, float hi) { f32x2_t v = {lo, hi}; bf16x2_t b = __builtin_convertvector(v, bf16x2_t); return __builtin_bit_cast(unsigned, b); }
__device__ __forceinline__ s16x4 vtr(lds_cptr p) { return __builtin_bit_cast(s16x4, __builtin_amdgcn_ds_read_tr16_b64_v4i16((LAS v4i16_t*)p)); }
#define ATT_WAITB(N) asm volatile("s_waitcnt vmcnt(" #N ") lgkmcnt(0)\n\ts_barrier" ::: "memory")
__device__ __forceinline__ float max3f(float a, float b, float c) { float r; asm volatile("v_max3_f32 %0, %1, %2, %3" : "=v"(r) : "v"(a), "v"(b), "v"(c)); return r; }
__device__ __forceinline__ float max3f_first(float a, float b, float c) { float r; asm volatile("s_nop 15\n\ts_nop 7\n\tv_max3_f32 %0, %1, %2, %3" : "=v"(r) : "v"(a), "v"(b), "v"(c)); return r; }

template <int THR>
__device__ __forceinline__ void attn_unit(bf16_t* Qb, const bf16_t* Kb, const bf16_t* Vb, int b, int h, int qb, LAS char* shm, const bool dry = false) {
    const int tid = otid(), lane = tid & 63, r32 = lane & 31, hi = lane >> 5;
    const int wid = __builtin_amdgcn_readfirstlane(tid >> 6);
    const size_t rowb = (size_t)b * SEQ; const int q0 = qb * 256;
    bf16_t* Qw = Qb + ((rowb + q0 + wid * 32) * 8 + h) * 96;
    const bf16_t* Kh = Kb + (rowb * 8 + h) * 96;
    const bf16_t* Vh = Vb + (rowb * 8 + h) * 64;
    const unsigned lds0 = (unsigned)(size_t)shm;
    LAS float* wsf = (LAS float*)(shm + LDS_WS) + wid * 64;
    const bf16_t* ksrc = Kh + (size_t)lane * 768 + wid * 8;
    const bf16_t* vsrc = Vh + (size_t)(16 * (wid & 3) + (lane >> 2)) * 512 + (wid >> 2) * 32 + (lane & 3) * 8;
    const unsigned kdst = lds0 + LDS_K + wid * 1024, vdst = lds0 + LDS_V + wid * 1024;
#define ATT_DMA(t, sl) do { glds16(ksrc + (size_t)(t) * 64 * 768, (unsigned)__builtin_amdgcn_readfirstlane(kdst + (sl) * KSLOT)); \
        if (wid < 4) glds16(ksrc + (size_t)(t) * 64 * 768 + 64, (unsigned)__builtin_amdgcn_readfirstlane(kdst + (sl) * KSLOT + 8192)); \
        glds16(vsrc + (size_t)(t) * 64 * 512, (unsigned)__builtin_amdgcn_readfirstlane(vdst + (sl) * VSLOT)); } while (0)
    const int NT = 4 * (qb + 1);
    ATT_DMA(0, 0);
    if (NT > 1) ATT_DMA(1, 1);
    bf16x8 qr[6];
#pragma unroll
    for (int d0 = 0; d0 < 6; ++d0) qr[d0] = *(const bf16x8*)(Qw + (size_t)r32 * 768 + d0 * 16 + hi * 8);
    asm volatile("s_waitcnt vmcnt(0)" : "+v"(qr[0]), "+v"(qr[1]), "+v"(qr[2]), "+v"(qr[3]), "+v"(qr[4]), "+v"(qr[5]) :: "memory");
    float m = 0.f, l = 0.f; f32x16 o[2], negm;
#pragma unroll
    for (int r = 0; r < 16; ++r) { o[0][r] = 0.f; o[1][r] = 0.f; negm[r] = 0.f; }
    const int qrel = wid * 32 + r32;
    const lds_cptr kp0 = (lds_cptr)shm + LDS_K + hi * 1024 + r32 * 16;
    const lds_cptr vp0 = (lds_cptr)shm + LDS_V + ((lane >> 4) & 1) * 32 + (lane & 3) * 8 + (4 * hi + ((lane & 15) >> 2)) * 64;
    int sl0 = 0, sl1 = 1, sl2 = 2;
    for (int t = 0; t < NT; ++t) {
        if (t + 1 < NT) { if (wid < 4) ATT_WAITB(3); else ATT_WAITB(2); } else ATT_WAITB(0);
        if (t + 2 < NT) ATT_DMA(t + 2, sl2);
        const int sl = sl0;
        sl0 = sl1; sl1 = sl2; sl2 = sl;
        const int jb = t - (NT - 4);
        if (jb >= 1 && 64 * jb > wid * 32 + 31) continue;
        f32x16 p0, p1;
        const lds_cptr kp = kp0 + sl * KSLOT;
        bf16x8 kf[12];
#pragma unroll
        for (int d0 = 0; d0 < 6; ++d0) { kf[2 * d0] = *(const LAS bf16x8*)(kp + d0 * 2048); kf[2 * d0 + 1] = *(const LAS bf16x8*)(kp + d0 * 2048 + 512); }
        __builtin_amdgcn_sched_barrier(0);
#pragma unroll
        for (int d0 = 0; d0 < 6; ++d0) {
            if (d0 == 0) { p0 = __builtin_amdgcn_mfma_f32_32x32x16_bf16(kf[0], qr[0], negm, 0, 0, 0); p1 = __builtin_amdgcn_mfma_f32_32x32x16_bf16(kf[1], qr[0], negm, 0, 0, 0); }
            else { p0 = __builtin_amdgcn_mfma_f32_32x32x16_bf16(kf[2 * d0], qr[d0], p0, 0, 0, 0); p1 = __builtin_amdgcn_mfma_f32_32x32x16_bf16(kf[2 * d0 + 1], qr[d0], p1, 0, 0, 0); }
        }
        const lds_cptr vp = vp0 + sl * VSLOT;
        s16x4 vlo[8], vhi[8];
#pragma unroll
        for (int i = 0; i < 8; ++i) { vlo[i] = vtr(vp + (i >> 2) * 4096 + (i & 3) * 1024); vhi[i] = vtr(vp + (i >> 2) * 4096 + (i & 3) * 1024 + 512); }
        __builtin_amdgcn_sched_barrier(0);
        if (jb >= 0) {
            const int kb = 64 * jb + 4 * hi;
#pragma unroll
            for (int r = 0; r < 16; ++r) { const int kv = kb + (r & 3) + 8 * (r >> 2); if (kv > qrel) p0[r] = -INFINITY; if (kv + 32 > qrel) p1[r] = -INFINITY; }
        }
        float mx = max3f_first(p0[0], p0[1], p1[0]), mb = max3f(p0[2], p0[3], p1[1]); mx = max3f(mx, p1[2], p1[3]);
#pragma unroll
        for (int r = 4; r < 16; r += 4) { mx = max3f(mx, p0[r], p0[r + 1]); mb = max3f(mb, p0[r + 2], p0[r + 3]); mx = max3f(mx, p1[r], p1[r + 1]); mb = max3f(mb, p1[r + 2], p1[r + 3]); }
        mx = fmaxf(mx, mb);
        { float x, y; swap32(mx, x, y); mx = fmaxf(x, y); }
        if (t == 0 || __any(mx > (float)THR)) {
            const float dl = (t == 0) ? mx : fmaxf(mx, 0.f);
            m += dl;
            const float alpha = __builtin_amdgcn_exp2f(-dl);
            l *= alpha;
#pragma unroll
            for (int r = 0; r < 16; ++r) { p0[r] -= dl; p1[r] -= dl; negm[r] = -m; }
            if (t > 0) {
                if (hi == 0) wsf[r32] = alpha;
#pragma unroll
                for (int r = 0; r < 16; ++r) { const float f = wsf[crow(r, hi)]; o[0][r] *= f; o[1][r] *= f; }
            }
        }
        float ps = 0.f;
#pragma unroll
        for (int r = 0; r < 16; ++r) { p0[r] = __builtin_amdgcn_exp2f(p0[r]); p1[r] = __builtin_amdgcn_exp2f(p1[r]); ps += p0[r] + p1[r]; }
        l += ps;
        u32x4 pw[4];
#pragma unroll
        for (int q = 0; q < 4; ++q) { pw[0][q] = cvtpk(p0[2 * q], p0[2 * q + 1]); pw[1][q] = cvtpk(p0[8 + 2 * q], p0[9 + 2 * q]); pw[2][q] = cvtpk(p1[2 * q], p1[2 * q + 1]); pw[3][q] = cvtpk(p1[8 + 2 * q], p1[9 + 2 * q]); }
#pragma unroll
        for (int d0 = 0; d0 < 2; ++d0)
#pragma unroll
            for (int ks = 0; ks < 4; ++ks) {
                const s16x4 lo = vlo[d0 * 4 + ks], hh = vhi[d0 * 4 + ks];
                const bf16x8 vf = (bf16x8){lo[0], lo[1], lo[2], lo[3], hh[0], hh[1], hh[2], hh[3]};
                o[d0] = __builtin_amdgcn_mfma_f32_32x32x16_bf16(__builtin_bit_cast(bf16x8, pw[ks]), vf, o[d0], 0, 0, 0);
            }
    }
    { float x, y; swap32(l, x, y); l = x + y; }
    if (hi == 0) wsf[32 + r32] = l;
    float rli[16];
#pragma unroll
    for (int r = 0; r < 16; ++r) rli[r] = 1.0f / wsf[32 + crow(r, hi)];
    LAS bf16_t* stg = (LAS bf16_t*)(shm + LDS_OST) + wid * 2048;
#pragma unroll
    for (int r = 0; r < 16; ++r) { const int orow = crow(r, hi);
#pragma unroll
        for (int d0 = 0; d0 < 2; ++d0) stg[orow * 64 + d0 * 32 + r32] = f2bf(o[d0][r] * rli[r]); }
#pragma unroll
    for (int i = 0; i < 4; ++i) { const int row = i * 8 + (lane >> 3), ch = lane & 7; const u32x4 v = *(const LAS u32x4*)(stg + row * 64 + ch * 8); if (!dry) *(u32x4*)(Qw + (size_t)row * 768 + ch * 8) = v; }
    asm volatile("s_waitcnt lgkmcnt(0)\n\ts_barrier" ::: "memory");
#undef ATT_DMA
}
}

__global__ void __launch_bounds__(512, 2) fwd_kernel(Args A) {
    extern __shared__ __attribute__((aligned(16))) unsigned char smem[];
    float* lds = (float*)smem;
    volatile LAS unsigned* xbw = (volatile LAS unsigned*)(smem + 147456 - 16);
    unsigned* ctl = (unsigned*)(ARG_WS + WS_CTL);
    const int tid = threadIdx.x;
    if (tid == 0) { xbw[0] = 0u; xbw[1] = 0u; xbw[2] = 0u; xbw[3] = 0u; }
    __syncthreads();
    XcdBarrier bar = xcd_barrier_post(ctl, xbw);
#if PROBE >= 50 && PROBE <= 52
    unsigned long long pc0 = 0, pr0 = 0, pc1 = 0, pr1 = 0;
    if (PROBE == 50) { pc0 = __builtin_amdgcn_s_memtime(); pr0 = __builtin_amdgcn_s_memrealtime(); }
#endif
    LAS int* s_unit = (LAS int*)(smem + 147456 - 32);

    bf16_t* PROJ = (bf16_t*)(ARG_WS + WS_PROJ);
    bf16_t* XN = (bf16_t*)(ARG_WS + WS_XN);
    float* rope = (float*)(ARG_WS + WS_ROPE);
    const int nwaves = gridDim.x * 8;
#define PHASE_IDS() const int ptid = otid(), lane = ptid & 63, wv = ptid >> 6, gw = blockIdx.x * 8 + wv; (void)lane; (void)gw

    PAMP_BEGIN(20);
    for (int idx = blockIdx.x * 512 + otid(); idx < SEQ * 16; idx += gridDim.x * 512) {
        const int t = idx >> 4, i = idx & 15;
        const float inv = powf(10000.0f, -((float)i * 2.0f / 32.0f));
        const float ang = (float)t * inv;
        const double twopi = 6.283185307179586476925286766559;
        double rr = (double)ang; rr -= twopi * floor(rr / twopi + 0.5);
        const double r2 = rr * rr; double ts = rr, ss = rr, tc = 1.0, cc = 1.0;
        for (int n = 1; n <= 13; ++n) { ts *= -r2 / (double)((2 * n) * (2 * n + 1)); ss += ts; tc *= -r2 / (double)((2 * n - 1) * (2 * n)); cc += tc; }
        rope[idx * 2] = (float)cc; rope[idx * 2 + 1] = (float)ss;
    }

    for (int prep = 0; prep < (PROBE == 11 ? 2 : 1); ++prep)
    for (int l = 0; l < DEPTH; ++l) {
        { const float* W = ARG(2) + (size_t)l * DM * DIN; const float* g = ARG(1) + (size_t)l * DM;
          transpose_w(DM, NPAD_IN, (bf16_t*)(ARG_WS + WS_WIN) + (size_t)l * NPAD_IN * DM, [=](int k, int n) -> f32x4_t { return n < DIN ? *(const f32x4_t*)(W + (size_t)k * DIN + orig_col(n)) * g[k] : (f32x4_t){0.f, 0.f, 0.f, 0.f}; }, lds); }
        { const float* W = ARG(26) + (size_t)l * DMIX * DM;
          transpose_w(DMIX, DM, (bf16_t*)(ARG_WS + WS_WOUT) + (size_t)l * DM * DMIX, [=](int k, int n) -> f32x4_t { return *(const f32x4_t*)(W + (size_t)k * DM + n); }, lds); }
        { const float* qg = ARG(21) + (size_t)l * QL; const float* wuq = ARG(22) + (size_t)l * QL * 768;
          const float* kg = ARG(23) + (size_t)l * KVL; const float* wukv = ARG(24) + (size_t)l * KVL * 1024;
          transpose_w(256, NMLA, (bf16_t*)(ARG_WS + WS_WMLA) + (size_t)l * NMLA * 256, [=](int k, int n) -> f32x4_t {
              if (n < 768) return *(const f32x4_t*)(wuq + (size_t)k * 768 + n) * qg[k];
              return k < KVL ? *(const f32x4_t*)(wukv + (size_t)k * 1024 + (n - 768)) * kg[k] : (f32x4_t){0.f, 0.f, 0.f, 0.f}; }, lds); }
    }
    { const float* w2 = ARG(5); const float* a2 = ARG(7);
      transpose_w(64, DEPTH * 512, (bf16_t*)(ARG_WS + WS_W2T), [=](int k, int n) -> f32x4_t { return *(const f32x4_t*)(w2 + ((size_t)(n >> 9) * 64 + k) * 512 + (n & 511)); }, lds);
      transpose_w(64, DEPTH * 512, (bf16_t*)(ARG_WS + WS_W2T) + (size_t)DEPTH * 512 * 64, [=](int k, int n) -> f32x4_t { return *(const f32x4_t*)(a2 + ((size_t)(n >> 9) * 64 + k) * 512 + (n & 511)); }, lds); }
    { const float* ga = ARG(15); const float* gx = ARG(17);
      transpose_w(64, DEPTH * 8 * 64, (bf16_t*)(ARG_WS + WS_GAT), [=](int k, int n) -> f32x4_t { return *(const f32x4_t*)(ga + ((size_t)(n >> 6) * 64 + k) * 64 + (n & 63)); }, lds);
      transpose_w(64, DEPTH * 8 * 64, (bf16_t*)(ARG_WS + WS_GAT) + (size_t)DEPTH * 8 * 64 * 64, [=](int k, int n) -> f32x4_t { return *(const f32x4_t*)(gx + ((size_t)(n >> 6) * 64 + k) * 64 + (n & 63)); }, lds); }
    {
        PHASE_IDS();
        const float* x = ARG(0); float* ssqh = (float*)(ARG_WS + WS_SSQH);
        for (int row = gw; row < MTOK; row += nwaves) {
            float4 v[4]; float ss = 0.f;
#pragma unroll
            for (int q = 0; q < 4; ++q) { v[q] = *(const float4*)&x[(size_t)row * DM + q * 256 + lane * 4]; ss += v[q].x * v[q].x + v[q].y * v[q].y + v[q].z * v[q].z + v[q].w * v[q].w; }
            ss = wave_sum(ss);
#pragma unroll
            for (int q = 0; q < 4; ++q) { ushort4 o; o.x = f2bf(v[q].x); o.y = f2bf(v[q].y); o.z = f2bf(v[q].z); o.w = f2bf(v[q].w); *(ushort4*)&XN[(size_t)row * DM + q * 256 + lane * 4] = o; }
            if (lane < 16) ssqh[(size_t)row * 16 + lane] = (lane == 0) ? ss : 0.f;
        }
    }
    PAMP_END(20);
    xcd_barrier(bar);

    for (int l = 0; l < DEPTH; ++l) {
#if PROBE == 10
        for (int rep = 0; rep < 8; ++rep) xcd_barrier(bar);
#endif
#if PROBE == 40
        { const unsigned long long t1_ = __builtin_amdgcn_s_memrealtime(); while (__builtin_amdgcn_s_memrealtime() - t1_ < 20000ull) __builtin_amdgcn_s_sleep(8); __syncthreads(); }
#endif
        PAMP_BEGIN(21);
#if PROBE == 51 || PROBE == 52
        if (l == (PROBE == 51 ? 0 : 3)) { pc0 = __builtin_amdgcn_s_memtime(); pr0 = __builtin_amdgcn_s_memrealtime(); }
#endif
        for (int rep = 0; rep < (PROBE == 9 ? 2 : 1); ++rep) {
            pg8::Gemm g{XN, (const bf16_t*)(ARG_WS + WS_WIN) + (size_t)l * NPAD_IN * DM, MTOK, NPAD_IN, DM, DM, DM, 1 << 30, 0};
            pg8::RowScaleOrder<16> S; S.init(MTOK, NPAD_IN, (int)gridDim.x, (int)blockIdx.x);
            S.part = (const float*)(ARG_WS + WS_SSQH); S.inv_dim = 1.0f / DM; S.tab = (PG8_LAS float*)(smem + 131072);
            pg8::EpiProj E{PROJ, DIN, DIN, (const PG8_LAS float*)(smem + 131072), (float*)(ARG_WS + WS_SQQ), (float*)(ARG_WS + WS_SQKV), (bf16_t*)(ARG_WS + WS_K), rope, (bf16_t*)(ARG_WS + WS_SAVA)};
            pg8::gemm_phase<pg8::EpiProj, pg8::RowScaleOrder<16>, true, true>((PG8_LAS unsigned char*)smem, g, S, E);
        }
#if PROBE == 51 || PROBE == 52
        if (l == (PROBE == 51 ? 0 : 3)) { __syncthreads(); pc1 = __builtin_amdgcn_s_memtime(); pr1 = __builtin_amdgcn_s_memrealtime(); }
#endif
        PAMP_END(21);
        xcd_barrier(bar);
        PAMP_BEGIN(22);
        for (int rep = 0; rep < (PROBE == 13 ? 2 : 1); ++rep) {
            int kmla = 256; asm volatile("" : "+s"(kmla));
            pg8::Gemm g{PROJ + C_QL, (const bf16_t*)(ARG_WS + WS_WMLA) + (size_t)l * NMLA * 256, MTOK, NMLA, kmla, DIN, 256, 3, 2 * (C_KVL - C_QL)};
            pg8::MlaOrder S; S.init(MTOK, NMLA, (int)gridDim.x, (int)blockIdx.x);
            S.sqq = (const float*)(ARG_WS + WS_SQQ); S.sqkv = (const float*)(ARG_WS + WS_SQKV); S.tab = (PG8_LAS float*)(smem + 131072 + 2048);
            pg8::EpiMla E{(bf16_t*)(DO_Q), (bf16_t*)(ARG_WS + WS_K), (bf16_t*)(ARG_WS + WS_V), (const PG8_LAS float*)(smem + 131072 + 2048), rope, 0.10206207261596577f * 1.4426950408889634f, 0};
            pg8::gemm_phase<pg8::EpiMla, pg8::MlaOrder, true, true>((PG8_LAS unsigned char*)smem, g, S, E);
        }
        PAMP_END(22);
#if PROBE == 1 || PROBE == 2
        {
            const bool dry = (xb_ld(ctl + CW_PROBE) == 0u);
            unsigned* qw = ctl + CW_PROBEQ + 64 * l;
            for (;;) {
                __syncthreads();
                if (threadIdx.x == 0) *s_unit = (int)atomicAdd(qw, 1u);
                __syncthreads();
                const int u = *s_unit;
#if PROBE == 1
                if (u >= 4096) break;
                (void)dry; break;
#else
                if (u >= 1024) break;
                break;
#endif
            }
        }
#endif
        PAMP_BEGIN(23);
#if PROBE == 1
        rw::r1_phase(l, (LAS char*)smem, (xb_ld(ctl + CW_PROBE) == 0u));
#endif
        rw::r1_phase(l, (LAS char*)smem);
        lru::phase<false>(l, (LAS char*)smem, ctl + CW_LCNT + 64 * l);
        PAMP_END(23);
        xcd_barrier(bar);
#if PROBE >= 3 && PROBE <= 5
        {
            const bool dry = (xb_ld(ctl + CW_PROBE) == 0u);
            unsigned* qw = ctl + CW_PROBEQ + 64 * l;
            for (;;) {
                __syncthreads();
                if (threadIdx.x == 0) *s_unit = (int)atomicAdd(qw, 1u);
                __syncthreads();
                const int u = *s_unit;
#if PROBE == 3
                if (u >= 64) break;
                rw::r2_unit(l, u >> 3, u & 7, (LAS char*)smem, dry);
#elif PROBE == 4
                if (u >= 1024) break;
                break;
#else
                if (u >= 1024) break;
                att::attn_unit<ATT_THR>((bf16_t*)(DO_Q), (const bf16_t*)(ARG_WS + WS_K), (const bf16_t*)(ARG_WS + WS_V), (u & 63) >> 3, u & 7, 15 - (u >> 6), (LAS char*)smem, dry);
#endif
            }
        }
#endif
        {
            unsigned* qw = ctl + CW_QUEUE + 64 * (2 * l + 1);
            PAMP_BEGIN(24);
            for (;;) {
                __syncthreads();
                if (threadIdx.x == 0) *s_unit = (int)atomicAdd(qw, 1u);
                __syncthreads();
                const int u = *s_unit;
                if (u >= 8 + 64) break;
                if (u < 8) lru::carry_unit(u, ctl + CW_LCNT + 64 * l);
                else { const int a = u - 8; rw::r2_unit(l, a >> 3, a & 7, (LAS char*)smem); }
            }
            PAMP_END(24);
            PAMP_BEGIN(25);
            {
                const int x0 = (int)(xb_xcc_id() & 7u);
                for (int k = 0; k < 8; ++k) {
                    const int x = (x0 + k) & 7;
                    unsigned* qa = ctl + CW_ATTQ + 32 * (l * 8 + x);
                    for (;;) {
                        __syncthreads();
                        if (threadIdx.x == 0) *s_unit = (int)atomicAdd(qa, 1u);
                        __syncthreads();
                        const int u = *s_unit;
                        if (u >= 128) break;
                        const int bh = 8 * x + (u & 7), qb = 15 - (u >> 3);
                        att::attn_unit<ATT_THR>((bf16_t*)(DO_Q), (const bf16_t*)(ARG_WS + WS_K), (const bf16_t*)(ARG_WS + WS_V), bh >> 3, bh & 7, qb, (LAS char*)smem);
                    }
                }
            }
            PAMP_END(25);
            PAMP_BEGIN(26);
            lru::phase<true>(l, (LAS char*)smem, ctl + CW_LCNT + 64 * l);
            PAMP_END(26);
        }
        xcd_barrier(bar);
        PAMP_BEGIN(27);
        for (int rep = 0; rep < (PROBE == 8 ? 2 : 1); ++rep) {
            const bool dry = (PROBE == 8) && (rep == 0) && (xb_ld(ctl + CW_PROBE) == 0u);
            typedef unsigned u32x4 __attribute__((ext_vector_type(4)));
            typedef float f32x4 __attribute__((ext_vector_type(4)));
            PHASE_IDS();
            const int hd = lane >> 3, c0 = hd * 64 + (lane & 7) * 8;
            const bf16_t* OATT = (const bf16_t*)(DO_Q);
            float gcv[8];
            { const float* p2 = ARG(25) + (size_t)l * 512 + c0; const f32x4 d0 = *(const f32x4*)p2, d1 = *(const f32x4*)(p2 + 4);
#pragma unroll
              for (int e = 0; e < 4; ++e) { gcv[e] = d0[e]; gcv[4 + e] = d1[e]; } }
            auto unpack = [](const u32x4 v, float (&x)[8]) { const unsigned w[4] = {v.x, v.y, v.z, v.w};
#pragma unroll
                for (int e = 0; e < 4; ++e) { x[2 * e] = bf2f((bf16_t)(w[e] & 0xffffu)); x[2 * e + 1] = bf2f((bf16_t)(w[e] >> 16)); } };
            for (int row = gw; row < MTOK; row += 4 * nwaves) {
                u32x4 rzc[4], ro[4];
#pragma unroll
                for (int k = 0; k < 4; ++k) { const size_t rr = (size_t)row + (size_t)k * nwaves; rzc[k] = *(const u32x4*)(PROJ + rr * DIN + C_ZC + c0); ro[k] = *(const u32x4*)(OATT + (rr * 8 + hd) * 96 + (lane & 7) * 8); }
#pragma unroll
                for (int k = 0; k < 4; ++k) {
                    const size_t rr = (size_t)row + (size_t)k * nwaves;
                    float zc[8], oa[8];
                    unpack(rzc[k], zc); unpack(ro[k], oa);
                    float sq = 0.f;
#pragma unroll
                    for (int e = 0; e < 8; ++e) sq += oa[e] * oa[e];
                    sq = wave_sum(sq);
                    const float rc = rsqrtf(sq * (1.0f / 512) + 1e-6f);
                    float yc[8];
#pragma unroll
                    for (int e = 0; e < 8; ++e) yc[e] = oa[e] * rc * gcv[e] * siluf_(zc[e]);
                    u32x4 wc;
                    wc.x = rw::pk2(yc[0], yc[1]); wc.y = rw::pk2(yc[2], yc[3]); wc.z = rw::pk2(yc[4], yc[5]); wc.w = rw::pk2(yc[6], yc[7]);
                    if (!dry) *(u32x4*)(PROJ + rr * DIN + C_ZC + c0) = wc;
                }
            }
        }
        PAMP_END(27);
        xcd_barrier(bar);
        PAMP_BEGIN(28);
        for (int rep = 0; rep < (PROBE == 14 ? 2 : 1); ++rep) {
            const bool odry = (PROBE == 14) && (rep == 0) && (xb_ld(ctl + CW_PROBE) == 0u);
            pg8::Gemm g{PROJ + C_ZA, (const bf16_t*)(ARG_WS + WS_WOUT) + (size_t)l * DM * DMIX, MTOK, DM, DMIX, DIN, DMIX, 1 << 30, 0};
            pg8::StaticOrder S; S.init(MTOK, DM, (int)gridDim.x, (int)blockIdx.x);
            pg8::EpiResid E{DM, odry, XN, (float*)(ARG_WS + WS_SSQH)};
            pg8::gemm_phase<pg8::EpiResid, pg8::StaticOrder, true, true>((PG8_LAS unsigned char*)smem, g, S, E);
        }
        PAMP_END(28);
        xcd_barrier(bar);
    }
    {
        const float* g = ARG(27); const float* ssqh = (const float*)(ARG_WS + WS_SSQH);
        PHASE_IDS();
        float* out = ARG_OUT;
        for (int row = gw; row < MTOK; row += nwaves) {
            float tsum = (lane < 16) ? ssqh[(size_t)row * 16 + lane] : 0.f;
            tsum = wave_sum(tsum);
            const float rs = rsqrtf(tsum * (1.0f / DM) + 1e-6f);
            typedef unsigned u32x4 __attribute__((ext_vector_type(4))); u32x4 v[2];
#pragma unroll
            for (int q = 0; q < 2; ++q) v[q] = *(const u32x4*)(XN + (size_t)row * DM + q * 512 + lane * 8);
#pragma unroll
            for (int q = 0; q < 2; ++q) {
                const float4 g0 = *(const float4*)&g[q * 512 + lane * 8], g1 = *(const float4*)&g[q * 512 + lane * 8 + 4];
                float4 o0, o1;
                o0.x = __uint_as_float(v[q].x << 16) * rs * g0.x; o0.y = __uint_as_float(v[q].x & 0xffff0000u) * rs * g0.y;
                o0.z = __uint_as_float(v[q].y << 16) * rs * g0.z; o0.w = __uint_as_float(v[q].y & 0xffff0000u) * rs * g0.w;
                o1.x = __uint_as_float(v[q].z << 16) * rs * g1.x; o1.y = __uint_as_float(v[q].z & 0xffff0000u) * rs * g1.y;
                o1.z = __uint_as_float(v[q].w << 16) * rs * g1.z; o1.w = __uint_as_float(v[q].w & 0xffff0000u) * rs * g1.w;
                *(float4*)&out[(size_t)row * DM + q * 512 + lane * 8] = o0;
                *(float4*)&out[(size_t)row * DM + q * 512 + lane * 8 + 4] = o1;
            }
        }
    }
#if PROBE >= 50 && PROBE <= 52
    if (PROBE == 50) { __syncthreads(); pc1 = __builtin_amdgcn_s_memtime(); pr1 = __builtin_amdgcn_s_memrealtime(); }
    if (blockIdx.x == 0) {
        const unsigned long long mhz = (pc1 - pc0) * 100ull / (pr1 - pr0 + 1ull);
        const unsigned long long t1_ = __builtin_amdgcn_s_memrealtime(), d_ = mhz * 25ull;
        while (__builtin_amdgcn_s_memrealtime() - t1_ < d_) __builtin_amdgcn_s_sleep(8);
    }
#endif
}

extern "C" void kernel_launch(void* const* d_in, const int* in_sizes, int n_in, void* d_out, int out_size, void* d_ws, size_t ws_size, hipStream_t stream) {
    (void)in_sizes; (void)n_in; (void)out_size; (void)ws_size;
    constexpr int kDynLds = 147456;
    static int grid = 0;
    if (!grid) {
        int dev = 0, cus = 0;
        hipGetDevice(&dev);
        hipDeviceGetAttribute(&cus, hipDeviceAttributeMultiprocessorCount, dev);
        hipFuncSetAttribute((const void*)fwd_kernel, hipFuncAttributeMaxDynamicSharedMemorySize, kDynLds);
        int per_cu = 0;
        hipOccupancyMaxActiveBlocksPerMultiprocessor(&per_cu, fwd_kernel, 512, kDynLds);
        if (per_cu < 1) fprintf(stderr, "occupancy query says %d\n", per_cu);
        grid = cus > 0 ? cus : 256;
    }
    hipMemsetAsync(d_ws, 0, CTL_BYTES, stream);
    Args a;
    memset(&a, 0, sizeof(a));
    for (int i = 0; i < 28; ++i) a.in[i] = (const float*)d_in[i];
    a.out = (float*)d_out;
    a.ws = (unsigned char*)d_ws;
    hipLaunchKernelGGL(fwd_kernel, dim3(grid), dim3(512), kDynLds, stream, a);
}
```

```cpp
#include <hip/hip_runtime.h>
#include <stdint.h>
#include <cstdio>
#include <cstring>
#ifndef PROBE
#define PROBE 0
#endif
#define PAMP_BEGIN(id) unsigned long long pamp_t0_##id = 0; if (PROBE == (id)) pamp_t0_##id = __builtin_amdgcn_s_memrealtime()
#define PAMP_END(id) do { if (PROBE == (id)) { __syncthreads(); const unsigned long long t1_ = __builtin_amdgcn_s_memrealtime(), d_ = t1_ - pamp_t0_##id; while (__builtin_amdgcn_s_memrealtime() - t1_ < d_) __builtin_amdgcn_s_sleep(8); __syncthreads(); } } while (0)

constexpr int DM = 1024, NB = 8, SEQ = 4096, DEPTH = 4, MTOK = NB * SEQ;
constexpr int GW = 512, HD = 64, NH = 8, DMIX = 1536, DIN = 4128;
constexpr int QL = 256, KVL = 128;
constexpr int C_R = 0, C_K = 512, C_V = 1024, C_WL = 1536, C_AL = 1600, C_UB = 1664, C_QL = 2176, C_KVL = 2432, C_KR = 2560,
              C_ZA = 2592, C_ZB = 3104, C_ZC = 3616;
__device__ __forceinline__ int orig_col(int c) {
    if (c < 1664) return c;
    if (c < 2176) return c - 1664 + 2176;
    if (c < 2432) return c - 2176 + 3200;
    if (c < 2560) return c - 2432 + 3456;
    if (c < 2592) return c - 2560 + 3584;
    if (c < 3104) return c - 2592 + 1664;
    if (c < 3616) return c - 3104 + 2688;
    return c;
}
constexpr size_t MiB = 1u << 20;
constexpr size_t WS_CTL = 0, CTL_BYTES = 65536;
constexpr size_t WS_ROPE = 64 * 1024;
constexpr size_t WS_W2T = 576 * 1024;
constexpr size_t WS_SQQ = 1088 * 1024;
constexpr size_t WS_SQKV = 2112 * 1024;
constexpr size_t WS_SSQH = 10 * MiB;
constexpr size_t WS_WMLA = 3 * MiB;
constexpr size_t WS_PROJ = 16 * MiB;
constexpr size_t WS_XN = 354 * MiB;
constexpr size_t WS_K = 274 * MiB;
constexpr size_t WS_V = 322 * MiB;
constexpr size_t WS_BON = 8 * MiB + 512 * 1024;
constexpr size_t WS_SAVA = 14 * MiB;
constexpr size_t WS_RWD = 480 * MiB;
constexpr size_t WS_GAT = 9 * MiB + 512 * 1024;
constexpr size_t WS_LSUM = 10 * MiB;
constexpr size_t WS_WIN = 434 * MiB;
constexpr size_t WS_WOUT = 468 * MiB;
constexpr size_t WS_FREE = 480 * MiB;
constexpr int NPAD_IN = 4352, NMLA = 1792, KMLA = 384;
constexpr int CW_QUEUE = 8192, CW_PROBEQ = 12288, CW_PROBE = 4000, CW_LCNT = 14336, CW_ATTQ = 15000, CW_GATE = 4608;

#ifndef ATT_THR
#define ATT_THR 8
#endif

typedef unsigned short bf16_t;
__device__ __forceinline__ float bf2f(bf16_t v) { return __builtin_bit_cast(float, (unsigned)v << 16); }
typedef float f32x2_cv __attribute__((ext_vector_type(2)));
typedef __bf16 bf16x2_cv __attribute__((ext_vector_type(2)));
__device__ __forceinline__ unsigned f2bf2(float lo, float hi) { f32x2_cv v = {lo, hi}; bf16x2_cv b = __builtin_convertvector(v, bf16x2_cv); return __builtin_bit_cast(unsigned, b); }
__device__ __forceinline__ bf16_t f2bf(float f) { return (bf16_t)(f2bf2(f, f) & 0xffffu); }
template <int MASK> __device__ __forceinline__ float shx(float v) {
    static_assert(MASK < 32, "shx: within 32 lanes");
    return __builtin_bit_cast(float, __builtin_amdgcn_ds_swizzle(__builtin_bit_cast(int, v), (MASK << 10) | 0x1f));
}
__device__ __forceinline__ void swap32(float v, float& x, float& y) {
    auto rr = __builtin_amdgcn_permlane32_swap(__builtin_bit_cast(unsigned, v), __builtin_bit_cast(unsigned, v), false, false);
    unsigned a = rr[0], b = rr[1]; asm("" : "+v"(a), "+v"(b));
    x = __builtin_bit_cast(float, a); y = __builtin_bit_cast(float, b);
}
template <int CTRL> __device__ __forceinline__ float dppx(float v) { return __builtin_bit_cast(float, __builtin_amdgcn_mov_dpp(__builtin_bit_cast(int, v), CTRL, 0xf, 0xf, true)); }
__device__ __forceinline__ float sum8(float v) { v += dppx<0xB1>(v); v += dppx<0x4E>(v); v += dppx<0x141>(v); return v; }
__device__ __forceinline__ float wave_sum(float v) {
    v += dppx<0xB1>(v); v += dppx<0x4E>(v); v += dppx<0x141>(v); v += dppx<0x140>(v);
    v += shx<16>(v);
    float x, y; swap32(v, x, y);
    return x + y;
}
__device__ __forceinline__ float fexp(float x) { return __builtin_amdgcn_exp2f(x * 1.4426950408889634f); }
__device__ __forceinline__ float frcp(float x) { return __builtin_amdgcn_rcpf(x); }
__device__ __forceinline__ float sigmoidf_(float x) { return frcp(1.0f + fexp(-x)); }
__device__ __forceinline__ float softplusf_(float x) { return x > 20.f ? x : __builtin_amdgcn_logf(1.0f + fexp(x)) * 0.6931471805599453f; }
__device__ __forceinline__ float siluf_(float x) { return x * frcp(1.0f + fexp(-x)); }
__device__ __forceinline__ float ftanh(float x) { return 1.0f - 2.0f * frcp(1.0f + fexp(2.0f * x)); }
__device__ __forceinline__ float nexpm1(float x) { return x > -0.02f ? -x * (1.0f + x * (0.5f + x * 0.16666667f)) : 1.0f - fexp(x); }

__device__ __forceinline__ int otid() { int t = threadIdx.x; asm volatile("" : "+v"(t)); return t; }
template <int K> __device__ __forceinline__ const float* argp() {
    int k = K; asm volatile("" : "+s"(k));
    return (const float*)(((const unsigned long long*)__builtin_amdgcn_kernarg_segment_ptr())[k]);
}
#define ARG(k) argp<k>()
#define ARG_OUT ((float*)argp<28>())
#define ARG_WS ((unsigned char*)argp<29>())
#define DO_Q ((unsigned char*)argp<28>())
#define DO_RWP ((unsigned char*)argp<28>() + 48 * MiB)

#define XB_TMO      128
#define XB_XCNT(j)  (256  + 64 * (j))
#define XB_XSUB(j)  (1280 + 64 * (j))
#define XB_XGEN(j)  (2304 + 64 * (j))
#define XB_TOP      3328
#define XB_TOPGEN   3392
#define XCD_BAR_WORDS 3456
#define XB_SPIN_CAP (1u << 24)
#define LAS __attribute__((address_space(3)))

__device__ __forceinline__ unsigned xb_ld(unsigned* p)              { return __hip_atomic_load(p, __ATOMIC_RELAXED, __HIP_MEMORY_SCOPE_AGENT); }
__device__ __forceinline__ unsigned xb_add(unsigned* p, unsigned v) { return __hip_atomic_fetch_add(p, v, __ATOMIC_RELAXED, __HIP_MEMORY_SCOPE_AGENT); }
__device__ __forceinline__ unsigned xb_xcc_id() { return (unsigned)__builtin_amdgcn_s_getreg((3 << 11) | 20) & 0xFu; }
#define XB_SPIN(cond, bar) do { unsigned _sp = 0; while (cond) { __builtin_amdgcn_s_sleep(1); \
    if ((++_sp & 255u) == 0u) { if (xb_ld(&(bar)[XB_TMO])) break; if (_sp > XB_SPIN_CAP) { atomicAdd(&(bar)[XB_TMO], 1u); break; } } } } while (0)

struct XcdBarrier { unsigned* bar; unsigned x; volatile LAS unsigned* st; };

__device__ __forceinline__ XcdBarrier xcd_barrier_post(unsigned* bar, volatile LAS unsigned* st) {
    XcdBarrier b; b.bar = bar; b.x = xb_xcc_id(); b.st = st;
    if (threadIdx.x == 0) (void)xb_add(&bar[XB_XCNT(b.x)], 1u);
    return b;
}
__device__ __forceinline__ void xcd_barrier_complete(unsigned* bar, unsigned x, unsigned& nloc, unsigned& nx) {
    const unsigned G = gridDim.x * gridDim.y * gridDim.z;
    unsigned sum, cnt, mine, sp = 0u;
    for (;;) {
        sum = 0u; cnt = 0u; mine = 0u;
#pragma unroll
        for (unsigned j = 0; j < 16; ++j) { const unsigned c = xb_ld(&bar[XB_XCNT(j)]); sum += c; cnt += (c > 0u) ? 1u : 0u; mine = (j == x) ? c : mine; }
        if (sum == G) break;
        __builtin_amdgcn_s_sleep(1);
        if ((++sp & 255u) == 0u) { if (xb_ld(&bar[XB_TMO])) break; if (sp > XB_SPIN_CAP) { atomicAdd(&bar[XB_TMO], 1u); break; } }
    }
    nloc = mine > 0u ? mine : 1u; nx = cnt > 0u ? cnt : 1u;
}
__device__ __forceinline__ void xcd_barrier_raw(const XcdBarrier& b);
__device__ __forceinline__ void xcd_barrier(const XcdBarrier& b) {
#if PROBE == 30
    const unsigned long long t0_ = __builtin_amdgcn_s_memrealtime();
    xcd_barrier_raw(b);
    const unsigned long long t1_ = __builtin_amdgcn_s_memrealtime(), d_ = t1_ - t0_;
    while (__builtin_amdgcn_s_memrealtime() - t1_ < d_) __builtin_amdgcn_s_sleep(8);
    __syncthreads();
#else
    xcd_barrier_raw(b);
#endif
}
__device__ __forceinline__ void xcd_barrier_raw(const XcdBarrier& b) {
    asm volatile("s_waitcnt vmcnt(0)" ::: "memory");
    __syncthreads();
    if (threadIdx.x == 0) {
        unsigned* bar = b.bar;
        __builtin_amdgcn_s_waitcnt(0);
        const unsigned bx = (unsigned)__builtin_amdgcn_readfirstlane((int)xb_xcc_id());
        unsigned nloc = b.st[0], nx = b.st[1];
        if (nloc == 0u) { xcd_barrier_complete(bar, bx, nloc, nx); b.st[0] = nloc; b.st[1] = nx; }
        const unsigned old = xb_add(&bar[XB_XSUB(bx)], 1u);
        const unsigned gen = old / nloc;
        if (old + 1u == (gen + 1u) * nloc) {
            __builtin_amdgcn_fence(__ATOMIC_RELEASE, "agent");
            asm volatile("s_waitcnt vmcnt(0)" ::: "memory");
            const unsigned og = xb_add(&bar[XB_TOP], 1u);
            const unsigned tg = og / nx;
            if (og + 1u == (tg + 1u) * nx) xb_add(&bar[XB_TOPGEN], 1u);
            else XB_SPIN(xb_ld(&bar[XB_TOPGEN]) == tg, bar);
            __builtin_amdgcn_fence(__ATOMIC_ACQUIRE, "agent");
            xb_add(&bar[XB_XGEN(bx)], 1u);
            asm volatile("s_waitcnt vmcnt(0)" ::: "memory");
        } else {
            XB_SPIN(xb_ld(&bar[XB_XGEN(bx)]) == gen, bar);
            __builtin_amdgcn_fence(__ATOMIC_ACQUIRE, "agent");
            asm volatile("s_waitcnt vmcnt(0)" ::: "memory");
        }
    }
    __syncthreads();
}

struct Args {
    const float* in[28];
    float* out;
    unsigned char* ws;
};

namespace pg8 {
#define PG8_LAS __attribute__((address_space(3)))
typedef unsigned short bf16_t;
typedef short bf16x8 __attribute__((ext_vector_type(8)));
typedef float f32x4 __attribute__((ext_vector_type(4)));
typedef unsigned u32x4 __attribute__((ext_vector_type(4)));
constexpr int BM = 256, BK = 64, HALF = 128, HTB = HALF * BK * 2  , STAGE_BYTES = 8 * HTB, NXCD = 8, WGM = 8;

__host__ __device__ __forceinline__ int lds_byte(int r, int c) { const int st = (r >> 4) * 2 + (c >> 5), rr = r & 15, cc = c & 31, ob = rr * 64 + cc * 2; return st * 1024 + (ob ^ (((ob >> 9) & 1) << 5)); }
__host__ __device__ __forceinline__ void stage_rc(int b, int& R, int& C) { const int st = b / 1024, sb = b % 1024, swz = sb ^ (((sb >> 9) & 1) << 5); R = (st >> 1) * 16 + swz / 64; C = (st & 1) * 32 + (swz % 64) / 2; }
__host__ __device__ __forceinline__ int perm32(int rho) { const int n = rho >> 4, i = rho & 15; return 8 * (i >> 2) + 4 * n + (i & 3); }

struct Unit { int pm, pn; };
struct Gemm { const bf16_t* A; const bf16_t* Bt; int M, N, K, lda, ldb; int a_split_pn; int a_split_off; };

struct StaticOrder {
    int nM, nN, nwg, G, c;
    __host__ __device__ void init(int M, int N, int G_, int c_) { nM = M / BM; nN = N / BM; nwg = nM * nN; G = G_; c = c_; }
    __host__ __device__ bool next(int i, Unit& u) const {
        const long L = (long)i * G + c; if (L >= nwg) return false;
        int wgid = (int)L; { const int q = nwg / NXCD, r = nwg % NXCD, xcd = wgid % NXCD, off = wgid / NXCD; wgid = (xcd < r ? xcd * (q + 1) : r * (q + 1) + (xcd - r) * q) + off; }
        const int nig = WGM * nN, gid = wgid / nig, fm = gid * WGM, gsz = (nM - fm) < WGM ? (nM - fm) : WGM;
        u.pm = fm + ((wgid % nig) % gsz); u.pn = (wgid % nig) / gsz; return true;
    }
    __device__ __forceinline__ void a_ready(const Unit&, int) const {}
    __device__ __forceinline__ void done(const Unit&) const {}
};

template <int NP>
struct RowScaleOrder : StaticOrder {
    const float* part; float inv_dim; PG8_LAS float* tab;
    __device__ __forceinline__ void a_ready(const Unit& u, int seq) const {
        const int t = otid();
        if (t < 256) {
            const float* p = part + (size_t)(u.pm * BM + t) * NP;
            float sm = 0.f;
#pragma unroll
            for (int k = 0; k < NP; k += 4) { const f32x4 v = *(const f32x4*)(p + k); sm += (v[0] + v[1]) + (v[2] + v[3]); }
            tab[(seq & 1) * 256 + t] = rsqrtf(sm * inv_dim + 1e-6f);
        }
    }
};

struct MlaOrder : StaticOrder {
    const float* sqq; const float* sqkv; PG8_LAS float* tab;
    __device__ __forceinline__ void a_ready(const Unit& u, int seq) const {
        const int t = otid();
        if (t < 256) {
            const size_t row = (size_t)(u.pm * BM + t);
            const f32x4 q0 = *(const f32x4*)(sqq + row * 8), q1 = *(const f32x4*)(sqq + row * 8 + 4), k0 = *(const f32x4*)(sqkv + row * 4);
            tab[((seq & 1) * 256 + t) * 2] = rsqrtf((((q0[0] + q0[1]) + (q0[2] + q0[3])) + ((q1[0] + q1[1]) + (q1[2] + q1[3]))) * (1.0f / QL) + 1e-6f);
            tab[((seq & 1) * 256 + t) * 2 + 1] = rsqrtf(((k0[0] + k0[1]) + (k0[2] + k0[3])) * (1.0f / KVL) + 1e-6f);
        }
    }
};

__device__ __forceinline__ unsigned cvt_pk_bf16(float lo, float hi) { unsigned r; asm volatile("v_cvt_pk_bf16_f32 %0, %1, %2" : "=v"(r) : "v"(lo), "v"(hi)); return r; }
template <class Epi, class Sched, bool ALIGN_EPI = false, bool SP2 = false>
__device__ __forceinline__ void gemm_phase(PG8_LAS unsigned char* lds, const Gemm g, const Sched& S, const Epi& E) {
    const int tid = otid(), wid = __builtin_amdgcn_readfirstlane(tid >> 6), lane = tid & 63, wr = wid >> 2, wc = wid & 3, fr = lane & 15, fq = lane >> 4;
    const int K = g.K, nt = K / BK;
    unsigned voffA[2], voffB[2];
#pragma unroll
    for (int i = 0; i < 2; ++i) { int R, C; stage_rc(tid * 16 + i * 8192, R, C); const int Rb = Epi::PERM ? ((R & ~31) + perm32(R & 31)) : R;
        voffA[i] = (unsigned)(R * g.lda + C) * 2u; voffB[i] = (unsigned)(Rb * g.ldb + C) * 2u; }
    const size_t kstep = (size_t)(BK * 2);
    const size_t hstepA = (size_t)HALF * g.lda * 2, hstepB = (size_t)HALF * g.ldb * 2;
    const size_t tstepA = 2 * hstepA, tstepB = 2 * hstepB;
    const unsigned ldsw = (unsigned)wid * 1024u;
    const int aoff = lds_byte(wr * 64 + fr, fq * 8), boff = lds_byte(wc * 32 + fr, fq * 8);
#define PG8_SA(b, h) (((b) * 2 + (h)) * HTB)
#define PG8_SB(b, h) ((4 + (b) * 2 + (h)) * HTB)
#define PG8_STAGE(bufoff, gbase, voff) do { _Pragma("unroll") for (int _i = 0; _i < 2; ++_i) \
        __builtin_amdgcn_global_load_lds((const unsigned*)((const char*)(gbase) + (voff)[_i]), (PG8_LAS unsigned*)(lds + (bufoff) + ldsw + _i * 8192), 16, 0, 0); } while (0)
#define PG8_LDA(dst, b, h) do { _Pragma("unroll") for (int m = 0; m < 4; ++m) _Pragma("unroll") for (int k = 0; k < 2; ++k) dst[m][k] = *(const PG8_LAS bf16x8*)(lds + PG8_SA(b, h) + aoff + m * 2048 + k * 1024); } while (0)
#define PG8_LDB(dst, b, h) do { _Pragma("unroll") for (int n = 0; n < 2; ++n) _Pragma("unroll") for (int k = 0; k < 2; ++k) dst[n][k] = *(const PG8_LAS bf16x8*)(lds + PG8_SB(b, h) + boff + n * 2048 + k * 1024); } while (0)
#define PG8_MMA(ai, bj, At, Bt) do { __builtin_amdgcn_s_setprio(1); _Pragma("unroll") for (int m = 0; m < 4; ++m) _Pragma("unroll") for (int n = 0; n < 2; ++n) _Pragma("unroll") for (int k = 0; k < 2; ++k) \
        acc[ai][bj][m][n] = __builtin_amdgcn_mfma_f32_16x16x32_bf16(Bt[n][k], At[m][k], acc[ai][bj][m][n], 0, 0, 0); __builtin_amdgcn_s_setprio(0); } while (0)
#define PG8_WAIT_V(n) asm volatile("s_waitcnt vmcnt(" #n ")" ::: "memory")
#define PG8_WAIT_L(n) asm volatile("s_waitcnt lgkmcnt(" #n ")" ::: "memory")
#define PG8_BAR __builtin_amdgcn_s_barrier()
#define PG8_SCHED __builtin_amdgcn_sched_barrier(0)
    Unit cur, nxt; int ui = 0;
    if (!S.next(0, cur)) return;
    f32x4 acc[2][2][4][2];
#pragma unroll
    for (int a = 0; a < 2; ++a)
#pragma unroll
        for (int b = 0; b < 2; ++b)
#pragma unroll
            for (int m = 0; m < 4; ++m)
#pragma unroll
                for (int n = 0; n < 2; ++n) acc[a][b][m][n] = (f32x4){0.f, 0.f, 0.f, 0.f};
    bf16x8 At[4][2], B0[2][2], B1[2][2];
    const char* cA = (const char*)g.A + (size_t)cur.pm * tstepA + (cur.pn >= g.a_split_pn ? g.a_split_off : 0); const char* cB = (const char*)g.Bt + (size_t)cur.pn * tstepB;
    S.a_ready(cur, 0);
    if constexpr (SP2) {
        PG8_STAGE(PG8_SB(0, 0), cB, voffB); PG8_STAGE(PG8_SB(0, 1), cB + hstepB, voffB); PG8_STAGE(PG8_SA(0, 0), cA, voffA); PG8_STAGE(PG8_SA(0, 1), cA + hstepA, voffA);
        if (wr == 1) PG8_BAR;
        PG8_WAIT_V(2); PG8_BAR;
        PG8_STAGE(PG8_SB(1, 0), cB + kstep, voffB); PG8_STAGE(PG8_SA(1, 0), cA + kstep, voffA); PG8_STAGE(PG8_SB(1, 1), cB + hstepB + kstep, voffB);
        PG8_WAIT_V(6); PG8_BAR;
    } else {
        PG8_STAGE(PG8_SB(0, 0), cB, voffB); PG8_STAGE(PG8_SA(0, 0), cA, voffA); PG8_STAGE(PG8_SB(0, 1), cB + hstepB, voffB); PG8_STAGE(PG8_SA(0, 1), cA + hstepA, voffA);
        if (wr == 1) PG8_BAR;
        PG8_WAIT_V(4); PG8_BAR;
        PG8_STAGE(PG8_SB(1, 0), cB + kstep, voffB); PG8_STAGE(PG8_SA(1, 0), cA + kstep, voffA); PG8_STAGE(PG8_SB(1, 1), cB + hstepB + kstep, voffB);
        PG8_WAIT_V(6); PG8_BAR;
    }
    for (;;) {
        const bool has_next = S.next(ui + 1, nxt);
        const char* nA = has_next ? (const char*)g.A + (size_t)nxt.pm * tstepA + (nxt.pn >= g.a_split_pn ? g.a_split_off : 0) : cA; const char* nB = has_next ? (const char*)g.Bt + (size_t)nxt.pn * tstepB : cB;
        for (int t = 0; t < nt; t += 2) {
            const bool last = (t == nt - 2);
            const char* a1 = cA + (size_t)(t + 1) * kstep;
            const char* a2 = last ? nA : cA + (size_t)(t + 2) * kstep; const char* b2 = last ? nB : cB + (size_t)(t + 2) * kstep;
            const char* a3 = a2 + kstep; const char* b3 = b2 + kstep;
            if (last && has_next) S.a_ready(nxt, ui + 1);
            if constexpr (SP2) {
            PG8_LDB(B0, 0, 0); PG8_LDB(B1, 0, 1); PG8_SCHED; PG8_LDA(At, 0, 0); PG8_STAGE(PG8_SA(1, 1), a1 + hstepA, voffA);
            PG8_WAIT_V(8); PG8_WAIT_L(0); PG8_BAR; PG8_MMA(0, 0, At, B0); PG8_MMA(0, 1, At, B1); PG8_BAR; PG8_SCHED;
            PG8_LDA(At, 0, 1); PG8_STAGE(PG8_SB(0, 0), b2, voffB); PG8_STAGE(PG8_SB(0, 1), b2 + hstepB, voffB); PG8_STAGE(PG8_SA(0, 0), a2, voffA);
            PG8_WAIT_V(8); PG8_WAIT_L(0); PG8_BAR; PG8_MMA(1, 0, At, B0); PG8_MMA(1, 1, At, B1); PG8_BAR; PG8_SCHED;
            PG8_LDB(B0, 1, 0); PG8_LDB(B1, 1, 1); PG8_SCHED; PG8_LDA(At, 1, 0); PG8_STAGE(PG8_SA(0, 1), a2 + hstepA, voffA);
            PG8_WAIT_V(8); PG8_WAIT_L(0); PG8_BAR; PG8_MMA(0, 0, At, B0); PG8_MMA(0, 1, At, B1); PG8_BAR; PG8_SCHED;
            PG8_LDA(At, 1, 1); PG8_STAGE(PG8_SB(1, 0), b3, voffB); PG8_STAGE(PG8_SB(1, 1), b3 + hstepB, voffB); PG8_STAGE(PG8_SA(1, 0), a3, voffA);
            PG8_WAIT_V(8); PG8_WAIT_L(0); PG8_BAR; PG8_MMA(1, 0, At, B0); PG8_MMA(1, 1, At, B1); PG8_BAR; PG8_SCHED;
            } else {
            PG8_LDB(B0, 0, 0); PG8_SCHED; PG8_LDA(At, 0, 0); PG8_STAGE(PG8_SA(1, 1), a1 + hstepA, voffA);
            PG8_WAIT_L(8); PG8_BAR; PG8_WAIT_L(0); PG8_MMA(0, 0, At, B0); PG8_BAR; PG8_SCHED;
            PG8_LDB(B1, 0, 1); PG8_STAGE(PG8_SB(0, 0), b2, voffB);
            PG8_BAR; PG8_WAIT_L(0); PG8_MMA(0, 1, At, B1); PG8_BAR;
            PG8_LDA(At, 0, 1); PG8_STAGE(PG8_SA(0, 0), a2, voffA);
            PG8_BAR; PG8_WAIT_L(0); PG8_MMA(1, 0, At, B0); PG8_BAR; PG8_SCHED;
            PG8_STAGE(PG8_SB(0, 1), b2 + hstepB, voffB);
            PG8_WAIT_V(6); PG8_BAR; PG8_MMA(1, 1, At, B1); PG8_BAR;
            PG8_LDB(B0, 1, 0); PG8_SCHED; PG8_LDA(At, 1, 0); PG8_STAGE(PG8_SA(0, 1), a2 + hstepA, voffA);
            PG8_WAIT_L(8); PG8_BAR; PG8_WAIT_L(0); PG8_MMA(0, 0, At, B0); PG8_BAR; PG8_SCHED;
            PG8_LDB(B1, 1, 1); PG8_STAGE(PG8_SB(1, 0), b3, voffB);
            PG8_BAR; PG8_WAIT_L(0); PG8_MMA(0, 1, At, B1); PG8_BAR;
            PG8_LDA(At, 1, 1); PG8_STAGE(PG8_SA(1, 0), a3, voffA);
            PG8_BAR; PG8_WAIT_L(0); PG8_MMA(1, 0, At, B0); PG8_BAR; PG8_SCHED;
            PG8_STAGE(PG8_SB(1, 1), b3 + hstepB, voffB);
            PG8_WAIT_V(6); PG8_BAR; PG8_MMA(1, 1, At, B1); PG8_BAR;
            }
        }
        if constexpr (ALIGN_EPI) { if (wr == 0) PG8_BAR; }
        if constexpr (!Epi::AFTER_DRAIN) { E(acc, cur, wr, wc, fr, fq, ui); S.done(cur); }
        if (!has_next) break;
#pragma unroll
        for (int a = 0; a < 2; ++a)
#pragma unroll
            for (int b = 0; b < 2; ++b)
#pragma unroll
                for (int m = 0; m < 4; ++m)
#pragma unroll
                    for (int n = 0; n < 2; ++n) acc[a][b][m][n] = (f32x4){0.f, 0.f, 0.f, 0.f};
        cur = nxt; cA = nA; cB = nB; ++ui;
        if constexpr (ALIGN_EPI) { if (wr == 1) PG8_BAR; }
    }
    PG8_WAIT_V(0);
    if constexpr (!ALIGN_EPI) { if (wr == 0) PG8_BAR; }
    PG8_BAR;
    if constexpr (Epi::AFTER_DRAIN) { E.fused(acc, cur, wr, wc, fr, fq, lds, wid, lane); S.done(cur); }
#undef PG8_SA
#undef PG8_SB
#undef PG8_STAGE
#undef PG8_LDA
#undef PG8_LDB
#undef PG8_MMA
#undef PG8_WAIT_V
#undef PG8_WAIT_L
#undef PG8_BAR
#undef PG8_SCHED
}
}

namespace pg8 {
struct EpiProj {
    static constexpr bool PERM = true, AFTER_DRAIN = false;
    bf16_t* O; int ldc; int ncols; const PG8_LAS float* tab; float* sqq; float* sqkv; bf16_t* Kb; const float* rope; bf16_t* sav;
    __device__ __forceinline__ void operator()(const f32x4 (&acc)[2][2][4][2], const Unit& u, int wr, int wc, int fr, int fq, int seq) const {
        const int row0 = u.pm * BM + wr * 64 + fr, col0 = u.pn * BM + wc * 32 + 8 * fq;
        const int lane_hi = (fq >> 1);
#pragma unroll
        for (int ai = 0; ai < 2; ++ai)
#pragma unroll
            for (int m = 0; m < 4; ++m) {
                const int row = row0 + ai * HALF + m * 16;
                const float rs = tab[(seq & 1) * 256 + wr * 64 + fr + ai * HALF + m * 16];
                bf16_t* rowp = O + (size_t)row * ldc + col0;
#pragma unroll
                for (int bj = 0; bj < 2; ++bj) {
                    const f32x4 v0 = acc[ai][bj][m][0] * rs, v1 = acc[ai][bj][m][1] * rs;
                    u32x4 w; w.x = cvt_pk_bf16(v0[0], v0[1]); w.y = cvt_pk_bf16(v0[2], v0[3]); w.z = cvt_pk_bf16(v1[0], v1[1]); w.w = cvt_pk_bf16(v1[2], v1[3]);
                    const int col = col0 + bj * HALF;
                    if (col < ncols) *(u32x4*)(rowp + bj * HALF) = w;
                    if (u.pn <= 6 && m == 3 && fr == 15 && col < 1664) {
                        const int t = row & (SEQ - 1), cn = (t >> 6) + 1;
                        if (cn < 64) *(u32x4*)(sav + ((size_t)(row >> 12) * 64 + cn) * 1664 + col) = w;
                    }
                    const bool isq = (u.pn == 8 && bj == 1) || (u.pn == 9 && bj == 0), iskv = (u.pn == 9 && bj == 1);
                    if (isq || iskv) {
                        float ss = (v0[0] * v0[0] + v0[1] * v0[1]) + (v0[2] * v0[2] + v0[3] * v0[3]) + (v1[0] * v1[0] + v1[1] * v1[1]) + (v1[2] * v1[2] + v1[3] * v1[3]);
                        ss += shx<16>(ss); { float x, y; swap32(ss, x, y); ss = x + y; }
                        if (fq == 0) { if (iskv) sqkv[(size_t)row * 4 + wc] = ss; else sqq[(size_t)row * 8 + (u.pn == 8 ? 0 : 4) + wc] = ss; }
                    }
                    if (u.pn == 10 && bj == 0 && wc == 0) {
                        const int t = row & (SEQ - 1);
                        const float* rp = rope + ((size_t)t * 16 + 8 * (fq & 1)) * 2;
                        const f32x4 c0 = *(const f32x4*)rp, c1 = *(const f32x4*)(rp + 4), c2 = *(const f32x4*)(rp + 8), c3 = *(const f32x4*)(rp + 12);
                        const float cs[8] = {c0[0], c0[2], c1[0], c1[2], c2[0], c2[2], c3[0], c3[2]}, sn[8] = {c0[1], c0[3], c1[1], c1[3], c2[1], c2[3], c3[1], c3[3]};
                        const float own[8] = {v0[0], v0[1], v0[2], v0[3], v1[0], v1[1], v1[2], v1[3]};
                        float o[8];
#pragma unroll
                        for (int e = 0; e < 8; ++e) { float x, y; swap32(own[e], x, y); const float oth = lane_hi ? x : y;
                            o[e] = lane_hi ? (oth * sn[e] + own[e] * cs[e]) : (own[e] * cs[e] - oth * sn[e]); }
                        u32x4 kw; kw.x = cvt_pk_bf16(o[0], o[1]); kw.y = cvt_pk_bf16(o[2], o[3]); kw.z = cvt_pk_bf16(o[4], o[5]); kw.w = cvt_pk_bf16(o[6], o[7]);
#pragma unroll
                        for (int hh = 0; hh < 8; ++hh) *(u32x4*)(Kb + ((size_t)row * 8 + hh) * 96 + 64 + 8 * fq) = kw;
                    }
                }
                asm volatile("" ::: "memory");
            }
    }
};
struct EpiResid {
    static constexpr bool PERM = true, AFTER_DRAIN = false;
    int ldc; bool dry; bf16_t* HB; float* ssq;
    __device__ __forceinline__ void operator()(const f32x4 (&acc)[2][2][4][2], const Unit& u, int wr, int wc, int fr, int fq, int seq) const {
        const int row0 = u.pm * BM + wr * 64 + fr, col0 = u.pn * BM + wc * 32 + 8 * fq;
#pragma unroll
        for (int ai = 0; ai < 2; ++ai) {
            u32x4 rv[4][2];
#pragma unroll
            for (int m = 0; m < 4; ++m)
#pragma unroll
                for (int bj = 0; bj < 2; ++bj) rv[m][bj] = *(const u32x4*)(HB + (size_t)(row0 + ai * HALF + m * 16) * ldc + col0 + bj * HALF);
#pragma unroll
            for (int m = 0; m < 4; ++m) { const int row = row0 + ai * HALF + m * 16; const size_t off = (size_t)row * ldc + col0;
                float ss = 0.f;
#pragma unroll
                for (int bj = 0; bj < 2; ++bj) { const u32x4 r = rv[m][bj]; f32x4 o0 = acc[ai][bj][m][0], o1 = acc[ai][bj][m][1];
                    o0[0] += __uint_as_float(r.x << 16); o0[1] += __uint_as_float(r.x & 0xffff0000u); o0[2] += __uint_as_float(r.y << 16); o0[3] += __uint_as_float(r.y & 0xffff0000u);
                    o1[0] += __uint_as_float(r.z << 16); o1[1] += __uint_as_float(r.z & 0xffff0000u); o1[2] += __uint_as_float(r.w << 16); o1[3] += __uint_as_float(r.w & 0xffff0000u);
                    ss += ((o0[0] * o0[0] + o0[1] * o0[1]) + (o0[2] * o0[2] + o0[3] * o0[3])) + ((o1[0] * o1[0] + o1[1] * o1[1]) + (o1[2] * o1[2] + o1[3] * o1[3]));
                    u32x4 hb; hb.x = cvt_pk_bf16(o0[0], o0[1]); hb.y = cvt_pk_bf16(o0[2], o0[3]); hb.z = cvt_pk_bf16(o1[0], o1[1]); hb.w = cvt_pk_bf16(o1[2], o1[3]);
                    if (!dry) *(u32x4*)(HB + off + bj * HALF) = hb; }
                ss += shx<16>(ss); { float x, y; swap32(ss, x, y); ss = x + y; }
                if (fq == 0 && !dry) ssq[(size_t)row * 16 + u.pn * 4 + wc] = ss;
            }
        }
    }
};
struct EpiMla {
    static constexpr bool PERM = true, AFTER_DRAIN = false;
    bf16_t* Q; bf16_t* K; bf16_t* V; const PG8_LAS float* tab; const float* rope; float c2; int pn0;
    __device__ __forceinline__ void operator()(const f32x4 (&acc)[2][2][4][2], const Unit& u, int wr, int wc, int fr, int fq, int seq) const {
        const int row0 = u.pm * BM + wr * 64 + fr;
        const int lane_hi = (fq >> 1);
#pragma unroll
        for (int ai = 0; ai < 2; ++ai)
#pragma unroll
            for (int m = 0; m < 4; ++m) {
                const int row = row0 + ai * HALF + m * 16;
                const int rl = wr * 64 + fr + ai * HALF + m * 16;
                const float rq = tab[((seq & 1) * 256 + rl) * 2], rk = tab[((seq & 1) * 256 + rl) * 2 + 1];
#pragma unroll
                for (int bj = 0; bj < 2; ++bj) {
                    const int pn = u.pn + pn0; const int cg = pn * BM + bj * HALF + wc * 32;
                    f32x4 v0 = acc[ai][bj][m][0], v1 = acc[ai][bj][m][1];
                    if (pn < 3) {
                        v0 = v0 * rq; v1 = v1 * rq;
                        if (((cg >> 5) % 3) == 2) {
                            const int t = row & (SEQ - 1);
                            const float* rp = rope + ((size_t)t * 16 + 8 * (fq & 1)) * 2;
                            const f32x4 c0 = *(const f32x4*)rp, c1 = *(const f32x4*)(rp + 4), c2_ = *(const f32x4*)(rp + 8), c3 = *(const f32x4*)(rp + 12);
                            const float cs[8] = {c0[0], c0[2], c1[0], c1[2], c2_[0], c2_[2], c3[0], c3[2]}, sn[8] = {c0[1], c0[3], c1[1], c1[3], c2_[1], c2_[3], c3[1], c3[3]};
                            const float own[8] = {v0[0], v0[1], v0[2], v0[3], v1[0], v1[1], v1[2], v1[3]};
                            float o[8];
#pragma unroll
                            for (int e = 0; e < 8; ++e) { float x, y; swap32(own[e], x, y); const float oth = lane_hi ? x : y;
                                o[e] = lane_hi ? (oth * sn[e] + own[e] * cs[e]) : (own[e] * cs[e] - oth * sn[e]); }
                            v0 = (f32x4){o[0], o[1], o[2], o[3]}; v1 = (f32x4){o[4], o[5], o[6], o[7]};
                        }
                        v0 = v0 * c2; v1 = v1 * c2;
                        u32x4 w; w.x = cvt_pk_bf16(v0[0], v0[1]); w.y = cvt_pk_bf16(v0[2], v0[3]); w.z = cvt_pk_bf16(v1[0], v1[1]); w.w = cvt_pk_bf16(v1[2], v1[3]);
                        *(u32x4*)(Q + (size_t)row * 768 + cg + 8 * fq) = w;
                    } else {
                        v0 = v0 * rk; v1 = v1 * rk;
                        const int c = cg - 768, hh = c >> 7, d = (c & 127) + 8 * fq;
                        u32x4 w; w.x = cvt_pk_bf16(v0[0], v0[1]); w.y = cvt_pk_bf16(v0[2], v0[3]); w.z = cvt_pk_bf16(v1[0], v1[1]); w.w = cvt_pk_bf16(v1[2], v1[3]);
                        bf16_t* p = (d < 64) ? K + ((size_t)row * 8 + hh) * 96 + d : V + ((size_t)row * 8 + hh) * 64 + (d - 64);
                        *(u32x4*)p = w;
                    }
                }
                asm volatile("" ::: "memory");
            }
    }
};
}

typedef float f32x4_t __attribute__((ext_vector_type(4)));
typedef unsigned u32x4_t __attribute__((ext_vector_type(4)));
template <class SRC4>
__device__ __forceinline__ void transpose_w(int K, int npad, bf16_t* WT, const SRC4& src4, float* lds) {
    const int tid = otid();
    const int tk = K / 64, tn = npad / 64;
    const int kk = tid >> 4, n4 = (tid & 15) * 4;
    const int nn = tid >> 3, k8 = (tid & 7) * 8;
    int par = 0;
    __syncthreads();
    for (int u = blockIdx.x; u < tk * tn; u += gridDim.x, par ^= 1) {
        const int k0 = (u % tk) * 64, n0 = (u / tk) * 64;
        float* tile = lds + par * (64 * 65);
        const f32x4_t v0 = src4(k0 + kk, n0 + n4), v1 = src4(k0 + kk + 32, n0 + n4);
#pragma unroll
        for (int e = 0; e < 4; ++e) { tile[kk * 65 + n4 + e] = v0[e]; tile[(kk + 32) * 65 + n4 + e] = v1[e]; }
        __syncthreads();
        u32x4_t w;
        w.x = f2bf2(tile[(k8 + 0) * 65 + nn], tile[(k8 + 1) * 65 + nn]); w.y = f2bf2(tile[(k8 + 2) * 65 + nn], tile[(k8 + 3) * 65 + nn]);
        w.z = f2bf2(tile[(k8 + 4) * 65 + nn], tile[(k8 + 5) * 65 + nn]); w.w = f2bf2(tile[(k8 + 6) * 65 + nn], tile[(k8 + 7) * 65 + nn]);
        *(u32x4_t*)(WT + (size_t)(n0 + nn) * K + k0 + k8) = w;
    }
}

template <class AL, class BL, class ST>
__device__ __forceinline__ void gemm_naive(int M, int N, int K, const AL& al, const BL& bl, const ST& st, float* lds) {
    float* As = lds;
    float* Bs = lds + 16 * 132;
    const int tid = otid(), ty = tid >> 4, tx = tid & 15;
    const int ntn = (N + 127) / 128, ntiles = (M / 128) * ntn;
    for (int u = blockIdx.x; u < ntiles; u += gridDim.x) {
        const int tm = u / ntn, tn = u % ntn;
        float acc[4][8];
#pragma unroll
        for (int i = 0; i < 4; ++i)
#pragma unroll
            for (int j = 0; j < 8; ++j) acc[i][j] = 0.f;
        for (int k0 = 0; k0 < K; k0 += 16) {
#pragma unroll
            for (int j = 0; j < 4; ++j) { const int idx = tid + j * 512, r = idx >> 4, k = idx & 15; As[k * 132 + r] = al(tm * 128 + r, k0 + k); }
#pragma unroll
            for (int j = 0; j < 4; ++j) { const int idx = tid + j * 512, k = idx >> 7, c = idx & 127; Bs[k * 132 + c] = bl(k0 + k, tn * 128 + c); }
            __syncthreads();
#pragma unroll 2
            for (int k = 0; k < 16; ++k) {
                const float4 a4 = *(const float4*)&As[k * 132 + ty * 4];
                const float4 b0 = *(const float4*)&Bs[k * 132 + tx * 8], b1 = *(const float4*)&Bs[k * 132 + tx * 8 + 4];
                const float av[4] = {a4.x, a4.y, a4.z, a4.w};
                const float bv[8] = {b0.x, b0.y, b0.z, b0.w, b1.x, b1.y, b1.z, b1.w};
#pragma unroll
                for (int i = 0; i < 4; ++i)
#pragma unroll
                    for (int j = 0; j < 8; ++j) acc[i][j] = fmaf(av[i], bv[j], acc[i][j]);
            }
            __syncthreads();
        }
#pragma unroll
        for (int i = 0; i < 4; ++i)
#pragma unroll
            for (int j = 0; j < 8; ++j) st(tm * 128 + ty * 4 + i, tn * 128 + tx * 8 + j, acc[i][j]);
    }
}

namespace rw {
typedef short bf16x8 __attribute__((ext_vector_type(8)));
typedef float f32x16 __attribute__((ext_vector_type(16)));
typedef float f32x4 __attribute__((ext_vector_type(4)));
typedef unsigned u32x2 __attribute__((ext_vector_type(2)));
typedef unsigned u32x4 __attribute__((ext_vector_type(4)));
constexpr int PB = 144, MB = 64 * PB;
constexpr int L_KKD = 0, L_RD = MB, L_BH = 2 * MB, L_KH = 3 * MB, L_BDT = 4 * MB, L_KDT = 5 * MB, L_VT = 6 * MB, L_KKDT = 7 * MB, L_BK = 8 * MB, L_WTT = 9 * MB, L_VTT = 10 * MB;
constexpr int L_AB = L_KKD, L_AK = L_BH, L_BB = L_KH, L_XWL = L_BK, L_XAL = L_WTT;
constexpr int L_F32 = 11 * MB;
constexpr int L_DEC = L_F32, L_AA = L_F32 + 17408, L_AKVT = L_F32, L_DIAG = L_F32 + 17408, L_TINV = L_DIAG + 4096;
constexpr int L_GC = L_F32 + 34816, L_SEG = L_GC + 256, L_END = L_SEG + 2048;
constexpr int L_MU = L_END;
constexpr int L_XR = 0, L_XK = 17408;
__device__ __forceinline__ int crow(int r, int hi) { return (r & 3) + 8 * (r >> 2) + 4 * hi; }
__device__ __forceinline__ unsigned pk2(float lo, float hi) { return f2bf2(lo, hi); }
#define RW_FRAG(base, row, ks) (*(const LAS bf16x8*)(shm + (base) + (row) * PB + (16 * (ks) + 8 * hi) * 2))
#define RW_MFMA(a, b, c) __builtin_amdgcn_mfma_f32_32x32x16_bf16(a, b, c, 0, 0, 0)
#define RW_PIN4(x) asm volatile("" : "+v"((x)[0]), "+v"((x)[1]), "+v"((x)[2]), "+v"((x)[3]))
#define RW_PIN8(x, y) asm volatile("" : "+v"((x)[0]), "+v"((x)[1]), "+v"((x)[2]), "+v"((x)[3]), "+v"((y)[0]), "+v"((y)[1]), "+v"((y)[2]), "+v"((y)[3]))

struct R1Raw { u32x4 cur[5], prv[5]; };
__device__ __forceinline__ void r1_load(R1Raw& r, const bf16_t* PROJ, const bf16_t* sava, int b, int h, int c, int tid) {
    const int t = tid >> 3, g = tid & 7;
    const unsigned row0 = (unsigned)b * SEQ + (unsigned)c * 64;
    const __amdgpu_buffer_rsrc_t rs = __builtin_amdgcn_make_buffer_rsrc((void*)PROJ, 0, 0x7fffffff, 0x00020000);
    const int cols[5] = {C_R + h * 64 + 8 * g, C_K + h * 64 + 8 * g, C_V + h * 64 + 8 * g, C_WL + 8 * g, C_AL + 8 * g};
    const unsigned rb = (unsigned)__builtin_amdgcn_readfirstlane((int)(row0 * (unsigned)(DIN * 2)));
    const int vo = t * (DIN * 2);
#pragma unroll
    for (int k = 0; k < 5; ++k) r.cur[k] = __builtin_bit_cast(u32x4, __builtin_amdgcn_raw_buffer_load_b128(rs, vo + cols[k] * 2, rb, 0));
    if (t > 0) {
#pragma unroll
        for (int k = 0; k < 5; ++k) r.prv[k] = __builtin_bit_cast(u32x4, __builtin_amdgcn_raw_buffer_load_b128(rs, vo - DIN * 2 + cols[k] * 2, rb, 0));
    } else if (c > 0) {
        const bf16_t* sav = sava + ((size_t)b * 64 + c) * 1664;
#pragma unroll
        for (int k = 0; k < 5; ++k) r.prv[k] = *(const u32x4*)(sav + cols[k]);
    } else {
#pragma unroll
        for (int k = 0; k < 5; ++k) r.prv[k] = (u32x4){0u, 0u, 0u, 0u};
    }
}
__device__ __forceinline__ void r1_phase(int l, LAS char* shm, const bool dry = false) {
    const int tid0 = otid(), lane_o = tid0 & 63, r32o = lane_o & 31, hio = lane_o >> 5;
    const int wid = __builtin_amdgcn_readfirstlane(tid0 >> 6);
    bf16_t* PROJ = (bf16_t*)(ARG_WS + WS_PROJ);
    const bf16_t* sava = (const bf16_t*)(ARG_WS + WS_SAVA);
    const int h = blockIdx.x & 7, jw = blockIdx.x >> 3, nper = gridDim.x >> 3;
    const int ch = h * 64 + lane_o;
    const int tq = wid * 8;
    const float* mu = ARG(3) + (size_t)l * 1664;
    __syncthreads();
    if (tid0 < 320) { const int k = tid0 >> 6, j = tid0 & 63; ((LAS float*)(shm + L_MU))[tid0] = mu[((k == 0) ? C_R + h * 64 : (k == 1) ? C_K + h * 64 : (k == 2) ? C_V + h * 64 : (k == 3) ? C_WL : C_AL) + j]; }
    __syncthreads();
    const float kkc = (ARG(8) + (size_t)l * 512)[ch], kac = (ARG(9) + (size_t)l * 512)[ch], rkc = (ARG(10) + (size_t)l * 512)[ch];
    const int pB = wid >> 2, tlB = wid & 3, trB = 32 * (tlB >> 1), ncB = 32 * (tlB & 1);
    const float biasB = ((pB ? ARG(6) : ARG(4)) + (size_t)l * 512)[h * 64 + ncB + r32o];
    R1Raw cur, nxt;
    if (jw < 512) r1_load(cur, PROJ, sava, jw >> 6, h, jw & 63, tid0);
    for (int idx = jw; idx < 512; idx += nper) {
    const int tidl = otid(), lanel = tidl & 63, r32 = lanel & 31, hi = lanel >> 5;
    (void)hio;
    const int lane = lanel;
    const int b = idx >> 6, c = idx & 63;
    const size_t row0 = (size_t)b * SEQ + (size_t)c * 64;
    const int unit = (b * 8 + h) * 64 + c;
    u32x4 vvst;
    bf16x8 wfr[4];
    { const bf16_t* wt = (const bf16_t*)(ARG_WS + WS_W2T) + (size_t)pB * DEPTH * 512 * 64 + ((size_t)l * 512 + h * 64 + ncB + r32) * 64;
#pragma unroll
      for (int ks = 0; ks < 4; ++ks) wfr[ks] = *(const bf16x8*)(wt + 16 * ks + 8 * hi); }
    f32x4 mu4[10];
#pragma unroll
    for (int k = 0; k < 5; ++k) { mu4[2 * k] = *(const LAS f32x4*)((const LAS float*)(shm + L_MU) + k * 64 + 8 * (tidl & 7)); mu4[2 * k + 1] = *(const LAS f32x4*)((const LAS float*)(shm + L_MU) + k * 64 + 8 * (tidl & 7) + 4); }
    __syncthreads();
    asm volatile("" : "+v"(mu4[0]), "+v"(mu4[1]), "+v"(mu4[2]), "+v"(mu4[3]), "+v"(mu4[4]), "+v"(mu4[5]), "+v"(mu4[6]), "+v"(mu4[7]), "+v"(mu4[8]), "+v"(mu4[9]));
    PAMP_BEGIN(31);
    {
        const int tA = tidl >> 3, gA = tidl & 7;
        auto lerp8 = [&](int k, float (&x)[8]) {
            const f32x4 m0 = mu4[2 * k], m1 = mu4[2 * k + 1];
            const float m[8] = {m0[0], m0[1], m0[2], m0[3], m1[0], m1[1], m1[2], m1[3]};
            const unsigned cw[4] = {cur.cur[k].x, cur.cur[k].y, cur.cur[k].z, cur.cur[k].w}, pw[4] = {cur.prv[k].x, cur.prv[k].y, cur.prv[k].z, cur.prv[k].w};
#pragma unroll
            for (int j = 0; j < 4; ++j) {
                const float c0 = __uint_as_float(cw[j] << 16), c1 = __uint_as_float(cw[j] & 0xffff0000u), p0 = __uint_as_float(pw[j] << 16), p1 = __uint_as_float(pw[j] & 0xffff0000u);
                x[2 * j] = c0 + m[2 * j] * (p0 - c0); x[2 * j + 1] = c1 + m[2 * j + 1] * (p1 - c1);
            }
        };
        float x[8];
        lerp8(0, x);
        *(LAS f32x4*)(shm + L_XR + (tA * 68 + 8 * gA) * 4) = (f32x4){x[0], x[1], x[2], x[3]}; *(LAS f32x4*)(shm + L_XR + (tA * 68 + 8 * gA + 4) * 4) = (f32x4){x[4], x[5], x[6], x[7]};
        lerp8(1, x);
        *(LAS f32x4*)(shm + L_XK + (tA * 68 + 8 * gA) * 4) = (f32x4){x[0], x[1], x[2], x[3]}; *(LAS f32x4*)(shm + L_XK + (tA * 68 + 8 * gA + 4) * 4) = (f32x4){x[4], x[5], x[6], x[7]};
        lerp8(2, x);
        vvst.x = pk2(x[0], x[1]); vvst.y = pk2(x[2], x[3]); vvst.z = pk2(x[4], x[5]); vvst.w = pk2(x[6], x[7]);
        { const unsigned wv[4] = {vvst.x, vvst.y, vvst.z, vvst.w};
#pragma unroll
          for (int j = 0; j < 8; ++j) *(LAS bf16_t*)(shm + L_VT + (8 * gA + j) * PB + tA * 2) = (bf16_t)((j & 1) ? (wv[j >> 1] >> 16) : (wv[j >> 1] & 0xffffu)); }
        lerp8(3, x);
        { u32x4 w; w.x = pk2(ftanh(x[0]), ftanh(x[1])); w.y = pk2(ftanh(x[2]), ftanh(x[3])); w.z = pk2(ftanh(x[4]), ftanh(x[5])); w.w = pk2(ftanh(x[6]), ftanh(x[7]));
          *(LAS u32x4*)(shm + L_XWL + tA * PB + gA * 16) = w; }
        lerp8(4, x);
        { u32x4 w; w.x = pk2(x[0], x[1]); w.y = pk2(x[2], x[3]); w.z = pk2(x[4], x[5]); w.w = pk2(x[6], x[7]);
          *(LAS u32x4*)(shm + L_XAL + tA * PB + gA * 16) = w; }
    }
    __syncthreads();
    {
        const int p = pB, tr = trB, nc = ncB;
        f32x16 acc;
#pragma unroll
        for (int r = 0; r < 16; ++r) acc[r] = biasB;
        const int xb = p ? L_XAL : L_XWL;
        bf16x8 fa[4];
#pragma unroll
        for (int ks = 0; ks < 4; ++ks) fa[ks] = RW_FRAG(xb, tr + r32, ks);
        RW_PIN4(fa);
#pragma unroll
        for (int ks = 0; ks < 4; ++ks) acc = RW_MFMA(fa[ks], wfr[ks], acc);
        LAS float* dst = (LAS float*)(shm + (p ? L_AA : L_DEC));
#pragma unroll
        for (int r = 0; r < 16; ++r) dst[(tr + crow(r, hi)) * 68 + nc + r32] = acc[r];
    }
    __syncthreads();
    PAMP_END(31);
    PAMP_BEGIN(32);
    {
        float* bon = (float*)(ARG_WS + WS_BON);
        float kkn[8], kpv[8], bbv[8], ld[8], lg[8], xr[8], xk[8];
#pragma unroll
        for (int e = 0; e < 8; ++e) { xr[e] = ((const LAS float*)(shm + L_XR))[(tq + e) * 68 + lane]; xk[e] = ((const LAS float*)(shm + L_XK))[(tq + e) * 68 + lane]; }
        float run = 0.f;
        LAS float* zb = (LAS float*)(shm + L_KKDT) + wid * (16 * 64 + 16);
#pragma unroll
        for (int e = 0; e < 8; ++e) {
            const float dec = ((const LAS float*)(shm + L_DEC))[(tq + e) * 68 + lane], aav = ((const LAS float*)(shm + L_AA))[(tq + e) * 68 + lane];
            ld[e] = -0.6065306597126334f * sigmoidf_(dec);
            const float av = sigmoidf_(aav);
            const float kkr = xk[e] * kkc;
            kkn[e] = kkr; bbv[e] = kkr * av;
            kpv[e] = xk[e] * (1.0f + (av - 1.0f) * kac);
            zb[e * 64 + lane] = kkr * kkr;
            zb[(8 + e) * 64 + lane] = xr[e] * kpv[e] * rkc;
            run += ld[e]; lg[e] = run;
        }
        {
            const LAS f32x4* zp = (const LAS f32x4*)(zb + (lane >> 2) * 64 + (lane & 3) * 16);
            const f32x4 z0 = zp[0], z1 = zp[1], z2 = zp[2], z3 = zp[3];
            float tsum = (((z0[0] + z0[1]) + (z0[2] + z0[3])) + ((z1[0] + z1[1]) + (z1[2] + z1[3]))) + (((z2[0] + z2[1]) + (z2[2] + z2[3])) + ((z3[0] + z3[1]) + (z3[2] + z3[3])));
            tsum += dppx<0xB1>(tsum); tsum += dppx<0x4E>(tsum);
            if ((lane & 3) == 0) zb[16 * 64 + (lane >> 2)] = tsum;
            const f32x4 n0 = *(const LAS f32x4*)(zb + 16 * 64), n1 = *(const LAS f32x4*)(zb + 16 * 64 + 4);
            const float n2[8] = {n0[0], n0[1], n0[2], n0[3], n1[0], n1[1], n1[2], n1[3]};
#pragma unroll
            for (int e = 0; e < 8; ++e) { const float rn = __builtin_amdgcn_rsqf(fmaxf(n2[e], 1e-24f)); kkn[e] *= rn; bbv[e] *= rn; }
            if (lane < 8 && !dry) bon[(row0 + tq + lane) * 8 + h] = zb[16 * 64 + 8 + lane];
        }
        ((LAS float*)(shm + L_SEG))[wid * 64 + lane] = run;
        __syncthreads();
        float off = 0.f, tot = 0.f;
#pragma unroll
        for (int w = 0; w < 8; ++w) { const float sgm = ((const LAS float*)(shm + L_SEG))[w * 64 + lane]; tot += sgm; if (w < wid) off += sgm; }
        const float gct = fexp(tot);
        if (wid == 0) ((LAS float*)(shm + L_GC))[lane] = gct;
        float tb[8], tk[8], tkk[8];
        float gprev = fexp(off);
#pragma unroll
        for (int e = 0; e < 8; ++e) {
            const float L = off + lg[e];
            const float g = fexp(L), gp = gprev, ig = frcp(g), ge = gct * ig;
            gprev = g;
            const int t = tq + e;
            const float kkd = kkn[e] * gp;
            *(LAS bf16_t*)(shm + L_KKD + t * PB + lane * 2) = f2bf(kkd);
            *(LAS bf16_t*)(shm + L_RD + t * PB + lane * 2) = f2bf(xr[e] * g);
            *(LAS bf16_t*)(shm + L_BH + t * PB + lane * 2) = f2bf(bbv[e] * ig);
            *(LAS bf16_t*)(shm + L_KH + t * PB + lane * 2) = f2bf(kpv[e] * ig);
            tb[e] = bbv[e] * ge; tk[e] = kpv[e] * ge; tkk[e] = kkd;
        }
        u32x4 v;
        v.x = pk2(tb[0], tb[1]); v.y = pk2(tb[2], tb[3]); v.z = pk2(tb[4], tb[5]); v.w = pk2(tb[6], tb[7]); *(LAS u32x4*)(shm + L_BDT + lane * PB + tq * 2) = v;
        v.x = pk2(tk[0], tk[1]); v.y = pk2(tk[2], tk[3]); v.z = pk2(tk[4], tk[5]); v.w = pk2(tk[6], tk[7]); *(LAS u32x4*)(shm + L_KDT + lane * PB + tq * 2) = v;
        v.x = pk2(tkk[0], tkk[1]); v.y = pk2(tkk[2], tkk[3]); v.z = pk2(tkk[4], tkk[5]); v.w = pk2(tkk[6], tkk[7]); *(LAS u32x4*)(shm + L_KKDT + lane * PB + tq * 2) = v;
    }
    __syncthreads();
    PAMP_END(32);
    PAMP_BEGIN(33);
    {
        const int mat = wid & 3;
        const int ab = (mat < 2) ? L_KKD : L_RD, bb = (mat & 1) ? L_KH : L_BH;
        const int ob = (mat == 0) ? L_AB : (mat == 1) ? L_AK : (mat == 2) ? L_BB : L_BK;
        f32x16 acc0, acc1;
#pragma unroll
        for (int r = 0; r < 16; ++r) { acc0[r] = 0.f; acc1[r] = 0.f; }
        if (wid < 4) {
            bf16x8 fa0[4], fb0[4], fa1[4], fb1[4];
#pragma unroll
            for (int ks = 0; ks < 4; ++ks) { fa0[ks] = RW_FRAG(ab, r32, ks); fb0[ks] = RW_FRAG(bb, r32, ks); fa1[ks] = RW_FRAG(ab, 32 + r32, ks); fb1[ks] = RW_FRAG(bb, 32 + r32, ks); }
            asm volatile("" : "+v"(fa0[0]), "+v"(fa0[1]), "+v"(fa0[2]), "+v"(fa0[3]), "+v"(fb0[0]), "+v"(fb0[1]), "+v"(fb0[2]), "+v"(fb0[3]),
                         "+v"(fa1[0]), "+v"(fa1[1]), "+v"(fa1[2]), "+v"(fa1[3]), "+v"(fb1[0]), "+v"(fb1[1]), "+v"(fb1[2]), "+v"(fb1[3]));
#pragma unroll
            for (int ks = 0; ks < 4; ++ks) { acc0 = RW_MFMA(fa0[ks], fb0[ks], acc0); acc1 = RW_MFMA(fa1[ks], fb1[ks], acc1); }
        } else {
            bf16x8 fa0[4], fb0[4];
#pragma unroll
            for (int ks = 0; ks < 4; ++ks) { fa0[ks] = RW_FRAG(ab, 32 + r32, ks); fb0[ks] = RW_FRAG(bb, r32, ks); }
            RW_PIN8(fa0, fb0);
#pragma unroll
            for (int ks = 0; ks < 4; ++ks) acc0 = RW_MFMA(fa0[ks], fb0[ks], acc0);
        }
        __syncthreads();
        if (wid < 4) {
            const int lim = (mat < 2) ? 1 : 0;
            LAS char* o0 = shm + ob + (4 * hi) * PB + r32 * 2; LAS char* o1 = shm + ob + (32 + 4 * hi) * PB + (32 + r32) * 2;
#pragma unroll
            for (int r = 0; r < 16; ++r) {
                const int tl_ = (r & 3) + 8 * (r >> 2);
                const bool keep = (tl_ + 4 * hi) >= (r32 + lim);
                acc0[r] = keep ? acc0[r] : 0.f; acc1[r] = keep ? acc1[r] : 0.f;
                *(LAS bf16_t*)(o0 + tl_ * PB) = f2bf(acc0[r]);
                *(LAS bf16_t*)(o1 + tl_ * PB) = f2bf(acc1[r]);
            }
            if (mat == 0) {
                const int bsel = r32 >> 4;
                LAS float* dg = (LAS float*)(shm + L_DIAG) + (r32 & 15);
#pragma unroll
                for (int rr = 0; rr < 8; ++rr) {
                    const int t16 = (rr & 3) + 8 * (rr >> 2) + 4 * hi;
                    const float v0 = bsel ? acc0[rr + 8] : acc0[rr], v1 = bsel ? acc1[rr + 8] : acc1[rr];
                    dg[(bsel) * 256 + t16 * 16] = v0; dg[(2 + bsel) * 256 + t16 * 16] = v1;
                }
            }
        } else {
            LAS char* o0 = shm + ob + (32 + 4 * hi) * PB + r32 * 2;
#pragma unroll
            for (int r = 0; r < 16; ++r) *(LAS bf16_t*)(o0 + ((r & 3) + 8 * (r >> 2)) * PB) = f2bf(acc0[r]);
        }
    }
    __syncthreads();
    PAMP_END(33);
    PAMP_BEGIN(34);
    if (wid >= 4) {
        const int tl = wid - 4, tr = 32 * (tl >> 1), ic = 32 * (tl & 1);
        f32x16 acc;
#pragma unroll
        for (int r = 0; r < 16; ++r) acc[r] = 0.f;
        bf16x8 fa[4], fb[4];
#pragma unroll
        for (int ks = 0; ks < 4; ++ks) { fa[ks] = RW_FRAG(L_AK, tr + r32, ks); fb[ks] = RW_FRAG(L_VT, ic + r32, ks); }
        RW_PIN8(fa, fb);
#pragma unroll
        for (int ks = 0; ks < 4; ++ks) if (tr > 0 || ks < 2) acc = RW_MFMA(fa[ks], fb[ks], acc);
        LAS float* dst = (LAS float*)(shm + L_AKVT) + (ic + r32) * 68;
#pragma unroll
        for (int g = 0; g < 4; ++g) *(LAS f32x4*)(dst + tr + 8 * g + 4 * hi) = (f32x4){acc[4 * g], acc[4 * g + 1], acc[4 * g + 2], acc[4 * g + 3]};
    } else if (wid == 0) {
        const int blk = lane >> 4, n = lane & 15;
        const LAS float* N = (const LAS float*)(shm + L_DIAG) + blk * 256;
        f32x4 nv[15][4];
#pragma unroll
        for (int t = 1; t < 16; ++t)
#pragma unroll
            for (int j = 0; j < (t + 3) / 4; ++j) nv[t - 1][j] = *(const LAS f32x4*)(N + t * 16 + 4 * j);
        asm volatile("" : "+v"(nv[0][0]), "+v"(nv[1][0]), "+v"(nv[2][0]), "+v"(nv[3][0]), "+v"(nv[4][0]), "+v"(nv[4][1]), "+v"(nv[5][0]), "+v"(nv[5][1]), "+v"(nv[6][0]), "+v"(nv[6][1]),
                     "+v"(nv[7][0]), "+v"(nv[7][1]), "+v"(nv[8][0]), "+v"(nv[8][1]), "+v"(nv[8][2]), "+v"(nv[9][0]), "+v"(nv[9][1]), "+v"(nv[9][2]));
        asm volatile("" : "+v"(nv[10][0]), "+v"(nv[10][1]), "+v"(nv[10][2]), "+v"(nv[11][0]), "+v"(nv[11][1]), "+v"(nv[11][2]), "+v"(nv[12][0]), "+v"(nv[12][1]), "+v"(nv[12][2]), "+v"(nv[12][3]),
                     "+v"(nv[13][0]), "+v"(nv[13][1]), "+v"(nv[13][2]), "+v"(nv[13][3]), "+v"(nv[14][0]), "+v"(nv[14][1]), "+v"(nv[14][2]), "+v"(nv[14][3]));
        float m[16];
#pragma unroll
        for (int t = 0; t < 16; ++t) {
            float a = (t == n) ? 1.f : 0.f;
#pragma unroll
            for (int s = 0; s < t; ++s) a = fmaf(-nv[t - 1][s >> 2][s & 3], m[s], a);
            m[t] = a;
            *(LAS bf16_t*)(shm + L_TINV + (blk * 256 + t * 16 + n) * 2) = f2bf(a);
        }
    }
    __syncthreads();
    if (idx + nper < 512) r1_load(nxt, PROJ, sava, (idx + nper) >> 6, h, (idx + nper) & 63, tidl);
    {
        const int n = lane & 15, q = lane >> 4;
        typedef float f32x4v __attribute__((ext_vector_type(4)));
        const int col = 16 * (wid & 3) + n;
        u32x2 xn[4];
        f32x4v rhs[4]; u32x2 abv[6], tiv[4];
        if (wid < 4) {
#pragma unroll
            for (int blk = 0; blk < 4; ++blk) { const u32x2 rv = *(const LAS u32x2*)(shm + L_KKDT + col * PB + (16 * blk + 4 * q) * 2);
                rhs[blk][0] = __uint_as_float(rv.x << 16); rhs[blk][1] = __uint_as_float(rv.x & 0xffff0000u); rhs[blk][2] = __uint_as_float(rv.y << 16); rhs[blk][3] = __uint_as_float(rv.y & 0xffff0000u); }
        } else {
#pragma unroll
            for (int blk = 0; blk < 4; ++blk) rhs[blk] = *(const LAS f32x4v*)((const LAS float*)(shm + L_AKVT) + col * 68 + 16 * blk + 4 * q);
        }
        {
            int i = 0;
#pragma unroll
            for (int blk = 1; blk < 4; ++blk)
#pragma unroll
                for (int a = 0; a < blk; ++a) abv[i++] = *(const LAS u32x2*)(shm + L_AB + (16 * blk + n) * PB + (16 * a + 4 * q) * 2);
        }
#pragma unroll
        for (int blk = 0; blk < 4; ++blk) tiv[blk] = *(const LAS u32x2*)(shm + L_TINV + (blk * 256 + n * 16 + 4 * q) * 2);
        asm volatile("" : "+v"(rhs[0]), "+v"(rhs[1]), "+v"(rhs[2]), "+v"(rhs[3]), "+v"(abv[0]), "+v"(abv[1]), "+v"(abv[2]), "+v"(abv[3]), "+v"(abv[4]), "+v"(abv[5]),
                     "+v"(tiv[0]), "+v"(tiv[1]), "+v"(tiv[2]), "+v"(tiv[3]));
#pragma unroll
        for (int blk = 0; blk < 4; ++blk) {
            f32x4v acc = rhs[blk];
#pragma unroll
            for (int a = 0; a < blk; a += 2) {
                const u32x2 a0 = abv[blk * (blk - 1) / 2 + a];
                const bool two = (a + 1 < blk);
                u32x2 a1 = {0u, 0u}, b1 = {0u, 0u};
                if (two) { a1 = abv[blk * (blk - 1) / 2 + a + 1]; b1 = xn[a + 1]; }
                const u32x4 af = {a0.x, a0.y, a1.x, a1.y}, bf = {xn[a].x, xn[a].y, b1.x, b1.y};
                acc = __builtin_amdgcn_mfma_f32_16x16x32_bf16(__builtin_bit_cast(bf16x8, af), __builtin_bit_cast(bf16x8, bf), acc, 0, 0, 0);
            }
            const u32x4 af = {tiv[blk].x, tiv[blk].y, 0u, 0u}, bf = {pk2(acc[0], acc[1]), pk2(acc[2], acc[3]), 0u, 0u};
            f32x4v x = {0.f, 0.f, 0.f, 0.f};
            x = __builtin_amdgcn_mfma_f32_16x16x32_bf16(__builtin_bit_cast(bf16x8, af), __builtin_bit_cast(bf16x8, bf), x, 0, 0, 0);
            xn[blk].x = pk2(-x[0], -x[1]); xn[blk].y = pk2(-x[2], -x[3]);
            *(LAS u32x2*)(shm + ((wid < 4) ? L_WTT : L_VTT) + col * PB + (16 * blk + 4 * q) * 2) = xn[blk];
        }
    }
    __syncthreads();
    PAMP_END(34);
    PAMP_BEGIN(35);
    {
        const int tl = wid & 3, tr = 32 * (tl >> 1), cc = 32 * (tl & 1);
        f32x16 a0, a1;
        if (wid < 4) {
#pragma unroll
            for (int r = 0; r < 16; ++r) { a0[r] = bf2f(*(const LAS bf16_t*)(shm + L_RD + (tr + crow(r, hi)) * PB + (cc + r32) * 2)); a1[r] = 0.f; }
            bf16x8 f1[4], f2[4], f3[4], f4[4], f5[4];
#pragma unroll
            for (int ks = 0; ks < 4; ++ks) { f1[ks] = RW_FRAG(L_BB, tr + r32, ks); f2[ks] = RW_FRAG(L_WTT, cc + r32, ks); f3[ks] = RW_FRAG(L_BK, tr + r32, ks); f4[ks] = RW_FRAG(L_VT, cc + r32, ks); f5[ks] = RW_FRAG(L_VTT, cc + r32, ks); }
            asm volatile("" : "+v"(a0), "+v"(f1[0]), "+v"(f1[1]), "+v"(f1[2]), "+v"(f1[3]), "+v"(f2[0]), "+v"(f2[1]), "+v"(f2[2]), "+v"(f2[3]), "+v"(f3[0]), "+v"(f3[1]), "+v"(f3[2]), "+v"(f3[3]),
                         "+v"(f4[0]), "+v"(f4[1]), "+v"(f4[2]), "+v"(f4[3]), "+v"(f5[0]), "+v"(f5[1]), "+v"(f5[2]), "+v"(f5[3]));
#pragma unroll
            for (int ks = 0; ks < 4; ++ks) if (tr > 0 || ks < 2) {
                a0 = RW_MFMA(f1[ks], f2[ks], a0);
                a1 = RW_MFMA(f3[ks], f4[ks], a1);
                a1 = RW_MFMA(f1[ks], f5[ks], a1);
            }
            {
                const __amdgpu_buffer_rsrc_t rs = __builtin_amdgcn_make_buffer_rsrc((void*)PROJ, 0, 0x7fffffff, 0x00020000);
                const int vo = (4 * hi) * (DIN * 2) + (h * 64 + cc + r32) * 2;
                const unsigned so = (unsigned)__builtin_amdgcn_readfirstlane((int)((unsigned)(row0 + tr) * (unsigned)(DIN * 2)));
#pragma unroll
                for (int r = 0; r < 16; ++r) if (!dry) {
                    const unsigned sr = so + (unsigned)(((r & 3) + 8 * (r >> 2)) * (DIN * 2));
                    __builtin_amdgcn_raw_buffer_store_b16((short)f2bf(a0[r]), rs, vo + C_K * 2, sr, 0);
                    __builtin_amdgcn_raw_buffer_store_b16((short)f2bf(a1[r]), rs, vo + C_R * 2, sr, 0);
#if PROBE == 61
                    __builtin_amdgcn_raw_buffer_store_b16((short)f2bf(a0[r]), rs, vo + C_K * 2, sr, 0);
                    __builtin_amdgcn_raw_buffer_store_b16((short)f2bf(a1[r]), rs, vo + C_R * 2, sr, 0);
#endif
                }
            }
        } else {
#pragma unroll
            for (int r = 0; r < 16; ++r) { a0[r] = 0.f; a1[r] = 0.f; }
            bf16x8 f1[4], f2[4], f3[4], f4[4], f5[4];
#pragma unroll
            for (int ks = 0; ks < 4; ++ks) { f1[ks] = RW_FRAG(L_BDT, tr + r32, ks); f2[ks] = RW_FRAG(L_WTT, cc + r32, ks); f3[ks] = RW_FRAG(L_KDT, tr + r32, ks); f4[ks] = RW_FRAG(L_VT, cc + r32, ks); f5[ks] = RW_FRAG(L_VTT, cc + r32, ks); }
            float gc = ((const LAS float*)(shm + L_GC))[cc + r32];
            asm volatile("" : "+v"(gc), "+v"(f1[0]), "+v"(f1[1]), "+v"(f1[2]), "+v"(f1[3]), "+v"(f2[0]), "+v"(f2[1]), "+v"(f2[2]), "+v"(f2[3]), "+v"(f3[0]), "+v"(f3[1]), "+v"(f3[2]), "+v"(f3[3]),
                         "+v"(f4[0]), "+v"(f4[1]), "+v"(f4[2]), "+v"(f4[3]), "+v"(f5[0]), "+v"(f5[1]), "+v"(f5[2]), "+v"(f5[3]));
#pragma unroll
            for (int ks = 0; ks < 4; ++ks) {
                a0 = RW_MFMA(f1[ks], f2[ks], a0);
                a1 = RW_MFMA(f3[ks], f4[ks], a1);
                a1 = RW_MFMA(f1[ks], f5[ks], a1);
            }
            bf16_t* Pm = (bf16_t*)(DO_RWP) + (size_t)unit * 4096;
            bf16_t* Dt = (bf16_t*)(ARG_WS + WS_RWD) + (size_t)unit * 4096;
#pragma unroll
            for (int r = 0; r < 16; ++r) { const int jr = tr + crow(r, hi), jc = cc + r32; if (!dry) Pm[jr * 64 + jc] = f2bf(a0[r] + ((jr == jc) ? gc : 0.f)); }
#pragma unroll
            for (int g = 0; g < 4; ++g) { u32x2 w; w.x = pk2(a1[4 * g], a1[4 * g + 1]); w.y = pk2(a1[4 * g + 2], a1[4 * g + 3]); if (!dry) *(u32x2*)(Dt + (cc + r32) * 64 + tr + 8 * g + 4 * hi) = w; }
        }
        if (!dry) {
            const __amdgpu_buffer_rsrc_t rs = __builtin_amdgcn_make_buffer_rsrc((void*)PROJ, 0, 0x7fffffff, 0x00020000);
            const unsigned so = (unsigned)__builtin_amdgcn_readfirstlane((int)((unsigned)row0 * (unsigned)(DIN * 2)));
            __builtin_amdgcn_raw_buffer_store_b128(__builtin_bit_cast(__attribute__((__vector_size__(4 * sizeof(unsigned)))) unsigned, vvst), rs, (tidl >> 3) * (DIN * 2) + (C_V + h * 64 + 8 * (tidl & 7)) * 2, so, 0);
        }
    }
    PAMP_END(35);
    cur = nxt;
    }
}

__device__ __forceinline__ void r2_unit(int l, int b, int h, LAS char* shm, const bool dry = false) {
    const int tid = otid(), lane = tid & 63, n = lane & 15, q = lane >> 4;
    const int wid = __builtin_amdgcn_readfirstlane(tid >> 6);
    typedef float f32x4v __attribute__((ext_vector_type(4)));
    bf16_t* PROJ = (bf16_t*)(ARG_WS + WS_PROJ);
    const bf16_t* Pm = (const bf16_t*)(DO_RWP) + (size_t)((b * 8 + h) * 64) * 4096;
    const bf16_t* Dt = (const bf16_t*)(ARG_WS + WS_RWD) + (size_t)((b * 8 + h) * 64) * 4096;
    constexpr int TPB = 144, TBUF = 64 * TPB;
    __syncthreads();
    for (int i = tid; i < 2 * TBUF / 4; i += 512) ((LAS unsigned*)shm)[i] = 0u;
    __syncthreads();
    const size_t rowb = (size_t)b * SEQ;
    if (wid < 4) {
        bf16x8 pa[2]; u32x2 dv[4];
        auto ldop = [&](int c) { const bf16_t* pp = Pm + (size_t)c * 4096 + (16 * wid + n) * 64 + 8 * q; pa[0] = *(const bf16x8*)pp; pa[1] = *(const bf16x8*)(pp + 32);
#pragma unroll
                                 for (int cg = 0; cg < 4; ++cg) dv[cg] = *(const u32x2*)(Dt + (size_t)c * 4096 + (16 * cg + n) * 64 + 16 * wid + 4 * q); };
        ldop(0);
        for (int c = 0; c < 64; ++c) {
            const bf16x8 a0 = pa[0], a1 = pa[1]; u32x2 d[4];
#pragma unroll
            for (int cg = 0; cg < 4; ++cg) d[cg] = dv[cg];
            if (c + 1 < 64) ldop(c + 1);
            const LAS char* tb = shm + (c & 1) * TBUF + n * TPB + 8 * q * 2;
            LAS char* tw_ = shm + ((c + 1) & 1) * TBUF + n * TPB + (16 * wid + 4 * q) * 2;
#pragma unroll
            for (int cg = 0; cg < 4; ++cg) {
                const bf16x8 t0 = *(const LAS bf16x8*)(tb + cg * 16 * TPB), t1 = *(const LAS bf16x8*)(tb + cg * 16 * TPB + 64);
                f32x4v acc = {bf2f((bf16_t)(d[cg].x & 0xffffu)), bf2f((bf16_t)(d[cg].x >> 16)), bf2f((bf16_t)(d[cg].y & 0xffffu)), bf2f((bf16_t)(d[cg].y >> 16))};
                acc = __builtin_amdgcn_mfma_f32_16x16x32_bf16(a0, t0, acc, 0, 0, 0);
                acc = __builtin_amdgcn_mfma_f32_16x16x32_bf16(a1, t1, acc, 0, 0, 0);
                u32x2 w; w.x = rw::pk2(acc[0], acc[1]); w.y = rw::pk2(acc[2], acc[3]);
                *(LAS u32x2*)(tw_ + cg * 16 * TPB) = w;
            }
            __syncthreads();
        }
    } else {
        const int tw = wid - 4;
        const float* lng = ARG(11) + (size_t)l * 512 + h * 64; const float* lnb = ARG(12) + (size_t)l * 512 + h * 64; const float* bon = (const float*)(ARG_WS + WS_BON);
        float gg[4][4], gb[4][4];
#pragma unroll
        for (int cg = 0; cg < 4; ++cg) { const f32x4v a4 = *(const f32x4v*)(lng + 16 * cg + 4 * q), b4 = *(const f32x4v*)(lnb + 16 * cg + 4 * q);
#pragma unroll
            for (int e = 0; e < 4; ++e) { gg[cg][e] = a4[e]; gb[cg][e] = b4[e]; } }
        bf16x8 rb[2]; u32x2 yv[4], vv[4], zv[4]; float bv;
        auto ldop = [&](int c) { const size_t row = rowb + (size_t)c * 64 + 16 * tw + n; const bf16_t* rp = PROJ + row * DIN + h * 64; rb[0] = *(const bf16x8*)(rp + C_K + 8 * q); rb[1] = *(const bf16x8*)(rp + C_K + 8 * q + 32);
                                 bv = bon[row * 8 + h];
#pragma unroll
                                 for (int cg = 0; cg < 4; ++cg) { yv[cg] = *(const u32x2*)(rp + C_R + 16 * cg + 4 * q); vv[cg] = *(const u32x2*)(rp + C_V + 16 * cg + 4 * q); zv[cg] = *(const u32x2*)(rp + C_ZA + 16 * cg + 4 * q); } };
        ldop(0);
        for (int c = 0; c < 64; ++c) {
            const bf16x8 b0 = rb[0], b1 = rb[1]; u32x2 y0[4], v0[4], z0[4]; const float bo = bv;
#pragma unroll
            for (int cg = 0; cg < 4; ++cg) { y0[cg] = yv[cg]; v0[cg] = vv[cg]; z0[cg] = zv[cg]; }
            if (c + 1 < 64) ldop(c + 1);
            const LAS char* tb = shm + (c & 1) * TBUF + n * TPB + 8 * q * 2;
            bf16_t* yp = PROJ + (rowb + (size_t)c * 64 + 16 * tw + n) * DIN + C_ZA + h * 64 + 4 * q;
            f32x4v acc[4];
#pragma unroll
            for (int cg = 0; cg < 4; ++cg) {
                const bf16x8 t0 = *(const LAS bf16x8*)(tb + cg * 16 * TPB), t1 = *(const LAS bf16x8*)(tb + cg * 16 * TPB + 64);
                acc[cg] = (f32x4v){bf2f((bf16_t)(y0[cg].x & 0xffffu)), bf2f((bf16_t)(y0[cg].x >> 16)), bf2f((bf16_t)(y0[cg].y & 0xffffu)), bf2f((bf16_t)(y0[cg].y >> 16))};
                acc[cg] = __builtin_amdgcn_mfma_f32_16x16x32_bf16(t0, b0, acc[cg], 0, 0, 0);
                acc[cg] = __builtin_amdgcn_mfma_f32_16x16x32_bf16(t1, b1, acc[cg], 0, 0, 0);
            }
            float sm = 0.f;
#pragma unroll
            for (int cg = 0; cg < 4; ++cg) sm += (acc[cg][0] + acc[cg][1]) + (acc[cg][2] + acc[cg][3]);
            sm += shx<16>(sm); { float x, y; swap32(sm, x, y); sm = x + y; }
            const float mean = sm * (1.0f / 64.0f);
            float sv = 0.f;
#pragma unroll
            for (int cg = 0; cg < 4; ++cg) { acc[cg] = acc[cg] - mean; sv += (acc[cg][0] * acc[cg][0] + acc[cg][1] * acc[cg][1]) + (acc[cg][2] * acc[cg][2] + acc[cg][3] * acc[cg][3]); }
            sv += shx<16>(sv); { float x, y; swap32(sv, x, y); sv = x + y; }
            const float rstd = rsqrtf(sv * (1.0f / 64.0f) + 64e-5f);
#pragma unroll
            for (int cg = 0; cg < 4; ++cg) {
                const float ve[4] = {bf2f((bf16_t)(v0[cg].x & 0xffffu)), bf2f((bf16_t)(v0[cg].x >> 16)), bf2f((bf16_t)(v0[cg].y & 0xffffu)), bf2f((bf16_t)(v0[cg].y >> 16))};
                const float ze[4] = {bf2f((bf16_t)(z0[cg].x & 0xffffu)), bf2f((bf16_t)(z0[cg].x >> 16)), bf2f((bf16_t)(z0[cg].y & 0xffffu)), bf2f((bf16_t)(z0[cg].y >> 16))};
                float o[4];
#pragma unroll
                for (int e = 0; e < 4; ++e) o[e] = (acc[cg][e] * rstd * gg[cg][e] + gb[cg][e] + bo * ve[e]) * siluf_(ze[e]);
                u32x2 w; w.x = rw::pk2(o[0], o[1]); w.y = rw::pk2(o[2], o[3]);
                if (!dry) *(u32x2*)(yp + 16 * cg) = w;
            }
            __syncthreads();
        }
    }
}
#undef RW_FRAG
#undef RW_MFMA
}

namespace lru {
typedef short bf16x8 __attribute__((ext_vector_type(8)));
typedef float f32x16 __attribute__((ext_vector_type(16)));
constexpr int TC = 32, XPITCH = 1040, LDS_XC = 0, LDS_OMA = 33280, LDS_BX = LDS_OMA + 32768, LDS_BYTES = LDS_BX + 32768;
__device__ __forceinline__ int crow(int r, int hi) { return (r & 3) + 8 * (r >> 2) + 4 * hi; }
__device__ __forceinline__ void carry_unit(int b, unsigned* cnt) {
    const int tid = otid();
    float2* sp = (float2*)(ARG_WS + WS_LSUM) + ((size_t)b * 128) * 512 + tid;
    float h = 0.f;
    for (int c0 = 0; c0 < 128; c0 += 16) {
        float2 ah[16];
#pragma unroll
        for (int k = 0; k < 16; ++k) ah[k] = sp[(size_t)(c0 + k) * 512];
#pragma unroll
        for (int k = 0; k < 16; ++k) { __hip_atomic_store(&sp[(size_t)(c0 + k) * 512].x, h, __ATOMIC_RELAXED, __HIP_MEMORY_SCOPE_AGENT); h = fmaf(ah[k].x, h, ah[k].y); }
    }
    asm volatile("s_waitcnt vmcnt(0)" ::: "memory");
    __syncthreads();
    if (threadIdx.x == 0) (void)xb_add(cnt, 1u);
}
constexpr int W_XC = 0, W_OMA = 4608, W_BX = 4608 + 4096, W_LDS = 4608 + 2 * 4096, L_PART = 8 * W_LDS;
template <bool FINAL>
__device__ __forceinline__ void phase(int l, LAS char* shm0, unsigned* cnt, const bool dry = false) {
    typedef unsigned u32x4 __attribute__((ext_vector_type(4)));
    typedef float f32x4 __attribute__((ext_vector_type(4)));
    const int tid0 = otid(), lane0 = tid0 & 63;
    const int hh = __builtin_amdgcn_readfirstlane(tid0 >> 6);
    bf16_t* PROJ = (bf16_t*)(ARG_WS + WS_PROJ);
    LAS char* shm = shm0 + hh * W_LDS;
    const int co0 = lane0 & 7, tg0 = lane0 >> 3;
    auto ldraw = [&](u32x4 (&raw)[7], int u) { const int b = u >> 7, t0 = (u & 127) * TC;
#pragma unroll
        for (int k = 0; k < 7; ++k) { const int t = t0 + 4 * tg0 - 3 + k; raw[k] = (t >= 0) ? *(const u32x4*)(PROJ + ((size_t)b * SEQ + t) * DIN + C_UB + hh * 64 + 8 * co0) : (u32x4){0u, 0u, 0u, 0u}; } };
    u32x4 raw[7], rawn[7];
    int parity = 0;
    if ((int)blockIdx.x < 1024) ldraw(raw, blockIdx.x);
    __syncthreads();
    for (int u = blockIdx.x; u < 1024; u += gridDim.x, parity ^= 1) {
        const int tid = otid(), lane = tid & 63, r32 = lane & 31, hi = lane >> 5, co = lane & 7, tg = lane >> 3;
        const int b = u >> 7, c = u & 127;
        const size_t row0 = (size_t)b * SEQ + (size_t)c * TC;
        const bf16_t* gat = (const bf16_t*)(ARG_WS + WS_GAT) + ((size_t)(l * 8 + hh) * 64) * 64;
        const bf16_t* gxt = gat + (size_t)DEPTH * 8 * 64 * 64;
        bf16x8 wr_[2][4], wi_[2][4];
#pragma unroll
        for (int nt = 0; nt < 2; ++nt)
#pragma unroll
            for (int ks = 0; ks < 4; ++ks) { wr_[nt][ks] = *(const bf16x8*)(gat + (size_t)(32 * nt + r32) * 64 + 16 * ks + 8 * hi); wi_[nt][ks] = *(const bf16x8*)(gxt + (size_t)(32 * nt + r32) * 64 + 16 * ks + 8 * hi); }
        float hcarry = 0.f;
        if (FINAL) {
            if (lane == 0 && !dry) XB_SPIN(xb_ld(cnt) < 8u, (unsigned*)(ARG_WS + WS_CTL));
            hcarry = __hip_atomic_load(&((float2*)(ARG_WS + WS_LSUM) + ((size_t)b * 128 + c) * 512 + hh * 64 + lane)->x, __ATOMIC_RELAXED, __HIP_MEMORY_SCOPE_AGENT);
        }
        {
            const float* conv_w = ARG(13) + (size_t)l * 4 * 512 + hh * 64 + 8 * co; const float* conv_b = ARG(14) + (size_t)l * 512 + hh * 64 + 8 * co;
            float cw[4][8], cb[8];
#pragma unroll
            for (int q = 0; q < 4; ++q) { const f32x4 a = *(const f32x4*)(conv_w + q * 512), bq = *(const f32x4*)(conv_w + q * 512 + 4);
                cw[q][0] = a[0]; cw[q][1] = a[1]; cw[q][2] = a[2]; cw[q][3] = a[3]; cw[q][4] = bq[0]; cw[q][5] = bq[1]; cw[q][6] = bq[2]; cw[q][7] = bq[3]; }
            { const f32x4 a = *(const f32x4*)conv_b, bq = *(const f32x4*)(conv_b + 4); cb[0] = a[0]; cb[1] = a[1]; cb[2] = a[2]; cb[3] = a[3]; cb[4] = bq[0]; cb[5] = bq[1]; cb[6] = bq[2]; cb[7] = bq[3]; }
#pragma unroll
            for (int tt = 0; tt < 4; ++tt) {
                float o[8];
#pragma unroll
                for (int e = 0; e < 8; ++e) o[e] = cb[e];
#pragma unroll
                for (int q = 0; q < 4; ++q) {
                    const u32x4 rv = raw[tt + q];
                    const unsigned wds[4] = {rv.x, rv.y, rv.z, rv.w};
#pragma unroll
                    for (int e = 0; e < 8; ++e) { const float x = bf2f((bf16_t)((e & 1) ? (wds[e >> 1] >> 16) : (wds[e >> 1] & 0xffffu))); o[e] = fmaf(x, cw[q][e], o[e]); }
                }
                u32x4 w; w.x = rw::pk2(o[0], o[1]); w.y = rw::pk2(o[2], o[3]); w.z = rw::pk2(o[4], o[5]); w.w = rw::pk2(o[6], o[7]);
                *(LAS u32x4*)(shm + W_XC + (4 * tg + tt) * 144 + co * 16) = w;
            }
        }
        if (u + (int)gridDim.x < 1024) ldraw(rawn, u + gridDim.x);
        {
            const float* ga_b = ARG(16) + (size_t)l * 512; const float* gx_b = ARG(18) + (size_t)l * 512; const float* lam = ARG(19) + (size_t)l * 512;
            f32x16 ar[2], ai[2];
#pragma unroll
            for (int nt = 0; nt < 2; ++nt)
#pragma unroll
                for (int r = 0; r < 16; ++r) { ar[nt][r] = 0.f; ai[nt][r] = 0.f; }
            const LAS char* xa = (const LAS char*)shm + W_XC + r32 * 144 + 8 * hi * 2;
#pragma unroll
            for (int ks = 0; ks < 4; ++ks) {
                const bf16x8 a = *(const LAS bf16x8*)(xa + ks * 32);
#pragma unroll
                for (int nt = 0; nt < 2; ++nt) {
                    ar[nt] = __builtin_amdgcn_mfma_f32_32x32x16_bf16(a, wr_[nt][ks], ar[nt], 0, 0, 0);
                    ai[nt] = __builtin_amdgcn_mfma_f32_32x32x16_bf16(a, wi_[nt][ks], ai[nt], 0, 0, 0);
                }
            }
            const LAS bf16_t* xc = (const LAS bf16_t*)(shm + W_XC); LAS unsigned* ob = (LAS unsigned*)(shm + W_OMA);
#pragma unroll
            for (int nt = 0; nt < 2; ++nt) {
                const int cl = 32 * nt + r32, ch = hh * 64 + cl;
                const float br = ga_b[ch], bi = gx_b[ch], c8l = -8.0f * 1.4426950408889634f * softplusf_(-lam[ch]);
#pragma unroll
                for (int r = 0; r < 16; ++r) {
                    const int t = crow(r, hi);
                    const float x = bf2f(xc[t * 72 + cl]);
                    const float om = 1.0f - __builtin_amdgcn_exp2f(sigmoidf_(ar[nt][r] + br) * c8l);
                    ob[t * 64 + cl] = f2bf2(om, __builtin_amdgcn_sqrtf(om * (2.0f - om)) * (sigmoidf_(ai[nt][r] + bi) * x));
                }
            }
        }
        {
            float2* lsum = (float2*)(ARG_WS + WS_LSUM) + ((size_t)b * 128 + c) * 512 + hh * 64 + lane;
            const LAS unsigned* ob = (const LAS unsigned*)(shm + W_OMA);
            float h = hcarry;
            unsigned pkv[TC];
#pragma unroll
            for (int t = 0; t < TC; ++t) pkv[t] = ob[t * 64 + lane];
            asm volatile("" : "+v"(pkv[0]), "+v"(pkv[1]), "+v"(pkv[2]), "+v"(pkv[3]), "+v"(pkv[4]), "+v"(pkv[5]), "+v"(pkv[6]), "+v"(pkv[7]), "+v"(pkv[8]), "+v"(pkv[9]), "+v"(pkv[10]), "+v"(pkv[11]), "+v"(pkv[12]), "+v"(pkv[13]), "+v"(pkv[14]), "+v"(pkv[15]));
            asm volatile("" : "+v"(pkv[16]), "+v"(pkv[17]), "+v"(pkv[18]), "+v"(pkv[19]), "+v"(pkv[20]), "+v"(pkv[21]), "+v"(pkv[22]), "+v"(pkv[23]), "+v"(pkv[24]), "+v"(pkv[25]), "+v"(pkv[26]), "+v"(pkv[27]), "+v"(pkv[28]), "+v"(pkv[29]), "+v"(pkv[30]), "+v"(pkv[31]));
            float ap = 1.f, hv[TC];
#pragma unroll
            for (int t = 0; t < TC; ++t) {
                const unsigned pk = pkv[t];
                const float om = __builtin_bit_cast(float, pk << 16), bx = __builtin_bit_cast(float, pk & 0xffff0000u);
                h = fmaf(-om, h, h) + bx; ap *= (1.0f - om); hv[t] = h;
            }
            if (!FINAL) { if (!dry) *lsum = make_float2(ap, h); }
            else {
                LAS float* hb = (LAS float*)(shm + W_XC);
#pragma unroll
                for (int t = 0; t < TC; ++t) hb[t * 64 + lane] = hv[t];
                { const LAS f32x4* hp = (const LAS f32x4*)(hb + (lane >> 1) * 64 + (lane & 1) * 32);
                  float ss = 0.f;
#pragma unroll
                  for (int k = 0; k < 8; ++k) { const f32x4 v = hp[k]; ss += (v[0] * v[0] + v[1] * v[1]) + (v[2] * v[2] + v[3] * v[3]); }
                  ss += dppx<0xB1>(ss);
                  if ((lane & 1) == 0) ((LAS float*)(shm0 + L_PART))[parity * 256 + (lane >> 1) * 8 + hh] = ss; }
            }
        }
        if (FINAL) {
            __syncthreads();
            const float* go = ARG(20) + (size_t)l * 512 + hh * 64 + 8 * co;
            const f32x4 g0 = *(const f32x4*)go, g1 = *(const f32x4*)(go + 4);
            const float gg[8] = {g0[0], g0[1], g0[2], g0[3], g1[0], g1[1], g1[2], g1[3]};
            const LAS float* hb = (const LAS float*)(shm + W_XC);
            u32x4 zvv[4];
#pragma unroll
            for (int tt = 0; tt < 4; ++tt) zvv[tt] = *(const u32x4*)(PROJ + (row0 + 4 * tg + tt) * DIN + C_ZB + hh * 64 + 8 * co);
#pragma unroll
            for (int tt = 0; tt < 4; ++tt) {
                const int t = 4 * tg + tt;
                const f32x4 p0 = *(const LAS f32x4*)((const LAS float*)(shm0 + L_PART) + parity * 256 + t * 8), p1 = *(const LAS f32x4*)((const LAS float*)(shm0 + L_PART) + parity * 256 + t * 8 + 4);
                const float rs = rsqrtf((((p0[0] + p0[1]) + (p0[2] + p0[3])) + ((p1[0] + p1[1]) + (p1[2] + p1[3]))) * (1.0f / 512) + 1e-6f);
                const f32x4 x0 = *(const LAS f32x4*)(hb + t * 64 + 8 * co), x1 = *(const LAS f32x4*)(hb + t * 64 + 8 * co + 4);
                const float x[8] = {x0[0], x0[1], x0[2], x0[3], x1[0], x1[1], x1[2], x1[3]};
                bf16_t* zp = PROJ + (row0 + t) * DIN + C_ZB + hh * 64 + 8 * co;
                const u32x4 zv = zvv[tt]; const unsigned zw[4] = {zv.x, zv.y, zv.z, zv.w};
                float o[8];
#pragma unroll
                for (int e = 0; e < 8; ++e) { const float z = bf2f((bf16_t)((e & 1) ? (zw[e >> 1] >> 16) : (zw[e >> 1] & 0xffffu))); o[e] = x[e] * rs * gg[e] * siluf_(z); }
                u32x4 w; w.x = rw::pk2(o[0], o[1]); w.y = rw::pk2(o[2], o[3]); w.z = rw::pk2(o[4], o[5]); w.w = rw::pk2(o[6], o[7]);
                if (!dry) *(u32x4*)zp = w;
            }
        }
#pragma unroll
        for (int k = 0; k < 7; ++k) raw[k] = rawn[k];
    }
}
}

namespace att {
typedef short bf16x8 __attribute__((ext_vector_type(8)));
typedef short s16x4 __attribute__((ext_vector_type(4)));
typedef short v4i16_t __attribute__((ext_vector_type(4)));
typedef float f32x16 __attribute__((ext_vector_type(16)));
typedef unsigned u32x4 __attribute__((ext_vector_type(4)));
typedef float f32x2_t __attribute__((ext_vector_type(2)));
typedef __bf16 bf16x2_t __attribute__((ext_vector_type(2)));
typedef LAS const char* lds_cptr;
constexpr int KSLOT = 12288, VSLOT = 8192, LDS_K = 0, LDS_V = 3 * KSLOT, LDS_WS = LDS_V + 3 * VSLOT, LDS_OST = LDS_WS + 8 * 256, LDS_BYTES = LDS_OST + 8 * 4096;
__device__ __forceinline__ int crow(int r, int hi) { return (r & 3) + 8 * (r >> 2) + 4 * hi; }
__device__ __forceinline__ void glds16(const void* gsrc, unsigned lds_dst) { unsigned keep;
    asm volatile("s_mov_b32 %0, m0\n\ts_mov_b32 m0, %2\n\ts_nop 0\n\tglobal_load_lds_dwordx4 %1, off\n\ts_mov_b32 m0, %0" : "=&s"(keep) : "v"(gsrc), "s"(lds_dst) : "memory"); }
__device__ __forceinline__ unsigned cvtpk(float lo, float hi) { f32x2_t v = {lo, hi}; bf16x2_t b = __builtin_convertvector(v, bf16x2_t); return __builtin_bit_cast(unsigned, b); }
__device__ __forceinline__ s16x4 vtr(lds_cptr p) { return __builtin_bit_cast(s16x4, __builtin_amdgcn_ds_read_tr16_b64_v4i16((LAS v4i16_t*)p)); }
#define ATT_WAITB(N) asm volatile("s_waitcnt vmcnt(" #N ") lgkmcnt(0)\n\ts_barrier" ::: "memory")
__device__ __forceinline__ float max3f(float a, float b, float c) { float r; asm volatile("v_max3_f32 %0, %1, %2, %3" : "=v"(r) : "v"(a), "v"(b), "v"(c)); return r; }
__device__ __forceinline__ float max3f_first(float a, float b, float c) { float r; asm volatile("s_nop 15\n\ts_nop 7\n\tv_max3_f32 %0, %1, %2, %3" : "=v"(r) : "v"(a), "v"(b), "v"(c)); return r; }

template <int THR>
__device__ __forceinline__ void attn_unit(bf16_t* Qb, const bf16_t* Kb, const bf16_t* Vb, int b, int h, int qb, LAS char* shm, const bool dry = false) {
    const int tid = otid(), lane = tid & 63, r32 = lane & 31, hi = lane >> 5;
    const int wid = __builtin_amdgcn_readfirstlane(tid >> 6);
    const size_t rowb = (size_t)b * SEQ; const int q0 = qb * 256;
    bf16_t* Qw = Qb + ((rowb + q0 + wid * 32) * 8 + h) * 96;
    const bf16_t* Kh = Kb + (rowb * 8 + h) * 96;
    const bf16_t* Vh = Vb + (rowb * 8 + h) * 64;
    const unsigned lds0 = (unsigned)(size_t)shm;
    LAS float* wsf = (LAS float*)(shm + LDS_WS) + wid * 64;
    const bf16_t* ksrc = Kh + (size_t)lane * 768 + wid * 8;
    const bf16_t* vsrc = Vh + (size_t)(16 * (wid & 3) + (lane >> 2)) * 512 + (wid >> 2) * 32 + (lane & 3) * 8;
    const unsigned kdst = lds0 + LDS_K + wid * 1024, vdst = lds0 + LDS_V + wid * 1024;
#define ATT_DMA(t, sl) do { glds16(ksrc + (size_t)(t) * 64 * 768, (unsigned)__builtin_amdgcn_readfirstlane(kdst + (sl) * KSLOT)); \
        if (wid < 4) glds16(ksrc + (size_t)(t) * 64 * 768 + 64, (unsigned)__builtin_amdgcn_readfirstlane(kdst + (sl) * KSLOT + 8192)); \
        glds16(vsrc + (size_t)(t) * 64 * 512, (unsigned)__builtin_amdgcn_readfirstlane(vdst + (sl) * VSLOT)); } while (0)
    const int NT = 4 * (qb + 1);
    ATT_DMA(0, 0);
    if (NT > 1) ATT_DMA(1, 1);
    bf16x8 qr[6];
#pragma unroll
    for (int d0 = 0; d0 < 6; ++d0) qr[d0] = *(const bf16x8*)(Qw + (size_t)r32 * 768 + d0 * 16 + hi * 8);
    asm volatile("s_waitcnt vmcnt(0)" : "+v"(qr[0]), "+v"(qr[1]), "+v"(qr[2]), "+v"(qr[3]), "+v"(qr[4]), "+v"(qr[5]) :: "memory");
    float m = 0.f, l = 0.f; f32x16 o[2], negm;
#pragma unroll
    for (int r = 0; r < 16; ++r) { o[0][r] = 0.f; o[1][r] = 0.f; negm[r] = 0.f; }
    const int qrel = wid * 32 + r32;
    const lds_cptr kp0 = (lds_cptr)shm + LDS_K + hi * 1024 + r32 * 16;
    const lds_cptr vp0 = (lds_cptr)shm + LDS_V + ((lane >> 4) & 1) * 32 + (lane & 3) * 8 + (4 * hi + ((lane & 15) >> 2)) * 64;
    int sl0 = 0, sl1 = 1, sl2 = 2;
    for (int t = 0; t < NT; ++t) {
        if (t + 1 < NT) { if (wid < 4) ATT_WAITB(3); else ATT_WAITB(2); } else ATT_WAITB(0);
        if (t + 2 < NT) ATT_DMA(t + 2, sl2);
        const int sl = sl0;
        sl0 = sl1; sl1 = sl2; sl2 = sl;
        const int jb = t - (NT - 4);
        if (jb >= 1 && 64 * jb > wid * 32 + 31) continue;
        f32x16 p0, p1;
        const lds_cptr kp = kp0 + sl * KSLOT;
        bf16x8 kf[12];
#pragma unroll
        for (int d0 = 0; d0 < 6; ++d0) { kf[2 * d0] = *(const LAS bf16x8*)(kp + d0 * 2048); kf[2 * d0 + 1] = *(const LAS bf16x8*)(kp + d0 * 2048 + 512); }
        __builtin_amdgcn_sched_barrier(0);
#pragma unroll
        for (int d0 = 0; d0 < 6; ++d0) {
            if (d0 == 0) { p0 = __builtin_amdgcn_mfma_f32_32x32x16_bf16(kf[0], qr[0], negm, 0, 0, 0); p1 = __builtin_amdgcn_mfma_f32_32x32x16_bf16(kf[1], qr[0], negm, 0, 0, 0); }
            else { p0 = __builtin_amdgcn_mfma_f32_32x32x16_bf16(kf[2 * d0], qr[d0], p0, 0, 0, 0); p1 = __builtin_amdgcn_mfma_f32_32x32x16_bf16(kf[2 * d0 + 1], qr[d0], p1, 0, 0, 0); }
        }
        const lds_cptr vp = vp0 + sl * VSLOT;
        s16x4 vlo[8], vhi[8];
#pragma unroll
        for (int i = 0; i < 8; ++i) { vlo[i] = vtr(vp + (i >> 2) * 4096 + (i & 3) * 1024); vhi[i] = vtr(vp + (i >> 2) * 4096 + (i & 3) * 1024 + 512); }
        __builtin_amdgcn_sched_barrier(0);
        if (jb >= 0) {
            const int kb = 64 * jb + 4 * hi;
#pragma unroll
            for (int r = 0; r < 16; ++r) { const int kv = kb + (r & 3) + 8 * (r >> 2); if (kv > qrel) p0[r] = -INFINITY; if (kv + 32 > qrel) p1[r] = -INFINITY; }
        }
        float mx = max3f_first(p0[0], p0[1], p1[0]), mb = max3f(p0[2], p0[3], p1[1]); mx = max3f(mx, p1[2], p1[3]);
#pragma unroll
        for (int r = 4; r < 16; r += 4) { mx = max3f(mx, p0[r], p0[r + 1]); mb = max3f(mb, p0[r + 2], p0[r + 3]); mx = max3f(mx, p1[r], p1[r + 1]); mb = max3f(mb, p1[r + 2], p1[r + 3]); }
        mx = fmaxf(mx, mb);
        { float x, y; swap32(mx, x, y); mx = fmaxf(x, y); }
        if (t == 0 || __any(mx > (float)THR)) {
            const float dl = (t == 0) ? mx : fmaxf(mx, 0.f);
            m += dl;
            const float alpha = __builtin_amdgcn_exp2f(-dl);
            l *= alpha;
#pragma unroll
            for (int r = 0; r < 16; ++r) { p0[r] -= dl; p1[r] -= dl; negm[r] = -m; }
            if (t > 0) {
                if (hi == 0) wsf[r32] = alpha;
#pragma unroll
                for (int r = 0; r < 16; ++r) { const float f = wsf[crow(r, hi)]; o[0][r] *= f; o[1][r] *= f; }
            }
        }
        float ps = 0.f;
#pragma unroll
        for (int r = 0; r < 16; ++r) { p0[r] = __builtin_amdgcn_exp2f(p0[r]); p1[r] = __builtin_amdgcn_exp2f(p1[r]); ps += p0[r] + p1[r]; }
        l += ps;
        u32x4 pw[4];
#pragma unroll
        for (int q = 0; q < 4; ++q) { pw[0][q] = cvtpk(p0[2 * q], p0[2 * q + 1]); pw[1][q] = cvtpk(p0[8 + 2 * q], p0[9 + 2 * q]); pw[2][q] = cvtpk(p1[2 * q], p1[2 * q + 1]); pw[3][q] = cvtpk(p1[8 + 2 * q], p1[9 + 2 * q]); }
#pragma unroll
        for (int d0 = 0; d0 < 2; ++d0)
#pragma unroll
            for (int ks = 0; ks < 4; ++ks) {
                const s16x4 lo = vlo[d0 * 4 + ks], hh = vhi[d0 * 4 + ks];
                const bf16x8 vf = (bf16x8){lo[0], lo[1], lo[2], lo[3], hh[0], hh[1], hh[2], hh[3]};
                o[d0] = __builtin_amdgcn_mfma_f32_32x32x16_bf16(__builtin_bit_cast(bf16x8, pw[ks]), vf, o[d0], 0, 0, 0);
            }
    }
    { float x, y; swap32(l, x, y); l = x + y; }
    if (hi == 0) wsf[32 + r32] = l;
    float rli[16];
#pragma unroll
    for (int r = 0; r < 16; ++r) rli[r] = 1.0f / wsf[32 + crow(r, hi)];
    LAS bf16_t* stg = (LAS bf16_t*)(shm + LDS_OST) + wid * 2048;
#pragma unroll
    for (int r = 0; r < 16; ++r) { const int orow = crow(r, hi);
#pragma unroll
        for (int d0 = 0; d0 < 2; ++d0) stg[orow * 64 + d0 * 32 + r32] = f2bf(o[d0][r] * rli[r]); }
#pragma unroll
    for (int i = 0; i < 4; ++i) { const int row = i * 8 + (lane >> 3), ch = lane & 7; const u32x4 v = *(const LAS u32x4*)(stg + row * 64 + ch * 8); if (!dry) *(u32x4*)(Qw + (size_t)row * 768 + ch * 8) = v; }
    asm volatile("s_waitcnt lgkmcnt(0)\n\ts_barrier" ::: "memory");
#undef ATT_DMA
}
}

__device__ __forceinline__ void gate_half(int l, size_t rbase) {
    typedef unsigned u32x4 __attribute__((ext_vector_type(4)));
    typedef float f32x4 __attribute__((ext_vector_type(4)));
    const int tid = otid(), lane = tid & 63, wid = __builtin_amdgcn_readfirstlane(tid >> 6);
    bf16_t* PROJ = (bf16_t*)(ARG_WS + WS_PROJ);
    const int hd = lane >> 3, c0 = hd * 64 + (lane & 7) * 8;
    const __amdgpu_buffer_rsrc_t rso = __builtin_amdgcn_make_buffer_rsrc((void*)(DO_Q), 0, 0x7fffffff, 0x00020000);
    float gcv[8];
    { const float* p2 = ARG(25) + (size_t)l * 512 + c0; const f32x4 d0 = *(const f32x4*)p2, d1 = *(const f32x4*)(p2 + 4);
#pragma unroll
      for (int e = 0; e < 4; ++e) { gcv[e] = d0[e]; gcv[4 + e] = d1[e]; } }
    auto unpack = [](const u32x4 v, float (&x)[8]) { const unsigned w[4] = {v.x, v.y, v.z, v.w};
#pragma unroll
        for (int e = 0; e < 4; ++e) { x[2 * e] = __uint_as_float(w[e] << 16); x[2 * e + 1] = __uint_as_float(w[e] & 0xffff0000u); } };
    for (int r = wid; r < 128; r += 64) {
        u32x4 rzc[8], ro[8];
#pragma unroll
        for (int k = 0; k < 8; ++k) { const size_t rr = rbase + r + 8 * k; rzc[k] = *(const u32x4*)(PROJ + rr * DIN + C_ZC + c0);
            ro[k] = __builtin_bit_cast(u32x4, __builtin_amdgcn_raw_buffer_load_b128(rso, (int)(((unsigned)(rr * 8 + hd) * 96u + (unsigned)(lane & 7) * 8u) * 2u), 0, 0)); }
#pragma unroll
        for (int k = 0; k < 8; ++k) {
            const size_t rr = rbase + r + 8 * k;
            float zc[8], oa[8];
            unpack(rzc[k], zc); unpack(ro[k], oa);
            float sq = 0.f;
#pragma unroll
            for (int e = 0; e < 8; ++e) sq += oa[e] * oa[e];
            sq = wave_sum(sq);
            const float rc = rsqrtf(sq * (1.0f / 512) + 1e-6f);
            float yc[8];
#pragma unroll
            for (int e = 0; e < 8; ++e) yc[e] = oa[e] * rc * gcv[e] * siluf_(zc[e]);
            u32x4 wc;
            wc.x = rw::pk2(yc[0], yc[1]); wc.y = rw::pk2(yc[2], yc[3]); wc.z = rw::pk2(yc[4], yc[5]); wc.w = rw::pk2(yc[6], yc[7]);
            *(u32x4*)(PROJ + rr * DIN + C_ZC + c0) = wc;
        }
    }
}

__global__ void __launch_bounds__(512, 2) fwd_kernel(Args A) {
    extern __shared__ __attribute__((aligned(16))) unsigned char smem[];
    float* lds = (float*)smem;
    volatile LAS unsigned* xbw = (volatile LAS unsigned*)(smem + 147456 - 16);
    unsigned* ctl = (unsigned*)(ARG_WS + WS_CTL);
    const int tid = threadIdx.x;
    if (tid == 0) { xbw[0] = 0u; xbw[1] = 0u; xbw[2] = 0u; xbw[3] = 0u; }
    __syncthreads();
    XcdBarrier bar = xcd_barrier_post(ctl, xbw);
#if PROBE >= 50 && PROBE <= 52
    unsigned long long pc0 = 0, pr0 = 0, pc1 = 0, pr1 = 0;
    if (PROBE == 50) { pc0 = __builtin_amdgcn_s_memtime(); pr0 = __builtin_amdgcn_s_memrealtime(); }
#endif
    LAS int* s_unit = (LAS int*)(smem + 147456 - 32);

    bf16_t* PROJ = (bf16_t*)(ARG_WS + WS_PROJ);
    bf16_t* XN = (bf16_t*)(ARG_WS + WS_XN);
    float* rope = (float*)(ARG_WS + WS_ROPE);
    const int nwaves = gridDim.x * 8;
#define PHASE_IDS() const int ptid = otid(), lane = ptid & 63, wv = ptid >> 6, gw = blockIdx.x * 8 + wv; (void)lane; (void)gw

    PAMP_BEGIN(20);
    for (int idx = blockIdx.x * 512 + otid(); idx < SEQ * 16; idx += gridDim.x * 512) {
        const int t = idx >> 4, i = idx & 15;
        const float inv = powf(10000.0f, -((float)i * 2.0f / 32.0f));
        const float ang = (float)t * inv;
        const double twopi = 6.283185307179586476925286766559;
        double rr = (double)ang; rr -= twopi * floor(rr / twopi + 0.5);
        const double r2 = rr * rr; double ts = rr, ss = rr, tc = 1.0, cc = 1.0;
        for (int n = 1; n <= 13; ++n) { ts *= -r2 / (double)((2 * n) * (2 * n + 1)); ss += ts; tc *= -r2 / (double)((2 * n - 1) * (2 * n)); cc += tc; }
        rope[idx * 2] = (float)cc; rope[idx * 2 + 1] = (float)ss;
    }

    for (int prep = 0; prep < (PROBE == 11 ? 2 : 1); ++prep)
    for (int l = 0; l < DEPTH; ++l) {
        { const float* W = ARG(2) + (size_t)l * DM * DIN; const float* g = ARG(1) + (size_t)l * DM;
          transpose_w(DM, NPAD_IN, (bf16_t*)(ARG_WS + WS_WIN) + (size_t)l * NPAD_IN * DM, [=](int k, int n) -> f32x4_t { return n < DIN ? *(const f32x4_t*)(W + (size_t)k * DIN + orig_col(n)) * g[k] : (f32x4_t){0.f, 0.f, 0.f, 0.f}; }, lds); }
        { const float* W = ARG(26) + (size_t)l * DMIX * DM;
          transpose_w(DMIX, DM, (bf16_t*)(ARG_WS + WS_WOUT) + (size_t)l * DM * DMIX, [=](int k, int n) -> f32x4_t { return *(const f32x4_t*)(W + (size_t)k * DM + n); }, lds); }
        { const float* qg = ARG(21) + (size_t)l * QL; const float* wuq = ARG(22) + (size_t)l * QL * 768;
          const float* kg = ARG(23) + (size_t)l * KVL; const float* wukv = ARG(24) + (size_t)l * KVL * 1024;
          transpose_w(256, NMLA, (bf16_t*)(ARG_WS + WS_WMLA) + (size_t)l * NMLA * 256, [=](int k, int n) -> f32x4_t {
              if (n < 768) return *(const f32x4_t*)(wuq + (size_t)k * 768 + n) * qg[k];
              return k < KVL ? *(const f32x4_t*)(wukv + (size_t)k * 1024 + (n - 768)) * kg[k] : (f32x4_t){0.f, 0.f, 0.f, 0.f}; }, lds); }
    }
    { const float* w2 = ARG(5); const float* a2 = ARG(7);
      transpose_w(64, DEPTH * 512, (bf16_t*)(ARG_WS + WS_W2T), [=](int k, int n) -> f32x4_t { return *(const f32x4_t*)(w2 + ((size_t)(n >> 9) * 64 + k) * 512 + (n & 511)); }, lds);
      transpose_w(64, DEPTH * 512, (bf16_t*)(ARG_WS + WS_W2T) + (size_t)DEPTH * 512 * 64, [=](int k, int n) -> f32x4_t { return *(const f32x4_t*)(a2 + ((size_t)(n >> 9) * 64 + k) * 512 + (n & 511)); }, lds); }
    { const float* ga = ARG(15); const float* gx = ARG(17);
      transpose_w(64, DEPTH * 8 * 64, (bf16_t*)(ARG_WS + WS_GAT), [=](int k, int n) -> f32x4_t { return *(const f32x4_t*)(ga + ((size_t)(n >> 6) * 64 + k) * 64 + (n & 63)); }, lds);
      transpose_w(64, DEPTH * 8 * 64, (bf16_t*)(ARG_WS + WS_GAT) + (size_t)DEPTH * 8 * 64 * 64, [=](int k, int n) -> f32x4_t { return *(const f32x4_t*)(gx + ((size_t)(n >> 6) * 64 + k) * 64 + (n & 63)); }, lds); }
    {
        PHASE_IDS();
        const float* x = ARG(0); float* ssqh = (float*)(ARG_WS + WS_SSQH);
        for (int row = gw; row < MTOK; row += nwaves) {
            float4 v[4]; float ss = 0.f;
#pragma unroll
            for (int q = 0; q < 4; ++q) { v[q] = *(const float4*)&x[(size_t)row * DM + q * 256 + lane * 4]; ss += v[q].x * v[q].x + v[q].y * v[q].y + v[q].z * v[q].z + v[q].w * v[q].w; }
            ss = wave_sum(ss);
#pragma unroll
            for (int q = 0; q < 4; ++q) { ushort4 o; o.x = f2bf(v[q].x); o.y = f2bf(v[q].y); o.z = f2bf(v[q].z); o.w = f2bf(v[q].w); *(ushort4*)&XN[(size_t)row * DM + q * 256 + lane * 4] = o; }
            if (lane < 16) ssqh[(size_t)row * 16 + lane] = (lane == 0) ? ss : 0.f;
        }
    }
    PAMP_END(20);
    xcd_barrier(bar);

    for (int l = 0; l < DEPTH; ++l) {
#if PROBE == 10
        for (int rep = 0; rep < 8; ++rep) xcd_barrier(bar);
#endif
#if PROBE == 40
        { const unsigned long long t1_ = __builtin_amdgcn_s_memrealtime(); while (__builtin_amdgcn_s_memrealtime() - t1_ < 20000ull) __builtin_amdgcn_s_sleep(8); __syncthreads(); }
#endif
        PAMP_BEGIN(21);
#if PROBE == 51 || PROBE == 52
        if (l == (PROBE == 51 ? 0 : 3)) { pc0 = __builtin_amdgcn_s_memtime(); pr0 = __builtin_amdgcn_s_memrealtime(); }
#endif
        for (int rep = 0; rep < (PROBE == 9 ? 2 : 1); ++rep) {
            pg8::Gemm g{XN, (const bf16_t*)(ARG_WS + WS_WIN) + (size_t)l * NPAD_IN * DM, MTOK, NPAD_IN, DM, DM, DM, 1 << 30, 0};
            pg8::RowScaleOrder<16> S; S.init(MTOK, NPAD_IN, (int)gridDim.x, (int)blockIdx.x);
            S.part = (const float*)(ARG_WS + WS_SSQH); S.inv_dim = 1.0f / DM; S.tab = (PG8_LAS float*)(smem + 131072);
            pg8::EpiProj E{PROJ, DIN, DIN, (const PG8_LAS float*)(smem + 131072), (float*)(ARG_WS + WS_SQQ), (float*)(ARG_WS + WS_SQKV), (bf16_t*)(ARG_WS + WS_K), rope, (bf16_t*)(ARG_WS + WS_SAVA)};
            pg8::gemm_phase<pg8::EpiProj, pg8::RowScaleOrder<16>, true, true>((PG8_LAS unsigned char*)smem, g, S, E);
        }
#if PROBE == 51 || PROBE == 52
        if (l == (PROBE == 51 ? 0 : 3)) { __syncthreads(); pc1 = __builtin_amdgcn_s_memtime(); pr1 = __builtin_amdgcn_s_memrealtime(); }
#endif
        PAMP_END(21);
        xcd_barrier(bar);
        PAMP_BEGIN(22);
        for (int rep = 0; rep < (PROBE == 13 ? 2 : 1); ++rep) {
            int kmla = 256; asm volatile("" : "+s"(kmla));
            pg8::Gemm g{PROJ + C_QL, (const bf16_t*)(ARG_WS + WS_WMLA) + (size_t)l * NMLA * 256, MTOK, NMLA, kmla, DIN, 256, 3, 2 * (C_KVL - C_QL)};
            pg8::MlaOrder S; S.init(MTOK, NMLA, (int)gridDim.x, (int)blockIdx.x);
            S.sqq = (const float*)(ARG_WS + WS_SQQ); S.sqkv = (const float*)(ARG_WS + WS_SQKV); S.tab = (PG8_LAS float*)(smem + 131072 + 2048);
            pg8::EpiMla E{(bf16_t*)(DO_Q), (bf16_t*)(ARG_WS + WS_K), (bf16_t*)(ARG_WS + WS_V), (const PG8_LAS float*)(smem + 131072 + 2048), rope, 0.10206207261596577f * 1.4426950408889634f, 0};
            pg8::gemm_phase<pg8::EpiMla, pg8::MlaOrder, true, true>((PG8_LAS unsigned char*)smem, g, S, E);
        }
        PAMP_END(22);
#if PROBE == 1 || PROBE == 2
        {
            const bool dry = (xb_ld(ctl + CW_PROBE) == 0u);
            unsigned* qw = ctl + CW_PROBEQ + 64 * l;
            for (;;) {
                __syncthreads();
                if (threadIdx.x == 0) *s_unit = (int)atomicAdd(qw, 1u);
                __syncthreads();
                const int u = *s_unit;
#if PROBE == 1
                if (u >= 4096) break;
                (void)dry; break;
#else
                if (u >= 1024) break;
                break;
#endif
            }
        }
#endif
        PAMP_BEGIN(23);
#if PROBE == 1
        rw::r1_phase(l, (LAS char*)smem, (xb_ld(ctl + CW_PROBE) == 0u));
#endif
        rw::r1_phase(l, (LAS char*)smem);
        lru::phase<false>(l, (LAS char*)smem, ctl + CW_LCNT + 64 * l);
        PAMP_END(23);
        xcd_barrier(bar);
#if PROBE >= 3 && PROBE <= 5
        {
            const bool dry = (xb_ld(ctl + CW_PROBE) == 0u);
            unsigned* qw = ctl + CW_PROBEQ + 64 * l;
            for (;;) {
                __syncthreads();
                if (threadIdx.x == 0) *s_unit = (int)atomicAdd(qw, 1u);
                __syncthreads();
                const int u = *s_unit;
#if PROBE == 3
                if (u >= 64) break;
                rw::r2_unit(l, u >> 3, u & 7, (LAS char*)smem, dry);
#elif PROBE == 4
                if (u >= 1024) break;
                break;
#else
                if (u >= 1024) break;
                att::attn_unit<ATT_THR>((bf16_t*)(DO_Q), (const bf16_t*)(ARG_WS + WS_K), (const bf16_t*)(ARG_WS + WS_V), (u & 63) >> 3, u & 7, 15 - (u >> 6), (LAS char*)smem, dry);
#endif
            }
        }
#endif
        {
            unsigned* qw = ctl + CW_QUEUE + 64 * (2 * l + 1);
            PAMP_BEGIN(24);
            for (;;) {
                __syncthreads();
                if (threadIdx.x == 0) *s_unit = (int)atomicAdd(qw, 1u);
                __syncthreads();
                const int u = *s_unit;
                if (u >= 8 + 64) break;
                if (u < 8) lru::carry_unit(u, ctl + CW_LCNT + 64 * l);
                else { const int a = u - 8; rw::r2_unit(l, a >> 3, a & 7, (LAS char*)smem); }
            }
            PAMP_END(24);
            PAMP_BEGIN(25);
            {
                const int x0 = (int)(xb_xcc_id() & 7u);
                for (int k = 0; k < 8; ++k) {
                    const int x = (x0 + k) & 7;
                    unsigned* qa = ctl + CW_ATTQ + 32 * (l * 8 + x);
                    for (;;) {
                        __syncthreads();
                        if (threadIdx.x == 0) *s_unit = (int)atomicAdd(qa, 1u);
                        __syncthreads();
                        const int u = *s_unit;
                        if (u >= 128) break;
                        const int bh = 8 * x + (u & 7), qb = 15 - (u >> 3);
                        att::attn_unit<ATT_THR>((bf16_t*)(DO_Q), (const bf16_t*)(ARG_WS + WS_K), (const bf16_t*)(ARG_WS + WS_V), bh >> 3, bh & 7, qb, (LAS char*)smem);
                    }
                }
            }
            asm volatile("s_waitcnt vmcnt(0)" ::: "memory");
            __syncthreads();
            if (threadIdx.x == 0) { __builtin_amdgcn_fence(__ATOMIC_RELEASE, "agent"); (void)xb_add(ctl + CW_GATE + 16 * l, 1u); }
            PAMP_END(25);
            PAMP_BEGIN(26);
            lru::phase<true>(l, (LAS char*)smem, ctl + CW_LCNT + 64 * l);
            PAMP_END(26);
            __syncthreads();
            if (threadIdx.x == 0) { XB_SPIN(xb_ld(ctl + CW_GATE + 16 * l) < (unsigned)gridDim.x, ctl); __builtin_amdgcn_fence(__ATOMIC_ACQUIRE, "agent"); }
            __syncthreads();
            for (int j = blockIdx.x; j < 256; j += gridDim.x) gate_half(l, (size_t)j * 128);
        }
        xcd_barrier(bar);
        PAMP_BEGIN(28);
        for (int rep = 0; rep < (PROBE == 14 ? 2 : 1); ++rep) {
            const bool odry = (PROBE == 14) && (rep == 0) && (xb_ld(ctl + CW_PROBE) == 0u);
            pg8::Gemm g{PROJ + C_ZA, (const bf16_t*)(ARG_WS + WS_WOUT) + (size_t)l * DM * DMIX, MTOK, DM, DMIX, DIN, DMIX, 1 << 30, 0};
            pg8::StaticOrder S; S.init(MTOK, DM, (int)gridDim.x, (int)blockIdx.x);
            pg8::EpiResid E{DM, odry, XN, (float*)(ARG_WS + WS_SSQH)};
            pg8::gemm_phase<pg8::EpiResid, pg8::StaticOrder, true, true>((PG8_LAS unsigned char*)smem, g, S, E);
        }
        PAMP_END(28);
        xcd_barrier(bar);
    }
    {
        const float* g = ARG(27); const float* ssqh = (const float*)(ARG_WS + WS_SSQH);
        PHASE_IDS();
        float* out = ARG_OUT;
        for (int row = gw; row < MTOK; row += nwaves) {
            float tsum = (lane < 16) ? ssqh[(size_t)row * 16 + lane] : 0.f;
            tsum = wave_sum(tsum);
            const float rs = rsqrtf(tsum * (1.0f / DM) + 1e-6f);
            typedef unsigned u32x4 __attribute__((ext_vector_type(4))); u32x4 v[2];
#pragma unroll
            for (int q = 0; q < 2; ++q) v[q] = *(const u32x4*)(XN + (size_t)row * DM + q * 512 + lane * 8);
#pragma unroll
            for (int q = 0; q < 2; ++q) {
                const float4 g0 = *(const float4*)&g[q * 512 + lane * 8], g1 = *(const float4*)&g[q * 512 + lane * 8 + 4];
                float4 o0, o1;
                o0.x = __uint_as_float(v[q].x << 16) * rs * g0.x; o0.y = __uint_as_float(v[q].x & 0xffff0000u) * rs * g0.y;
                o0.z = __uint_as_float(v[q].y << 16) * rs * g0.z; o0.w = __uint_as_float(v[q].y & 0xffff0000u) * rs * g0.w;
                o1.x = __uint_as_float(v[q].z << 16) * rs * g1.x; o1.y = __uint_as_float(v[q].z & 0xffff0000u) * rs * g1.y;
                o1.z = __uint_as_float(v[q].w << 16) * rs * g1.z; o1.w = __uint_as_float(v[q].w & 0xffff0000u) * rs * g1.w;
                *(float4*)&out[(size_t)row * DM + q * 512 + lane * 8] = o0;
                *(float4*)&out[(size_t)row * DM + q * 512 + lane * 8 + 4] = o1;
            }
        }
    }
#if PROBE >= 50 && PROBE <= 52
    if (PROBE == 50) { __syncthreads(); pc1 = __builtin_amdgcn_s_memtime(); pr1 = __builtin_amdgcn_s_memrealtime(); }
    if (blockIdx.x == 0) {
        const unsigned long long mhz = (pc1 - pc0) * 100ull / (pr1 - pr0 + 1ull);
        const unsigned long long t1_ = __builtin_amdgcn_s_memrealtime(), d_ = mhz * 25ull;
        while (__builtin_amdgcn_s_memrealtime() - t1_ < d_) __builtin_amdgcn_s_sleep(8);
    }
#endif
}

extern "C" void kernel_launch(void* const* d_in, const int* in_sizes, int n_in, void* d_out, int out_size, void* d_ws, size_t ws_size, hipStream_t stream) {
    (void)in_sizes; (void)n_in; (void)out_size; (void)ws_size;
    constexpr int kDynLds = 147456;
    static int grid = 0;
    if (!grid) {
        int dev = 0, cus = 0;
        hipGetDevice(&dev);
        hipDeviceGetAttribute(&cus, hipDeviceAttributeMultiprocessorCount, dev);
        hipFuncSetAttribute((const void*)fwd_kernel, hipFuncAttributeMaxDynamicSharedMemorySize, kDynLds);
        int per_cu = 0;
        hipOccupancyMaxActiveBlocksPerMultiprocessor(&per_cu, fwd_kernel, 512, kDynLds);
        if (per_cu < 1) fprintf(stderr, "occupancy query says %d\n", per_cu);
        grid = cus > 0 ? cus : 256;
    }
    hipMemsetAsync(d_ws, 0, CTL_BYTES, stream);
    Args a;
    memset(&a, 0, sizeof(a));
    for (int i = 0; i < 28; ++i) a.in[i] = (const float*)d_in[i];
    a.out = (float*)d_out;
    a.ws = (unsigned char*)d_ws;
    hipLaunchKernelGGL(fwd_kernel, dim3(grid), dim3(512), kDynLds, stream, a);
}
```

```cpp
#include <hip/hip_runtime.h>
#include <stdint.h>
#include <cstdio>
#include <cstring>
#ifndef PROBE
#define PROBE 0
#endif
#define PAMP_BEGIN(id) unsigned long long pamp_t0_##id = 0; if (PROBE == (id)) pamp_t0_##id = __builtin_amdgcn_s_memrealtime()
#define PAMP_END(id) do { if (PROBE == (id)) { __syncthreads(); const unsigned long long t1_ = __builtin_amdgcn_s_memrealtime(), d_ = t1_ - pamp_t0_##id; while (__builtin_amdgcn_s_memrealtime() - t1_ < d_) __builtin_amdgcn_s_sleep(8); __syncthreads(); } } while (0)

constexpr int DM = 1024, NB = 8, SEQ = 4096, DEPTH = 4, MTOK = NB * SEQ;
constexpr int GW = 512, HD = 64, NH = 8, DMIX = 1536, DIN = 4128;
constexpr int QL = 256, KVL = 128;
constexpr int C_R = 0, C_K = 512, C_V = 1024, C_WL = 1536, C_AL = 1600, C_UB = 1664, C_QL = 2176, C_KVL = 2432, C_KR = 2560,
              C_ZA = 2592, C_ZB = 3104, C_ZC = 3616;
__device__ __forceinline__ int orig_col(int c) {
    if (c < 1664) return c;
    if (c < 2176) return c - 1664 + 2176;
    if (c < 2432) return c - 2176 + 3200;
    if (c < 2560) return c - 2432 + 3456;
    if (c < 2592) return c - 2560 + 3584;
    if (c < 3104) return c - 2592 + 1664;
    if (c < 3616) return c - 3104 + 2688;
    return c;
}
constexpr size_t MiB = 1u << 20;
constexpr size_t WS_CTL = 0, CTL_BYTES = 65536;
constexpr size_t WS_ROPE = 64 * 1024;
constexpr size_t WS_W2T = 576 * 1024;
constexpr size_t WS_SQQ = 1088 * 1024;
constexpr size_t WS_SQKV = 2112 * 1024;
constexpr size_t WS_SSQH = 10 * MiB;
constexpr size_t WS_WMLA = 3 * MiB;
constexpr size_t WS_PROJ = 16 * MiB;
constexpr size_t WS_XN = 354 * MiB;
constexpr size_t WS_K = 274 * MiB;
constexpr size_t WS_V = 322 * MiB;
constexpr size_t WS_BON = 8 * MiB + 512 * 1024;
constexpr size_t WS_XFIN = 7 * MiB;
constexpr size_t WS_SAVA = 14 * MiB;
constexpr size_t WS_RWD = 480 * MiB;
constexpr size_t WS_GAT = 9 * MiB + 512 * 1024;
constexpr size_t WS_LSUM = 10 * MiB;
constexpr size_t WS_WIN = 434 * MiB;
constexpr size_t WS_WOUT = 468 * MiB;
constexpr size_t WS_FREE = 480 * MiB;
constexpr int NPAD_IN = 4352, NMLA = 1792, KMLA = 384;
constexpr int CW_QUEUE = 8192, CW_PROBEQ = 12288, CW_PROBE = 4000, CW_LCNT = 14336, CW_ATTQ = 15000, CW_GATE = 4608, CW_FIN = 5632;
constexpr int CW_PAD0 = 0;

#ifndef ATT_THR
#define ATT_THR 8
#endif

typedef unsigned short bf16_t;
__device__ __forceinline__ float bf2f(bf16_t v) { return __builtin_bit_cast(float, (unsigned)v << 16); }
typedef float f32x2_cv __attribute__((ext_vector_type(2)));
typedef __bf16 bf16x2_cv __attribute__((ext_vector_type(2)));
__device__ __forceinline__ unsigned f2bf2(float lo, float hi) { f32x2_cv v = {lo, hi}; bf16x2_cv b = __builtin_convertvector(v, bf16x2_cv); return __builtin_bit_cast(unsigned, b); }
__device__ __forceinline__ bf16_t f2bf(float f) { return (bf16_t)(f2bf2(f, f) & 0xffffu); }
template <int MASK> __device__ __forceinline__ float shx(float v) {
    static_assert(MASK < 32, "shx: within 32 lanes");
    return __builtin_bit_cast(float, __builtin_amdgcn_ds_swizzle(__builtin_bit_cast(int, v), (MASK << 10) | 0x1f));
}
__device__ __forceinline__ void swap32(float v, float& x, float& y) {
    auto rr = __builtin_amdgcn_permlane32_swap(__builtin_bit_cast(unsigned, v), __builtin_bit_cast(unsigned, v), false, false);
    unsigned a = rr[0], b = rr[1]; asm("" : "+v"(a), "+v"(b));
    x = __builtin_bit_cast(float, a); y = __builtin_bit_cast(float, b);
}
template <int CTRL> __device__ __forceinline__ float dppx(float v) { return __builtin_bit_cast(float, __builtin_amdgcn_mov_dpp(__builtin_bit_cast(int, v), CTRL, 0xf, 0xf, true)); }
__device__ __forceinline__ float sum8(float v) { v += dppx<0xB1>(v); v += dppx<0x4E>(v); v += dppx<0x141>(v); return v; }
__device__ __forceinline__ float wave_sum(float v) {
    v += dppx<0xB1>(v); v += dppx<0x4E>(v); v += dppx<0x141>(v); v += dppx<0x140>(v);
    v += shx<16>(v);
    float x, y; swap32(v, x, y);
    return x + y;
}
__device__ __forceinline__ float fexp(float x) { return __builtin_amdgcn_exp2f(x * 1.4426950408889634f); }
__device__ __forceinline__ float frcp(float x) { return __builtin_amdgcn_rcpf(x); }
__device__ __forceinline__ float sigmoidf_(float x) { return frcp(1.0f + fexp(-x)); }
__device__ __forceinline__ float softplusf_(float x) { return x > 20.f ? x : __builtin_amdgcn_logf(1.0f + fexp(x)) * 0.6931471805599453f; }
__device__ __forceinline__ float siluf_(float x) { return x * frcp(1.0f + fexp(-x)); }
__device__ __forceinline__ float ftanh(float x) { return 1.0f - 2.0f * frcp(1.0f + fexp(2.0f * x)); }
__device__ __forceinline__ float nexpm1(float x) { return x > -0.02f ? -x * (1.0f + x * (0.5f + x * 0.16666667f)) : 1.0f - fexp(x); }

__device__ __forceinline__ int otid() { int t = threadIdx.x; asm volatile("" : "+v"(t)); return t; }
template <int K> __device__ __forceinline__ const float* argp() {
    int k = K; asm volatile("" : "+s"(k));
    typedef const __attribute__((address_space(1))) float* gptr_t;
    return (const float*)(gptr_t)(((const unsigned long long*)__builtin_amdgcn_kernarg_segment_ptr())[k]);
}
#define ARG(k) argp<k>()
#define ARG_OUT ((float*)argp<28>())
#define ARG_WS ((unsigned char*)argp<29>())
#define DO_Q ((unsigned char*)argp<28>())
#define DO_RWP ((unsigned char*)argp<28>() + 48 * MiB)

#define XB_TMO      128
#define XB_XCNT(j)  (256  + 64 * (j))
#define XB_XSUB(j)  (1280 + 64 * (j))
#define XB_XGEN(j)  (2304 + 64 * (j))
#define XB_TOP      3328
#define XB_TOPGEN   3392
#define XCD_BAR_WORDS 3456
#define XB_SPIN_CAP (1u << 24)
#define LAS __attribute__((address_space(3)))

__device__ __forceinline__ unsigned xb_ld(unsigned* p)              { return __hip_atomic_load(p, __ATOMIC_RELAXED, __HIP_MEMORY_SCOPE_AGENT); }
__device__ __forceinline__ unsigned xb_add(unsigned* p, unsigned v) { return __hip_atomic_fetch_add(p, v, __ATOMIC_RELAXED, __HIP_MEMORY_SCOPE_AGENT); }
__device__ __forceinline__ unsigned xb_xcc_id() { return (unsigned)__builtin_amdgcn_s_getreg((3 << 11) | 20) & 0xFu; }
#define XB_SPIN(cond, bar) do { unsigned _sp = 0; while (cond) { __builtin_amdgcn_s_sleep(1); \
    if ((++_sp & 255u) == 0u) { if (xb_ld(&(bar)[XB_TMO])) break; if (_sp > XB_SPIN_CAP) { atomicAdd(&(bar)[XB_TMO], 1u); break; } } } } while (0)

struct XcdBarrier { unsigned* bar; unsigned x; volatile LAS unsigned* st; };

__device__ __forceinline__ XcdBarrier xcd_barrier_post(unsigned* bar, volatile LAS unsigned* st) {
    XcdBarrier b; b.bar = bar; b.x = xb_xcc_id(); b.st = st;
    if (threadIdx.x == 0) (void)xb_add(&bar[XB_XCNT(b.x)], 1u);
    return b;
}
__device__ __forceinline__ void xcd_barrier_complete(unsigned* bar, unsigned x, unsigned& nloc, unsigned& nx) {
    const unsigned G = gridDim.x * gridDim.y * gridDim.z;
    unsigned sum, cnt, mine, sp = 0u;
    for (;;) {
        sum = 0u; cnt = 0u; mine = 0u;
#pragma unroll
        for (unsigned j = 0; j < 16; ++j) { const unsigned c = xb_ld(&bar[XB_XCNT(j)]); sum += c; cnt += (c > 0u) ? 1u : 0u; mine = (j == x) ? c : mine; }
        if (sum == G) break;
        __builtin_amdgcn_s_sleep(1);
        if ((++sp & 255u) == 0u) { if (xb_ld(&bar[XB_TMO])) break; if (sp > XB_SPIN_CAP) { atomicAdd(&bar[XB_TMO], 1u); break; } }
    }
    nloc = mine > 0u ? mine : 1u; nx = cnt > 0u ? cnt : 1u;
}
__device__ __forceinline__ void xcd_barrier_raw(const XcdBarrier& b);
__device__ __forceinline__ void xcd_barrier(const XcdBarrier& b) {
#if PROBE == 30
    const unsigned long long t0_ = __builtin_amdgcn_s_memrealtime();
    xcd_barrier_raw(b);
    const unsigned long long t1_ = __builtin_amdgcn_s_memrealtime(), d_ = t1_ - t0_;
    while (__builtin_amdgcn_s_memrealtime() - t1_ < d_) __builtin_amdgcn_s_sleep(8);
    __syncthreads();
#else
    xcd_barrier_raw(b);
#endif
}
__device__ __forceinline__ void xcd_barrier_raw(const XcdBarrier& b) {
    asm volatile("s_waitcnt vmcnt(0)" ::: "memory");
    __syncthreads();
    if (threadIdx.x == 0) {
        unsigned* bar = b.bar;
        __builtin_amdgcn_s_waitcnt(0);
        const unsigned bx = (unsigned)__builtin_amdgcn_readfirstlane((int)xb_xcc_id());
        unsigned nloc = b.st[0], nx = b.st[1];
        if (nloc == 0u) { xcd_barrier_complete(bar, bx, nloc, nx); b.st[0] = nloc; b.st[1] = nx; }
        const unsigned old = xb_add(&bar[XB_XSUB(bx)], 1u);
        const unsigned gen = old / nloc;
        if (old + 1u == (gen + 1u) * nloc) {
            __builtin_amdgcn_fence(__ATOMIC_RELEASE, "agent");
            asm volatile("s_waitcnt vmcnt(0)" ::: "memory");
            const unsigned og = xb_add(&bar[XB_TOP], 1u);
            const unsigned tg = og / nx;
            if (og + 1u == (tg + 1u) * nx) xb_add(&bar[XB_TOPGEN], 1u);
            else XB_SPIN(xb_ld(&bar[XB_TOPGEN]) == tg, bar);
            __builtin_amdgcn_fence(__ATOMIC_ACQUIRE, "agent");
            xb_add(&bar[XB_XGEN(bx)], 1u);
            asm volatile("s_waitcnt vmcnt(0)" ::: "memory");
        } else {
            XB_SPIN(xb_ld(&bar[XB_XGEN(bx)]) == gen, bar);
            __builtin_amdgcn_fence(__ATOMIC_ACQUIRE, "agent");
            asm volatile("s_waitcnt vmcnt(0)" ::: "memory");
        }
    }
    __syncthreads();
}

struct Args {
    const float* in[28];
    float* out;
    unsigned char* ws;
};

namespace pg8 {
#define PG8_LAS __attribute__((address_space(3)))
typedef unsigned short bf16_t;
typedef short bf16x8 __attribute__((ext_vector_type(8)));
typedef float f32x4 __attribute__((ext_vector_type(4)));
typedef unsigned u32x4 __attribute__((ext_vector_type(4)));
constexpr int BM = 256, BK = 64, HALF = 128, HTB = HALF * BK * 2  , STAGE_BYTES = 8 * HTB, NXCD = 8, WGM = 8;

__host__ __device__ __forceinline__ int lds_byte(int r, int c) { const int st = (r >> 4) * 2 + (c >> 5), rr = r & 15, cc = c & 31, ob = rr * 64 + cc * 2; return st * 1024 + (ob ^ (((ob >> 9) & 1) << 5)); }
__host__ __device__ __forceinline__ void stage_rc(int b, int& R, int& C) { const int st = b / 1024, sb = b % 1024, swz = sb ^ (((sb >> 9) & 1) << 5); R = (st >> 1) * 16 + swz / 64; C = (st & 1) * 32 + (swz % 64) / 2; }
__host__ __device__ __forceinline__ int perm32(int rho) { const int n = rho >> 4, i = rho & 15; return 8 * (i >> 2) + 4 * n + (i & 3); }

struct Unit { int pm, pn; };
struct Gemm { const bf16_t* A; const bf16_t* Bt; int M, N, K, lda, ldb; int a_split_pn; int a_split_off; };

struct StaticOrder {
    int nM, nN, nwg, G, c;
    __host__ __device__ void init(int M, int N, int G_, int c_) { nM = M / BM; nN = N / BM; nwg = nM * nN; G = G_; c = c_; }
    __host__ __device__ bool next(int i, Unit& u) const {
        const long L = (long)i * G + c; if (L >= nwg) return false;
        int wgid = (int)L; { const int q = nwg / NXCD, r = nwg % NXCD, xcd = wgid % NXCD, off = wgid / NXCD; wgid = (xcd < r ? xcd * (q + 1) : r * (q + 1) + (xcd - r) * q) + off; }
        const int nig = WGM * nN, gid = wgid / nig, fm = gid * WGM, gsz = (nM - fm) < WGM ? (nM - fm) : WGM;
        u.pm = fm + ((wgid % nig) % gsz); u.pn = (wgid % nig) / gsz; return true;
    }
    __device__ __forceinline__ void a_ready(const Unit&, int) const {}
    __device__ __forceinline__ void a_req(const Unit&, PG8_LAS unsigned char*) const {}
    __device__ __forceinline__ void a_fin(const Unit&, int, PG8_LAS unsigned char*) const {}
    __device__ __forceinline__ void done(const Unit&) const {}
};

constexpr int A_SCR = 131072 + 12288;
template <int NP>
struct RowScaleOrder : StaticOrder {
    const float* part; float inv_dim; PG8_LAS float* tab;
    __device__ __forceinline__ void a_ready(const Unit& u, int seq) const {
        const int t = otid();
        if (t < 256) {
            const float* p = part + (size_t)(u.pm * BM + t) * NP;
            float sm = 0.f;
#pragma unroll
            for (int k = 0; k < NP; k += 4) { const f32x4 v = *(const f32x4*)(p + k); sm += (v[0] + v[1]) + (v[2] + v[3]); }
            tab[(seq & 1) * 256 + t] = rsqrtf(sm * inv_dim + 1e-6f);
        }
    }
    __device__ __forceinline__ void a_req(const Unit& u, PG8_LAS unsigned char* lds) const {
        const int t = otid();
        if (t < 256) {
            const float* p = part + (size_t)(u.pm * BM + t) * NP;
            const int w = __builtin_amdgcn_readfirstlane(t >> 6);
#pragma unroll
            for (int k = 0; k < NP / 4; ++k) __builtin_amdgcn_global_load_lds((const unsigned*)(p + 4 * k), (PG8_LAS unsigned*)(lds + A_SCR + k * 4096 + w * 1024), 16, 0, 0);
        }
    }
    __device__ __forceinline__ void a_fin(const Unit&, int seq, PG8_LAS unsigned char* lds) const {
        const int t = otid();
        if (t < 256) {
            float sm = 0.f;
#pragma unroll
            for (int k = 0; k < NP; k += 4) { const f32x4 v = *(const PG8_LAS f32x4*)(lds + A_SCR + (k / 4) * 4096 + t * 16); sm += (v[0] + v[1]) + (v[2] + v[3]); }
            tab[(seq & 1) * 256 + t] = rsqrtf(sm * inv_dim + 1e-6f);
        }
    }
};

struct MlaOrder : StaticOrder {
    const float* sqq; const float* sqkv; PG8_LAS float* tab;
    __device__ __forceinline__ void a_ready(const Unit& u, int seq) const {
        const int t = otid();
        if (t < 256) {
            const size_t row = (size_t)(u.pm * BM + t);
            const f32x4 q0 = *(const f32x4*)(sqq + row * 8), q1 = *(const f32x4*)(sqq + row * 8 + 4), k0 = *(const f32x4*)(sqkv + row * 4);
            tab[((seq % 3) * 256 + t) * 2] = rsqrtf((((q0[0] + q0[1]) + (q0[2] + q0[3])) + ((q1[0] + q1[1]) + (q1[2] + q1[3]))) * (1.0f / QL) + 1e-6f);
            tab[((seq % 3) * 256 + t) * 2 + 1] = rsqrtf(((k0[0] + k0[1]) + (k0[2] + k0[3])) * (1.0f / KVL) + 1e-6f);
        }
    }
    __device__ __forceinline__ void a_req(const Unit& u, PG8_LAS unsigned char* lds) const {
        const int t = otid();
        if (t < 256) {
            const size_t row = (size_t)(u.pm * BM + t);
            const int w = __builtin_amdgcn_readfirstlane(t >> 6);
            __builtin_amdgcn_global_load_lds((const unsigned*)(sqq + row * 8), (PG8_LAS unsigned*)(lds + A_SCR + w * 1024), 16, 0, 0);
            __builtin_amdgcn_global_load_lds((const unsigned*)(sqq + row * 8 + 4), (PG8_LAS unsigned*)(lds + A_SCR + 4096 + w * 1024), 16, 0, 0);
            __builtin_amdgcn_global_load_lds((const unsigned*)(sqkv + row * 4), (PG8_LAS unsigned*)(lds + A_SCR + 8192 + w * 1024), 16, 0, 0);
        }
    }
    __device__ __forceinline__ void a_fin(const Unit&, int seq, PG8_LAS unsigned char* lds) const {
        const int t = otid();
        if (t < 256) {
            const f32x4 q0 = *(const PG8_LAS f32x4*)(lds + A_SCR + t * 16), q1 = *(const PG8_LAS f32x4*)(lds + A_SCR + 4096 + t * 16), k0 = *(const PG8_LAS f32x4*)(lds + A_SCR + 8192 + t * 16);
            tab[((seq % 3) * 256 + t) * 2] = rsqrtf((((q0[0] + q0[1]) + (q0[2] + q0[3])) + ((q1[0] + q1[1]) + (q1[2] + q1[3]))) * (1.0f / QL) + 1e-6f);
            tab[((seq % 3) * 256 + t) * 2 + 1] = rsqrtf(((k0[0] + k0[1]) + (k0[2] + k0[3])) * (1.0f / KVL) + 1e-6f);
        }
    }
};

__device__ __forceinline__ unsigned cvt_pk_bf16(float lo, float hi) { unsigned r; asm volatile("v_cvt_pk_bf16_f32 %0, %1, %2" : "=v"(r) : "v"(lo), "v"(hi)); return r; }
template <class Epi, class Sched, bool ALIGN_EPI = false, bool SP2 = false>
__device__ __forceinline__ void gemm_phase(PG8_LAS unsigned char* lds, const Gemm g, const Sched& S, const Epi& E) {
    const int tid = otid(), wid = __builtin_amdgcn_readfirstlane(tid >> 6), lane = tid & 63, wr = wid >> 2, wc = wid & 3, fr = lane & 15, fq = lane >> 4;
    const int K = g.K, nt = K / BK;
    unsigned voffA[2], voffB[2];
#pragma unroll
    for (int i = 0; i < 2; ++i) { int R, C; stage_rc(tid * 16 + i * 8192, R, C); const int Rb = Epi::PERM ? ((R & ~31) + perm32(R & 31)) : R;
        voffA[i] = (unsigned)(R * g.lda + C) * 2u; voffB[i] = (unsigned)(Rb * g.ldb + C) * 2u; }
    const size_t kstep = (size_t)(BK * 2);
    const size_t hstepA = (size_t)HALF * g.lda * 2, hstepB = (size_t)HALF * g.ldb * 2;
    const size_t tstepA = 2 * hstepA, tstepB = 2 * hstepB;
    const unsigned ldsw = (unsigned)wid * 1024u;
    const int aoff = lds_byte(wr * 64 + fr, fq * 8), boff = lds_byte(wc * 32 + fr, fq * 8);
#define PG8_SA(b, h) (((b) * 2 + (h)) * HTB)
#define PG8_SB(b, h) ((4 + (b) * 2 + (h)) * HTB)
#define PG8_STAGE(bufoff, gbase, voff) do { _Pragma("unroll") for (int _i = 0; _i < 2; ++_i) \
        __builtin_amdgcn_global_load_lds((const unsigned*)((const char*)(gbase) + (voff)[_i]), (PG8_LAS unsigned*)(lds + (bufoff) + ldsw + _i * 8192), 16, 0, 0); } while (0)
#define PG8_LDA(dst, b, h) do { _Pragma("unroll") for (int m = 0; m < 4; ++m) _Pragma("unroll") for (int k = 0; k < 2; ++k) dst[m][k] = *(const PG8_LAS bf16x8*)(lds + PG8_SA(b, h) + aoff + m * 2048 + k * 1024); } while (0)
#define PG8_LDB(dst, b, h) do { _Pragma("unroll") for (int n = 0; n < 2; ++n) _Pragma("unroll") for (int k = 0; k < 2; ++k) dst[n][k] = *(const PG8_LAS bf16x8*)(lds + PG8_SB(b, h) + boff + n * 2048 + k * 1024); } while (0)
#define PG8_MMA(ai, bj, At, Bt) do { __builtin_amdgcn_s_setprio(1); _Pragma("unroll") for (int m = 0; m < 4; ++m) _Pragma("unroll") for (int n = 0; n < 2; ++n) _Pragma("unroll") for (int k = 0; k < 2; ++k) \
        acc[ai][bj][m][n] = __builtin_amdgcn_mfma_f32_16x16x32_bf16(Bt[n][k], At[m][k], acc[ai][bj][m][n], 0, 0, 0); __builtin_amdgcn_s_setprio(0); } while (0)
#define PG8_WAIT_V(n) asm volatile("s_waitcnt vmcnt(" #n ")" ::: "memory")
#define PG8_WAIT_L(n) asm volatile("s_waitcnt lgkmcnt(" #n ")" ::: "memory")
#define PG8_BAR __builtin_amdgcn_s_barrier()
#define PG8_SCHED __builtin_amdgcn_sched_barrier(0)
    Unit cur, nxt; int ui = 0;
    if (!S.next(0, cur)) return;
    f32x4 acc[2][2][4][2];
#pragma unroll
    for (int a = 0; a < 2; ++a)
#pragma unroll
        for (int b = 0; b < 2; ++b)
#pragma unroll
            for (int m = 0; m < 4; ++m)
#pragma unroll
                for (int n = 0; n < 2; ++n) acc[a][b][m][n] = (f32x4){0.f, 0.f, 0.f, 0.f};
    bf16x8 At[4][2], B0[2][2], B1[2][2];
    const char* cA = (const char*)g.A + (size_t)cur.pm * tstepA + (cur.pn >= g.a_split_pn ? g.a_split_off : 0); const char* cB = (const char*)g.Bt + (size_t)cur.pn * tstepB;
    S.a_ready(cur, 0);
    if constexpr (SP2) {
        PG8_STAGE(PG8_SB(0, 0), cB, voffB); PG8_STAGE(PG8_SB(0, 1), cB + hstepB, voffB); PG8_STAGE(PG8_SA(0, 0), cA, voffA); PG8_STAGE(PG8_SA(0, 1), cA + hstepA, voffA);
        if (wr == 1) PG8_BAR;
        PG8_WAIT_V(2); PG8_BAR;
        PG8_STAGE(PG8_SB(1, 0), cB + kstep, voffB); PG8_STAGE(PG8_SA(1, 0), cA + kstep, voffA); PG8_STAGE(PG8_SB(1, 1), cB + hstepB + kstep, voffB);
        PG8_WAIT_V(6); PG8_BAR;
    } else {
        PG8_STAGE(PG8_SB(0, 0), cB, voffB); PG8_STAGE(PG8_SA(0, 0), cA, voffA); PG8_STAGE(PG8_SB(0, 1), cB + hstepB, voffB); PG8_STAGE(PG8_SA(0, 1), cA + hstepA, voffA);
        if (wr == 1) PG8_BAR;
        PG8_WAIT_V(4); PG8_BAR;
        PG8_STAGE(PG8_SB(1, 0), cB + kstep, voffB); PG8_STAGE(PG8_SA(1, 0), cA + kstep, voffA); PG8_STAGE(PG8_SB(1, 1), cB + hstepB + kstep, voffB);
        PG8_WAIT_V(6); PG8_BAR;
    }
    for (;;) {
        const bool has_next = S.next(ui + 1, nxt);
        const char* nA = has_next ? (const char*)g.A + (size_t)nxt.pm * tstepA + (nxt.pn >= g.a_split_pn ? g.a_split_off : 0) : cA; const char* nB = has_next ? (const char*)g.Bt + (size_t)nxt.pn * tstepB : cB;
        for (int t = 0; t < nt; t += 2) {
            const bool last = (t == nt - 2);
            const char* a1 = cA + (size_t)(t + 1) * kstep;
            const char* a2 = last ? nA : cA + (size_t)(t + 2) * kstep; const char* b2 = last ? nB : cB + (size_t)(t + 2) * kstep;
            const char* a3 = a2 + kstep; const char* b3 = b2 + kstep;
            if (last && has_next) { if constexpr (SP2) S.a_req(nxt, lds); else S.a_ready(nxt, ui + 1); }
            if constexpr (SP2) {
            PG8_LDB(B0, 0, 0); PG8_LDB(B1, 0, 1); PG8_SCHED; PG8_LDA(At, 0, 0); PG8_STAGE(PG8_SA(1, 1), a1 + hstepA, voffA);
            PG8_WAIT_V(8); PG8_WAIT_L(0); PG8_BAR; PG8_MMA(0, 0, At, B0); PG8_MMA(0, 1, At, B1); PG8_BAR; PG8_SCHED;
            PG8_LDA(At, 0, 1); PG8_STAGE(PG8_SB(0, 0), b2, voffB); PG8_STAGE(PG8_SB(0, 1), b2 + hstepB, voffB); PG8_STAGE(PG8_SA(0, 0), a2, voffA);
            PG8_WAIT_V(8); if (last && has_next) S.a_fin(nxt, ui + 1, lds);
            PG8_WAIT_L(0); PG8_BAR; PG8_MMA(1, 0, At, B0); PG8_MMA(1, 1, At, B1); PG8_BAR; PG8_SCHED;
            PG8_LDB(B0, 1, 0); PG8_LDB(B1, 1, 1); PG8_SCHED; PG8_LDA(At, 1, 0); PG8_STAGE(PG8_SA(0, 1), a2 + hstepA, voffA);
            PG8_WAIT_V(8); PG8_WAIT_L(0); PG8_BAR; PG8_MMA(0, 0, At, B0); PG8_MMA(0, 1, At, B1); PG8_BAR; PG8_SCHED;
            PG8_LDA(At, 1, 1); PG8_STAGE(PG8_SB(1, 0), b3, voffB); PG8_STAGE(PG8_SB(1, 1), b3 + hstepB, voffB); PG8_STAGE(PG8_SA(1, 0), a3, voffA);
            PG8_WAIT_V(8); PG8_WAIT_L(0); PG8_BAR; PG8_MMA(1, 0, At, B0); PG8_MMA(1, 1, At, B1); PG8_BAR; PG8_SCHED;
            } else {
            PG8_LDB(B0, 0, 0); PG8_SCHED; PG8_LDA(At, 0, 0); PG8_STAGE(PG8_SA(1, 1), a1 + hstepA, voffA);
            PG8_WAIT_L(8); PG8_BAR; PG8_WAIT_L(0); PG8_MMA(0, 0, At, B0); PG8_BAR; PG8_SCHED;
            PG8_LDB(B1, 0, 1); PG8_STAGE(PG8_SB(0, 0), b2, voffB);
            PG8_BAR; PG8_WAIT_L(0); PG8_MMA(0, 1, At, B1); PG8_BAR;
            PG8_LDA(At, 0, 1); PG8_STAGE(PG8_SA(0, 0), a2, voffA);
            PG8_BAR; PG8_WAIT_L(0); PG8_MMA(1, 0, At, B0); PG8_BAR; PG8_SCHED;
            PG8_STAGE(PG8_SB(0, 1), b2 + hstepB, voffB);
            PG8_WAIT_V(6); PG8_BAR; PG8_MMA(1, 1, At, B1); PG8_BAR;
            PG8_LDB(B0, 1, 0); PG8_SCHED; PG8_LDA(At, 1, 0); PG8_STAGE(PG8_SA(0, 1), a2 + hstepA, voffA);
            PG8_WAIT_L(8); PG8_BAR; PG8_WAIT_L(0); PG8_MMA(0, 0, At, B0); PG8_BAR; PG8_SCHED;
            PG8_LDB(B1, 1, 1); PG8_STAGE(PG8_SB(1, 0), b3, voffB);
            PG8_BAR; PG8_WAIT_L(0); PG8_MMA(0, 1, At, B1); PG8_BAR;
            PG8_LDA(At, 1, 1); PG8_STAGE(PG8_SA(1, 0), a3, voffA);
            PG8_BAR; PG8_WAIT_L(0); PG8_MMA(1, 0, At, B0); PG8_BAR; PG8_SCHED;
            PG8_STAGE(PG8_SB(1, 1), b3 + hstepB, voffB);
            PG8_WAIT_V(6); PG8_BAR; PG8_MMA(1, 1, At, B1); PG8_BAR;
            }
        }
        if constexpr (ALIGN_EPI) { if (wr == 0) PG8_BAR; }
        if constexpr (!Epi::AFTER_DRAIN) { E(acc, cur, wr, wc, fr, fq, ui); S.done(cur); }
        if (!has_next) break;
#pragma unroll
        for (int a = 0; a < 2; ++a)
#pragma unroll
            for (int b = 0; b < 2; ++b)
#pragma unroll
                for (int m = 0; m < 4; ++m)
#pragma unroll
                    for (int n = 0; n < 2; ++n) acc[a][b][m][n] = (f32x4){0.f, 0.f, 0.f, 0.f};
        cur = nxt; cA = nA; cB = nB; ++ui;
        if constexpr (ALIGN_EPI) { if (wr == 1) PG8_BAR; }
    }
    PG8_WAIT_V(0);
    if constexpr (!ALIGN_EPI) { if (wr == 0) PG8_BAR; }
    PG8_BAR;
    if constexpr (Epi::AFTER_DRAIN) { E.fused(acc, cur, wr, wc, fr, fq, lds, wid, lane); S.done(cur); }
#undef PG8_SA
#undef PG8_SB
#undef PG8_STAGE
#undef PG8_LDA
#undef PG8_LDB
#undef PG8_MMA
#undef PG8_WAIT_V
#undef PG8_WAIT_L
#undef PG8_BAR
#undef PG8_SCHED
}
}

namespace pg8 {
struct EpiProj {
    static constexpr bool PERM = true, AFTER_DRAIN = false;
    bf16_t* O; int ldc; int ncols; const PG8_LAS float* tab; float* sqq; float* sqkv; bf16_t* Kb; const float* rope; bf16_t* sav;
    __device__ __forceinline__ void operator()(const f32x4 (&acc)[2][2][4][2], const Unit& u, int wr, int wc, int fr, int fq, int seq) const {
        const int row0 = u.pm * BM + wr * 64 + fr, col0 = u.pn * BM + wc * 32 + 8 * fq;
        const int lane_hi = (fq >> 1);
#pragma unroll
        for (int ai = 0; ai < 2; ++ai)
#pragma unroll
            for (int m = 0; m < 4; ++m) {
                const int row = row0 + ai * HALF + m * 16;
                const float rs = tab[(seq & 1) * 256 + wr * 64 + fr + ai * HALF + m * 16];
                bf16_t* rowp = O + (size_t)row * ldc + col0;
#pragma unroll
                for (int bj = 0; bj < 2; ++bj) {
                    const f32x4 v0 = acc[ai][bj][m][0] * rs, v1 = acc[ai][bj][m][1] * rs;
                    u32x4 w; w.x = cvt_pk_bf16(v0[0], v0[1]); w.y = cvt_pk_bf16(v0[2], v0[3]); w.z = cvt_pk_bf16(v1[0], v1[1]); w.w = cvt_pk_bf16(v1[2], v1[3]);
                    const int col = col0 + bj * HALF;
                    if (col < ncols) *(u32x4*)(rowp + bj * HALF) = w;
                    if (u.pn <= 6 && m == 3 && fr == 15 && col < 1664) {
                        const int t = row & (SEQ - 1), cn = (t >> 6) + 1;
                        if (cn < 64) *(u32x4*)(sav + ((size_t)(row >> 12) * 64 + cn) * 1664 + col) = w;
                    }
                    const bool isq = (u.pn == 8 && bj == 1) || (u.pn == 9 && bj == 0), iskv = (u.pn == 9 && bj == 1);
                    if (isq || iskv) {
                        float ss = (v0[0] * v0[0] + v0[1] * v0[1]) + (v0[2] * v0[2] + v0[3] * v0[3]) + (v1[0] * v1[0] + v1[1] * v1[1]) + (v1[2] * v1[2] + v1[3] * v1[3]);
                        ss += shx<16>(ss); { float x, y; swap32(ss, x, y); ss = x + y; }
                        if (fq == 0) { if (iskv) sqkv[(size_t)row * 4 + wc] = ss; else sqq[(size_t)row * 8 + (u.pn == 8 ? 0 : 4) + wc] = ss; }
                    }
                    if (u.pn == 10 && bj == 0 && wc == 0) {
                        const int t = row & (SEQ - 1);
                        const float* rp = rope + ((size_t)t * 16 + 8 * (fq & 1)) * 2;
                        const f32x4 c0 = *(const f32x4*)rp, c1 = *(const f32x4*)(rp + 4), c2 = *(const f32x4*)(rp + 8), c3 = *(const f32x4*)(rp + 12);
                        const float cs[8] = {c0[0], c0[2], c1[0], c1[2], c2[0], c2[2], c3[0], c3[2]}, sn[8] = {c0[1], c0[3], c1[1], c1[3], c2[1], c2[3], c3[1], c3[3]};
                        const float own[8] = {v0[0], v0[1], v0[2], v0[3], v1[0], v1[1], v1[2], v1[3]};
                        float o[8];
#pragma unroll
                        for (int e = 0; e < 8; ++e) { float x, y; swap32(own[e], x, y); const float oth = lane_hi ? x : y;
                            o[e] = lane_hi ? (oth * sn[e] + own[e] * cs[e]) : (own[e] * cs[e] - oth * sn[e]); }
                        u32x4 kw; kw.x = cvt_pk_bf16(o[0], o[1]); kw.y = cvt_pk_bf16(o[2], o[3]); kw.z = cvt_pk_bf16(o[4], o[5]); kw.w = cvt_pk_bf16(o[6], o[7]);
#pragma unroll
                        for (int hh = 0; hh < 8; ++hh) *(u32x4*)(Kb + ((size_t)row * 8 + hh) * 96 + 64 + 8 * fq) = kw;
                    }
                }
                asm volatile("" ::: "memory");
            }
    }
};
struct EpiResid {
    static constexpr bool PERM = true, AFTER_DRAIN = false;
    int ldc; bool dry; bf16_t* HB; float* ssq;
    __device__ __forceinline__ void operator()(const f32x4 (&acc)[2][2][4][2], const Unit& u, int wr, int wc, int fr, int fq, int seq) const {
        const int row0 = u.pm * BM + wr * 64 + fr, col0 = u.pn * BM + wc * 32 + 8 * fq;
        u32x4 rva[2][4][2];
#pragma unroll
        for (int ai = 0; ai < 2; ++ai)
#pragma unroll
            for (int m = 0; m < 4; ++m)
#pragma unroll
                for (int bj = 0; bj < 2; ++bj) rva[ai][m][bj] = *(const u32x4*)(HB + (size_t)(row0 + ai * HALF + m * 16) * ldc + col0 + bj * HALF);
#pragma unroll
        for (int ai = 0; ai < 2; ++ai) {
            const u32x4 (&rv)[4][2] = rva[ai];
#pragma unroll
            for (int m = 0; m < 4; ++m) { const int row = row0 + ai * HALF + m * 16; const size_t off = (size_t)row * ldc + col0;
                float ss = 0.f;
#pragma unroll
                for (int bj = 0; bj < 2; ++bj) { const u32x4 r = rv[m][bj]; f32x4 o0 = acc[ai][bj][m][0], o1 = acc[ai][bj][m][1];
                    o0[0] += __uint_as_float(r.x << 16); o0[1] += __uint_as_float(r.x & 0xffff0000u); o0[2] += __uint_as_float(r.y << 16); o0[3] += __uint_as_float(r.y & 0xffff0000u);
                    o1[0] += __uint_as_float(r.z << 16); o1[1] += __uint_as_float(r.z & 0xffff0000u); o1[2] += __uint_as_float(r.w << 16); o1[3] += __uint_as_float(r.w & 0xffff0000u);
                    ss += ((o0[0] * o0[0] + o0[1] * o0[1]) + (o0[2] * o0[2] + o0[3] * o0[3])) + ((o1[0] * o1[0] + o1[1] * o1[1]) + (o1[2] * o1[2] + o1[3] * o1[3]));
                    u32x4 hb; hb.x = cvt_pk_bf16(o0[0], o0[1]); hb.y = cvt_pk_bf16(o0[2], o0[3]); hb.z = cvt_pk_bf16(o1[0], o1[1]); hb.w = cvt_pk_bf16(o1[2], o1[3]);
                    if (!dry) *(u32x4*)(HB + off + bj * HALF) = hb; }
                ss += shx<16>(ss); { float x, y; swap32(ss, x, y); ss = x + y; }
                if (fq == 0 && !dry) ssq[(size_t)row * 16 + u.pn * 4 + wc] = ss;
            }
        }
    }
};
struct EpiFinal {
    static constexpr bool PERM = true, AFTER_DRAIN = false;
    int ldc; const bf16_t* HB; float* out; const float* gain; float* xs; unsigned* cnt; unsigned* ctl; PG8_LAS float* part; PG8_LAS float* rtab;
    __device__ __forceinline__ void operator()(f32x4 (&acc)[2][2][4][2], const Unit& u, int wr, int wc, int fr, int fq, int seq) const {
        (void)seq;
        const int row0 = u.pm * BM + wr * 64 + fr, col0 = u.pn * BM + wc * 32 + 8 * fq;
#pragma unroll
        for (int ai = 0; ai < 2; ++ai) {
            u32x4 rv[4][2];
#pragma unroll
            for (int m = 0; m < 4; ++m)
#pragma unroll
                for (int bj = 0; bj < 2; ++bj) rv[m][bj] = *(const u32x4*)(HB + (size_t)(row0 + ai * HALF + m * 16) * ldc + col0 + bj * HALF);
#pragma unroll
            for (int m = 0; m < 4; ++m) {
                float ss = 0.f;
#pragma unroll
                for (int bj = 0; bj < 2; ++bj) { const u32x4 r = rv[m][bj]; f32x4 o0 = acc[ai][bj][m][0], o1 = acc[ai][bj][m][1];
                    o0[0] += __uint_as_float(r.x << 16); o0[1] += __uint_as_float(r.x & 0xffff0000u); o0[2] += __uint_as_float(r.y << 16); o0[3] += __uint_as_float(r.y & 0xffff0000u);
                    o1[0] += __uint_as_float(r.z << 16); o1[1] += __uint_as_float(r.z & 0xffff0000u); o1[2] += __uint_as_float(r.w << 16); o1[3] += __uint_as_float(r.w & 0xffff0000u);
                    ss += ((o0[0] * o0[0] + o0[1] * o0[1]) + (o0[2] * o0[2] + o0[3] * o0[3])) + ((o1[0] * o1[0] + o1[1] * o1[1]) + (o1[2] * o1[2] + o1[3] * o1[3]));
                    acc[ai][bj][m][0] = o0; acc[ai][bj][m][1] = o1; }
                ss += shx<16>(ss); { float x, y; swap32(ss, x, y); ss = x + y; }
                if (fq == 0) part[(wr * 64 + fr + ai * HALF + m * 16) * 4 + wc] = ss;
            }
        }
        asm volatile("s_waitcnt lgkmcnt(0)\n\ts_barrier" ::: "memory");
        const int t = otid();
        float* slot = xs + (size_t)(u.pm * 4) * 256 + t;
        if (t < 256) { const f32x4 p = *(const PG8_LAS f32x4*)(part + t * 4);
            __hip_atomic_store(slot + u.pn * 256, (p[0] + p[1]) + (p[2] + p[3]), __ATOMIC_RELAXED, __HIP_MEMORY_SCOPE_AGENT); }
        asm volatile("s_waitcnt vmcnt(0)\n\ts_barrier" ::: "memory");
        if (t == 0) { (void)xb_add(cnt + 16 * u.pm, 1u); XB_SPIN(xb_ld(cnt + 16 * u.pm) < 4u, ctl); }
        asm volatile("s_barrier" ::: "memory");
        if (t < 256) { float tot = 0.f;
#pragma unroll
            for (int j = 0; j < 4; ++j) tot += __hip_atomic_load(slot + j * 256, __ATOMIC_RELAXED, __HIP_MEMORY_SCOPE_AGENT);
            rtab[t] = rsqrtf(tot * (1.0f / 1024.0f) + 1e-6f); }
        asm volatile("s_waitcnt vmcnt(0) lgkmcnt(0)\n\ts_barrier" ::: "memory");
        f32x4 gg[2][2];
#pragma unroll
        for (int bj = 0; bj < 2; ++bj) { gg[bj][0] = *(const f32x4*)(gain + col0 + bj * HALF); gg[bj][1] = *(const f32x4*)(gain + col0 + bj * HALF + 4); }
#pragma unroll
        for (int ai = 0; ai < 2; ++ai)
#pragma unroll
            for (int m = 0; m < 4; ++m) {
                const int rl = wr * 64 + fr + ai * HALF + m * 16;
                const float rs = rtab[rl];
                float* op = out + (size_t)(u.pm * BM + rl) * 1024 + col0;
#pragma unroll
                for (int bj = 0; bj < 2; ++bj) { *(f32x4*)(op + bj * HALF) = acc[ai][bj][m][0] * rs * gg[bj][0]; *(f32x4*)(op + bj * HALF + 4) = acc[ai][bj][m][1] * rs * gg[bj][1]; }
            }
    }
};
struct EpiMla {
    static constexpr bool PERM = true, AFTER_DRAIN = false;
    bf16_t* Q; bf16_t* K; bf16_t* V; const PG8_LAS float* tab; const float* rope; float c2; int pn0;
    __device__ __forceinline__ void operator()(const f32x4 (&acc)[2][2][4][2], const Unit& u, int wr, int wc, int fr, int fq, int seq) const {
        const int row0 = u.pm * BM + wr * 64 + fr;
        const int lane_hi = (fq >> 1);
#pragma unroll
        for (int ai = 0; ai < 2; ++ai)
#pragma unroll
            for (int m = 0; m < 4; ++m) {
                const int row = row0 + ai * HALF + m * 16;
                const int rl = wr * 64 + fr + ai * HALF + m * 16;
                const float rq = tab[((seq % 3) * 256 + rl) * 2], rk = tab[((seq % 3) * 256 + rl) * 2 + 1];
#pragma unroll
                for (int bj = 0; bj < 2; ++bj) {
                    const int pn = u.pn + pn0; const int cg = pn * BM + bj * HALF + wc * 32;
                    f32x4 v0 = acc[ai][bj][m][0], v1 = acc[ai][bj][m][1];
                    if (pn < 3) {
                        v0 = v0 * rq; v1 = v1 * rq;
                        if (((cg >> 5) % 3) == 2) {
                            const int t = row & (SEQ - 1);
                            const float* rp = rope + ((size_t)t * 16 + 8 * (fq & 1)) * 2;
                            const f32x4 c0 = *(const f32x4*)rp, c1 = *(const f32x4*)(rp + 4), c2_ = *(const f32x4*)(rp + 8), c3 = *(const f32x4*)(rp + 12);
                            const float cs[8] = {c0[0], c0[2], c1[0], c1[2], c2_[0], c2_[2], c3[0], c3[2]}, sn[8] = {c0[1], c0[3], c1[1], c1[3], c2_[1], c2_[3], c3[1], c3[3]};
                            const float own[8] = {v0[0], v0[1], v0[2], v0[3], v1[0], v1[1], v1[2], v1[3]};
                            float o[8];
#pragma unroll
                            for (int e = 0; e < 8; ++e) { float x, y; swap32(own[e], x, y); const float oth = lane_hi ? x : y;
                                o[e] = lane_hi ? (oth * sn[e] + own[e] * cs[e]) : (own[e] * cs[e] - oth * sn[e]); }
                            v0 = (f32x4){o[0], o[1], o[2], o[3]}; v1 = (f32x4){o[4], o[5], o[6], o[7]};
                        }
                        v0 = v0 * c2; v1 = v1 * c2;
                        u32x4 w; w.x = cvt_pk_bf16(v0[0], v0[1]); w.y = cvt_pk_bf16(v0[2], v0[3]); w.z = cvt_pk_bf16(v1[0], v1[1]); w.w = cvt_pk_bf16(v1[2], v1[3]);
                        *(u32x4*)(Q + (size_t)row * 768 + cg + 8 * fq) = w;
                    } else {
                        v0 = v0 * rk; v1 = v1 * rk;
                        const int c = cg - 768, hh = c >> 7, d = (c & 127) + 8 * fq;
                        u32x4 w; w.x = cvt_pk_bf16(v0[0], v0[1]); w.y = cvt_pk_bf16(v0[2], v0[3]); w.z = cvt_pk_bf16(v1[0], v1[1]); w.w = cvt_pk_bf16(v1[2], v1[3]);
                        bf16_t* p = (d < 64) ? K + ((size_t)row * 8 + hh) * 96 + d : V + ((size_t)row * 8 + hh) * 64 + (d - 64);
                        *(u32x4*)p = w;
                    }
                }
                asm volatile("" ::: "memory");
            }
    }
};
}

typedef float f32x4_t __attribute__((ext_vector_type(4)));
typedef unsigned u32x4_t __attribute__((ext_vector_type(4)));
template <class SRC4>
__device__ __forceinline__ void transpose_w(int K, int npad, bf16_t* WT, const SRC4& src4, float* lds) {
    const int tid = otid();
    const int tk = K / 64, tn = npad / 64;
    const int kk = tid >> 4, n4 = (tid & 15) * 4;
    const int nn = tid >> 3, k8 = (tid & 7) * 8;
    int par = 0;
    __syncthreads();
    for (int u = blockIdx.x; u < tk * tn; u += gridDim.x, par ^= 1) {
        const int k0 = (u % tk) * 64, n0 = (u / tk) * 64;
        float* tile = lds + par * (64 * 65);
        const f32x4_t v0 = src4(k0 + kk, n0 + n4), v1 = src4(k0 + kk + 32, n0 + n4);
#pragma unroll
        for (int e = 0; e < 4; ++e) { tile[kk * 65 + n4 + e] = v0[e]; tile[(kk + 32) * 65 + n4 + e] = v1[e]; }
        __syncthreads();
        u32x4_t w;
        w.x = f2bf2(tile[(k8 + 0) * 65 + nn], tile[(k8 + 1) * 65 + nn]); w.y = f2bf2(tile[(k8 + 2) * 65 + nn], tile[(k8 + 3) * 65 + nn]);
        w.z = f2bf2(tile[(k8 + 4) * 65 + nn], tile[(k8 + 5) * 65 + nn]); w.w = f2bf2(tile[(k8 + 6) * 65 + nn], tile[(k8 + 7) * 65 + nn]);
        *(u32x4_t*)(WT + (size_t)(n0 + nn) * K + k0 + k8) = w;
    }
}

template <class AL, class BL, class ST>
__device__ __forceinline__ void gemm_naive(int M, int N, int K, const AL& al, const BL& bl, const ST& st, float* lds) {
    float* As = lds;
    float* Bs = lds + 16 * 132;
    const int tid = otid(), ty = tid >> 4, tx = tid & 15;
    const int ntn = (N + 127) / 128, ntiles = (M / 128) * ntn;
    for (int u = blockIdx.x; u < ntiles; u += gridDim.x) {
        const int tm = u / ntn, tn = u % ntn;
        float acc[4][8];
#pragma unroll
        for (int i = 0; i < 4; ++i)
#pragma unroll
            for (int j = 0; j < 8; ++j) acc[i][j] = 0.f;
        for (int k0 = 0; k0 < K; k0 += 16) {
#pragma unroll
            for (int j = 0; j < 4; ++j) { const int idx = tid + j * 512, r = idx >> 4, k = idx & 15; As[k * 132 + r] = al(tm * 128 + r, k0 + k); }
#pragma unroll
            for (int j = 0; j < 4; ++j) { const int idx = tid + j * 512, k = idx >> 7, c = idx & 127; Bs[k * 132 + c] = bl(k0 + k, tn * 128 + c); }
            __syncthreads();
#pragma unroll 2
            for (int k = 0; k < 16; ++k) {
                const float4 a4 = *(const float4*)&As[k * 132 + ty * 4];
                const float4 b0 = *(const float4*)&Bs[k * 132 + tx * 8], b1 = *(const float4*)&Bs[k * 132 + tx * 8 + 4];
                const float av[4] = {a4.x, a4.y, a4.z, a4.w};
                const float bv[8] = {b0.x, b0.y, b0.z, b0.w, b1.x, b1.y, b1.z, b1.w};
#pragma unroll
                for (int i = 0; i < 4; ++i)
#pragma unroll
                    for (int j = 0; j < 8; ++j) acc[i][j] = fmaf(av[i], bv[j], acc[i][j]);
            }
            __syncthreads();
        }
#pragma unroll
        for (int i = 0; i < 4; ++i)
#pragma unroll
            for (int j = 0; j < 8; ++j) st(tm * 128 + ty * 4 + i, tn * 128 + tx * 8 + j, acc[i][j]);
    }
}

namespace rw {
typedef short bf16x8 __attribute__((ext_vector_type(8)));
typedef float f32x16 __attribute__((ext_vector_type(16)));
typedef float f32x4 __attribute__((ext_vector_type(4)));
typedef unsigned u32x2 __attribute__((ext_vector_type(2)));
typedef unsigned u32x4 __attribute__((ext_vector_type(4)));
constexpr int PB = 144, MB = 64 * PB;
constexpr int L_KKD = 0, L_RD = MB, L_BH = 2 * MB, L_KH = 3 * MB, L_BDT = 4 * MB, L_KDT = 5 * MB, L_VT = 6 * MB, L_KKDT = 7 * MB, L_BK = 8 * MB, L_WTT = 9 * MB, L_VTT = 10 * MB;
constexpr int L_AB = L_KKD, L_AK = L_BH, L_BB = L_KH;
constexpr int L_F32 = 11 * MB;
constexpr int L_DEC = L_F32, L_AA = L_F32 + 17408, L_AKVT = L_F32, L_DIAG = L_F32 + 17408, L_TINV = L_DIAG + 4096;
constexpr int L_GC = L_F32 + 34816, L_SEG = L_GC + 256, L_END = L_SEG + 2048;
constexpr int L_MU = L_END;
constexpr int L_XWL = L_MU + 6656, L_XAL = L_XWL + MB;
constexpr int L_XR = 0, L_XK = 17408;
__device__ __forceinline__ int crow(int r, int hi) { return (r & 3) + 8 * (r >> 2) + 4 * hi; }
__device__ __forceinline__ unsigned pk2(float lo, float hi) { return f2bf2(lo, hi); }
#define RW_FRAG(base, row, ks) (*(const LAS bf16x8*)(shm + (base) + (row) * PB + (16 * (ks) + 8 * hi) * 2))
#define RW_MFMA(a, b, c) __builtin_amdgcn_mfma_f32_32x32x16_bf16(a, b, c, 0, 0, 0)
#define RW_PIN4(x) asm volatile("" : "+v"((x)[0]), "+v"((x)[1]), "+v"((x)[2]), "+v"((x)[3]))
#define RW_PIN8(x, y) asm volatile("" : "+v"((x)[0]), "+v"((x)[1]), "+v"((x)[2]), "+v"((x)[3]), "+v"((y)[0]), "+v"((y)[1]), "+v"((y)[2]), "+v"((y)[3]))

struct R1Raw { u32x4 cur[5], prv[5]; };
__device__ __forceinline__ void r1_load(R1Raw& r, const bf16_t* PROJ, const bf16_t* sava, int b, int h, int c, int tid) {
    const int t = tid >> 3, g = tid & 7;
    const size_t row = (size_t)b * SEQ + (size_t)c * 64 + t;
    const char* pw = (const char*)(PROJ + row * DIN) + g * 16;
    const char* qw = (t > 0) ? pw - DIN * 2 : (const char*)(sava + ((size_t)b * 64 + c) * 1664) + g * 16;
    const char* pc = pw + h * 128; const char* qc = qw + h * 128;
#define R1_LD(dst, ptr, off) asm volatile("global_load_dwordx4 %0, %1, off offset:%2" : "=v"(dst) : "v"(ptr), "i"(off) : "memory")
    R1_LD(r.cur[0], pc, C_R * 2); R1_LD(r.cur[1], pc, C_K * 2); R1_LD(r.cur[2], pc, C_V * 2);
    R1_LD(r.prv[0], qc, C_R * 2); R1_LD(r.prv[1], qc, C_K * 2); R1_LD(r.prv[2], qc, C_V * 2);
    if (h == 0) {
        R1_LD(r.cur[3], pw, C_WL * 2); R1_LD(r.cur[4], pw, C_AL * 2); R1_LD(r.prv[3], qw, C_WL * 2); R1_LD(r.prv[4], qw, C_AL * 2);
    }
#undef R1_LD
}
__device__ __forceinline__ void r1_phase(int l, LAS char* shm, const bool dry = false) {
    const int tid0 = otid(), lane_o = tid0 & 63, r32o = lane_o & 31, hio = lane_o >> 5;
    const int wid = __builtin_amdgcn_readfirstlane(tid0 >> 6);
    bf16_t* PROJ = (bf16_t*)(ARG_WS + WS_PROJ);
    const bf16_t* sava = (const bf16_t*)(ARG_WS + WS_SAVA);
    const int tq = wid * 8;
    const float* mu = ARG(3) + (size_t)l * 1664;
    __syncthreads();
    for (int i = tid0; i < 1664; i += 512) ((LAS float*)(shm + L_MU))[i] = mu[i];
    __syncthreads();
    const int pB = wid >> 2, tlB = wid & 3, trB = 32 * (tlB >> 1), ncB = 32 * (tlB & 1);
    R1Raw cur;
    bool first = true;
    struct HeadC { float kkc, kac, rkc, biasB; bf16x8 wfr[4]; } hc;
    auto hload = [&](HeadC& o, int hh, int ln) {
        const int chh = hh * 64 + (ln & 63), r32l = ln & 31, hil = (ln >> 5) & 1;
        o.kkc = (ARG(8) + (size_t)l * 512)[chh]; o.kac = (ARG(9) + (size_t)l * 512)[chh]; o.rkc = (ARG(10) + (size_t)l * 512)[chh];
        o.biasB = ((pB ? ARG(6) : ARG(4)) + (size_t)l * 512)[hh * 64 + ncB + r32l];
        const bf16_t* wt = (const bf16_t*)(ARG_WS + WS_W2T) + (size_t)pB * DEPTH * 512 * 64 + ((size_t)l * 512 + hh * 64 + ncB + r32l) * 64 + 8 * hil;
#pragma unroll
        for (int ks = 0; ks < 4; ++ks) o.wfr[ks] = *(const bf16x8*)(wt + 16 * ks);
    };
    if ((int)blockIdx.x < 512) { r1_load(cur, PROJ, sava, (int)blockIdx.x >> 6, 0, (int)blockIdx.x & 63, tid0); hload(hc, 0, tid0); }
    for (int idx = blockIdx.x, h = 0; idx < 512; ) {
    const int tidl = otid(), lanel = tidl & 63, r32 = lanel & 31, hi = lanel >> 5;
    (void)hio;
    const int lane = lanel;
    const int b = idx >> 6, c = idx & 63;
    const size_t row0 = (size_t)b * SEQ + (size_t)c * 64;
    const int unit = (b * 8 + h) * 64 + c;
    u32x4 vvst;
    f32x4 mu4[10];
#pragma unroll
    for (int k = 0; k < 3; ++k) { mu4[2 * k] = *(const LAS f32x4*)((const LAS float*)(shm + L_MU) + (8 * k + h) * 64 + 8 * (tidl & 7)); mu4[2 * k + 1] = *(const LAS f32x4*)((const LAS float*)(shm + L_MU) + (8 * k + h) * 64 + 8 * (tidl & 7) + 4); }
    const float kkc = hc.kkc, kac = hc.kac, rkc = hc.rkc, biasB = hc.biasB;
    bf16x8 wfr[4] = {hc.wfr[0], hc.wfr[1], hc.wfr[2], hc.wfr[3]};
    __syncthreads();
    asm volatile("" : "+v"(mu4[0]), "+v"(mu4[1]), "+v"(mu4[2]), "+v"(mu4[3]), "+v"(mu4[4]), "+v"(mu4[5]));
    if (first) asm volatile("s_waitcnt vmcnt(0)" ::: "memory");
    else if (wid < 4) asm volatile("s_waitcnt vmcnt(32)" ::: "memory");
    else asm volatile("s_waitcnt vmcnt(20)" ::: "memory");
    first = false;
    asm volatile("" : "+v"(cur.cur[0]), "+v"(cur.cur[1]), "+v"(cur.cur[2]), "+v"(cur.prv[0]), "+v"(cur.prv[1]), "+v"(cur.prv[2]) :: "memory");
    if (h == 0) asm volatile("" : "+v"(cur.cur[3]), "+v"(cur.cur[4]), "+v"(cur.prv[3]), "+v"(cur.prv[4]) :: "memory");
    if (c == 0 && (tidl >> 3) == 0) {
#pragma unroll
        for (int k = 0; k < 5; ++k) cur.prv[k] = (u32x4){0u, 0u, 0u, 0u};
    }
    PAMP_BEGIN(31);
    {
        const int tA = tidl >> 3, gA = tidl & 7;
        auto lerp8 = [&](int k, float (&x)[8]) {
            const f32x4 m0 = mu4[2 * k], m1 = mu4[2 * k + 1];
            const float m[8] = {m0[0], m0[1], m0[2], m0[3], m1[0], m1[1], m1[2], m1[3]};
            const unsigned cw[4] = {cur.cur[k].x, cur.cur[k].y, cur.cur[k].z, cur.cur[k].w}, pw[4] = {cur.prv[k].x, cur.prv[k].y, cur.prv[k].z, cur.prv[k].w};
#pragma unroll
            for (int j = 0; j < 4; ++j) {
                const float c0 = __uint_as_float(cw[j] << 16), c1 = __uint_as_float(cw[j] & 0xffff0000u), p0 = __uint_as_float(pw[j] << 16), p1 = __uint_as_float(pw[j] & 0xffff0000u);
                x[2 * j] = c0 + m[2 * j] * (p0 - c0); x[2 * j + 1] = c1 + m[2 * j + 1] * (p1 - c1);
            }
        };
        float x[8];
        lerp8(0, x);
        *(LAS f32x4*)(shm + L_XR + (tA * 68 + 8 * gA) * 4) = (f32x4){x[0], x[1], x[2], x[3]}; *(LAS f32x4*)(shm + L_XR + (tA * 68 + 8 * gA + 4) * 4) = (f32x4){x[4], x[5], x[6], x[7]};
        lerp8(1, x);
        *(LAS f32x4*)(shm + L_XK + (tA * 68 + 8 * gA) * 4) = (f32x4){x[0], x[1], x[2], x[3]}; *(LAS f32x4*)(shm + L_XK + (tA * 68 + 8 * gA + 4) * 4) = (f32x4){x[4], x[5], x[6], x[7]};
        lerp8(2, x);
        vvst.x = pk2(x[0], x[1]); vvst.y = pk2(x[2], x[3]); vvst.z = pk2(x[4], x[5]); vvst.w = pk2(x[6], x[7]);
        { const unsigned wv[4] = {vvst.x, vvst.y, vvst.z, vvst.w};
#pragma unroll
          for (int j = 0; j < 8; ++j) *(LAS bf16_t*)(shm + L_VT + (8 * gA + j) * PB + tA * 2) = (bf16_t)((j & 1) ? (wv[j >> 1] >> 16) : (wv[j >> 1] & 0xffffu)); }
        if (h == 0) {
#pragma unroll
            for (int k = 3; k < 5; ++k) { mu4[2 * k] = *(const LAS f32x4*)((const LAS float*)(shm + L_MU) + (21 + k) * 64 + 8 * gA); mu4[2 * k + 1] = *(const LAS f32x4*)((const LAS float*)(shm + L_MU) + (21 + k) * 64 + 8 * gA + 4); }
            lerp8(3, x);
            { u32x4 w; w.x = pk2(ftanh(x[0]), ftanh(x[1])); w.y = pk2(ftanh(x[2]), ftanh(x[3])); w.z = pk2(ftanh(x[4]), ftanh(x[5])); w.w = pk2(ftanh(x[6]), ftanh(x[7]));
              *(LAS u32x4*)(shm + L_XWL + tA * PB + gA * 16) = w; }
            lerp8(4, x);
            { u32x4 w; w.x = pk2(x[0], x[1]); w.y = pk2(x[2], x[3]); w.z = pk2(x[4], x[5]); w.w = pk2(x[6], x[7]);
              *(LAS u32x4*)(shm + L_XAL + tA * PB + gA * 16) = w; }
        }
    }
    if (h == 0) __syncthreads();
    {
        const int p = pB, tr = trB, nc = ncB;
        f32x16 acc;
#pragma unroll
        for (int r = 0; r < 16; ++r) acc[r] = biasB;
        const int xb = p ? L_XAL : L_XWL;
        bf16x8 fa[4];
#pragma unroll
        for (int ks = 0; ks < 4; ++ks) fa[ks] = RW_FRAG(xb, tr + r32, ks);
        RW_PIN4(fa);
#pragma unroll
        for (int ks = 0; ks < 4; ++ks) acc = RW_MFMA(fa[ks], wfr[ks], acc);
        LAS float* dst = (LAS float*)(shm + (p ? L_AA : L_DEC));
#pragma unroll
        for (int r = 0; r < 16; ++r) dst[(tr + crow(r, hi)) * 68 + nc + r32] = acc[r];
    }
    __syncthreads();
    PAMP_END(31);
    PAMP_BEGIN(32);
    {
        float* bon = (float*)(ARG_WS + WS_BON);
        float kkn[8], kpv[8], bbv[8], ld[8], lg[8], xr[8], xk[8];
#pragma unroll
        for (int e = 0; e < 8; ++e) { xr[e] = ((const LAS float*)(shm + L_XR))[(tq + e) * 68 + lane]; xk[e] = ((const LAS float*)(shm + L_XK))[(tq + e) * 68 + lane]; }
        float run = 0.f;
        LAS float* zb = (LAS float*)(shm + L_KKDT) + wid * (16 * 64 + 16);
#pragma unroll
        for (int e = 0; e < 8; ++e) {
            const float dec = ((const LAS float*)(shm + L_DEC))[(tq + e) * 68 + lane], aav = ((const LAS float*)(shm + L_AA))[(tq + e) * 68 + lane];
            ld[e] = -0.6065306597126334f * sigmoidf_(dec);
            const float av = sigmoidf_(aav);
            const float kkr = xk[e] * kkc;
            kkn[e] = kkr; bbv[e] = kkr * av;
            kpv[e] = xk[e] * (1.0f + (av - 1.0f) * kac);
            zb[e * 64 + lane] = kkr * kkr;
            zb[(8 + e) * 64 + lane] = xr[e] * kpv[e] * rkc;
            run += ld[e]; lg[e] = run;
        }
        {
            const LAS f32x4* zp = (const LAS f32x4*)(zb + (lane >> 2) * 64 + (lane & 3) * 16);
            const f32x4 z0 = zp[0], z1 = zp[1], z2 = zp[2], z3 = zp[3];
            float tsum = (((z0[0] + z0[1]) + (z0[2] + z0[3])) + ((z1[0] + z1[1]) + (z1[2] + z1[3]))) + (((z2[0] + z2[1]) + (z2[2] + z2[3])) + ((z3[0] + z3[1]) + (z3[2] + z3[3])));
            tsum += dppx<0xB1>(tsum); tsum += dppx<0x4E>(tsum);
            if ((lane & 3) == 0) zb[16 * 64 + (lane >> 2)] = tsum;
            const f32x4 n0 = *(const LAS f32x4*)(zb + 16 * 64), n1 = *(const LAS f32x4*)(zb + 16 * 64 + 4);
            const float n2[8] = {n0[0], n0[1], n0[2], n0[3], n1[0], n1[1], n1[2], n1[3]};
#pragma unroll
            for (int e = 0; e < 8; ++e) { const float rn = __builtin_amdgcn_rsqf(fmaxf(n2[e], 1e-24f)); kkn[e] *= rn; bbv[e] *= rn; }
            if (lane < 8 && !dry) bon[(row0 + tq + lane) * 8 + h] = zb[16 * 64 + 8 + lane];
        }
        ((LAS float*)(shm + L_SEG))[wid * 64 + lane] = run;
        __syncthreads();
        float off = 0.f, tot = 0.f;
#pragma unroll
        for (int w = 0; w < 8; ++w) { const float sgm = ((const LAS float*)(shm + L_SEG))[w * 64 + lane]; tot += sgm; if (w < wid) off += sgm; }
        const float gct = fexp(tot);
        if (wid == 0) ((LAS float*)(shm + L_GC))[lane] = gct;
        float tb[8], tk[8], tkk[8];
        float gprev = fexp(off);
#pragma unroll
        for (int e = 0; e < 8; ++e) {
            const float L = off + lg[e];
            const float g = fexp(L), gp = gprev, ig = frcp(g), ge = gct * ig;
            gprev = g;
            const int t = tq + e;
            const float kkd = kkn[e] * gp;
            *(LAS bf16_t*)(shm + L_KKD + t * PB + lane * 2) = f2bf(kkd);
            *(LAS bf16_t*)(shm + L_RD + t * PB + lane * 2) = f2bf(xr[e] * g);
            *(LAS bf16_t*)(shm + L_BH + t * PB + lane * 2) = f2bf(bbv[e] * ig);
            *(LAS bf16_t*)(shm + L_KH + t * PB + lane * 2) = f2bf(kpv[e] * ig);
            tb[e] = bbv[e] * ge; tk[e] = kpv[e] * ge; tkk[e] = kkd;
        }
        u32x4 v;
        v.x = pk2(tb[0], tb[1]); v.y = pk2(tb[2], tb[3]); v.z = pk2(tb[4], tb[5]); v.w = pk2(tb[6], tb[7]); *(LAS u32x4*)(shm + L_BDT + lane * PB + tq * 2) = v;
        v.x = pk2(tk[0], tk[1]); v.y = pk2(tk[2], tk[3]); v.z = pk2(tk[4], tk[5]); v.w = pk2(tk[6], tk[7]); *(LAS u32x4*)(shm + L_KDT + lane * PB + tq * 2) = v;
        v.x = pk2(tkk[0], tkk[1]); v.y = pk2(tkk[2], tkk[3]); v.z = pk2(tkk[4], tkk[5]); v.w = pk2(tkk[6], tkk[7]); *(LAS u32x4*)(shm + L_KKDT + lane * PB + tq * 2) = v;
    }
    __syncthreads();
    PAMP_END(32);
    PAMP_BEGIN(33);
    {
        const int mat = wid & 3;
        const int ab = (mat < 2) ? L_KKD : L_RD, bb = (mat & 1) ? L_KH : L_BH;
        const int ob = (mat == 0) ? L_AB : (mat == 1) ? L_AK : (mat == 2) ? L_BB : L_BK;
        f32x16 acc0, acc1;
#pragma unroll
        for (int r = 0; r < 16; ++r) { acc0[r] = 0.f; acc1[r] = 0.f; }
        if (wid < 4) {
            bf16x8 fa0[4], fb0[4], fa1[4], fb1[4];
#pragma unroll
            for (int ks = 0; ks < 4; ++ks) { fa0[ks] = RW_FRAG(ab, r32, ks); fb0[ks] = RW_FRAG(bb, r32, ks); fa1[ks] = RW_FRAG(ab, 32 + r32, ks); fb1[ks] = RW_FRAG(bb, 32 + r32, ks); }
            asm volatile("" : "+v"(fa0[0]), "+v"(fa0[1]), "+v"(fa0[2]), "+v"(fa0[3]), "+v"(fb0[0]), "+v"(fb0[1]), "+v"(fb0[2]), "+v"(fb0[3]),
                         "+v"(fa1[0]), "+v"(fa1[1]), "+v"(fa1[2]), "+v"(fa1[3]), "+v"(fb1[0]), "+v"(fb1[1]), "+v"(fb1[2]), "+v"(fb1[3]));
#pragma unroll
            for (int ks = 0; ks < 4; ++ks) { acc0 = RW_MFMA(fb0[ks], fa0[ks], acc0); acc1 = RW_MFMA(fb1[ks], fa1[ks], acc1); }
        } else {
            bf16x8 fa0[4], fb0[4];
#pragma unroll
            for (int ks = 0; ks < 4; ++ks) { fa0[ks] = RW_FRAG(ab, 32 + r32, ks); fb0[ks] = RW_FRAG(bb, r32, ks); }
            RW_PIN8(fa0, fb0);
#pragma unroll
            for (int ks = 0; ks < 4; ++ks) acc0 = RW_MFMA(fb0[ks], fa0[ks], acc0);
        }
        __syncthreads();
        if (wid < 4) {
            const int lim = (mat < 2) ? 1 : 0;
#pragma unroll
            for (int g = 0; g < 4; ++g) {
                const int s0 = 8 * g + 4 * hi;
#pragma unroll
                for (int e = 0; e < 4; ++e) { const bool keep = r32 >= (s0 + e + lim); acc0[4 * g + e] = keep ? acc0[4 * g + e] : 0.f; acc1[4 * g + e] = keep ? acc1[4 * g + e] : 0.f; }
                u32x2 w0, w1; w0.x = pk2(acc0[4 * g], acc0[4 * g + 1]); w0.y = pk2(acc0[4 * g + 2], acc0[4 * g + 3]); w1.x = pk2(acc1[4 * g], acc1[4 * g + 1]); w1.y = pk2(acc1[4 * g + 2], acc1[4 * g + 3]);
                *(LAS u32x2*)(shm + ob + r32 * PB + s0 * 2) = w0;
                *(LAS u32x2*)(shm + ob + (32 + r32) * PB + (32 + s0) * 2) = w1;
            }
            if (mat == 0) {
                const int bsel = r32 >> 4;
                LAS float* dg = (LAS float*)(shm + L_DIAG) + (r32 & 15) * 16;
#pragma unroll
                for (int g2 = 0; g2 < 2; ++g2) {
                    const int s0 = 8 * g2 + 4 * hi, r0 = 4 * g2;
                    const f32x4 a = bsel ? (f32x4){acc0[r0 + 8], acc0[r0 + 9], acc0[r0 + 10], acc0[r0 + 11]} : (f32x4){acc0[r0], acc0[r0 + 1], acc0[r0 + 2], acc0[r0 + 3]};
                    const f32x4 c = bsel ? (f32x4){acc1[r0 + 8], acc1[r0 + 9], acc1[r0 + 10], acc1[r0 + 11]} : (f32x4){acc1[r0], acc1[r0 + 1], acc1[r0 + 2], acc1[r0 + 3]};
                    *(LAS f32x4*)(dg + bsel * 256 + s0) = a; *(LAS f32x4*)(dg + (2 + bsel) * 256 + s0) = c;
                }
            }
        } else {
#pragma unroll
            for (int g = 0; g < 4; ++g) { u32x2 w0; w0.x = pk2(acc0[4 * g], acc0[4 * g + 1]); w0.y = pk2(acc0[4 * g + 2], acc0[4 * g + 3]);
                *(LAS u32x2*)(shm + ob + (32 + r32) * PB + (8 * g + 4 * hi) * 2) = w0; }
        }
    }
    __syncthreads();
    PAMP_END(33);
    PAMP_BEGIN(34);
    if (wid >= 4) {
        const int tl = wid - 4, tr = 32 * (tl >> 1), ic = 32 * (tl & 1);
        f32x16 acc;
#pragma unroll
        for (int r = 0; r < 16; ++r) acc[r] = 0.f;
        bf16x8 fa[4], fb[4];
#pragma unroll
        for (int ks = 0; ks < 4; ++ks) { fa[ks] = RW_FRAG(L_AK, tr + r32, ks); fb[ks] = RW_FRAG(L_VT, ic + r32, ks); }
        RW_PIN8(fa, fb);
#pragma unroll
        for (int ks = 0; ks < 4; ++ks) if (tr > 0 || ks < 2) acc = RW_MFMA(fa[ks], fb[ks], acc);
        LAS float* dst = (LAS float*)(shm + L_AKVT) + (ic + r32) * 68;
#pragma unroll
        for (int g = 0; g < 4; ++g) *(LAS f32x4*)(dst + tr + 8 * g + 4 * hi) = (f32x4){acc[4 * g], acc[4 * g + 1], acc[4 * g + 2], acc[4 * g + 3]};
    } else if (wid == 0) {
        const int blk = lane >> 4, n = lane & 15;
        const LAS float* N = (const LAS float*)(shm + L_DIAG) + blk * 256;
        f32x4 nv[15][4];
#pragma unroll
        for (int t = 1; t < 16; ++t)
#pragma unroll
            for (int j = 0; j < (t + 3) / 4; ++j) nv[t - 1][j] = *(const LAS f32x4*)(N + t * 16 + 4 * j);
        asm volatile("" : "+v"(nv[0][0]), "+v"(nv[1][0]), "+v"(nv[2][0]), "+v"(nv[3][0]), "+v"(nv[4][0]), "+v"(nv[4][1]), "+v"(nv[5][0]), "+v"(nv[5][1]), "+v"(nv[6][0]), "+v"(nv[6][1]),
                     "+v"(nv[7][0]), "+v"(nv[7][1]), "+v"(nv[8][0]), "+v"(nv[8][1]), "+v"(nv[8][2]), "+v"(nv[9][0]), "+v"(nv[9][1]), "+v"(nv[9][2]));
        asm volatile("" : "+v"(nv[10][0]), "+v"(nv[10][1]), "+v"(nv[10][2]), "+v"(nv[11][0]), "+v"(nv[11][1]), "+v"(nv[11][2]), "+v"(nv[12][0]), "+v"(nv[12][1]), "+v"(nv[12][2]), "+v"(nv[12][3]),
                     "+v"(nv[13][0]), "+v"(nv[13][1]), "+v"(nv[13][2]), "+v"(nv[13][3]), "+v"(nv[14][0]), "+v"(nv[14][1]), "+v"(nv[14][2]), "+v"(nv[14][3]));
        float m[16];
#pragma unroll
        for (int t = 0; t < 16; ++t) {
            float a = (t == n) ? 1.f : 0.f;
#pragma unroll
            for (int s = 0; s < t; ++s) a = fmaf(-nv[t - 1][s >> 2][s & 3], m[s], a);
            m[t] = a;
            *(LAS bf16_t*)(shm + L_TINV + (blk * 256 + t * 16 + n) * 2) = f2bf(a);
        }
    }
    __syncthreads();
    const int nh = (h + 1) & 7, nidx = (nh == 0) ? idx + (int)gridDim.x : idx;
    if (nidx < 512) { r1_load(cur, PROJ, sava, nidx >> 6, nh, nidx & 63, tidl); hload(hc, nh, tidl); }
    {
        const int n = lane & 15, q = lane >> 4;
        typedef float f32x4v __attribute__((ext_vector_type(4)));
        const int col = 16 * (wid & 3) + n;
        u32x2 xn[4];
        f32x4v rhs[4]; u32x2 abv[6], tiv[4];
        if (wid < 4) {
#pragma unroll
            for (int blk = 0; blk < 4; ++blk) { const u32x2 rv = *(const LAS u32x2*)(shm + L_KKDT + col * PB + (16 * blk + 4 * q) * 2);
                rhs[blk][0] = __uint_as_float(rv.x << 16); rhs[blk][1] = __uint_as_float(rv.x & 0xffff0000u); rhs[blk][2] = __uint_as_float(rv.y << 16); rhs[blk][3] = __uint_as_float(rv.y & 0xffff0000u); }
        } else {
#pragma unroll
            for (int blk = 0; blk < 4; ++blk) rhs[blk] = *(const LAS f32x4v*)((const LAS float*)(shm + L_AKVT) + col * 68 + 16 * blk + 4 * q);
        }
        {
            int i = 0;
#pragma unroll
            for (int blk = 1; blk < 4; ++blk)
#pragma unroll
                for (int a = 0; a < blk; ++a) abv[i++] = *(const LAS u32x2*)(shm + L_AB + (16 * blk + n) * PB + (16 * a + 4 * q) * 2);
        }
#pragma unroll
        for (int blk = 0; blk < 4; ++blk) tiv[blk] = *(const LAS u32x2*)(shm + L_TINV + (blk * 256 + n * 16 + 4 * q) * 2);
        asm volatile("" : "+v"(rhs[0]), "+v"(rhs[1]), "+v"(rhs[2]), "+v"(rhs[3]), "+v"(abv[0]), "+v"(abv[1]), "+v"(abv[2]), "+v"(abv[3]), "+v"(abv[4]), "+v"(abv[5]),
                     "+v"(tiv[0]), "+v"(tiv[1]), "+v"(tiv[2]), "+v"(tiv[3]));
#pragma unroll
        for (int blk = 0; blk < 4; ++blk) {
            f32x4v acc = rhs[blk];
#pragma unroll
            for (int a = 0; a < blk; a += 2) {
                const u32x2 a0 = abv[blk * (blk - 1) / 2 + a];
                const bool two = (a + 1 < blk);
                u32x2 a1 = {0u, 0u}, b1 = {0u, 0u};
                if (two) { a1 = abv[blk * (blk - 1) / 2 + a + 1]; b1 = xn[a + 1]; }
                const u32x4 af = {a0.x, a0.y, a1.x, a1.y}, bf = {xn[a].x, xn[a].y, b1.x, b1.y};
                acc = __builtin_amdgcn_mfma_f32_16x16x32_bf16(__builtin_bit_cast(bf16x8, af), __builtin_bit_cast(bf16x8, bf), acc, 0, 0, 0);
            }
            const u32x4 af = {tiv[blk].x, tiv[blk].y, 0u, 0u}, bf = {pk2(acc[0], acc[1]), pk2(acc[2], acc[3]), 0u, 0u};
            f32x4v x = {0.f, 0.f, 0.f, 0.f};
            x = __builtin_amdgcn_mfma_f32_16x16x32_bf16(__builtin_bit_cast(bf16x8, af), __builtin_bit_cast(bf16x8, bf), x, 0, 0, 0);
            xn[blk].x = pk2(-x[0], -x[1]); xn[blk].y = pk2(-x[2], -x[3]);
            *(LAS u32x2*)(shm + ((wid < 4) ? L_WTT : L_VTT) + col * PB + (16 * blk + 4 * q) * 2) = xn[blk];
        }
    }
    __syncthreads();
    PAMP_END(34);
    PAMP_BEGIN(35);
    {
        const int tl = wid & 3, tr = 32 * (tl >> 1), cc = 32 * (tl & 1);
        f32x16 a0, a1;
        if (wid < 4) {
#pragma unroll
            for (int r = 0; r < 16; ++r) { a0[r] = bf2f(*(const LAS bf16_t*)(shm + L_RD + (tr + crow(r, hi)) * PB + (cc + r32) * 2)); a1[r] = 0.f; }
            bf16x8 f1[4], f2[4], f3[4], f4[4], f5[4];
#pragma unroll
            for (int ks = 0; ks < 4; ++ks) { f1[ks] = RW_FRAG(L_BB, tr + r32, ks); f2[ks] = RW_FRAG(L_WTT, cc + r32, ks); f3[ks] = RW_FRAG(L_BK, tr + r32, ks); f4[ks] = RW_FRAG(L_VT, cc + r32, ks); f5[ks] = RW_FRAG(L_VTT, cc + r32, ks); }
            asm volatile("" : "+v"(a0), "+v"(f1[0]), "+v"(f1[1]), "+v"(f1[2]), "+v"(f1[3]), "+v"(f2[0]), "+v"(f2[1]), "+v"(f2[2]), "+v"(f2[3]), "+v"(f3[0]), "+v"(f3[1]), "+v"(f3[2]), "+v"(f3[3]),
                         "+v"(f4[0]), "+v"(f4[1]), "+v"(f4[2]), "+v"(f4[3]), "+v"(f5[0]), "+v"(f5[1]), "+v"(f5[2]), "+v"(f5[3]));
#pragma unroll
            for (int ks = 0; ks < 4; ++ks) if (tr > 0 || ks < 2) {
                a0 = RW_MFMA(f1[ks], f2[ks], a0);
                a1 = RW_MFMA(f3[ks], f4[ks], a1);
                a1 = RW_MFMA(f1[ks], f5[ks], a1);
            }
            {
                const __amdgpu_buffer_rsrc_t rs = __builtin_amdgcn_make_buffer_rsrc((void*)PROJ, 0, 0x7fffffff, 0x00020000);
                const int vo = (4 * hi) * (DIN * 2) + (h * 64 + cc + r32) * 2;
                const unsigned so = (unsigned)__builtin_amdgcn_readfirstlane((int)((unsigned)(row0 + tr) * (unsigned)(DIN * 2)));
#pragma unroll
                for (int r = 0; r < 16; ++r) if (!dry) {
                    const unsigned sr = so + (unsigned)(((r & 3) + 8 * (r >> 2)) * (DIN * 2));
                    __builtin_amdgcn_raw_buffer_store_b16((short)f2bf(a0[r]), rs, vo + C_K * 2, sr, 0);
                    __builtin_amdgcn_raw_buffer_store_b16((short)f2bf(a1[r]), rs, vo + C_R * 2, sr, 0);
#if PROBE == 61
                    __builtin_amdgcn_raw_buffer_store_b16((short)f2bf(a0[r]), rs, vo + C_K * 2, sr, 0);
                    __builtin_amdgcn_raw_buffer_store_b16((short)f2bf(a1[r]), rs, vo + C_R * 2, sr, 0);
#endif
                }
            }
        } else {
#pragma unroll
            for (int r = 0; r < 16; ++r) { a0[r] = 0.f; a1[r] = 0.f; }
            bf16x8 f1[4], f2[4], f3[4], f4[4], f5[4];
#pragma unroll
            for (int ks = 0; ks < 4; ++ks) { f1[ks] = RW_FRAG(L_BDT, tr + r32, ks); f2[ks] = RW_FRAG(L_WTT, cc + r32, ks); f3[ks] = RW_FRAG(L_KDT, tr + r32, ks); f4[ks] = RW_FRAG(L_VT, cc + r32, ks); f5[ks] = RW_FRAG(L_VTT, cc + r32, ks); }
            float gc = ((const LAS float*)(shm + L_GC))[cc + r32];
            asm volatile("" : "+v"(gc), "+v"(f1[0]), "+v"(f1[1]), "+v"(f1[2]), "+v"(f1[3]), "+v"(f2[0]), "+v"(f2[1]), "+v"(f2[2]), "+v"(f2[3]), "+v"(f3[0]), "+v"(f3[1]), "+v"(f3[2]), "+v"(f3[3]),
                         "+v"(f4[0]), "+v"(f4[1]), "+v"(f4[2]), "+v"(f4[3]), "+v"(f5[0]), "+v"(f5[1]), "+v"(f5[2]), "+v"(f5[3]));
#pragma unroll
            for (int ks = 0; ks < 4; ++ks) {
                a0 = RW_MFMA(f1[ks], f2[ks], a0);
                a1 = RW_MFMA(f3[ks], f4[ks], a1);
                a1 = RW_MFMA(f1[ks], f5[ks], a1);
            }
            bf16_t* Pm = (bf16_t*)(DO_RWP) + (size_t)unit * 4096;
            bf16_t* Dt = (bf16_t*)(ARG_WS + WS_RWD) + (size_t)unit * 4096;
#pragma unroll
            for (int r = 0; r < 16; ++r) { const int jr = tr + crow(r, hi), jc = cc + r32; if (!dry) Pm[jr * 64 + jc] = f2bf(a0[r] + ((jr == jc) ? gc : 0.f)); }
#pragma unroll
            for (int g = 0; g < 4; ++g) { u32x2 w; w.x = pk2(a1[4 * g], a1[4 * g + 1]); w.y = pk2(a1[4 * g + 2], a1[4 * g + 3]); if (!dry) *(u32x2*)(Dt + (cc + r32) * 64 + tr + 8 * g + 4 * hi) = w; }
        }
        if (!dry) {
            const __amdgpu_buffer_rsrc_t rs = __builtin_amdgcn_make_buffer_rsrc((void*)PROJ, 0, 0x7fffffff, 0x00020000);
            const unsigned so = (unsigned)__builtin_amdgcn_readfirstlane((int)((unsigned)row0 * (unsigned)(DIN * 2)));
            __builtin_amdgcn_raw_buffer_store_b128(__builtin_bit_cast(__attribute__((__vector_size__(4 * sizeof(unsigned)))) unsigned, vvst), rs, (tidl >> 3) * (DIN * 2) + (C_V + h * 64 + 8 * (tidl & 7)) * 2, so, 0);
        }
    }
    PAMP_END(35);
    h = nh; idx = nidx;
    }
}

__device__ __forceinline__ void r2_unit(int l, int b, int h, LAS char* shm, const bool dry = false) {
    const int tid = otid(), lane = tid & 63, n = lane & 15, q = lane >> 4;
    const int wid = __builtin_amdgcn_readfirstlane(tid >> 6);
    typedef float f32x4v __attribute__((ext_vector_type(4)));
    bf16_t* PROJ = (bf16_t*)(ARG_WS + WS_PROJ);
    const bf16_t* Pm = (const bf16_t*)(DO_RWP) + (size_t)((b * 8 + h) * 64) * 4096;
    const bf16_t* Dt = (const bf16_t*)(ARG_WS + WS_RWD) + (size_t)((b * 8 + h) * 64) * 4096;
    constexpr int TPB = 144, TBUF = 64 * TPB;
    __syncthreads();
    for (int i = tid; i < 2 * TBUF / 4; i += 512) ((LAS unsigned*)shm)[i] = 0u;
    __syncthreads();
    const size_t rowb = (size_t)b * SEQ;
    if (wid < 4) {
        bf16x8 pa[2], pb[2]; u32x2 dv[4], dw[4];
        auto ldop = [&](int c, bf16x8 (&pp_)[2], u32x2 (&dd_)[4]) { const bf16_t* pp = Pm + (size_t)c * 4096 + (16 * wid + n) * 64 + 8 * q; pp_[0] = *(const bf16x8*)pp; pp_[1] = *(const bf16x8*)(pp + 32);
#pragma unroll
                                 for (int cg = 0; cg < 4; ++cg) dd_[cg] = *(const u32x2*)(Dt + (size_t)c * 4096 + (16 * cg + n) * 64 + 16 * wid + 4 * q); };
        ldop(0, pa, dv); ldop(1, pb, dw);
        for (int c = 0; c < 64; ++c) {
            const bf16x8 a0 = pa[0], a1 = pa[1]; u32x2 d[4];
#pragma unroll
            for (int cg = 0; cg < 4; ++cg) d[cg] = dv[cg];
            pa[0] = pb[0]; pa[1] = pb[1];
#pragma unroll
            for (int cg = 0; cg < 4; ++cg) dv[cg] = dw[cg];
            if (c + 2 < 64) ldop(c + 2, pb, dw);
            const LAS char* tb = shm + (c & 1) * TBUF + n * TPB + 8 * q * 2;
            LAS char* tw_ = shm + ((c + 1) & 1) * TBUF + n * TPB + (16 * wid + 4 * q) * 2;
#pragma unroll
            for (int cg = 0; cg < 4; ++cg) {
                const bf16x8 t0 = *(const LAS bf16x8*)(tb + cg * 16 * TPB), t1 = *(const LAS bf16x8*)(tb + cg * 16 * TPB + 64);
                f32x4v acc = {bf2f((bf16_t)(d[cg].x & 0xffffu)), bf2f((bf16_t)(d[cg].x >> 16)), bf2f((bf16_t)(d[cg].y & 0xffffu)), bf2f((bf16_t)(d[cg].y >> 16))};
                acc = __builtin_amdgcn_mfma_f32_16x16x32_bf16(a0, t0, acc, 0, 0, 0);
                acc = __builtin_amdgcn_mfma_f32_16x16x32_bf16(a1, t1, acc, 0, 0, 0);
                u32x2 w; w.x = rw::pk2(acc[0], acc[1]); w.y = rw::pk2(acc[2], acc[3]);
                *(LAS u32x2*)(tw_ + cg * 16 * TPB) = w;
            }
            __syncthreads();
        }
    } else {
        const int tw = wid - 4;
        const float* lng = ARG(11) + (size_t)l * 512 + h * 64; const float* lnb = ARG(12) + (size_t)l * 512 + h * 64; const float* bon = (const float*)(ARG_WS + WS_BON);
        float gg[4][4], gb[4][4];
#pragma unroll
        for (int cg = 0; cg < 4; ++cg) { const f32x4v a4 = *(const f32x4v*)(lng + 16 * cg + 4 * q), b4 = *(const f32x4v*)(lnb + 16 * cg + 4 * q);
#pragma unroll
            for (int e = 0; e < 4; ++e) { gg[cg][e] = a4[e]; gb[cg][e] = b4[e]; } }
        struct YOps { bf16x8 rb[2]; u32x2 yv[4], vv[4], zv[4]; float bv; };
        YOps o1, o2;
        auto ldop = [&](int c, YOps& o) { const size_t row = rowb + (size_t)c * 64 + 16 * tw + n; const bf16_t* rp = PROJ + row * DIN + h * 64; o.rb[0] = *(const bf16x8*)(rp + C_K + 8 * q); o.rb[1] = *(const bf16x8*)(rp + C_K + 8 * q + 32);
                                 o.bv = bon[row * 8 + h];
#pragma unroll
                                 for (int cg = 0; cg < 4; ++cg) { o.yv[cg] = *(const u32x2*)(rp + C_R + 16 * cg + 4 * q); o.vv[cg] = *(const u32x2*)(rp + C_V + 16 * cg + 4 * q); o.zv[cg] = *(const u32x2*)(rp + C_ZA + 16 * cg + 4 * q); } };
        ldop(0, o1); ldop(1, o2);
        for (int c = 0; c < 64; ++c) {
            const bf16x8 b0 = o1.rb[0], b1 = o1.rb[1]; u32x2 y0[4], v0[4], z0[4]; const float bo = o1.bv;
#pragma unroll
            for (int cg = 0; cg < 4; ++cg) { y0[cg] = o1.yv[cg]; v0[cg] = o1.vv[cg]; z0[cg] = o1.zv[cg]; }
            o1 = o2;
            if (c + 2 < 64) ldop(c + 2, o2);
            const LAS char* tb = shm + (c & 1) * TBUF + n * TPB + 8 * q * 2;
            bf16_t* yp = PROJ + (rowb + (size_t)c * 64 + 16 * tw + n) * DIN + C_ZA + h * 64 + 4 * q;
            f32x4v acc[4];
#pragma unroll
            for (int cg = 0; cg < 4; ++cg) {
                const bf16x8 t0 = *(const LAS bf16x8*)(tb + cg * 16 * TPB), t1 = *(const LAS bf16x8*)(tb + cg * 16 * TPB + 64);
                acc[cg] = (f32x4v){bf2f((bf16_t)(y0[cg].x & 0xffffu)), bf2f((bf16_t)(y0[cg].x >> 16)), bf2f((bf16_t)(y0[cg].y & 0xffffu)), bf2f((bf16_t)(y0[cg].y >> 16))};
                acc[cg] = __builtin_amdgcn_mfma_f32_16x16x32_bf16(t0, b0, acc[cg], 0, 0, 0);
                acc[cg] = __builtin_amdgcn_mfma_f32_16x16x32_bf16(t1, b1, acc[cg], 0, 0, 0);
            }
            float sm = 0.f;
#pragma unroll
            for (int cg = 0; cg < 4; ++cg) sm += (acc[cg][0] + acc[cg][1]) + (acc[cg][2] + acc[cg][3]);
            sm += shx<16>(sm); { float x, y; swap32(sm, x, y); sm = x + y; }
            const float mean = sm * (1.0f / 64.0f);
            float sv = 0.f;
#pragma unroll
            for (int cg = 0; cg < 4; ++cg) { acc[cg] = acc[cg] - mean; sv += (acc[cg][0] * acc[cg][0] + acc[cg][1] * acc[cg][1]) + (acc[cg][2] * acc[cg][2] + acc[cg][3] * acc[cg][3]); }
            sv += shx<16>(sv); { float x, y; swap32(sv, x, y); sv = x + y; }
            const float rstd = rsqrtf(sv * (1.0f / 64.0f) + 64e-5f);
#pragma unroll
            for (int cg = 0; cg < 4; ++cg) {
                const float ve[4] = {bf2f((bf16_t)(v0[cg].x & 0xffffu)), bf2f((bf16_t)(v0[cg].x >> 16)), bf2f((bf16_t)(v0[cg].y & 0xffffu)), bf2f((bf16_t)(v0[cg].y >> 16))};
                const float ze[4] = {bf2f((bf16_t)(z0[cg].x & 0xffffu)), bf2f((bf16_t)(z0[cg].x >> 16)), bf2f((bf16_t)(z0[cg].y & 0xffffu)), bf2f((bf16_t)(z0[cg].y >> 16))};
                float o[4];
#pragma unroll
                for (int e = 0; e < 4; ++e) o[e] = (acc[cg][e] * rstd * gg[cg][e] + gb[cg][e] + bo * ve[e]) * siluf_(ze[e]);
                u32x2 w; w.x = rw::pk2(o[0], o[1]); w.y = rw::pk2(o[2], o[3]);
                if (!dry) *(u32x2*)(yp + 16 * cg) = w;
            }
            __syncthreads();
        }
    }
}
#undef RW_FRAG
#undef RW_MFMA
}

namespace lru {
typedef short bf16x8 __attribute__((ext_vector_type(8)));
typedef float f32x16 __attribute__((ext_vector_type(16)));
constexpr int TC = 32, XPITCH = 1040, LDS_XC = 0, LDS_OMA = 33280, LDS_BX = LDS_OMA + 32768, LDS_BYTES = LDS_BX + 32768;
__device__ __forceinline__ int crow(int r, int hi) { return (r & 3) + 8 * (r >> 2) + 4 * hi; }
__device__ __forceinline__ void carry_unit(int b, unsigned* cnt) {
    const int tid = otid();
    float2* sp = (float2*)(ARG_WS + WS_LSUM) + ((size_t)b * 128) * 512 + tid;
    float h = 0.f;
    for (int c0 = 0; c0 < 128; c0 += 16) {
        float2 ah[16];
#pragma unroll
        for (int k = 0; k < 16; ++k) ah[k] = sp[(size_t)(c0 + k) * 512];
#pragma unroll
        for (int k = 0; k < 16; ++k) { __hip_atomic_store(&sp[(size_t)(c0 + k) * 512].x, h, __ATOMIC_RELAXED, __HIP_MEMORY_SCOPE_AGENT); h = fmaf(ah[k].x, h, ah[k].y); }
    }
    asm volatile("s_waitcnt vmcnt(0)" ::: "memory");
    __syncthreads();
    if (threadIdx.x == 0) (void)xb_add(cnt, 1u);
}
constexpr int W_XC = 0, W_OMA = 4608, W_BX = 4608 + 4096, W_LDS = 4608 + 2 * 4096, L_PART = 8 * W_LDS;
template <bool FINAL>
__device__ __forceinline__ void phase(int l, LAS char* shm0, unsigned* cnt, const bool dry = false) {
    typedef unsigned u32x4 __attribute__((ext_vector_type(4)));
    typedef float f32x4 __attribute__((ext_vector_type(4)));
    const int tid0 = otid(), lane0 = tid0 & 63;
    const int hh = __builtin_amdgcn_readfirstlane(tid0 >> 6);
    bf16_t* PROJ = (bf16_t*)(ARG_WS + WS_PROJ);
    LAS char* shm = shm0 + hh * W_LDS;
    const int co0 = lane0 & 7, tg0 = lane0 >> 3;
    auto ldraw = [&](u32x4 (&raw)[7], int u) { const int b = u >> 7, t0 = (u & 127) * TC;
#pragma unroll
        for (int k = 0; k < 7; ++k) { const int t = t0 + 4 * tg0 - 3 + k; raw[k] = (t >= 0) ? *(const u32x4*)(PROJ + ((size_t)b * SEQ + t) * DIN + C_UB + hh * 64 + 8 * co0) : (u32x4){0u, 0u, 0u, 0u}; } };
    u32x4 raw[7], rawn[7];
    int parity = 0;
    auto gate_tile = [&](int u) -> u32x4* { const int b = u >> 7, c = u & 127;
        unsigned char* base = (b < 6) ? (DO_Q + 80 * MiB + (size_t)b * 8 * MiB) : (ARG_WS + 418 * MiB + (size_t)(b - 6) * 8 * MiB);
        return (u32x4*)(base + (size_t)(c * 8 + hh) * 8192); };
    u32x4 gt[8], gtn[8];
    auto ldgate = [&](u32x4 (&g)[8], int u) { const u32x4* gp = gate_tile(u);
#pragma unroll
        for (int k = 0; k < 8; ++k) g[k] = gp[k * 64 + lane0]; };
    bf16x8 wr_[2][4], wi_[2][4];
    { const bf16_t* gat = (const bf16_t*)(ARG_WS + WS_GAT) + ((size_t)(l * 8 + hh) * 64) * 64;
      const bf16_t* gxt = gat + (size_t)DEPTH * 8 * 64 * 64;
#pragma unroll
      for (int nt = 0; nt < 2; ++nt)
#pragma unroll
          for (int ks = 0; ks < 4; ++ks) { wr_[nt][ks] = *(const bf16x8*)(gat + (size_t)(32 * nt + (lane0 & 31)) * 64 + 16 * ks + 8 * (lane0 >> 5)); wi_[nt][ks] = *(const bf16x8*)(gxt + (size_t)(32 * nt + (lane0 & 31)) * 64 + 16 * ks + 8 * (lane0 >> 5)); } }
    float gg[8];
    if (FINAL) { const float* go = ARG(20) + (size_t)l * 512 + hh * 64 + 8 * co0; const f32x4 g0 = *(const f32x4*)go, g1 = *(const f32x4*)(go + 4);
        gg[0] = g0[0]; gg[1] = g0[1]; gg[2] = g0[2]; gg[3] = g0[3]; gg[4] = g1[0]; gg[5] = g1[1]; gg[6] = g1[2]; gg[7] = g1[3]; }
    float gbr[2], gbi[2], gc8[2];
#pragma unroll
    for (int nt = 0; nt < 2; ++nt) { const int ch = hh * 64 + 32 * nt + (lane0 & 31);
        gbr[nt] = -1.4426950408889634f * (ARG(16) + (size_t)l * 512)[ch]; gbi[nt] = -1.4426950408889634f * (ARG(18) + (size_t)l * 512)[ch]; gc8[nt] = -8.0f * 1.4426950408889634f * softplusf_(-(ARG(19) + (size_t)l * 512)[ch]); }
    float cw[4][8], cb[8];
    { const float* conv_w = ARG(13) + (size_t)l * 4 * 512 + hh * 64 + 8 * co0; const float* conv_b = ARG(14) + (size_t)l * 512 + hh * 64 + 8 * co0;
#pragma unroll
      for (int q = 0; q < 4; ++q) { const f32x4 a = *(const f32x4*)(conv_w + q * 512), bq = *(const f32x4*)(conv_w + q * 512 + 4);
          cw[q][0] = a[0]; cw[q][1] = a[1]; cw[q][2] = a[2]; cw[q][3] = a[3]; cw[q][4] = bq[0]; cw[q][5] = bq[1]; cw[q][6] = bq[2]; cw[q][7] = bq[3]; }
      { const f32x4 a = *(const f32x4*)conv_b, bq = *(const f32x4*)(conv_b + 4); cb[0] = a[0]; cb[1] = a[1]; cb[2] = a[2]; cb[3] = a[3]; cb[4] = bq[0]; cb[5] = bq[1]; cb[6] = bq[2]; cb[7] = bq[3]; } }
    if ((int)blockIdx.x < 1024) { if (FINAL) ldgate(gt, blockIdx.x); else ldraw(raw, blockIdx.x); }
    __syncthreads();
    for (int u = blockIdx.x; u < 1024; u += gridDim.x, parity ^= 1) {
        const int tid = otid(), lane = tid & 63, r32 = lane & 31, hi = lane >> 5, co = lane & 7, tg = lane >> 3;
        const int b = u >> 7, c = u & 127;
        const size_t row0 = (size_t)b * SEQ + (size_t)c * TC;
        float hcarry = 0.f;
        if (FINAL) {
            if (lane == 0 && !dry) XB_SPIN(xb_ld(cnt) < 8u, (unsigned*)(ARG_WS + WS_CTL));
            hcarry = __hip_atomic_load(&((float2*)(ARG_WS + WS_LSUM) + ((size_t)b * 128 + c) * 512 + hh * 64 + lane)->x, __ATOMIC_RELAXED, __HIP_MEMORY_SCOPE_AGENT);
        }
        if (FINAL) {
#pragma unroll
            for (int k = 0; k < 8; ++k) *(LAS u32x4*)(shm + W_OMA + (k * 64 + lane) * 16) = gt[k];
            if (u + (int)gridDim.x < 1024) ldgate(gtn, u + gridDim.x);
        } else {
        {
#pragma unroll
            for (int tt = 0; tt < 4; ++tt) {
                float o[8];
#pragma unroll
                for (int e = 0; e < 8; ++e) o[e] = cb[e];
#pragma unroll
                for (int q = 0; q < 4; ++q) {
                    const u32x4 rv = raw[tt + q];
                    const unsigned wds[4] = {rv.x, rv.y, rv.z, rv.w};
#pragma unroll
                    for (int e = 0; e < 8; ++e) { const float x = bf2f((bf16_t)((e & 1) ? (wds[e >> 1] >> 16) : (wds[e >> 1] & 0xffffu))); o[e] = fmaf(x, cw[q][e], o[e]); }
                }
                u32x4 w; w.x = rw::pk2(o[0], o[1]); w.y = rw::pk2(o[2], o[3]); w.z = rw::pk2(o[4], o[5]); w.w = rw::pk2(o[6], o[7]);
                *(LAS u32x4*)(shm + W_XC + (4 * tg + tt) * 144 + co * 16) = w;
            }
        }
        if (u + (int)gridDim.x < 1024) ldraw(rawn, u + gridDim.x);
        {
            f32x16 ar[2], ai[2];
#pragma unroll
            for (int nt = 0; nt < 2; ++nt)
#pragma unroll
                for (int r = 0; r < 16; ++r) { ar[nt][r] = 0.f; ai[nt][r] = 0.f; }
            const LAS char* xa = (const LAS char*)shm + W_XC + r32 * 144 + 8 * hi * 2;
#pragma unroll
            for (int ks = 0; ks < 4; ++ks) {
                const bf16x8 a = *(const LAS bf16x8*)(xa + ks * 32);
#pragma unroll
                for (int nt = 0; nt < 2; ++nt) {
                    ar[nt] = __builtin_amdgcn_mfma_f32_32x32x16_bf16(a, wr_[nt][ks], ar[nt], 0, 0, 0);
                    ai[nt] = __builtin_amdgcn_mfma_f32_32x32x16_bf16(a, wi_[nt][ks], ai[nt], 0, 0, 0);
                }
            }
#pragma unroll
            for (int nt = 0; nt < 2; ++nt) {
                const int cl = 32 * nt + r32;
                const float brs = gbr[nt], bis = gbi[nt], c8l = gc8[nt];
                const LAS char* xcp = (const LAS char*)shm + W_XC + (4 * hi) * 144 + cl * 2;
                LAS unsigned* obp = (LAS unsigned*)(shm + W_OMA) + (4 * hi) * 64 + cl;
#pragma unroll
                for (int r = 0; r < 16; ++r) {
                    const int tc = (r & 3) + 8 * (r >> 2);
                    const float x = bf2f(*(const LAS bf16_t*)(xcp + tc * 144));
                    const float sr = frcp(1.0f + __builtin_amdgcn_exp2f(fmaf(ar[nt][r], -1.4426950408889634f, brs)));
                    const float om = 1.0f - __builtin_amdgcn_exp2f(sr * c8l);
                    const float si = frcp(1.0f + __builtin_amdgcn_exp2f(fmaf(ai[nt][r], -1.4426950408889634f, bis)));
                    obp[tc * 64] = f2bf2(om, __builtin_amdgcn_sqrtf(om * (2.0f - om)) * (si * x));
                }
            }
        }
        {
            u32x4* gp = gate_tile(u);
#pragma unroll
            for (int k = 0; k < 8; ++k) { const u32x4 v = *(const LAS u32x4*)(shm + W_OMA + (k * 64 + lane) * 16); if (!dry) gp[k * 64 + lane] = v; }
        }
        }
        u32x4 zvv[4];
        if (FINAL) {
#pragma unroll
            for (int tt = 0; tt < 4; ++tt) zvv[tt] = *(const u32x4*)(PROJ + (row0 + 4 * tg + tt) * DIN + C_ZB + hh * 64 + 8 * co);
        }
        {
            float2* lsum = (float2*)(ARG_WS + WS_LSUM) + ((size_t)b * 128 + c) * 512 + hh * 64 + lane;
            const LAS unsigned* ob = (const LAS unsigned*)(shm + W_OMA);
            float h = hcarry;
            unsigned pkv[TC];
#pragma unroll
            for (int t = 0; t < TC; ++t) pkv[t] = ob[t * 64 + lane];
            asm volatile("" : "+v"(pkv[0]), "+v"(pkv[1]), "+v"(pkv[2]), "+v"(pkv[3]), "+v"(pkv[4]), "+v"(pkv[5]), "+v"(pkv[6]), "+v"(pkv[7]), "+v"(pkv[8]), "+v"(pkv[9]), "+v"(pkv[10]), "+v"(pkv[11]), "+v"(pkv[12]), "+v"(pkv[13]), "+v"(pkv[14]), "+v"(pkv[15]));
            asm volatile("" : "+v"(pkv[16]), "+v"(pkv[17]), "+v"(pkv[18]), "+v"(pkv[19]), "+v"(pkv[20]), "+v"(pkv[21]), "+v"(pkv[22]), "+v"(pkv[23]), "+v"(pkv[24]), "+v"(pkv[25]), "+v"(pkv[26]), "+v"(pkv[27]), "+v"(pkv[28]), "+v"(pkv[29]), "+v"(pkv[30]), "+v"(pkv[31]));
            float ap = 1.f, hv[TC];
#pragma unroll
            for (int t = 0; t < TC; ++t) {
                const unsigned pk = pkv[t];
                const float om = __builtin_bit_cast(float, pk << 16), bx = __builtin_bit_cast(float, pk & 0xffff0000u);
                h = fmaf(-om, h, h) + bx; ap *= (1.0f - om); hv[t] = h;
            }
            if (!FINAL) { if (!dry) *lsum = make_float2(ap, h); }
            else {
                LAS float* hb = (LAS float*)(shm + W_XC);
#pragma unroll
                for (int t = 0; t < TC; ++t) hb[t * 64 + lane] = hv[t];
                { const LAS f32x4* hp = (const LAS f32x4*)(hb + (lane >> 1) * 64 + (lane & 1) * 32);
                  float ss = 0.f;
#pragma unroll
                  for (int k = 0; k < 8; ++k) { const f32x4 v = hp[k]; ss += (v[0] * v[0] + v[1] * v[1]) + (v[2] * v[2] + v[3] * v[3]); }
                  ss += dppx<0xB1>(ss);
                  if ((lane & 1) == 0) ((LAS float*)(shm0 + L_PART))[parity * 256 + (lane >> 1) * 8 + hh] = ss; }
            }
        }
        if (FINAL) {
            __syncthreads();
            const LAS float* hb = (const LAS float*)(shm + W_XC);
#pragma unroll
            for (int tt = 0; tt < 4; ++tt) {
                const int t = 4 * tg + tt;
                const f32x4 p0 = *(const LAS f32x4*)((const LAS float*)(shm0 + L_PART) + parity * 256 + t * 8), p1 = *(const LAS f32x4*)((const LAS float*)(shm0 + L_PART) + parity * 256 + t * 8 + 4);
                const float rs = rsqrtf((((p0[0] + p0[1]) + (p0[2] + p0[3])) + ((p1[0] + p1[1]) + (p1[2] + p1[3]))) * (1.0f / 512) + 1e-6f);
                const f32x4 x0 = *(const LAS f32x4*)(hb + t * 64 + 8 * co), x1 = *(const LAS f32x4*)(hb + t * 64 + 8 * co + 4);
                const float x[8] = {x0[0], x0[1], x0[2], x0[3], x1[0], x1[1], x1[2], x1[3]};
                bf16_t* zp = PROJ + (row0 + t) * DIN + C_ZB + hh * 64 + 8 * co;
                const u32x4 zv = zvv[tt]; const unsigned zw[4] = {zv.x, zv.y, zv.z, zv.w};
                float o[8];
#pragma unroll
                for (int e = 0; e < 8; ++e) { const float z = bf2f((bf16_t)((e & 1) ? (zw[e >> 1] >> 16) : (zw[e >> 1] & 0xffffu))); o[e] = x[e] * rs * gg[e] * siluf_(z); }
                u32x4 w; w.x = rw::pk2(o[0], o[1]); w.y = rw::pk2(o[2], o[3]); w.z = rw::pk2(o[4], o[5]); w.w = rw::pk2(o[6], o[7]);
                if (!dry) *(u32x4*)zp = w;
            }
        }
        if (FINAL) {
#pragma unroll
            for (int k = 0; k < 8; ++k) gt[k] = gtn[k];
        } else {
#pragma unroll
            for (int k = 0; k < 7; ++k) raw[k] = rawn[k];
        }
    }
}
}

namespace att {
typedef short bf16x8 __attribute__((ext_vector_type(8)));
typedef short s16x4 __attribute__((ext_vector_type(4)));
typedef short v4i16_t __attribute__((ext_vector_type(4)));
typedef float f32x16 __attribute__((ext_vector_type(16)));
typedef unsigned u32x4 __attribute__((ext_vector_type(4)));
typedef float f32x2_t __attribute__((ext_vector_type(2)));
typedef __bf16 bf16x2_t __attribute__((ext_vector_type(2)));
typedef LAS const char* lds_cptr;
constexpr int KSLOT = 12288, VSLOT = 8192, LDS_K = 0, LDS_V = 3 * KSLOT, LDS_WS = LDS_V + 3 * VSLOT, LDS_OST = LDS_WS + 8 * 256, LDS_BYTES = LDS_OST + 8 * 4096;
__device__ __forceinline__ int crow(int r, int hi) { return (r & 3) + 8 * (r >> 2) + 4 * hi; }
__device__ __forceinline__ void glds16(const void* gsrc, unsigned lds_dst) { unsigned keep;
    asm volatile("s_mov_b32 %0, m0\n\ts_mov_b32 m0, %2\n\ts_nop 0\n\tglobal_load_lds_dwordx4 %1, off\n\ts_mov_b32 m0, %0" : "=&s"(keep) : "v"(gsrc), "s"(lds_dst) : "memory"); }
__device__ __forceinline__ unsigned cvtpk(float lo, float hi) { f32x2_t v = {lo, hi}; bf16x2_t b = __builtin_convertvector(v, bf16x2_t); return __builtin_bit_cast(unsigned, b); }
__device__ __forceinline__ s16x4 vtr(lds_cptr p) { return __builtin_bit_cast(s16x4, __builtin_amdgcn_ds_read_tr16_b64_v4i16((LAS v4i16_t*)p)); }
#define ATT_WAITB(N) asm volatile("s_waitcnt vmcnt(" #N ") lgkmcnt(0)\n\ts_barrier" ::: "memory")
__device__ __forceinline__ float addf(float a, float b) { float r; asm volatile("v_add_f32 %0, %1, %2" : "=v"(r) : "v"(a), "v"(b)); return r; }
__device__ __forceinline__ float addf_first(float a, float b) { float r; asm volatile("s_nop 1\n\tv_add_f32 %0, %1, %2" : "=v"(r) : "v"(a), "v"(b)); return r; }
__device__ __forceinline__ float max3f(float a, float b, float c) { float r; asm volatile("v_max3_f32 %0, %1, %2, %3" : "=v"(r) : "v"(a), "v"(b), "v"(c)); return r; }
__device__ __forceinline__ float max3f_first(float a, float b, float c) { float r; asm volatile("s_nop 15\n\ts_nop 7\n\tv_max3_f32 %0, %1, %2, %3" : "=v"(r) : "v"(a), "v"(b), "v"(c)); return r; }

template <int THR>
__device__ __forceinline__ void attn_unit(bf16_t* Qb, const bf16_t* Kb, const bf16_t* Vb, int b, int h, int qb, LAS char* shm, const bool dry = false) {
    const int tid = otid(), lane = tid & 63, r32 = lane & 31, hi = lane >> 5;
    const int wid = __builtin_amdgcn_readfirstlane(tid >> 6);
    const size_t rowb = (size_t)b * SEQ; const int q0 = qb * 256;
    bf16_t* Qw = Qb + ((rowb + q0 + wid * 32) * 8 + h) * 96;
    const bf16_t* Kh = Kb + (rowb * 8 + h) * 96;
    const bf16_t* Vh = Vb + (rowb * 8 + h) * 64;
    const unsigned lds0 = (unsigned)(size_t)shm;
    LAS float* wsf = (LAS float*)(shm + LDS_WS) + wid * 64;
    const bf16_t* ksrc = Kh + (size_t)lane * 768 + wid * 8;
    const bf16_t* vsrc = Vh + (size_t)(16 * (wid & 3) + (lane >> 2)) * 512 + (wid >> 2) * 32 + (lane & 3) * 8;
    const unsigned kdst = lds0 + LDS_K + wid * 1024, vdst = lds0 + LDS_V + wid * 1024;
#define ATT_DMA(t, sl) do { glds16(ksrc + (size_t)(t) * 64 * 768, (unsigned)__builtin_amdgcn_readfirstlane(kdst + (sl) * KSLOT)); \
        if (wid < 4) glds16(ksrc + (size_t)(t) * 64 * 768 + 64, (unsigned)__builtin_amdgcn_readfirstlane(kdst + (sl) * KSLOT + 8192)); \
        glds16(vsrc + (size_t)(t) * 64 * 512, (unsigned)__builtin_amdgcn_readfirstlane(vdst + (sl) * VSLOT)); } while (0)
    const int NT = 4 * (qb + 1);
    ATT_DMA(0, 0);
    if (NT > 1) ATT_DMA(1, 1);
    bf16x8 qr[6];
#pragma unroll
    for (int d0 = 0; d0 < 6; ++d0) qr[d0] = *(const bf16x8*)(Qw + (size_t)r32 * 768 + d0 * 16 + hi * 8);
    asm volatile("s_waitcnt vmcnt(0)" : "+v"(qr[0]), "+v"(qr[1]), "+v"(qr[2]), "+v"(qr[3]), "+v"(qr[4]), "+v"(qr[5]) :: "memory");
    float m = 0.f, l = 0.f; f32x16 o[2], negm;
#pragma unroll
    for (int r = 0; r < 16; ++r) { o[0][r] = 0.f; o[1][r] = 0.f; negm[r] = 0.f; }
    const int qrel = wid * 32 + r32;
    const lds_cptr kp0 = (lds_cptr)shm + LDS_K + hi * 1024 + r32 * 16;
    const lds_cptr vp0 = (lds_cptr)shm + LDS_V + ((lane >> 4) & 1) * 32 + (lane & 3) * 8 + (4 * hi + ((lane & 15) >> 2)) * 64;
    int sl0 = 0, sl1 = 1, sl2 = 2;
    for (int t = 0; t < NT; ++t) {
        if (t + 1 < NT) { if (wid < 4) ATT_WAITB(3); else ATT_WAITB(2); } else ATT_WAITB(0);
        if (t + 2 < NT) ATT_DMA(t + 2, sl2);
        const int sl = sl0;
        sl0 = sl1; sl1 = sl2; sl2 = sl;
        const int jb = t - (NT - 4);
        if (jb >= 1 && 64 * jb > wid * 32 + 31) continue;
        f32x16 p0, p1;
        const lds_cptr kp = kp0 + sl * KSLOT;
        bf16x8 kf[12];
#pragma unroll
        for (int d0 = 0; d0 < 6; ++d0) { kf[2 * d0] = *(const LAS bf16x8*)(kp + d0 * 2048); kf[2 * d0 + 1] = *(const LAS bf16x8*)(kp + d0 * 2048 + 512); }
        __builtin_amdgcn_sched_barrier(0);
#pragma unroll
        for (int d0 = 0; d0 < 6; ++d0) {
            if (d0 == 0) { p0 = __builtin_amdgcn_mfma_f32_32x32x16_bf16(kf[0], qr[0], negm, 0, 0, 0); p1 = __builtin_amdgcn_mfma_f32_32x32x16_bf16(kf[1], qr[0], negm, 0, 0, 0); }
            else { p0 = __builtin_amdgcn_mfma_f32_32x32x16_bf16(kf[2 * d0], qr[d0], p0, 0, 0, 0); p1 = __builtin_amdgcn_mfma_f32_32x32x16_bf16(kf[2 * d0 + 1], qr[d0], p1, 0, 0, 0); }
        }
        const lds_cptr vp = vp0 + sl * VSLOT;
        s16x4 vlo[8], vhi[8];
#pragma unroll
        for (int i = 0; i < 8; ++i) { vlo[i] = vtr(vp + (i >> 2) * 4096 + (i & 3) * 1024); vhi[i] = vtr(vp + (i >> 2) * 4096 + (i & 3) * 1024 + 512); }
        __builtin_amdgcn_sched_barrier(0);
        if (jb >= 0 && 64 * jb + 63 > wid * 32) {
            const int kb = 64 * jb + 4 * hi;
#pragma unroll
            for (int r = 0; r < 16; ++r) { const int kv = kb + (r & 3) + 8 * (r >> 2); if (kv > qrel) p0[r] = -INFINITY; if (kv + 32 > qrel) p1[r] = -INFINITY; }
        }
        if ((t & 3) == 0) {
        float mx = max3f_first(p0[0], p0[1], p1[0]), mb = max3f(p0[2], p0[3], p1[1]); mx = max3f(mx, p1[2], p1[3]);
#pragma unroll
        for (int r = 4; r < 16; r += 4) { mx = max3f(mx, p0[r], p0[r + 1]); mb = max3f(mb, p0[r + 2], p0[r + 3]); mx = max3f(mx, p1[r], p1[r + 1]); mb = max3f(mb, p1[r + 2], p1[r + 3]); }
        mx = fmaxf(mx, mb);
        { float x, y; swap32(mx, x, y); mx = fmaxf(x, y); }
        if (t == 0 || __any(mx > (float)THR)) {
            const float dl = (t == 0) ? mx : fmaxf(mx, 0.f);
            m += dl;
            const float alpha = __builtin_amdgcn_exp2f(-dl);
            l *= alpha;
#pragma unroll
            for (int r = 0; r < 16; ++r) { p0[r] -= dl; p1[r] -= dl; negm[r] = -m; }
            if (t > 0) {
                if (hi == 0) wsf[r32] = alpha;
#pragma unroll
                for (int r = 0; r < 16; ++r) { const float f = wsf[crow(r, hi)]; o[0][r] *= f; o[1][r] *= f; }
            }
        }
        }
#pragma unroll
        for (int r = 0; r < 16; ++r) { p0[r] = __builtin_amdgcn_exp2f(p0[r]); p1[r] = __builtin_amdgcn_exp2f(p1[r]); }
        u32x4 pw[4];
#pragma unroll
        for (int q = 0; q < 4; ++q) { pw[0][q] = cvtpk(p0[2 * q], p0[2 * q + 1]); pw[1][q] = cvtpk(p0[8 + 2 * q], p0[9 + 2 * q]); pw[2][q] = cvtpk(p1[2 * q], p1[2 * q + 1]); pw[3][q] = cvtpk(p1[8 + 2 * q], p1[9 + 2 * q]); }
        __builtin_amdgcn_sched_barrier(0);
        {
            float ps = addf_first(p0[0], p1[0]), pt = addf(p0[1], p1[1]);
#pragma unroll
            for (int r = 2; r < 16; r += 2) { ps = addf(ps, p0[r]); pt = addf(pt, p0[r + 1]); ps = addf(ps, p1[r]); pt = addf(pt, p1[r + 1]); }
            l += addf(ps, pt);
        }
#pragma unroll
        for (int d0 = 0; d0 < 2; ++d0)
#pragma unroll
            for (int ks = 0; ks < 4; ++ks) {
                const s16x4 lo = vlo[d0 * 4 + ks], hh = vhi[d0 * 4 + ks];
                const bf16x8 vf = (bf16x8){lo[0], lo[1], lo[2], lo[3], hh[0], hh[1], hh[2], hh[3]};
                o[d0] = __builtin_amdgcn_mfma_f32_32x32x16_bf16(__builtin_bit_cast(bf16x8, pw[ks]), vf, o[d0], 0, 0, 0);
            }
    }
    { float x, y; swap32(l, x, y); l = x + y; }
    if (hi == 0) wsf[32 + r32] = l;
    float rli[16];
#pragma unroll
    for (int r = 0; r < 16; ++r) rli[r] = 1.0f / wsf[32 + crow(r, hi)];
    LAS bf16_t* stg = (LAS bf16_t*)(shm + LDS_OST) + wid * 2048;
#pragma unroll
    for (int r = 0; r < 16; ++r) { const int orow = crow(r, hi);
#pragma unroll
        for (int d0 = 0; d0 < 2; ++d0) stg[orow * 64 + d0 * 32 + r32] = f2bf(o[d0][r] * rli[r]); }
#pragma unroll
    for (int i = 0; i < 4; ++i) { const int row = i * 8 + (lane >> 3), ch = lane & 7; const u32x4 v = *(const LAS u32x4*)(stg + row * 64 + ch * 8); if (!dry) *(u32x4*)(Qw + (size_t)row * 768 + ch * 8) = v; }
    asm volatile("s_waitcnt lgkmcnt(0)\n\ts_barrier" ::: "memory");
#undef ATT_DMA
}
}

__device__ __forceinline__ void gate_half(int l, size_t rbase) {
    typedef unsigned u32x4 __attribute__((ext_vector_type(4)));
    typedef float f32x4 __attribute__((ext_vector_type(4)));
    const int tid = otid(), lane = tid & 63, wid = __builtin_amdgcn_readfirstlane(tid >> 6);
    bf16_t* PROJ = (bf16_t*)(ARG_WS + WS_PROJ);
    const int hd = lane >> 3, c0 = hd * 64 + (lane & 7) * 8;
    const __amdgpu_buffer_rsrc_t rso = __builtin_amdgcn_make_buffer_rsrc((void*)(DO_Q), 0, 0x7fffffff, 0x00020000);
    float gcv[8];
    { const float* p2 = ARG(25) + (size_t)l * 512 + c0; const f32x4 d0 = *(const f32x4*)p2, d1 = *(const f32x4*)(p2 + 4);
#pragma unroll
      for (int e = 0; e < 4; ++e) { gcv[e] = d0[e]; gcv[4 + e] = d1[e]; } }
    auto unpack = [](const u32x4 v, float (&x)[8]) { const unsigned w[4] = {v.x, v.y, v.z, v.w};
#pragma unroll
        for (int e = 0; e < 4; ++e) { x[2 * e] = __uint_as_float(w[e] << 16); x[2 * e + 1] = __uint_as_float(w[e] & 0xffff0000u); } };
    u32x4 rzc[2][8], ro[2][8];
#pragma unroll
    for (int j = 0; j < 2; ++j)
#pragma unroll
        for (int k = 0; k < 8; ++k) { const size_t rr = rbase + wid + 64 * j + 8 * k; rzc[j][k] = *(const u32x4*)(PROJ + rr * DIN + C_ZC + c0);
            ro[j][k] = __builtin_bit_cast(u32x4, __builtin_amdgcn_raw_buffer_load_b128(rso, (int)(((unsigned)(rr * 8 + hd) * 96u + (unsigned)(lane & 7) * 8u) * 2u), 0, 0)); }
#pragma unroll
    for (int j = 0; j < 2; ++j) {
        const int r = wid + 64 * j;
#pragma unroll
        for (int k = 0; k < 8; ++k) {
            const size_t rr = rbase + r + 8 * k;
            float zc[8], oa[8];
            unpack(rzc[j][k], zc); unpack(ro[j][k], oa);
            float sq = 0.f;
#pragma unroll
            for (int e = 0; e < 8; ++e) sq += oa[e] * oa[e];
            sq = wave_sum(sq);
            const float rc = rsqrtf(sq * (1.0f / 512) + 1e-6f);
            float yc[8];
#pragma unroll
            for (int e = 0; e < 8; ++e) yc[e] = oa[e] * rc * gcv[e] * siluf_(zc[e]);
            u32x4 wc;
            wc.x = rw::pk2(yc[0], yc[1]); wc.y = rw::pk2(yc[2], yc[3]); wc.z = rw::pk2(yc[4], yc[5]); wc.w = rw::pk2(yc[6], yc[7]);
            *(u32x4*)(PROJ + rr * DIN + C_ZC + c0) = wc;
        }
    }
}

__global__ void __launch_bounds__(512, 2) fwd_kernel(Args A) {
    extern __shared__ __attribute__((aligned(16))) unsigned char smem[];
    float* lds = (float*)smem;
    volatile LAS unsigned* xbw = (volatile LAS unsigned*)(smem + 163840 - 16);
    unsigned* ctl = (unsigned*)(ARG_WS + WS_CTL);
    const int tid = threadIdx.x;
    if (tid == 0) { xbw[0] = 0u; xbw[1] = 0u; xbw[2] = 0u; xbw[3] = 0u; }
    __syncthreads();
    XcdBarrier bar = xcd_barrier_post(ctl, xbw);
#if PROBE >= 50 && PROBE <= 52
    unsigned long long pc0 = 0, pr0 = 0, pc1 = 0, pr1 = 0;
    if (PROBE == 50) { pc0 = __builtin_amdgcn_s_memtime(); pr0 = __builtin_amdgcn_s_memrealtime(); }
#endif
    LAS int* s_unit = (LAS int*)(smem + 163840 - 32);

    bf16_t* PROJ = (bf16_t*)(ARG_WS + WS_PROJ);
    bf16_t* XN = (bf16_t*)(ARG_WS + WS_XN);
    float* rope = (float*)(ARG_WS + WS_ROPE);
    const int nwaves = gridDim.x * 8;
#define PHASE_IDS() const int ptid = otid(), lane = ptid & 63, wv = ptid >> 6, gw = blockIdx.x * 8 + wv; (void)lane; (void)gw

    PAMP_BEGIN(20);
    for (int idx = blockIdx.x * 512 + otid(); idx < SEQ * 16; idx += gridDim.x * 512) {
        const int t = idx >> 4, i = idx & 15;
        const float inv = powf(10000.0f, -((float)i * 2.0f / 32.0f));
        const float ang = (float)t * inv;
        const double twopi = 6.283185307179586476925286766559;
        double rr = (double)ang; rr -= twopi * floor(rr / twopi + 0.5);
        const double r2 = rr * rr; double ts = rr, ss = rr, tc = 1.0, cc = 1.0;
        for (int n = 1; n <= 13; ++n) { ts *= -r2 / (double)((2 * n) * (2 * n + 1)); ss += ts; tc *= -r2 / (double)((2 * n - 1) * (2 * n)); cc += tc; }
        rope[idx * 2] = (float)cc; rope[idx * 2 + 1] = (float)ss;
    }

    for (int prep = 0; prep < (PROBE == 11 ? 2 : 1); ++prep)
    for (int l = 0; l < DEPTH; ++l) {
        { const float* W = ARG(2) + (size_t)l * DM * DIN; const float* g = ARG(1) + (size_t)l * DM;
          transpose_w(DM, NPAD_IN, (bf16_t*)(ARG_WS + WS_WIN) + (size_t)l * NPAD_IN * DM, [=](int k, int n) -> f32x4_t { return n < DIN ? *(const f32x4_t*)(W + (size_t)k * DIN + orig_col(n)) * g[k] : (f32x4_t){0.f, 0.f, 0.f, 0.f}; }, lds); }
        { const float* W = ARG(26) + (size_t)l * DMIX * DM;
          transpose_w(DMIX, DM, (bf16_t*)(ARG_WS + WS_WOUT) + (size_t)l * DM * DMIX, [=](int k, int n) -> f32x4_t { return *(const f32x4_t*)(W + (size_t)k * DM + n); }, lds); }
        { const float* qg = ARG(21) + (size_t)l * QL; const float* wuq = ARG(22) + (size_t)l * QL * 768;
          const float* kg = ARG(23) + (size_t)l * KVL; const float* wukv = ARG(24) + (size_t)l * KVL * 1024;
          transpose_w(256, NMLA, (bf16_t*)(ARG_WS + WS_WMLA) + (size_t)l * NMLA * 256, [=](int k, int n) -> f32x4_t {
              if (n < 768) return *(const f32x4_t*)(wuq + (size_t)k * 768 + n) * qg[k];
              return k < KVL ? *(const f32x4_t*)(wukv + (size_t)k * 1024 + (n - 768)) * kg[k] : (f32x4_t){0.f, 0.f, 0.f, 0.f}; }, lds); }
    }
    { const float* w2 = ARG(5); const float* a2 = ARG(7);
      transpose_w(64, DEPTH * 512, (bf16_t*)(ARG_WS + WS_W2T), [=](int k, int n) -> f32x4_t { return *(const f32x4_t*)(w2 + ((size_t)(n >> 9) * 64 + k) * 512 + (n & 511)); }, lds);
      transpose_w(64, DEPTH * 512, (bf16_t*)(ARG_WS + WS_W2T) + (size_t)DEPTH * 512 * 64, [=](int k, int n) -> f32x4_t { return *(const f32x4_t*)(a2 + ((size_t)(n >> 9) * 64 + k) * 512 + (n & 511)); }, lds); }
    { const float* ga = ARG(15); const float* gx = ARG(17);
      transpose_w(64, DEPTH * 8 * 64, (bf16_t*)(ARG_WS + WS_GAT), [=](int k, int n) -> f32x4_t { return *(const f32x4_t*)(ga + ((size_t)(n >> 6) * 64 + k) * 64 + (n & 63)); }, lds);
      transpose_w(64, DEPTH * 8 * 64, (bf16_t*)(ARG_WS + WS_GAT) + (size_t)DEPTH * 8 * 64 * 64, [=](int k, int n) -> f32x4_t { return *(const f32x4_t*)(gx + ((size_t)(n >> 6) * 64 + k) * 64 + (n & 63)); }, lds); }
    {
        PHASE_IDS();
        const float* x = ARG(0); float* ssqh = (float*)(ARG_WS + WS_SSQH);
        typedef unsigned u32x4 __attribute__((ext_vector_type(4)));
        for (int row = gw; row < MTOK; row += 4 * nwaves) {
            float4 v[4][4];
#pragma unroll
            for (int k = 0; k < 4; ++k) { const size_t rr = (size_t)row + (size_t)k * nwaves;
#pragma unroll
                for (int q = 0; q < 2; ++q) { v[k][2 * q] = *(const float4*)&x[rr * DM + q * 512 + lane * 8]; v[k][2 * q + 1] = *(const float4*)&x[rr * DM + q * 512 + lane * 8 + 4]; } }
#pragma unroll
            for (int k = 0; k < 4; ++k) { const size_t rr = (size_t)row + (size_t)k * nwaves;
                float ss = 0.f;
#pragma unroll
                for (int q = 0; q < 4; ++q) ss += (v[k][q].x * v[k][q].x + v[k][q].y * v[k][q].y) + (v[k][q].z * v[k][q].z + v[k][q].w * v[k][q].w);
                ss = wave_sum(ss);
#pragma unroll
                for (int q = 0; q < 2; ++q) { u32x4 o; o.x = f2bf2(v[k][2 * q].x, v[k][2 * q].y); o.y = f2bf2(v[k][2 * q].z, v[k][2 * q].w); o.z = f2bf2(v[k][2 * q + 1].x, v[k][2 * q + 1].y); o.w = f2bf2(v[k][2 * q + 1].z, v[k][2 * q + 1].w);
                    *(u32x4*)&XN[rr * DM + q * 512 + lane * 8] = o; }
                if (lane < 16) ssqh[rr * 16 + lane] = (lane == 0) ? ss : 0.f;
            }
        }
    }
    PAMP_END(20);
    xcd_barrier(bar);

    for (int l = 0; l < DEPTH; ++l) {
#if PROBE == 10
        for (int rep = 0; rep < 8; ++rep) xcd_barrier(bar);
#endif
#if PROBE == 40
        { const unsigned long long t1_ = __builtin_amdgcn_s_memrealtime(); while (__builtin_amdgcn_s_memrealtime() - t1_ < 20000ull) __builtin_amdgcn_s_sleep(8); __syncthreads(); }
#endif
        PAMP_BEGIN(21);
#if PROBE == 51 || PROBE == 52
        if (l == (PROBE == 51 ? 0 : 3)) { pc0 = __builtin_amdgcn_s_memtime(); pr0 = __builtin_amdgcn_s_memrealtime(); }
#endif
        for (int rep = 0; rep < (PROBE == 9 ? 2 : 1); ++rep) {
            pg8::Gemm g{XN, (const bf16_t*)(ARG_WS + WS_WIN) + (size_t)l * NPAD_IN * DM, MTOK, NPAD_IN, DM, DM, DM, 1 << 30, 0};
            pg8::RowScaleOrder<16> S; S.init(MTOK, NPAD_IN, (int)gridDim.x, (int)blockIdx.x);
            S.part = (const float*)(ARG_WS + WS_SSQH); S.inv_dim = 1.0f / DM; S.tab = (PG8_LAS float*)(smem + 131072);
            pg8::EpiProj E{PROJ, DIN, DIN, (const PG8_LAS float*)(smem + 131072), (float*)(ARG_WS + WS_SQQ), (float*)(ARG_WS + WS_SQKV), (bf16_t*)(ARG_WS + WS_K), rope, (bf16_t*)(ARG_WS + WS_SAVA)};
            pg8::gemm_phase<pg8::EpiProj, pg8::RowScaleOrder<16>, true, true>((PG8_LAS unsigned char*)smem, g, S, E);
        }
#if PROBE == 51 || PROBE == 52
        if (l == (PROBE == 51 ? 0 : 3)) { __syncthreads(); pc1 = __builtin_amdgcn_s_memtime(); pr1 = __builtin_amdgcn_s_memrealtime(); }
#endif
        PAMP_END(21);
        xcd_barrier(bar);
        PAMP_BEGIN(22);
        {
            int kmla = 256; asm volatile("" : "+s"(kmla));
            pg8::Gemm g{PROJ + C_QL, (const bf16_t*)(ARG_WS + WS_WMLA) + (size_t)l * NMLA * 256, MTOK, 768, kmla, DIN, 256, 1 << 30, 0};
            pg8::MlaOrder S; S.init(MTOK, 768, (int)gridDim.x, (int)blockIdx.x);
            S.sqq = (const float*)(ARG_WS + WS_SQQ); S.sqkv = (const float*)(ARG_WS + WS_SQKV); S.tab = (PG8_LAS float*)(smem + 131072 + 2048);
            pg8::EpiMla E{(bf16_t*)(DO_Q), (bf16_t*)(ARG_WS + WS_K), (bf16_t*)(ARG_WS + WS_V), (const PG8_LAS float*)(smem + 131072 + 2048), rope, 0.10206207261596577f * 1.4426950408889634f, 0};
            pg8::gemm_phase<pg8::EpiMla, pg8::MlaOrder, true, true>((PG8_LAS unsigned char*)smem, g, S, E);
        }
        __syncthreads();
        {
            int kmla = 128; asm volatile("" : "+s"(kmla));
            pg8::Gemm g{PROJ + C_KVL, (const bf16_t*)(ARG_WS + WS_WMLA) + ((size_t)l * NMLA + 768) * 256, MTOK, 1024, kmla, DIN, 256, 1 << 30, 0};
            pg8::MlaOrder S; S.init(MTOK, 1024, (int)gridDim.x, (int)blockIdx.x);
            S.sqq = (const float*)(ARG_WS + WS_SQQ); S.sqkv = (const float*)(ARG_WS + WS_SQKV); S.tab = (PG8_LAS float*)(smem + 131072 + 2048);
            pg8::EpiMla E{(bf16_t*)(DO_Q), (bf16_t*)(ARG_WS + WS_K), (bf16_t*)(ARG_WS + WS_V), (const PG8_LAS float*)(smem + 131072 + 2048), rope, 0.10206207261596577f * 1.4426950408889634f, 3};
            pg8::gemm_phase<pg8::EpiMla, pg8::MlaOrder, true, true>((PG8_LAS unsigned char*)smem, g, S, E);
        }
        PAMP_END(22);
#if PROBE == 1 || PROBE == 2
        {
            const bool dry = (xb_ld(ctl + CW_PROBE) == 0u);
            unsigned* qw = ctl + CW_PROBEQ + 64 * l;
            for (;;) {
                __syncthreads();
                if (threadIdx.x == 0) *s_unit = (int)atomicAdd(qw, 1u);
                __syncthreads();
                const int u = *s_unit;
#if PROBE == 1
                if (u >= 4096) break;
                (void)dry; break;
#else
                if (u >= 1024) break;
                break;
#endif
            }
        }
#endif
        PAMP_BEGIN(23);
#if PROBE == 1
        rw::r1_phase(l, (LAS char*)smem, (xb_ld(ctl + CW_PROBE) == 0u));
#endif
        { PAMP_BEGIN(36); rw::r1_phase(l, (LAS char*)smem); PAMP_END(36); }
        { PAMP_BEGIN(37); lru::phase<false>(l, (LAS char*)smem, ctl + CW_LCNT + 64 * l); PAMP_END(37); }
        PAMP_END(23);
        xcd_barrier(bar);
#if PROBE >= 3 && PROBE <= 5
        {
            const bool dry = (xb_ld(ctl + CW_PROBE) == 0u);
            unsigned* qw = ctl + CW_PROBEQ + 64 * l;
            for (;;) {
                __syncthreads();
                if (threadIdx.x == 0) *s_unit = (int)atomicAdd(qw, 1u);
                __syncthreads();
                const int u = *s_unit;
#if PROBE == 3
                if (u >= 64) break;
                rw::r2_unit(l, u >> 3, u & 7, (LAS char*)smem, dry);
#elif PROBE == 4
                if (u >= 1024) break;
                break;
#else
                if (u >= 1024) break;
                att::attn_unit<ATT_THR>((bf16_t*)(DO_Q), (const bf16_t*)(ARG_WS + WS_K), (const bf16_t*)(ARG_WS + WS_V), (u & 63) >> 3, u & 7, 15 - (u >> 6), (LAS char*)smem, dry);
#endif
            }
        }
#endif
        {
            unsigned* qw = ctl + CW_QUEUE + 64 * (2 * l + 1);
            PAMP_BEGIN(24);
            for (;;) {
                __syncthreads();
                if (threadIdx.x == 0) *s_unit = (int)atomicAdd(qw, 1u);
                __syncthreads();
                const int u = *s_unit;
                if (u >= 8 + 64) break;
                if (u < 8) lru::carry_unit(u, ctl + CW_LCNT + 64 * l);
                else { const int a = u - 8; rw::r2_unit(l, a >> 3, a & 7, (LAS char*)smem); }
            }
            PAMP_END(24);
            PAMP_BEGIN(25);
            {
                const int x0 = (int)(xb_xcc_id() & 7u);
                for (int k = 0; k < 8; ++k) {
                    const int x = (x0 + k) & 7;
                    unsigned* qa = ctl + CW_ATTQ + 32 * (l * 8 + x);
                    for (;;) {
                        __syncthreads();
                        if (threadIdx.x == 0) *s_unit = (int)atomicAdd(qa, 1u);
                        __syncthreads();
                        const int u = *s_unit;
                        if (u >= 128) break;
                        const int bh = 8 * x + (u & 7), qb = 15 - (u >> 3);
                        att::attn_unit<ATT_THR>((bf16_t*)(DO_Q), (const bf16_t*)(ARG_WS + WS_K), (const bf16_t*)(ARG_WS + WS_V), bh >> 3, bh & 7, qb, (LAS char*)smem);
                    }
                }
            }
            asm volatile("s_waitcnt vmcnt(0)" ::: "memory");
            __syncthreads();
            if (threadIdx.x == 0) { __builtin_amdgcn_fence(__ATOMIC_RELEASE, "agent"); (void)xb_add(ctl + CW_GATE + 16 * l, 1u); }
            PAMP_END(25);
            PAMP_BEGIN(26);
            lru::phase<true>(l, (LAS char*)smem, ctl + CW_LCNT + 64 * l);
            PAMP_END(26);
            __syncthreads();
            if (threadIdx.x == 0) { XB_SPIN(xb_ld(ctl + CW_GATE + 16 * l) < (unsigned)gridDim.x, ctl); __builtin_amdgcn_fence(__ATOMIC_ACQUIRE, "agent"); }
            __syncthreads();
            for (int j = blockIdx.x; j < 256; j += gridDim.x) gate_half(l, (size_t)j * 128);
        }
        xcd_barrier(bar);
        PAMP_BEGIN(28);
        if (l == DEPTH - 1 && gridDim.x == 256) {
            pg8::Gemm g{PROJ + C_ZA, (const bf16_t*)(ARG_WS + WS_WOUT) + (size_t)l * DM * DMIX, MTOK, DM, DMIX, DIN, DMIX, 1 << 30, 0};
            pg8::StaticOrder S; S.init(MTOK, DM, (int)gridDim.x, (int)blockIdx.x);
            pg8::EpiFinal E{DM, XN, ARG_OUT, ARG(27), (float*)(ARG_WS + WS_XFIN), ctl + CW_FIN, ctl, (PG8_LAS float*)(smem + 131072), (PG8_LAS float*)(smem + 131072 + 4096)};
            pg8::gemm_phase<pg8::EpiFinal, pg8::StaticOrder, true, true>((PG8_LAS unsigned char*)smem, g, S, E);
            PAMP_END(28);
            break;
        }
        for (int rep = 0; rep < (PROBE == 14 ? 2 : 1); ++rep) {
            const bool odry = (PROBE == 14) && (rep == 0) && (xb_ld(ctl + CW_PROBE) == 0u);
            pg8::Gemm g{PROJ + C_ZA, (const bf16_t*)(ARG_WS + WS_WOUT) + (size_t)l * DM * DMIX, MTOK, DM, DMIX, DIN, DMIX, 1 << 30, 0};
            pg8::StaticOrder S; S.init(MTOK, DM, (int)gridDim.x, (int)blockIdx.x);
            pg8::EpiResid E{DM, odry, XN, (float*)(ARG_WS + WS_SSQH)};
            pg8::gemm_phase<pg8::EpiResid, pg8::StaticOrder, true, true>((PG8_LAS unsigned char*)smem, g, S, E);
        }
        PAMP_END(28);
        xcd_barrier(bar);
    }
    if (gridDim.x != 256) {
        const float* g = ARG(27); const float* ssqh = (const float*)(ARG_WS + WS_SSQH);
        PHASE_IDS();
        float* out = ARG_OUT;
        typedef unsigned u32x4 __attribute__((ext_vector_type(4)));
        float4 gv[4];
#pragma unroll
        for (int q = 0; q < 2; ++q) { gv[2 * q] = *(const float4*)&g[q * 512 + lane * 8]; gv[2 * q + 1] = *(const float4*)&g[q * 512 + lane * 8 + 4]; }
        for (int row = gw; row < MTOK; row += 4 * nwaves) {
            float ts[4]; u32x4 v[4][2];
#pragma unroll
            for (int k = 0; k < 4; ++k) { const size_t rr = (size_t)row + (size_t)k * nwaves; ts[k] = (lane < 16) ? ssqh[rr * 16 + lane] : 0.f;
#pragma unroll
                for (int q = 0; q < 2; ++q) v[k][q] = *(const u32x4*)(XN + rr * DM + q * 512 + lane * 8); }
#pragma unroll
            for (int k = 0; k < 4; ++k) {
                const size_t rr = (size_t)row + (size_t)k * nwaves;
                const float rs = rsqrtf(wave_sum(ts[k]) * (1.0f / DM) + 1e-6f);
#pragma unroll
                for (int q = 0; q < 2; ++q) {
                    const float4 g0 = gv[2 * q], g1 = gv[2 * q + 1];
                    float4 o0, o1;
                    o0.x = __uint_as_float(v[k][q].x << 16) * rs * g0.x; o0.y = __uint_as_float(v[k][q].x & 0xffff0000u) * rs * g0.y;
                    o0.z = __uint_as_float(v[k][q].y << 16) * rs * g0.z; o0.w = __uint_as_float(v[k][q].y & 0xffff0000u) * rs * g0.w;
                    o1.x = __uint_as_float(v[k][q].z << 16) * rs * g1.x; o1.y = __uint_as_float(v[k][q].z & 0xffff0000u) * rs * g1.y;
                    o1.z = __uint_as_float(v[k][q].w << 16) * rs * g1.z; o1.w = __uint_as_float(v[k][q].w & 0xffff0000u) * rs * g1.w;
                    *(float4*)&out[rr * DM + q * 512 + lane * 8] = o0;
                    *(float4*)&out[rr * DM + q * 512 + lane * 8 + 4] = o1;
                }
            }
        }
    }
#if PROBE >= 50 && PROBE <= 52
    if (PROBE == 50) { __syncthreads(); pc1 = __builtin_amdgcn_s_memtime(); pr1 = __builtin_amdgcn_s_memrealtime(); }
    if (blockIdx.x == 0) {
        const unsigned long long mhz = (pc1 - pc0) * 100ull / (pr1 - pr0 + 1ull);
        const unsigned long long t1_ = __builtin_amdgcn_s_memrealtime(), d_ = mhz * 25ull;
        while (__builtin_amdgcn_s_memrealtime() - t1_ < d_) __builtin_amdgcn_s_sleep(8);
    }
#endif
}

extern "C" void kernel_launch(void* const* d_in, const int* in_sizes, int n_in, void* d_out, int out_size, void* d_ws, size_t ws_size, hipStream_t stream) {
    (void)in_sizes; (void)n_in; (void)out_size; (void)ws_size;
    constexpr int kDynLds = 163840;
    static int grid = 0;
    if (!grid) {
        int dev = 0, cus = 0;
        hipGetDevice(&dev);
        hipDeviceGetAttribute(&cus, hipDeviceAttributeMultiprocessorCount, dev);
        hipFuncSetAttribute((const void*)fwd_kernel, hipFuncAttributeMaxDynamicSharedMemorySize, kDynLds);
        int per_cu = 0;
        hipOccupancyMaxActiveBlocksPerMultiprocessor(&per_cu, fwd_kernel, 512, kDynLds);
        if (per_cu < 1) fprintf(stderr, "occupancy query says %d\n", per_cu);
        grid = cus > 0 ? cus : 256;
    }
    hipMemsetAsync(d_ws, 0, CTL_BYTES, stream);
    Args a;
    memset(&a, 0, sizeof(a));
    for (int i = 0; i < 28; ++i) a.in[i] = (const float*)d_in[i];
    a.out = (float*)d_out;
    a.ws = (unsigned char*)d_ws;
    hipLaunchKernelGGL(fwd_kernel, dim3(grid), dim3(512), kDynLds, stream, a);
}
```
